# Optimizing an MI355X kernel written in HIP

```python
import math
import jax, jax.numpy as jnp
from jax import lax
import numpy as np

D_MODEL = 1024
BATCH = 4
SEQ = 4096
DEPTH = 2

A_WIDTH = D_MODEL // 2
A_GROUPS = 4
A_GROUP_DIM = A_WIDTH // A_GROUPS
CHUNK = 128
B_WIDTH = D_MODEL // 2
POOL_WINDOWS = (2, 4, 8, 16)
B_GROUP_DIM = B_WIDTH // len(POOL_WINDOWS)
HEAD_DIM = 64
C_HEADS = (3 * D_MODEL) // (8 * HEAD_DIM)
C_WIDTH = C_HEADS * 2 * HEAD_DIM
D_PATTERNS = ((128, 1), (512, 4), (2048, 16))
D_HEADS_PER_GROUP = D_MODEL // (4 * HEAD_DIM)
D_HEADS = D_HEADS_PER_GROUP * len(D_PATTERNS)
D_QKV_WIDTH = D_HEADS * HEAD_DIM
D_OUT_WIDTH = D_HEADS_PER_GROUP * HEAD_DIM
Q_BLOCK = 128
ROPE_THETA = 500000.0
ROPE_DIM = HEAD_DIM // 4
D_FF = 2816
CONV_WIDTH = 3
EPS = 1e-6
MAX_POS_OFFSET = 1024

kernel_name = "hybrid_gmlp_pool_diffattn_dilated_block"


def rms_norm(x, g, eps=EPS):
    xf = x.astype(jnp.float32)
    y = xf * lax.rsqrt(jnp.mean(xf * xf, axis=-1, keepdims=True) + eps)
    return (y * g.astype(jnp.float32)).astype(x.dtype)


def rope_tables(positions):
    inv = ROPE_THETA ** (-jnp.arange(0, ROPE_DIM, 2, dtype=jnp.float32) / ROPE_DIM)
    ang = positions.astype(jnp.float32)[..., None] * inv
    return jnp.cos(ang), jnp.sin(ang)


def apply_partial_rope(x, cos, sin):
    half = ROPE_DIM // 2
    xr = x[..., :ROPE_DIM].astype(jnp.float32)
    x1, x2 = xr[..., :half], xr[..., half:]
    c, s = cos[:, :, None, :], sin[:, :, None, :]
    rot = jnp.concatenate([x1 * c - x2 * s, x2 * c + x1 * s], axis=-1).astype(x.dtype)
    return jnp.concatenate([rot, x[..., ROPE_DIM:]], axis=-1)


def chunked_gmlp(z, v_gain, w_s, b_s):
    Bn, S, _ = z.shape
    u, v = jnp.split(z, 2, axis=-1)
    v = rms_norm(v, v_gain)
    nc = S // CHUNK
    v = v.reshape(Bn, nc, CHUNK, A_GROUPS, A_GROUP_DIM)
    causal = jnp.tril(jnp.ones((CHUNK, CHUNK), dtype=bool))
    w = jnp.where(causal[None], w_s, 0).astype(v.dtype)
    mixed = jnp.einsum('gts,bnsgc->bntgc', w, v) + b_s.T[:, :, None]
    return u * mixed.reshape(Bn, S, A_WIDTH)


def multiscale_pool(xb, pool_w, pool_scale):
    Bn, S, _ = xb.shape
    G = len(POOL_WINDOWS)
    xg = xb.reshape(Bn, S, G, B_GROUP_DIM)
    csum = jnp.pad(jnp.cumsum(xg.astype(jnp.float32), axis=1), ((0, 0), (1, 0), (0, 0), (0, 0)))
    t = jnp.arange(S)
    pooled = []
    for g, w in enumerate(POOL_WINDOWS):
        cg = csum[:, :, g]
        lagged = jnp.pad(cg, ((0, 0), (w - 1, 0), (0, 0)))[:, :S]
        count = jnp.minimum(t + 1, w).astype(jnp.float32)
        pooled.append((cg[:, 1:] - lagged) / count[None, :, None])
    pooled = jnp.stack(pooled, axis=2).astype(xb.dtype) - xg
    y = jnp.einsum('bsgc,gcd->bsgd', pooled, pool_w)
    return y.reshape(Bn, S, B_WIDTH) * pool_scale


def even_mixer(h, w_in, v_gain, w_s, b_s, pool_w, pool_scale, w_out):
    p = h @ w_in
    ya = chunked_gmlp(jax.nn.gelu(p[..., :2 * A_WIDTH]), v_gain, w_s, b_s)
    yb = multiscale_pool(p[..., 2 * A_WIDTH:], pool_w, pool_scale)
    return jnp.concatenate([ya, yb], axis=-1) @ w_out


def diff_attention(q, k, v, cos, sin, lq1, lk1, lq2, lk2, subln_gain, lambda_init):
    Bn, S, _ = q.shape
    f32 = jnp.float32
    q = apply_partial_rope(q.reshape(Bn, S, 2 * C_HEADS, HEAD_DIM), cos, sin)
    k = apply_partial_rope(k.reshape(Bn, S, 2 * C_HEADS, HEAD_DIM), cos, sin)
    v = v.reshape(Bn, S, C_HEADS, 2 * HEAD_DIM)
    lam = (jnp.exp(jnp.sum(lq1.astype(f32) * lk1.astype(f32)))
           - jnp.exp(jnp.sum(lq2.astype(f32) * lk2.astype(f32))) + lambda_init)
    nb = S // Q_BLOCK
    q_blocks = q.reshape(Bn, nb, Q_BLOCK, 2 * C_HEADS, HEAD_DIM).transpose(1, 0, 2, 3, 4)
    k_pos = jnp.arange(S)
    scale = HEAD_DIM ** -0.5

    def attend(args):
        qb, blk = args
        s = jnp.einsum('bqhd,bkhd->bhqk', qb, k).astype(f32) * scale
        q_pos = blk * Q_BLOCK + jnp.arange(Q_BLOCK)
        s = jnp.where(k_pos[None, :] <= q_pos[:, None], s, -jnp.inf)
        p = jax.nn.softmax(s, axis=-1).reshape(Bn, C_HEADS, 2, Q_BLOCK, S)
        a = p[:, :, 0] - lam * p[:, :, 1]
        return jnp.einsum('bhqk,bkhd->bqhd', a.astype(v.dtype), v)

    o = lax.map(attend, (q_blocks, jnp.arange(nb)))
    o = o.transpose(1, 0, 2, 3, 4).reshape(Bn, S, C_HEADS, 2 * HEAD_DIM)
    o = rms_norm(o, subln_gain) * (1.0 - lambda_init)
    return o.reshape(Bn, S, C_WIDTH)


def strided_band_attention(q, k, v, window, dilation):
    Bn, S, H, dh = q.shape
    nk = window // dilation
    L = S // dilation
    nb = -(-L // nk)
    Lp = nb * nk

    def strided(t):
        return t.reshape(Bn, L, dilation, H, dh).transpose(0, 2, 1, 3, 4)

    def banded(t):
        t = jnp.pad(strided(t), ((0, 0), (0, 0), (nk, Lp - L), (0, 0), (0, 0)))
        prev = t[:, :, :Lp].reshape(Bn, dilation, nb, nk, H, dh)
        cur = t[:, :, nk:].reshape(Bn, dilation, nb, nk, H, dh)
        return jnp.concatenate([prev, cur], axis=3)

    qs = jnp.pad(strided(q), ((0, 0), (0, 0), (0, Lp - L), (0, 0), (0, 0))).reshape(Bn, dilation, nb, nk, H, dh)
    kb, vb = banded(k), banded(v)
    a = jnp.arange(nk)[:, None]
    m = jnp.arange(2 * nk)[None, :]
    dist = a + nk - m
    k_pos = (jnp.arange(nb)[:, None, None] - 1) * nk + m[None]
    mask = (dist >= 0) & (dist <= nk) & (k_pos >= 0)
    s = jnp.einsum('brnqhd,brnkhd->brnhqk', qs, kb).astype(jnp.float32) * (HEAD_DIM ** -0.5)
    s = jnp.where(mask[:, None], s, -jnp.inf)
    lse = jax.nn.logsumexp(s, axis=-1)
    p = jnp.exp(s - lse[..., None])
    o = jnp.einsum('brnhqk,brnkhd->brnqhd', p.astype(v.dtype), vb)
    o = o.reshape(Bn, dilation, Lp, H, dh)[:, :, :L].transpose(0, 2, 1, 3, 4).reshape(Bn, S, H, dh)
    lse = lse.transpose(0, 1, 2, 4, 3).reshape(Bn, dilation, Lp, H)[:, :, :L]
    lse = lse.transpose(0, 2, 1, 3).reshape(Bn, S, H)
    return o, lse


def dilated_attention(q, k, v, cos, sin):
    Bn, S, _ = q.shape
    q = apply_partial_rope(q.reshape(Bn, S, D_HEADS, HEAD_DIM), cos, sin)
    k = apply_partial_rope(k.reshape(Bn, S, D_HEADS, HEAD_DIM), cos, sin)
    v = v.reshape(Bn, S, D_HEADS, HEAD_DIM)
    outs, lses = [], []
    for g, (window, dilation) in enumerate(D_PATTERNS):
        hs = slice(g * D_HEADS_PER_GROUP, (g + 1) * D_HEADS_PER_GROUP)
        o, lse = strided_band_attention(q[:, :, hs], k[:, :, hs], v[:, :, hs], window, dilation)
        outs.append(o)
        lses.append(lse)
    wts = jax.nn.softmax(jnp.stack(lses, axis=0), axis=0)
    o = jnp.sum(wts[..., None] * jnp.stack(outs, axis=0).astype(jnp.float32), axis=0)
    return o.astype(q.dtype).reshape(Bn, S, D_OUT_WIDTH)


def odd_mixer(h, cos, sin, w_in, lq1, lk1, lq2, lk2, subln_gain, w_out, layer):
    splits = [int(i) for i in np.cumsum([C_WIDTH, C_WIDTH, C_WIDTH, D_QKV_WIDTH, D_QKV_WIDTH])]
    cq, ck, cv, dq, dk, dv = jnp.split(h @ w_in, splits, axis=-1)
    lambda_init = 0.8 - 0.6 * math.exp(-0.3 * layer)
    yc = diff_attention(cq, ck, cv, cos, sin, lq1, lk1, lq2, lk2, subln_gain, lambda_init)
    yd = dilated_attention(dq, dk, dv, cos, sin)
    return jnp.concatenate([yc, yd], axis=-1) @ w_out


def conv_ffn(h, w_up, conv_w, conv_b, w_down):
    a, g = jnp.split(h @ w_up, 2, axis=-1)
    a = lax.conv_general_dilated(a, conv_w, window_strides=(1,), padding=((CONV_WIDTH - 1, 0),),
                                 dimension_numbers=('NWC', 'WIO', 'NWC'), feature_group_count=D_FF) + conv_b
    return (jax.nn.gelu(a) * g) @ w_down


def setup_inputs(seed: int = 0) -> dict:
    key = jax.random.key(seed)
    keys = iter(jax.random.split(key, 32))
    n_even, n_odd = (DEPTH + 1) // 2, DEPTH // 2
    f32 = jnp.float32

    def normal(shape, scale):
        return jax.random.normal(next(keys), shape, f32) * scale

    def gain(shape):
        return 1.0 + normal(shape, 0.02)

    x = normal((BATCH, SEQ, D_MODEL), 1.0)
    positions = (jnp.arange(SEQ, dtype=jnp.int32)[None, :]
                 + jax.random.randint(next(keys), (BATCH, 1), 0, MAX_POS_OFFSET, dtype=jnp.int32))
    odd_in = 3 * C_WIDTH + 3 * D_QKV_WIDTH
    return {
        'x': x,
        'positions': positions,
        'norm_mix': gain((DEPTH, D_MODEL)),
        'norm_ffn': gain((DEPTH, D_MODEL)),
        'final_norm': gain((D_MODEL,)),
        'even_w_in': normal((n_even, D_MODEL, 2 * A_WIDTH + B_WIDTH), D_MODEL ** -0.5),
        'gmlp_v_gain': gain((n_even, A_WIDTH)),
        'gmlp_w_s': normal((n_even, A_GROUPS, CHUNK, CHUNK), CHUNK ** -0.5),
        'gmlp_b_s': gain((n_even, A_GROUPS, CHUNK)),
        'pool_w': normal((n_even, len(POOL_WINDOWS), B_GROUP_DIM, B_GROUP_DIM), B_GROUP_DIM ** -0.5),
        'pool_scale': gain((n_even, B_WIDTH)),
        'even_w_out': normal((n_even, A_WIDTH + B_WIDTH, D_MODEL), (A_WIDTH + B_WIDTH) ** -0.5),
        'odd_w_in': normal((n_odd, D_MODEL, odd_in), D_MODEL ** -0.5),
        'lambda_q1': normal((n_odd, HEAD_DIM), 0.1),
        'lambda_k1': normal((n_odd, HEAD_DIM), 0.1),
        'lambda_q2': normal((n_odd, HEAD_DIM), 0.1),
        'lambda_k2': normal((n_odd, HEAD_DIM), 0.1),
        'subln_gain': gain((n_odd, 2 * HEAD_DIM)),
        'odd_w_out': normal((n_odd, C_WIDTH + D_OUT_WIDTH, D_MODEL), (C_WIDTH + D_OUT_WIDTH) ** -0.5),
        'ffn_w_up': normal((DEPTH, D_MODEL, 2 * D_FF), D_MODEL ** -0.5),
        'ffn_conv_w': normal((DEPTH, CONV_WIDTH, 1, D_FF), CONV_WIDTH ** -0.5),
        'ffn_conv_b': normal((DEPTH, D_FF), 0.02),
        'ffn_w_down': normal((DEPTH, D_FF, D_MODEL), D_FF ** -0.5),
    }


def reference(x, positions, norm_mix, norm_ffn, final_norm, even_w_in, gmlp_v_gain, gmlp_w_s, gmlp_b_s,
              pool_w, pool_scale, even_w_out, odd_w_in, lambda_q1, lambda_k1, lambda_q2, lambda_k2,
              subln_gain, odd_w_out, ffn_w_up, ffn_conv_w, ffn_conv_b, ffn_w_down):
    cos, sin = rope_tables(positions)
    h = x
    for layer in range(DEPTH):
        i = layer // 2
        hn = rms_norm(h, norm_mix[layer])
        if layer % 2 == 0:
            mix = even_mixer(hn, even_w_in[i], gmlp_v_gain[i], gmlp_w_s[i], gmlp_b_s[i],
                             pool_w[i], pool_scale[i], even_w_out[i])
        else:
            mix = odd_mixer(hn, cos, sin, odd_w_in[i], lambda_q1[i], lambda_k1[i], lambda_q2[i],
                            lambda_k2[i], subln_gain[i], odd_w_out[i], layer)
        h = h + mix
        h = h + conv_ffn(rms_norm(h, norm_ffn[layer]), ffn_w_up[layer], ffn_conv_w[layer],
                         ffn_conv_b[layer], ffn_w_down[layer])
    return rms_norm(h, final_norm)
```

```cpp
#include <hip/hip_runtime.h>
#include <cstdint>
#include <cstdio>

typedef unsigned short bf16_t;
typedef short bf16x8 __attribute__((ext_vector_type(8)));
typedef float f32x4 __attribute__((ext_vector_type(4)));
typedef unsigned u32x4 __attribute__((ext_vector_type(4)));

constexpr int BATCH = 4, SEQ = 4096, DM = 1024, M = BATCH * SEQ;
constexpr int DFF = 2816, NUP = 2 * DFF;
constexpr int N_IN0 = 1536, N_QKV = 4608;
constexpr float EPS = 1e-6f;
constexpr float LAMBDA_INIT = 0.35550906759f;

__device__ __forceinline__ float bf2f(bf16_t v) { return __uint_as_float(((unsigned)v) << 16); }
__device__ __forceinline__ bf16_t f2bf(float f) { unsigned u = __float_as_uint(f); return (bf16_t)((u + 0x7fffu + ((u >> 16) & 1u)) >> 16); }
__device__ __forceinline__ float gelu_tanh(float x) {
    const float y = 0.7978845608028654f * (x + 0.044715f * x * x * x);
    return x / (1.0f + __expf(-2.0f * y));
}
__device__ __forceinline__ float wave_sum(float v) {
#pragma unroll
    for (int o = 1; o < 64; o <<= 1) v += __shfl_xor(v, o);
    return v;
}

constexpr size_t MiB = 1u << 20;
constexpr size_t WS_W_IN0 = 1 * MiB;
constexpr size_t WS_W_OUT0 = 4 * MiB;
constexpr size_t WS_W_QKV = 6 * MiB;
constexpr size_t WS_W_OUT1 = 15 * MiB;
constexpr size_t WS_W_UP = 17 * MiB;
constexpr size_t WS_W_DN = 39 * MiB;
constexpr size_t WS_ROPE = 50 * MiB;
constexpr size_t WS_XN = 52 * MiB;
constexpr size_t WS_BUF = 84 * MiB;
constexpr size_t WS_P = WS_BUF, WS_Y = 132 * MiB;
constexpr size_t WS_AG = WS_BUF, WS_HMID = 128 * MiB;
constexpr size_t WS_QKV = WS_BUF;

__global__ void k_transpose(const float* __restrict__ W, int K, int N, bf16_t* __restrict__ WT, int mode) {
    __shared__ float t[32][33];
    const int tx = threadIdx.x & 31, ty = threadIdx.x >> 5;
    const int n0 = blockIdx.x * 32, k0 = blockIdx.y * 32;
#pragma unroll
    for (int i = 0; i < 4; ++i) t[ty + 8 * i][tx] = W[(size_t)(k0 + ty + 8 * i) * N + n0 + tx];
    __syncthreads();
#pragma unroll
    for (int i = 0; i < 4; ++i) {
        const int n = n0 + ty + 8 * i;
        int nd = n;
        if (mode == 1) { if (n < DFF) nd = 256 * (n / 128) + (n % 128); else { const int q = n - DFF; nd = 256 * (q / 128) + 128 + (q % 128); } }
        WT[(size_t)nd * K + k0 + tx] = f2bf(t[tx][ty + 8 * i]);
    }
}
__global__ void k_rope_table(const int* __restrict__ pos, float* __restrict__ tab) {
    const int idx = blockIdx.x * blockDim.x + threadIdx.x;
    if (idx >= M * 8) return;
    const int row = idx >> 3, i = idx & 7;
    const double inv = exp2(-(double)(2 * i) / 16.0 * 18.931568569324174);
    const float ang = (float)pos[row] * (float)inv;
    const double rev = (double)ang * 0.15915494309189535;
    const double fr = rev - floor(rev);
    const float a = (float)(fr * 6.283185307179586);
    tab[row * 16 + i] = cosf(a);
    tab[row * 16 + 8 + i] = sinf(a);
}
__global__ void k_rmsnorm_bf16(const float* __restrict__ x, const float* __restrict__ g, bf16_t* __restrict__ out) {
    const int row = blockIdx.x * 4 + (threadIdx.x >> 6), lane = threadIdx.x & 63;
    const f32x4* xr = (const f32x4*)(x + (size_t)row * DM) + lane;
    f32x4 v[4]; float s = 0.f;
#pragma unroll
    for (int j = 0; j < 4; ++j) { v[j] = xr[64 * j]; s += v[j].x * v[j].x + v[j].y * v[j].y + v[j].z * v[j].z + v[j].w * v[j].w; }
    const float r = rsqrtf(wave_sum(s) * (1.f / DM) + EPS);
#pragma unroll
    for (int j = 0; j < 4; ++j) {
        const f32x4 gg = *((const f32x4*)g + lane + 64 * j);
        bf16_t* o = out + (size_t)row * DM + (lane + 64 * j) * 4;
        o[0] = f2bf(v[j].x * r * gg.x); o[1] = f2bf(v[j].y * r * gg.y); o[2] = f2bf(v[j].z * r * gg.z); o[3] = f2bf(v[j].w * r * gg.w);
    }
}
__global__ void k_rmsnorm_f32_inplace(float* __restrict__ x, const float* __restrict__ g) {
    const int row = blockIdx.x * 4 + (threadIdx.x >> 6), lane = threadIdx.x & 63;
    f32x4* xr = (f32x4*)(x + (size_t)row * DM) + lane;
    f32x4 v[4]; float s = 0.f;
#pragma unroll
    for (int j = 0; j < 4; ++j) { v[j] = xr[64 * j]; s += v[j].x * v[j].x + v[j].y * v[j].y + v[j].z * v[j].z + v[j].w * v[j].w; }
    const float r = rsqrtf(wave_sum(s) * (1.f / DM) + EPS);
#pragma unroll
    for (int j = 0; j < 4; ++j) { const f32x4 gg = *((const f32x4*)g + lane + 64 * j); xr[64 * j] = v[j] * r * gg; }
}

struct Epi {
    int mode;
    bf16_t* obf; int ldo; int gelu_cols; const float* base; float* outf;
};
__global__ __launch_bounds__(256) void k_gemm(const bf16_t* __restrict__ A, const bf16_t* __restrict__ Bt, int K, Epi e) {
    const int wid = threadIdx.x >> 6, lane = threadIdx.x & 63, fr = lane & 15, fq = lane >> 4;
    const int row0 = blockIdx.y * 128 + (wid >> 1) * 64, col0 = blockIdx.x * 128 + (wid & 1) * 64;
    f32x4 acc[4][4];
#pragma unroll
    for (int m = 0; m < 4; ++m)
#pragma unroll
        for (int n = 0; n < 4; ++n) acc[m][n] = (f32x4){0.f, 0.f, 0.f, 0.f};
    const bf16_t* ap = A + (size_t)(row0 + fr) * K + fq * 8;
    const bf16_t* bp = Bt + (size_t)(col0 + fr) * K + fq * 8;
    for (int k0 = 0; k0 < K; k0 += 32) {
        bf16x8 a[4], b[4];
#pragma unroll
        for (int m = 0; m < 4; ++m) a[m] = *(const bf16x8*)(ap + (size_t)(m * 16) * K + k0);
#pragma unroll
        for (int n = 0; n < 4; ++n) b[n] = *(const bf16x8*)(bp + (size_t)(n * 16) * K + k0);
#pragma unroll
        for (int m = 0; m < 4; ++m)
#pragma unroll
            for (int n = 0; n < 4; ++n) acc[m][n] = __builtin_amdgcn_mfma_f32_16x16x32_bf16(b[n], a[m], acc[m][n], 0, 0, 0);
    }
#pragma unroll
    for (int m = 0; m < 4; ++m)
#pragma unroll
        for (int n = 0; n < 4; ++n) {
            const int row = row0 + 16 * m + fr, col = col0 + 16 * n + 4 * fq;
            f32x4 v = acc[m][n];
            if (e.mode == 0) {
                if (col < e.gelu_cols) { v.x = gelu_tanh(v.x); v.y = gelu_tanh(v.y); v.z = gelu_tanh(v.z); v.w = gelu_tanh(v.w); }
                bf16_t* o = e.obf + (size_t)row * e.ldo + col;
                o[0] = f2bf(v.x); o[1] = f2bf(v.y); o[2] = f2bf(v.z); o[3] = f2bf(v.w);
            } else {
                const size_t off = (size_t)row * e.ldo + col;
                const f32x4 b = *(const f32x4*)(e.base + off);
                *(f32x4*)(e.outf + off) = b + v;
            }
        }
}

__global__ __launch_bounds__(256) void k_mixA(const bf16_t* __restrict__ P, const float* __restrict__ v_gain, const float* __restrict__ w_s,
                                               const float* __restrict__ b_s, bf16_t* __restrict__ Y) {
    __shared__ float vn[128][64];
    __shared__ float rs[128];
    const int chunk = blockIdx.x >> 3, g = (blockIdx.x >> 1) & 3, half = blockIdx.x & 1;
    const int row0 = chunk * 128, tid = threadIdx.x, wid = tid >> 6, lane = tid & 63;
    for (int i = 0; i < 32; ++i) {
        const int s = wid * 32 + i;
        const bf16x8 x = *(const bf16x8*)(P + (size_t)(row0 + s) * N_IN0 + 512 + lane * 8);
        float q = 0.f;
#pragma unroll
        for (int j = 0; j < 8; ++j) { const float f = bf2f((bf16_t)x[j]); q += f * f; }
        q = wave_sum(q);
        if (lane == 0) rs[s] = rsqrtf(q * (1.f / 512.f) + EPS);
    }
    __syncthreads();
    const int cbase = g * 128 + half * 64;
    for (int e = tid; e < 128 * 64; e += 256) {
        const int s = e >> 6, c = e & 63;
        vn[s][c] = bf2f(P[(size_t)(row0 + s) * N_IN0 + 512 + cbase + c]) * rs[s] * v_gain[cbase + c];
    }
    __syncthreads();
    const int c = lane;
    for (int i = 0; i < 32; ++i) {
        const int t = wid + 4 * i;
        const float* wr = w_s + ((size_t)g * 128 + t) * 128;
        float acc = 0.f;
        for (int s = 0; s <= t; ++s) acc += wr[s] * vn[s][c];
        const float mixed = acc + b_s[g * 128 + t];
        const float u = bf2f(P[(size_t)(row0 + t) * N_IN0 + cbase + c]);
        Y[(size_t)(row0 + t) * DM + cbase + c] = f2bf(u * mixed);
    }
}
__global__ __launch_bounds__(256) void k_mixB(const bf16_t* __restrict__ P, const float* __restrict__ pool_w, const float* __restrict__ pool_scale, bf16_t* __restrict__ Y) {
    __shared__ float pl[64][128];
    const int rb = blockIdx.x >> 2, g = blockIdx.x & 3, row0 = rb * 64, tid = threadIdx.x;
    const int w = 2 << g;
    for (int e = tid; e < 64 * 128; e += 256) {
        const int tt = e >> 7, c = e & 127, row = row0 + tt, t = row & (SEQ - 1);
        const int cnt = (t + 1 < w) ? (t + 1) : w;
        float s = 0.f;
        for (int j = 0; j < cnt; ++j) s += bf2f(P[(size_t)(row - j) * N_IN0 + 1024 + g * 128 + c]);
        pl[tt][c] = s / (float)cnt - bf2f(P[(size_t)row * N_IN0 + 1024 + g * 128 + c]);
    }
    __syncthreads();
    const int d = tid & 127, tg = tid >> 7;
    const float* pw = pool_w + (size_t)g * 128 * 128 + d;
    const float sc = pool_scale[g * 128 + d];
    for (int i = 0; i < 32; ++i) {
        const int tt = tg + 2 * i;
        float acc = 0.f;
        for (int c = 0; c < 128; ++c) acc += pl[tt][c] * pw[(size_t)c * 128];
        Y[(size_t)(row0 + tt) * DM + 512 + g * 128 + d] = f2bf(acc * sc);
    }
}

__global__ void k_convgate(const bf16_t* __restrict__ AG, const float* __restrict__ cw, const float* __restrict__ cb, bf16_t* __restrict__ hm) {
    const int idx = blockIdx.x * blockDim.x + threadIdx.x;
    if (idx >= SEQ * DFF) return;
    const int t = idx / DFF, c = idx % DFF;
    const int ca = 256 * (c / 128) + (c % 128), cg = ca + 128;
    float a = cw[2 * DFF + c] * bf2f(AG[(size_t)t * NUP + ca]) + cb[c];
    if (t >= 1) a += cw[1 * DFF + c] * bf2f(AG[(size_t)(t - 1) * NUP + ca]);
    if (t >= 2) a += cw[0 * DFF + c] * bf2f(AG[(size_t)(t - 2) * NUP + ca]);
    hm[(size_t)t * DFF + c] = f2bf(gelu_tanh(a) * bf2f(AG[(size_t)t * NUP + cg]));
}

__global__ void k_rope(bf16_t* __restrict__ QKV, const float* __restrict__ tab) {
    const int idx = blockIdx.x * blockDim.x + threadIdx.x;
    if (idx >= M * 48 * 8) return;
    const int i = idx & 7, hs = (idx >> 3) % 48, row = idx / (48 * 8);
    const int col = (hs < 24 ? hs * 64 : 2304 + (hs - 24) * 64);
    bf16_t* p = QKV + (size_t)row * N_QKV + col;
    const float c = tab[row * 16 + i], s = tab[row * 16 + 8 + i];
    const float x1 = bf2f(p[i]), x2 = bf2f(p[8 + i]);
    p[i] = f2bf(x1 * c - x2 * s);
    p[8 + i] = f2bf(x2 * c + x1 * s);
}

__global__ __launch_bounds__(64) void k_diffattn(const bf16_t* __restrict__ QKV, const float* __restrict__ lq1, const float* __restrict__ lk1,
                                                  const float* __restrict__ lq2, const float* __restrict__ lk2, const float* __restrict__ subln, bf16_t* __restrict__ Y1) {
    __shared__ float Ks[64][64];
    __shared__ float Vs[64][64];
    __shared__ float Res[64][65];
    const int qt = blockIdx.x, h = blockIdx.y, b = blockIdx.z, lane = threadIdx.x;
    const int t = qt * 64 + lane; const size_t row = (size_t)b * SEQ + t;
    const float lam = __expf(wave_sum(lq1[lane] * lk1[lane])) - __expf(wave_sum(lq2[lane] * lk2[lane])) + LAMBDA_INIT;
    float res[64];
    for (int half = 0; half < 2; ++half) {
#pragma unroll
        for (int d = 0; d < 64; ++d) res[d] = 0.f;
        for (int s = 0; s < 2; ++s) {
            const int j = 2 * h + s;
            float q[64], o[64];
#pragma unroll
            for (int d8 = 0; d8 < 8; ++d8) {
                const bf16x8 x = *(const bf16x8*)(QKV + row * N_QKV + j * 64 + d8 * 8);
#pragma unroll
                for (int jj = 0; jj < 8; ++jj) q[d8 * 8 + jj] = bf2f((bf16_t)x[jj]) * 0.125f;
            }
#pragma unroll
            for (int d = 0; d < 64; ++d) o[d] = 0.f;
            float mx = -1e30f, l = 0.f;
            for (int kt = 0; kt <= qt; ++kt) {
                __syncthreads();
#pragma unroll
                for (int r = 0; r < 8; ++r) {
                    const int idx = lane + 64 * r, kk = idx >> 3, ch = idx & 7;
                    const size_t krow = (size_t)b * SEQ + kt * 64 + kk;
                    const bf16x8 kx = *(const bf16x8*)(QKV + krow * N_QKV + 768 + j * 64 + ch * 8);
                    const bf16x8 vx = *(const bf16x8*)(QKV + krow * N_QKV + 1536 + h * 128 + half * 64 + ch * 8);
#pragma unroll
                    for (int jj = 0; jj < 8; ++jj) { Ks[kk][ch * 8 + jj] = bf2f((bf16_t)kx[jj]); Vs[kk][ch * 8 + jj] = bf2f((bf16_t)vx[jj]); }
                }
                __syncthreads();
                for (int kk = 0; kk < 64; ++kk) {
                    float sc = 0.f;
#pragma unroll
                    for (int d = 0; d < 64; ++d) sc += q[d] * Ks[kk][d];
                    const bool ok = (kt < qt) || (kk <= lane);
                    if (ok) {
                        if (sc > mx) {
                            const float al = __expf(mx - sc);
                            l *= al;
#pragma unroll
                            for (int d = 0; d < 64; ++d) o[d] *= al;
                            mx = sc;
                        }
                        const float p = __expf(sc - mx);
                        l += p;
#pragma unroll
                        for (int d = 0; d < 64; ++d) o[d] += p * Vs[kk][d];
                    }
                }
            }
            const float f = (s == 0 ? 1.f : -lam) / l;
#pragma unroll
            for (int d = 0; d < 64; ++d) res[d] += f * o[d];
        }
        if (half == 0) {
#pragma unroll
            for (int d = 0; d < 64; ++d) Res[lane][d] = res[d];
        }
    }
    float ss = 0.f;
#pragma unroll
    for (int d = 0; d < 64; ++d) { const float a = Res[lane][d]; ss += a * a + res[d] * res[d]; }
    const float r = rsqrtf(ss * (1.f / 128.f) + EPS) * (1.f - LAMBDA_INIT);
    bf16_t* o = Y1 + row * DM + h * 128;
#pragma unroll
    for (int d = 0; d < 64; ++d) { o[d] = f2bf(Res[lane][d] * r * subln[d]); o[64 + d] = f2bf(res[d] * r * subln[64 + d]); }
}

__global__ __launch_bounds__(64) void k_dilattn(const bf16_t* __restrict__ QKV, bf16_t* __restrict__ Y1) {
    const int idx = blockIdx.x * 64 + threadIdx.x;
    const int hh = idx & 3; const int rowi = idx >> 2; const int t = rowi & (SEQ - 1); const size_t row = rowi;
    float o[64];
#pragma unroll
    for (int d = 0; d < 64; ++d) o[d] = 0.f;
    float mx = -1e30f, l = 0.f;
    for (int g = 0; g < 3; ++g) {
        const int dil = (g == 0) ? 1 : (g == 1 ? 4 : 16);
        const int head = g * 4 + hh;
        float q[64];
#pragma unroll
        for (int d8 = 0; d8 < 8; ++d8) {
            const bf16x8 x = *(const bf16x8*)(QKV + row * N_QKV + 2304 + head * 64 + d8 * 8);
#pragma unroll
            for (int jj = 0; jj < 8; ++jj) q[d8 * 8 + jj] = bf2f((bf16_t)x[jj]) * 0.125f;
        }
        for (int j = 0; j <= 128; ++j) {
            const int tk = t - j * dil;
            if (tk < 0) break;
            const size_t krow = row - (size_t)(j * dil);
            float sc = 0.f;
#pragma unroll
            for (int d8 = 0; d8 < 8; ++d8) {
                const bf16x8 kx = *(const bf16x8*)(QKV + krow * N_QKV + 3072 + head * 64 + d8 * 8);
#pragma unroll
                for (int jj = 0; jj < 8; ++jj) sc += q[d8 * 8 + jj] * bf2f((bf16_t)kx[jj]);
            }
            if (sc > mx) {
                const float al = __expf(mx - sc);
                l *= al;
#pragma unroll
                for (int d = 0; d < 64; ++d) o[d] *= al;
                mx = sc;
            }
            const float p = __expf(sc - mx);
            l += p;
#pragma unroll
            for (int d8 = 0; d8 < 8; ++d8) {
                const bf16x8 vx = *(const bf16x8*)(QKV + krow * N_QKV + 3840 + head * 64 + d8 * 8);
#pragma unroll
                for (int jj = 0; jj < 8; ++jj) o[d8 * 8 + jj] += p * bf2f((bf16_t)vx[jj]);
            }
        }
    }
    const float il = 1.f / l;
    bf16_t* op = Y1 + row * DM + 768 + hh * 64;
#pragma unroll
    for (int d = 0; d < 64; ++d) op[d] = f2bf(o[d] * il);
}

static void gemm(hipStream_t st, const bf16_t* A, const bf16_t* Bt, int Mr, int N, int K, Epi e) {
    hipLaunchKernelGGL(k_gemm, dim3(N / 128, Mr / 128), dim3(256), 0, st, A, Bt, K, e);
}
static void transpose(hipStream_t st, const float* W, int K, int N, bf16_t* WT, int mode) {
    hipLaunchKernelGGL(k_transpose, dim3(N / 32, K / 32), dim3(256), 0, st, W, K, N, WT, mode);
}

extern "C" void kernel_launch(void* const* d_in, const int* in_sizes, int n_in, void* d_out, int out_size, void* d_ws, size_t ws_size, hipStream_t stream) {
    const float* x = (const float*)d_in[0]; const int* pos = (const int*)d_in[1];
    const float* norm_mix = (const float*)d_in[2]; const float* norm_ffn = (const float*)d_in[3]; const float* final_norm = (const float*)d_in[4];
    const float* even_w_in = (const float*)d_in[5]; const float* v_gain = (const float*)d_in[6]; const float* w_s = (const float*)d_in[7];
    const float* b_s = (const float*)d_in[8]; const float* pool_w = (const float*)d_in[9]; const float* pool_scale = (const float*)d_in[10];
    const float* even_w_out = (const float*)d_in[11]; const float* odd_w_in = (const float*)d_in[12];
    const float* lq1 = (const float*)d_in[13]; const float* lk1 = (const float*)d_in[14]; const float* lq2 = (const float*)d_in[15]; const float* lk2 = (const float*)d_in[16];
    const float* subln = (const float*)d_in[17]; const float* odd_w_out = (const float*)d_in[18];
    const float* w_up = (const float*)d_in[19]; const float* conv_w = (const float*)d_in[20]; const float* conv_b = (const float*)d_in[21]; const float* w_down = (const float*)d_in[22];
    float* out = (float*)d_out; unsigned char* ws = (unsigned char*)d_ws;
    bf16_t* Win0 = (bf16_t*)(ws + WS_W_IN0); bf16_t* Wout0 = (bf16_t*)(ws + WS_W_OUT0); bf16_t* Wqkv = (bf16_t*)(ws + WS_W_QKV); bf16_t* Wout1 = (bf16_t*)(ws + WS_W_OUT1);
    bf16_t* Wup = (bf16_t*)(ws + WS_W_UP); bf16_t* Wdn = (bf16_t*)(ws + WS_W_DN);
    float* rope = (float*)(ws + WS_ROPE); bf16_t* XN = (bf16_t*)(ws + WS_XN);
    bf16_t* P = (bf16_t*)(ws + WS_P); bf16_t* Y = (bf16_t*)(ws + WS_Y); bf16_t* AG = (bf16_t*)(ws + WS_AG); bf16_t* HM = (bf16_t*)(ws + WS_HMID); bf16_t* QKV = (bf16_t*)(ws + WS_QKV);
    hipStream_t st = stream;
    transpose(st, even_w_in, DM, N_IN0, Win0, 0);
    transpose(st, even_w_out, DM, DM, Wout0, 0);
    transpose(st, odd_w_in, DM, N_QKV, Wqkv, 0);
    transpose(st, odd_w_out, DM, DM, Wout1, 0);
    for (int l = 0; l < 2; ++l) {
        transpose(st, w_up + (size_t)l * DM * NUP, DM, NUP, Wup + (size_t)l * NUP * DM, 1);
        transpose(st, w_down + (size_t)l * DFF * DM, DFF, DM, Wdn + (size_t)l * DM * DFF, 0);
    }
    hipLaunchKernelGGL(k_rope_table, dim3(M * 8 / 256), dim3(256), 0, st, pos, rope);
    for (int layer = 0; layer < 2; ++layer) {
        const float* hin = (layer == 0) ? x : out;
        hipLaunchKernelGGL(k_rmsnorm_bf16, dim3(M / 4), dim3(256), 0, st, hin, norm_mix + layer * DM, XN);
        if (layer == 0) {
            gemm(st, XN, Win0, M, N_IN0, DM, Epi{0, P, N_IN0, 1024, nullptr, nullptr});
            hipLaunchKernelGGL(k_mixA, dim3(128 * 8), dim3(256), 0, st, P, v_gain, w_s, b_s, Y);
            hipLaunchKernelGGL(k_mixB, dim3((M / 64) * 4), dim3(256), 0, st, P, pool_w, pool_scale, Y);
            gemm(st, Y, Wout0, M, DM, DM, Epi{1, nullptr, DM, 0, x, out});
        } else {
            gemm(st, XN, Wqkv, M, N_QKV, DM, Epi{0, QKV, N_QKV, 0, nullptr, nullptr});
            hipLaunchKernelGGL(k_rope, dim3(M * 48 * 8 / 256), dim3(256), 0, st, QKV, rope);
            bf16_t* Y1 = XN;
            hipLaunchKernelGGL(k_diffattn, dim3(SEQ / 64, 6, BATCH), dim3(64), 0, st, QKV, lq1, lk1, lq2, lk2, subln, Y1);
            hipLaunchKernelGGL(k_dilattn, dim3(M * 4 / 64), dim3(64), 0, st, QKV, Y1);
            gemm(st, Y1, Wout1, M, DM, DM, Epi{1, nullptr, DM, 0, out, out});
        }
        hipLaunchKernelGGL(k_rmsnorm_bf16, dim3(M / 4), dim3(256), 0, st, out, norm_ffn + layer * DM, XN);
        for (int c = 0; c < BATCH; ++c) {
            gemm(st, XN + (size_t)c * SEQ * DM, Wup + (size_t)layer * NUP * DM, SEQ, NUP, DM, Epi{0, AG, NUP, 0, nullptr, nullptr});
            hipLaunchKernelGGL(k_convgate, dim3(SEQ * DFF / 256), dim3(256), 0, st, AG, conv_w + (size_t)layer * 3 * DFF, conv_b + (size_t)layer * DFF, HM + (size_t)c * SEQ * DFF);
        }
        gemm(st, HM, Wdn + (size_t)layer * DM * DFF, M, DM, DFF, Epi{1, nullptr, DM, 0, out, out});
    }
    hipLaunchKernelGGL(k_rmsnorm_f32_inplace, dim3(M / 4), dim3(256), 0, st, out, final_norm);
}
```

```cpp
#include <hip/hip_runtime.h>
#include <cstdint>
#include <cstdio>

typedef unsigned short bf16_t;
typedef short bf16x8 __attribute__((ext_vector_type(8)));
typedef float f32x4 __attribute__((ext_vector_type(4)));
typedef float f32x2 __attribute__((ext_vector_type(2)));
typedef unsigned u32x4 __attribute__((ext_vector_type(4)));
typedef unsigned u32x2 __attribute__((ext_vector_type(2)));

constexpr int BATCH = 4, SEQ = 4096, DM = 1024, M = BATCH * SEQ;
constexpr int DFF = 2816, NUP = 2 * DFF;
constexpr int N_IN0 = 1536, N_QKV = 4608;
constexpr float EPS = 1e-6f;
constexpr float LAMBDA_INIT = 0.35550906759f;

__device__ __forceinline__ float bf2f(bf16_t v) { return __uint_as_float(((unsigned)v) << 16); }
__device__ __forceinline__ bf16_t f2bf(float f) { unsigned u = __float_as_uint(f); return (bf16_t)((u + 0x7fffu + ((u >> 16) & 1u)) >> 16); }
__device__ __forceinline__ unsigned pk2bf(float lo, float hi) { return (unsigned)f2bf(lo) | ((unsigned)f2bf(hi) << 16); }
__device__ __forceinline__ float gelu_tanh(float x) {
    const float y = x * (0.7978845608028654f + 0.035677408136300125f * x * x);
    return x * __builtin_amdgcn_rcpf(1.0f + __builtin_amdgcn_exp2f(-2.8853900817779268f * y));
}
template <int CTRL> __device__ __forceinline__ float dpp_f(float v) { return __int_as_float(__builtin_amdgcn_update_dpp(0, __float_as_int(v), CTRL, 0xf, 0xf, true)); }
__device__ __forceinline__ float swz_xor16(float v) { return __int_as_float(__builtin_amdgcn_ds_swizzle(__float_as_int(v), 0x401F)); }
__device__ __forceinline__ float wave_sum(float v) {
    v += dpp_f<0xB1>(v);
    v += dpp_f<0x4E>(v);
    v += dpp_f<0x141>(v);
    v += dpp_f<0x140>(v);
    v += swz_xor16(v);
    const auto rr = __builtin_amdgcn_permlane32_swap(__float_as_uint(v), __float_as_uint(v), false, false);
    return __uint_as_float(rr[0]) + __uint_as_float(rr[1]);
}

constexpr size_t MiB = 1u << 20;
constexpr size_t WS_CTL = 0, CTL_ZERO_BYTES = 1 * MiB;
constexpr size_t WS_W_IN0 = 1 * MiB;
constexpr size_t WS_W_OUT0 = 4 * MiB;
constexpr size_t WS_W_QKV = 6 * MiB;
constexpr size_t WS_W_OUT1 = 15 * MiB;
constexpr size_t WS_W_UP = 17 * MiB;
constexpr size_t WS_W_DN = 39 * MiB;
constexpr size_t WS_ROPE = 50 * MiB;
constexpr size_t WS_WSB = 51 * MiB;
constexpr size_t WS_PWT = 51 * MiB + 256 * 1024;
constexpr size_t WS_XN = 52 * MiB;
constexpr size_t WS_BUF = 84 * MiB;
constexpr size_t WS_P = WS_BUF, WS_Y = 132 * MiB;
constexpr size_t WS_HMID = WS_BUF;
constexpr size_t WS_HALO = 172 * MiB, WS_TOPS = 174 * MiB, WS_TOPG = 176 * MiB;
constexpr size_t WS_QKV = WS_BUF;
constexpr size_t WS_OCA = 228 * MiB;
constexpr size_t WS_RSQ = 253 * MiB;
constexpr size_t WS_LSE = 252 * MiB;
namespace pg8 {
#define PG8_LAS __attribute__((address_space(3)))
typedef unsigned short bf16_t;
typedef short bf16x8 __attribute__((ext_vector_type(8)));
typedef float f32x4 __attribute__((ext_vector_type(4)));
typedef unsigned u32x4 __attribute__((ext_vector_type(4)));
constexpr int BM = 256, BK = 64, HALF = 128, HTB = HALF * BK * 2  , STAGE_BYTES = 8 * HTB, NXCD = 8, WGM = 8;

__host__ __device__ __forceinline__ int lds_byte(int r, int c) { const int st = (r >> 4) * 2 + (c >> 5), rr = r & 15, cc = c & 31, ob = rr * 64 + cc * 2; return st * 1024 + (ob ^ (((ob >> 9) & 1) << 5)); }
__host__ __device__ __forceinline__ void stage_rc(int b, int& R, int& C) { const int st = b / 1024, sb = b % 1024, swz = sb ^ (((sb >> 9) & 1) << 5); R = (st >> 1) * 16 + swz / 64; C = (st & 1) * 32 + (swz % 64) / 2; }
__host__ __device__ __forceinline__ int perm32(int rho) { const int n = rho >> 4, i = rho & 15; return 8 * (i >> 2) + 4 * n + (i & 3); }

struct Unit { int pm, pn; };
struct Gemm { const bf16_t* A; const bf16_t* Bt; int M, N, K; };

struct StaticOrder {
    int nM, nN, nwg, G, c;
    __host__ __device__ void init(int M, int N, int G_, int c_) { nM = M / BM; nN = N / BM; nwg = nM * nN; G = G_; c = c_; }
    __host__ __device__ bool next(int i, Unit& u) const {
        const long L = (long)i * G + c; if (L >= nwg) return false;
        int wgid = (int)L; { const int q = nwg / NXCD, r = nwg % NXCD, xcd = wgid % NXCD, off = wgid / NXCD; wgid = (xcd < r ? xcd * (q + 1) : r * (q + 1) + (xcd - r) * q) + off; }
        const int nig = WGM * nN, gid = wgid / nig, fm = gid * WGM, gsz = (nM - fm) < WGM ? (nM - fm) : WGM;
        u.pm = fm + ((wgid % nig) % gsz); u.pn = (wgid % nig) / gsz; return true;
    }
    __device__ __forceinline__ void a_ready(const Unit&) const {}
    __device__ __forceinline__ void done(const Unit&) const {}
};


__device__ __forceinline__ unsigned cvt_pk_bf16(float lo, float hi) { unsigned r; asm volatile("v_cvt_pk_bf16_f32 %0, %1, %2" : "=v"(r) : "v"(lo), "v"(hi)); return r; }

__device__ __forceinline__ float rstd_of(const f32x4 p) { return rsqrtf(((p[0] + p[1]) + (p[2] + p[3])) * (1.f / 1024.f) + 1e-6f); }
struct EpiBf16G {
    static constexpr bool PERM = true, AFTER_DRAIN = false;
    bf16_t* O; int ldc; int gelu_tiles; const float* rsq;
    __device__ __forceinline__ void operator()(const f32x4 (&acc)[2][2][4][2], const Unit& u, int wr, int wc, int fr, int fq) const {
        const int row0 = u.pm * BM + wr * 64 + fr, col0 = u.pn * BM + wc * 32 + 8 * fq;
        const bool g = u.pn < gelu_tiles;
        f32x4 pr[2][4];
#pragma unroll
        for (int ai = 0; ai < 2; ++ai)
#pragma unroll
            for (int m = 0; m < 4; ++m) pr[ai][m] = *(const f32x4*)(rsq + (size_t)(row0 + ai * HALF + m * 16) * 4);
#pragma unroll
        for (int ai = 0; ai < 2; ++ai)
#pragma unroll
            for (int m = 0; m < 4; ++m) { bf16_t* rowp = O + (size_t)(row0 + ai * HALF + m * 16) * ldc + col0; const float rstd = rstd_of(pr[ai][m]);
#pragma unroll
                for (int bj = 0; bj < 2; ++bj) { f32x4 v0 = acc[ai][bj][m][0] * rstd, v1 = acc[ai][bj][m][1] * rstd;
                    if (g) { v0 = (f32x4){gelu_tanh(v0[0]), gelu_tanh(v0[1]), gelu_tanh(v0[2]), gelu_tanh(v0[3])}; v1 = (f32x4){gelu_tanh(v1[0]), gelu_tanh(v1[1]), gelu_tanh(v1[2]), gelu_tanh(v1[3])}; }
                    u32x4 w; w.x = cvt_pk_bf16(v0[0], v0[1]); w.y = cvt_pk_bf16(v0[2], v0[3]); w.z = cvt_pk_bf16(v1[0], v1[1]); w.w = cvt_pk_bf16(v1[2], v1[3]);
                    *(u32x4*)(rowp + bj * HALF) = w; } }
    }
};
constexpr int XCH_LDS_OFF = 132096;
struct EpiRes {
    static constexpr bool PERM = false, AFTER_DRAIN = false;
    const float* base; float* out; bf16_t* hb; float* rsq;
    __device__ __forceinline__ void operator()(const f32x4 (&acc)[2][2][4][2], const Unit& u, int wr, int wc, int fr, int fq) const {
        extern __shared__ __attribute__((aligned(16))) unsigned char lds_all_[];
        PG8_LAS float* S = (PG8_LAS float*)((PG8_LAS unsigned char*)lds_all_ + XCH_LDS_OFF);
        const int row0 = u.pm * BM + wr * 64 + fr, col0 = u.pn * BM + wc * 32 + 4 * fq;
#pragma unroll
        for (int ai = 0; ai < 2; ++ai)
#pragma unroll
            for (int m = 0; m < 4; ++m) { const int row = row0 + ai * HALF + m * 16; const size_t off = (size_t)row * 1024 + col0; float q = 0.f;
#pragma unroll
                for (int bj = 0; bj < 2; ++bj)
#pragma unroll
                    for (int n = 0; n < 2; ++n) { const f32x4 b = *(const f32x4*)(base + off + bj * HALF + n * 16); const f32x4 h = b + acc[ai][bj][m][n];
                        *(f32x4*)(out + off + bj * HALF + n * 16) = h; q += (h[0] * h[0] + h[1] * h[1]) + (h[2] * h[2] + h[3] * h[3]);
                        u32x2 w; w.x = cvt_pk_bf16(h[0], h[1]); w.y = cvt_pk_bf16(h[2], h[3]); *(u32x2*)(hb + off + bj * HALF + n * 16) = w; }
                q += swz_xor16(q);
                { const auto rr = __builtin_amdgcn_permlane32_swap(__float_as_uint(q), __float_as_uint(q), false, false); q = __uint_as_float(rr[0]) + __uint_as_float(rr[1]); }
                if (fq == 0) S[(ai * HALF + wr * 64 + m * 16 + fr) * 4 + wc] = q; }
        asm volatile("s_waitcnt lgkmcnt(0)" ::: "memory"); __builtin_amdgcn_s_barrier(); asm volatile("" ::: "memory");
        const int t = (int)threadIdx.x;
        if (t < 256) { const f32x4 p = *(const PG8_LAS f32x4*)(S + t * 4); rsq[(size_t)(u.pm * BM + t) * 4 + u.pn] = (p[0] + p[1]) + (p[2] + p[3]); }
    }
};
constexpr float ATT_C2 = 0.125f * 1.4426950408889634f;
struct EpiQKV {
    static constexpr bool PERM = true, AFTER_DRAIN = false;
    bf16_t* O; const float* rope; const float* rsq;
    __device__ __forceinline__ void operator()(const f32x4 (&acc)[2][2][4][2], const Unit& u, int wr, int wc, int fr, int fq) const {
        const int row0 = u.pm * BM + wr * 64 + fr, col0 = u.pn * BM + wc * 32 + 8 * fq;
        const int pn = u.pn;
        const bool is_rope = (pn < 6) || (pn >= 9 && pn < 15);
        const bool is_q = (pn < 3) || (pn >= 9 && pn < 12);
        const float sc = is_q ? ATT_C2 : 1.f;
        const bool do_rot = is_rope && ((wc & 1) == 0);
        const float sgn = (fq == 0) ? -1.f : 1.f;
        f32x4 pr[2][4];
#pragma unroll
        for (int ai = 0; ai < 2; ++ai)
#pragma unroll
            for (int m = 0; m < 4; ++m) pr[ai][m] = *(const f32x4*)(rsq + (size_t)(row0 + ai * HALF + m * 16) * 4);
#pragma unroll
        for (int ai = 0; ai < 2; ++ai)
#pragma unroll
            for (int m = 0; m < 4; ++m) { const int row = row0 + ai * HALF + m * 16; bf16_t* rowp = O + (size_t)row * 4608 + col0;
                f32x4 cs0 = {1.f, 1.f, 1.f, 1.f}, cs1 = cs0, sn0 = {0.f, 0.f, 0.f, 0.f}, sn1 = sn0;
                if (do_rot) { const f32x4* t = (const f32x4*)(rope + (size_t)row * 16); cs0 = t[0]; cs1 = t[1]; sn0 = t[2] * sgn; sn1 = t[3] * sgn; }
                const float rstd = rstd_of(pr[ai][m]) * sc;
#pragma unroll
                for (int bj = 0; bj < 2; ++bj) { f32x4 v0 = acc[ai][bj][m][0] * rstd, v1 = acc[ai][bj][m][1] * rstd;
                    if (do_rot) {
                        f32x4 p0, p1;
#pragma unroll
                        for (int e = 0; e < 4; ++e) { p0[e] = swz_xor16(v0[e]); p1[e] = swz_xor16(v1[e]); }
                        if (fq < 2) { v0 = v0 * cs0 + p0 * sn0; v1 = v1 * cs1 + p1 * sn1; }
                    }
                    u32x4 w; w.x = cvt_pk_bf16(v0[0], v0[1]); w.y = cvt_pk_bf16(v0[2], v0[3]); w.z = cvt_pk_bf16(v1[0], v1[1]); w.w = cvt_pk_bf16(v1[2], v1[3]);
                    *(u32x4*)(rowp + bj * HALF) = w; } }
    }
};

template <int CTRL> __device__ __forceinline__ f32x4 dpp4(f32x4 v) { return (f32x4){dpp_f<CTRL>(v[0]), dpp_f<CTRL>(v[1]), dpp_f<CTRL>(v[2]), dpp_f<CTRL>(v[3])}; }
struct EpiUpConv {
    static constexpr bool PERM = true, AFTER_DRAIN = false;
    bf16_t* HM; const float* cw; const float* cb; float* halo; float* tops; float* topg; const float* rsq;
    __device__ __forceinline__ void operator()(const f32x4 (&acc)[2][2][4][2], const Unit& u, int wr_, int wc_, int fr_, int fq_) const {
        int tid_ = threadIdx.x; asm volatile("" : "+v"(tid_));
        const int wid_ = __builtin_amdgcn_readfirstlane(tid_ >> 6), wr = wid_ >> 2, wc = wid_ & 3, fr = tid_ & 15, fq = (tid_ >> 4) & 3; (void)wr_; (void)wc_; (void)fr_; (void)fq_;
        extern __shared__ __attribute__((aligned(16))) unsigned char lds_all_[];
        PG8_LAS float* X = (PG8_LAS float*)((PG8_LAS unsigned char*)lds_all_ + XCH_LDS_OFF);
        const int cl = wc * 32 + 8 * fq, hc = u.pn * 128 + cl;
        float rstd[2][4];
        { f32x4 pr[2][4];
#pragma unroll
          for (int ai = 0; ai < 2; ++ai)
#pragma unroll
              for (int m = 0; m < 4; ++m) pr[ai][m] = *(const f32x4*)(rsq + (size_t)(u.pm * BM + ai * HALF + wr * 64 + m * 16 + fr) * 4);
#pragma unroll
          for (int ai = 0; ai < 2; ++ai)
#pragma unroll
              for (int m = 0; m < 4; ++m) rstd[ai][m] = rstd_of(pr[ai][m]); }
        if (fr >= 14) {
#pragma unroll
            for (int ai = 0; ai < 2; ++ai) { PG8_LAS float* xp = X + (((ai * 2 + wr) * 2 + (fr - 14)) * 128 + cl);
                *(PG8_LAS f32x4*)xp = acc[ai][0][3][0] * rstd[ai][3]; *(PG8_LAS f32x4*)(xp + 4) = acc[ai][0][3][1] * rstd[ai][3]; }
            if (wr == 1) { float* hp = halo + ((size_t)u.pm * 2 + (fr - 14)) * 2816 + hc; *(f32x4*)hp = acc[1][0][3][0] * rstd[1][3]; *(f32x4*)(hp + 4) = acc[1][0][3][1] * rstd[1][3]; }
        }
        asm volatile("s_waitcnt lgkmcnt(0)" ::: "memory"); __builtin_amdgcn_s_barrier(); asm volatile("" ::: "memory");
        const bool needs_fix = (u.pm & 15) != 0;
#pragma unroll
        for (int n = 0; n < 2; ++n) {
            const f32x4 w0 = *(const f32x4*)(cw + hc + 4 * n), w1 = *(const f32x4*)(cw + 2816 + hc + 4 * n), w2 = *(const f32x4*)(cw + 2 * 2816 + hc + 4 * n), bb = *(const f32x4*)(cb + hc + 4 * n);
#pragma unroll
            for (int ai = 0; ai < 2; ++ai) {
                f32x4 pa, pb;
                const bool has_pred = !(ai == 0 && wr == 0);
                const int pblk = (wr == 1) ? (ai * 2) : 1;
                if (has_pred) { pa = *(const PG8_LAS f32x4*)(X + ((pblk * 2 + 1) * 128 + cl + 4 * n)); pb = *(const PG8_LAS f32x4*)(X + ((pblk * 2 + 0) * 128 + cl + 4 * n)); }
                else { pa = (f32x4){0.f, 0.f, 0.f, 0.f}; pb = pa; }
                f32x4 r1p = pa, r2p = (fr == 1) ? pa : pb;
                size_t ho = (size_t)(u.pm * BM + ai * HALF + wr * 64 + fr) * 2816 + hc + 4 * n; asm volatile("" : "+v"(ho));
#pragma unroll
                for (int m = 0; m < 4; ++m) {
                    const f32x4 x = acc[ai][0][m][n] * rstd[ai][m];
                    const f32x4 R1 = dpp4<0x121>(x), R2 = dpp4<0x122>(x);
                    const f32x4 p1 = (fr >= 1) ? R1 : r1p;
                    const f32x4 p2 = (fr >= 2) ? R2 : r2p;
                    const f32x4 sv = w2 * x + w1 * p1 + w0 * p2 + bb;
                    r1p = R1; r2p = R2;
                    const f32x4 g = acc[ai][1][m][n] * rstd[ai][m];
                    if (ai == 0 && m == 0) { if (wr == 0 && fr < 2 && needs_fix) { const size_t off = ((size_t)u.pm * 2 + fr) * 2816 + hc + 4 * n; *(f32x4*)(tops + off) = sv; *(f32x4*)(topg + off) = g; } }
                    u32x2 w; w.x = cvt_pk_bf16(gelu_tanh(sv[0]) * g[0], gelu_tanh(sv[1]) * g[1]); w.y = cvt_pk_bf16(gelu_tanh(sv[2]) * g[2], gelu_tanh(sv[3]) * g[3]);
                    *(u32x2*)(HM + ho) = w; ho += 16 * 2816;
                    asm volatile("" : "+v"(ho) :: "memory");
                }
            }
        }
    }
};
template <class Epi, class Sched, bool ALIGN_EPI = false, bool SP2 = false>
__device__ __forceinline__ void gemm_phase(PG8_LAS unsigned char* lds, const Gemm g, const Sched& S, const Epi& E) {
    int tid_ = threadIdx.x; asm volatile("" : "+v"(tid_));
    const int tid = tid_, wid = __builtin_amdgcn_readfirstlane(tid >> 6), lane = tid & 63, wr = wid >> 2, wc = wid & 3, fr = lane & 15, fq = lane >> 4;
    const int K = g.K, nt = K / BK;
    unsigned voffA[2], voffB[2];
#pragma unroll
    for (int i = 0; i < 2; ++i) { int R, C; stage_rc(tid * 16 + i * 8192, R, C); const int Rb = Epi::PERM ? ((R & ~31) + perm32(R & 31)) : R;
        voffA[i] = (unsigned)(R * K + C) * 2u; voffB[i] = (unsigned)(Rb * K + C) * 2u; }
    const size_t kstep = (size_t)(BK * 2);
    const size_t hstep = (size_t)HALF * K * 2;
    const size_t tstep = 2 * hstep;
    const unsigned ldsw = (unsigned)wid * 1024u;
    const int aoff = lds_byte(wr * 64 + fr, fq * 8), boff = lds_byte(wc * 32 + fr, fq * 8);
#define PG8_SA(b, h) (((b) * 2 + (h)) * HTB)
#define PG8_SB(b, h) ((4 + (b) * 2 + (h)) * HTB)
#define PG8_STAGE(bufoff, gbase, voff) do { _Pragma("unroll") for (int _i = 0; _i < 2; ++_i) \
        __builtin_amdgcn_global_load_lds((const unsigned*)((const char*)(gbase) + (voff)[_i]), (PG8_LAS unsigned*)(lds + (bufoff) + ldsw + _i * 8192), 16, 0, 0); } while (0)
#define PG8_LDA(dst, b, h) do { _Pragma("unroll") for (int m = 0; m < 4; ++m) _Pragma("unroll") for (int k = 0; k < 2; ++k) dst[m][k] = *(const PG8_LAS bf16x8*)(lds + PG8_SA(b, h) + aoff + m * 2048 + k * 1024); } while (0)
#define PG8_LDB(dst, b, h) do { _Pragma("unroll") for (int n = 0; n < 2; ++n) _Pragma("unroll") for (int k = 0; k < 2; ++k) dst[n][k] = *(const PG8_LAS bf16x8*)(lds + PG8_SB(b, h) + boff + n * 2048 + k * 1024); } while (0)
#define PG8_MMA(ai, bj, At, Bt) do { __builtin_amdgcn_s_setprio(1); _Pragma("unroll") for (int m = 0; m < 4; ++m) _Pragma("unroll") for (int n = 0; n < 2; ++n) _Pragma("unroll") for (int k = 0; k < 2; ++k) \
        acc[ai][bj][m][n] = __builtin_amdgcn_mfma_f32_16x16x32_bf16(Bt[n][k], At[m][k], acc[ai][bj][m][n], 0, 0, 0); __builtin_amdgcn_s_setprio(0); } while (0)
#define PG8_WAIT_V(n) asm volatile("s_waitcnt vmcnt(" #n ")" ::: "memory")
#define PG8_WAIT_L(n) asm volatile("s_waitcnt lgkmcnt(" #n ")" ::: "memory")
#define PG8_BAR __builtin_amdgcn_s_barrier()
#define PG8_SCHED __builtin_amdgcn_sched_barrier(0)
    Unit cur, nxt; int ui = 0;
    if (!S.next(0, cur)) return;
    f32x4 acc[2][2][4][2];
#pragma unroll
    for (int a = 0; a < 2; ++a)
#pragma unroll
        for (int b = 0; b < 2; ++b)
#pragma unroll
            for (int m = 0; m < 4; ++m)
#pragma unroll
                for (int n = 0; n < 2; ++n) acc[a][b][m][n] = (f32x4){0.f, 0.f, 0.f, 0.f};
    bf16x8 At[4][2], B0[2][2], B1[2][2];
    const char* cA = (const char*)g.A + (size_t)cur.pm * tstep; const char* cB = (const char*)g.Bt + (size_t)cur.pn * tstep;
    S.a_ready(cur);
    if constexpr (SP2) {
        PG8_STAGE(PG8_SB(0, 0), cB, voffB); PG8_STAGE(PG8_SB(0, 1), cB + hstep, voffB); PG8_STAGE(PG8_SA(0, 0), cA, voffA); PG8_STAGE(PG8_SA(0, 1), cA + hstep, voffA);
        if (wr == 1) PG8_BAR;
        PG8_WAIT_V(2); PG8_BAR;
        PG8_STAGE(PG8_SB(1, 0), cB + kstep, voffB); PG8_STAGE(PG8_SA(1, 0), cA + kstep, voffA); PG8_STAGE(PG8_SB(1, 1), cB + hstep + kstep, voffB);
        PG8_WAIT_V(6); PG8_BAR;
    } else {
        PG8_STAGE(PG8_SB(0, 0), cB, voffB); PG8_STAGE(PG8_SA(0, 0), cA, voffA); PG8_STAGE(PG8_SB(0, 1), cB + hstep, voffB); PG8_STAGE(PG8_SA(0, 1), cA + hstep, voffA);
        if (wr == 1) PG8_BAR;
        PG8_WAIT_V(4); PG8_BAR;
        PG8_STAGE(PG8_SB(1, 0), cB + kstep, voffB); PG8_STAGE(PG8_SA(1, 0), cA + kstep, voffA); PG8_STAGE(PG8_SB(1, 1), cB + hstep + kstep, voffB);
        PG8_WAIT_V(6); PG8_BAR;
    }
    for (;;) {
        const bool has_next = S.next(ui + 1, nxt);
        const char* nA = has_next ? (const char*)g.A + (size_t)nxt.pm * tstep : cA; const char* nB = has_next ? (const char*)g.Bt + (size_t)nxt.pn * tstep : cB;
        for (int t = 0; t < nt; t += 2) {
            const bool last = (t == nt - 2);
            const char* a1 = cA + (size_t)(t + 1) * kstep;
            const char* a2 = last ? nA : cA + (size_t)(t + 2) * kstep; const char* b2 = last ? nB : cB + (size_t)(t + 2) * kstep;
            const char* a3 = a2 + kstep; const char* b3 = b2 + kstep;
            if (last && has_next) S.a_ready(nxt);
            if constexpr (SP2) {
            PG8_LDB(B0, 0, 0); PG8_LDB(B1, 0, 1); PG8_SCHED; PG8_LDA(At, 0, 0); PG8_STAGE(PG8_SA(1, 1), a1 + hstep, voffA);
            PG8_WAIT_V(8); PG8_WAIT_L(0); PG8_BAR; PG8_MMA(0, 0, At, B0); PG8_MMA(0, 1, At, B1); PG8_BAR; PG8_SCHED;
            PG8_LDA(At, 0, 1); PG8_STAGE(PG8_SB(0, 0), b2, voffB); PG8_STAGE(PG8_SB(0, 1), b2 + hstep, voffB); PG8_STAGE(PG8_SA(0, 0), a2, voffA);
            PG8_WAIT_V(8); PG8_WAIT_L(0); PG8_BAR; PG8_MMA(1, 0, At, B0); PG8_MMA(1, 1, At, B1); PG8_BAR; PG8_SCHED;
            PG8_LDB(B0, 1, 0); PG8_LDB(B1, 1, 1); PG8_SCHED; PG8_LDA(At, 1, 0); PG8_STAGE(PG8_SA(0, 1), a2 + hstep, voffA);
            PG8_WAIT_V(8); PG8_WAIT_L(0); PG8_BAR; PG8_MMA(0, 0, At, B0); PG8_MMA(0, 1, At, B1); PG8_BAR; PG8_SCHED;
            PG8_LDA(At, 1, 1); PG8_STAGE(PG8_SB(1, 0), b3, voffB); PG8_STAGE(PG8_SB(1, 1), b3 + hstep, voffB); PG8_STAGE(PG8_SA(1, 0), a3, voffA);
            PG8_WAIT_V(8); PG8_WAIT_L(0); PG8_BAR; PG8_MMA(1, 0, At, B0); PG8_MMA(1, 1, At, B1); PG8_BAR; PG8_SCHED;
            } else {
            PG8_LDB(B0, 0, 0); PG8_SCHED; PG8_LDA(At, 0, 0); PG8_STAGE(PG8_SA(1, 1), a1 + hstep, voffA);
            PG8_WAIT_L(8); PG8_BAR; PG8_WAIT_L(0); PG8_MMA(0, 0, At, B0); PG8_BAR; PG8_SCHED;
            PG8_LDB(B1, 0, 1); PG8_STAGE(PG8_SB(0, 0), b2, voffB);
            PG8_BAR; PG8_WAIT_L(0); PG8_MMA(0, 1, At, B1); PG8_BAR;
            PG8_LDA(At, 0, 1); PG8_STAGE(PG8_SA(0, 0), a2, voffA);
            PG8_BAR; PG8_WAIT_L(0); PG8_MMA(1, 0, At, B0); PG8_BAR; PG8_SCHED;
            PG8_STAGE(PG8_SB(0, 1), b2 + hstep, voffB);
            PG8_WAIT_V(6); PG8_BAR; PG8_MMA(1, 1, At, B1); PG8_BAR;
            PG8_LDB(B0, 1, 0); PG8_SCHED; PG8_LDA(At, 1, 0); PG8_STAGE(PG8_SA(0, 1), a2 + hstep, voffA);
            PG8_WAIT_L(8); PG8_BAR; PG8_WAIT_L(0); PG8_MMA(0, 0, At, B0); PG8_BAR; PG8_SCHED;
            PG8_LDB(B1, 1, 1); PG8_STAGE(PG8_SB(1, 0), b3, voffB);
            PG8_BAR; PG8_WAIT_L(0); PG8_MMA(0, 1, At, B1); PG8_BAR;
            PG8_LDA(At, 1, 1); PG8_STAGE(PG8_SA(1, 0), a3, voffA);
            PG8_BAR; PG8_WAIT_L(0); PG8_MMA(1, 0, At, B0); PG8_BAR; PG8_SCHED;
            PG8_STAGE(PG8_SB(1, 1), b3 + hstep, voffB);
            PG8_WAIT_V(6); PG8_BAR; PG8_MMA(1, 1, At, B1); PG8_BAR;
            }
        }
        if constexpr (ALIGN_EPI) { if (wr == 0) PG8_BAR; }
        if constexpr (!Epi::AFTER_DRAIN) { E(acc, cur, wr, wc, fr, fq); S.done(cur); }
        if (!has_next) break;
#pragma unroll
        for (int a = 0; a < 2; ++a)
#pragma unroll
            for (int b = 0; b < 2; ++b)
#pragma unroll
                for (int m = 0; m < 4; ++m)
#pragma unroll
                    for (int n = 0; n < 2; ++n) acc[a][b][m][n] = (f32x4){0.f, 0.f, 0.f, 0.f};
        cur = nxt; cA = nA; cB = nB; ++ui;
        if constexpr (ALIGN_EPI) { if (wr == 1) PG8_BAR; }
    }
    PG8_WAIT_V(0);
    if constexpr (!ALIGN_EPI) { if (wr == 0) PG8_BAR; }
    PG8_BAR;
    if constexpr (Epi::AFTER_DRAIN) { E.fused(acc, cur, wr, wc, fr, fq, lds, wid, lane); S.done(cur); }
#undef PG8_SA
#undef PG8_SB
#undef PG8_STAGE
#undef PG8_LDA
#undef PG8_LDB
#undef PG8_MMA
#undef PG8_WAIT_V
#undef PG8_WAIT_L
#undef PG8_BAR
#undef PG8_SCHED
}
}
#include <hip/hip_bf16.h>
#include <cmath>
namespace attn_body {
using bf16=__hip_bfloat16;
using bf16x8=__attribute__((ext_vector_type(8)))short;
using s16x4=__attribute__((ext_vector_type(4)))short;
using f32x16=__attribute__((ext_vector_type(16)))float;
using u32x4=__attribute__((ext_vector_type(4)))unsigned;
constexpr int D=64,PITCH=4608;
constexpr int NW=8,QBLK=32,QB=QBLK*NW,KVBLK=64;
constexpr int ATTN_UNIT_ROWS=QB;
__device__ __forceinline__ int crow(int r,int hi){return (r&3)+8*(r>>2)+4*hi;}
#define SBAR() __builtin_amdgcn_sched_barrier(0)
template<bool BAND> __device__ __forceinline__ void cmask(f32x16&p0,f32x16&p1,int kvbase,int qrel,int hi){
  const float NEG=-INFINITY; int kb=kvbase+4*hi;
  #pragma unroll
  for(int r=0;r<16;++r){int kv=kb+(r&3)+8*(r>>2); if(kv>qrel||(BAND&&kv<qrel-128))p0[r]=NEG; if(kv+32>qrel||(BAND&&kv+32<qrel-128))p1[r]=NEG;}
}

constexpr int NSLOT=3, SLOTB=8192;
constexpr int LDS_K=0, LDS_V=NSLOT*SLOTB, LDS_WS=2*NSLOT*SLOTB, LDS_OST=LDS_WS+NW*64*4, LDS_BYTES=LDS_OST+NW*4096;
constexpr float C2=0.125f*1.4426950408889634f;
__device__ __forceinline__ void glds16(const void*gsrc,unsigned lds_dst){unsigned keep;
  asm volatile("s_mov_b32 %0, m0\n\ts_mov_b32 m0, %2\n\ts_nop 0\n\tglobal_load_lds_dwordx4 %1, off\n\ts_mov_b32 m0, %0":"=&s"(keep):"v"(gsrc),"s"(lds_dst):"memory");}
__device__ __forceinline__ float max3f(float a,float b,float c){float r;asm("v_max3_f32 %0, %1, %2, %3":"=v"(r):"v"(a),"v"(b),"v"(c));return r;}
__device__ __forceinline__ float max2f(float a,float b){float r;asm("v_max_f32_e32 %0, %1, %2":"=v"(r):"v"(a),"v"(b));return r;}
__device__ __forceinline__ float fadd_s(float a,float b){float r;asm("v_add_f32_e32 %0, %1, %2":"=v"(r):"v"(a),"v"(b));return r;}
__device__ __forceinline__ float fsub_s(float a,float b){float r;asm("v_sub_f32_e32 %0, %1, %2":"=v"(r):"v"(a),"v"(b));return r;}
typedef float f32x2_t __attribute__((ext_vector_type(2))); typedef __bf16 bf16x2_t __attribute__((ext_vector_type(2)));
__device__ __forceinline__ unsigned cvtpk_s(float lo,float hi){f32x2_t v={lo,hi};bf16x2_t b=__builtin_convertvector(v,bf16x2_t);return __builtin_bit_cast(unsigned,b);}
#define WAIT_BAR(N) asm volatile("s_waitcnt vmcnt(" #N ") lgkmcnt(0)\n\ts_barrier":::"memory")

__device__ __forceinline__ void qkt(f32x16&p0,f32x16&p1,const char*Kslot,const bf16x8*qr,const f32x16&negm,int r32,int hi){
  const char*kb=Kslot+hi*1024+r32*16;
  #pragma unroll
  for(int d0=0;d0<4;++d0){
    const bf16x8 b0=*reinterpret_cast<const bf16x8*>(kb+d0*2048);
    const bf16x8 b1=*reinterpret_cast<const bf16x8*>(kb+d0*2048+512);
    if(d0==0){p0=__builtin_amdgcn_mfma_f32_32x32x16_bf16(b0,qr[0],negm,0,0,0);p1=__builtin_amdgcn_mfma_f32_32x32x16_bf16(b1,qr[0],negm,0,0,0);}
    else{p0=__builtin_amdgcn_mfma_f32_32x32x16_bf16(b0,qr[d0],p0,0,0,0);p1=__builtin_amdgcn_mfma_f32_32x32x16_bf16(b1,qr[d0],p1,0,0,0);}}
}
typedef __attribute__((address_space(3))) const char* lds_cptr;
typedef short v4i16_t __attribute__((ext_vector_type(4)));
__device__ __forceinline__ void kload8(bf16x8*kf,lds_cptr kp){
  kf[0]=*(const __attribute__((address_space(3))) bf16x8*)(kp);      kf[1]=*(const __attribute__((address_space(3))) bf16x8*)(kp+512);
  kf[2]=*(const __attribute__((address_space(3))) bf16x8*)(kp+2048); kf[3]=*(const __attribute__((address_space(3))) bf16x8*)(kp+2560);
  kf[4]=*(const __attribute__((address_space(3))) bf16x8*)(kp+4096); kf[5]=*(const __attribute__((address_space(3))) bf16x8*)(kp+4608);
  kf[6]=*(const __attribute__((address_space(3))) bf16x8*)(kp+6144); kf[7]=*(const __attribute__((address_space(3))) bf16x8*)(kp+6656);
}
__device__ __forceinline__ void kload2(bf16x8*kf,lds_cptr kp,int j){ kf[2*j]=*(const __attribute__((address_space(3))) bf16x8*)(kp+j*2048); kf[2*j+1]=*(const __attribute__((address_space(3))) bf16x8*)(kp+j*2048+512); }
__device__ __forceinline__ s16x4 vtr(lds_cptr p){ return __builtin_bit_cast(s16x4,__builtin_amdgcn_ds_read_tr16_b64_v4i16((__attribute__((address_space(3))) v4i16_t*)p)); }
__device__ __forceinline__ float rowmax(const f32x16&p0,const f32x16&p1){
  float a=max3f(p0[0],p0[1],p1[0]),b=max3f(p0[2],p0[3],p1[1]);a=max3f(a,p1[2],p1[3]);
  #pragma unroll
  for(int r=4;r<16;r+=4){a=max3f(a,p0[r],p0[r+1]);b=max3f(b,p0[r+2],p0[r+3]);a=max3f(a,p1[r],p1[r+1]);b=max3f(b,p1[r+2],p1[r+3]);}
  const float m=max2f(a,b);
  auto rr=__builtin_amdgcn_permlane32_swap(__float_as_uint(m),__float_as_uint(m),false,false);
  return max2f(__uint_as_float(rr[0]),__uint_as_float(rr[1]));
}
__device__ __forceinline__ void pv(f32x16*o,int vb,bf16x8 pa0,bf16x8 pa1,bf16x8 pa2,bf16x8 pa3){
  #pragma unroll
  for(int d0=0;d0<2;++d0){s16x4 lo[4],hi[4];
    #pragma unroll
    for(int ks=0;ks<4;++ks){
      asm volatile("ds_read_b64_tr_b16 %0,%1 offset:%c2":"=&v"(lo[ks]):"v"(vb),"i"(d0*4096+ks*1024):"memory");
      asm volatile("ds_read_b64_tr_b16 %0,%1 offset:%c2":"=&v"(hi[ks]):"v"(vb),"i"(d0*4096+ks*1024+512):"memory");}
    asm volatile("s_waitcnt lgkmcnt(0)":::"memory");SBAR();
    #define PK(k) (bf16x8){lo[k][0],lo[k][1],lo[k][2],lo[k][3],hi[k][0],hi[k][1],hi[k][2],hi[k][3]}
    o[d0]=__builtin_amdgcn_mfma_f32_32x32x16_bf16(pa0,PK(0),o[d0],0,0,0);
    o[d0]=__builtin_amdgcn_mfma_f32_32x32x16_bf16(pa1,PK(1),o[d0],0,0,0);
    o[d0]=__builtin_amdgcn_mfma_f32_32x32x16_bf16(pa2,PK(2),o[d0],0,0,0);
    o[d0]=__builtin_amdgcn_mfma_f32_32x32x16_bf16(pa3,PK(3),o[d0],0,0,0);
    #undef PK
  }
}

#ifndef ATTN_STORE16
#define ATTN_STORE16(p,v) (*(u32x4*)(p)=(v))
#endif
template<int THRL,bool BAND> __device__ __forceinline__ void attn_unit(const bf16*Qb,const bf16*__restrict__ Kb,const bf16*__restrict__ Vb,bf16*Ob,const long rs,const long ors,const int NT,const int moff,float*lse,const long lrs,char*shm){
  int tid_=threadIdx.x; asm volatile("":"+v"(tid_));
  const int tid=tid_,lane=tid&63,r32=lane&31,hi=lane>>5; const int wid=__builtin_amdgcn_readfirstlane(tid>>6);
  const bf16*Qw=Qb+(long)(wid*QBLK)*rs;
  const bf16*Kh=Kb,*Vh=Vb;
  const unsigned lds0=(unsigned)(uintptr_t)shm;
  float*wsf=(float*)(shm+LDS_WS)+wid*64;
  const bf16*ksrc=Kh+(long)lane*rs+wid*8;
  const bf16*vsrc=Vh+(long)(16*(wid&3)+(lane>>2))*rs+(wid>>2)*32+(lane&3)*8;
  const unsigned kdst=lds0+LDS_K+wid*1024, vdst=lds0+LDS_V+wid*1024;
  #define DMA_K(t,slot) glds16(ksrc+(long)(t)*KVBLK*rs,(unsigned)__builtin_amdgcn_readfirstlane(kdst+(slot)))
  #define DMA_V(t,slot) glds16(vsrc+(long)(t)*KVBLK*rs,(unsigned)__builtin_amdgcn_readfirstlane(vdst+(slot)))
  const int vb0=(int)(lds0+LDS_V)+((lane>>4)&1)*32+(lane&3)*8+(4*hi+((lane&15)>>2))*64;
  const char*Kbase=shm+LDS_K; bf16x8 kf[8];
  const lds_cptr shm3=(lds_cptr)shm; const lds_cptr kp0=shm3+LDS_K+hi*1024+r32*16; const lds_cptr vp0=shm3+LDS_V+((lane>>4)&1)*32+(lane&3)*8+(4*hi+((lane&15)>>2))*64;
  DMA_K(0,0);DMA_V(0,0);DMA_K(1,SLOTB);
  bf16x8 qr[4];
  #pragma unroll
  for(int d0=0;d0<4;++d0)qr[d0]=*reinterpret_cast<const bf16x8*>(&Qw[(long)r32*rs+d0*16+hi*8]);
  float mhat=0.f,l_reg=0.f;f32x16 o[2];o[0]=f32x16{};o[1]=f32x16{};f32x16 negm=f32x16{};asm volatile("":"+v"(negm));
  const int qrel=wid*QBLK+r32;
  #define CMASK(P0,P1,t) do{int jb_=(t)-(NT-4); if(BAND||jb_>=0)cmask<BAND>(P0,P1,64*(t)-moff,qrel,hi);}while(0)
  bool resc=false;
  #define START(P0,P1) do{ const float rm=BAND?__builtin_fmaxf(rowmax(P0,P1),-64.f):rowmax(P0,P1); resc=false; \
    { const float dl=rm; mhat=fadd_s(mhat,dl); \
      _Pragma("unroll") for(int r=0;r<16;++r){P0[r]=fsub_s(P0[r],dl);P1[r]=fsub_s(P1[r],dl);} \
      _Pragma("unroll") for(int r=0;r<16;++r)negm[r]=-mhat; asm volatile("":"+v"(negm)); } \
    _Pragma("unroll") for(int r=0;r<16;++r)P0[r]=__builtin_amdgcn_exp2f(P0[r]); }while(0)
  #define RESC() do{ if(resc){ asm volatile("s_waitcnt lgkmcnt(0)":::"memory"); \
      _Pragma("unroll") for(int d_=0;d_<2;++d_) _Pragma("unroll") for(int r=0;r<16;++r)o[d_][r]*=wsf[crow(r,hi)]; } }while(0)
  f32x16 pA0,pA1,pB0,pB1;
  int sl_prev=0,sl_cur=0,sl_next=SLOTB;
  #define ROT() do{sl_prev=sl_cur;sl_cur=sl_next;sl_next=(sl_next==(NSLOT-1)*SLOTB)?0:sl_next+SLOTB;}while(0)
  DMA_K(2,2*SLOTB);
  WAIT_BAR(3);
  qkt(pA0,pA1,Kbase,qr,negm,r32,hi);asm volatile("s_nop 15\n\ts_nop 7":"+v"(pA0),"+v"(pA1));CMASK(pA0,pA1,0);
  START(pA0,pA1);
  _Pragma("unroll") for(int r=0;r<16;++r)pA1[r]=__builtin_amdgcn_exp2f(pA1[r]);
  WAIT_BAR(0);
  DMA_K(3,0);DMA_V(1,SLOTB);
  ROT();
  kload8(kf,kp0+sl_cur);
  WAIT_BAR(2);
  s16x4 vlo[8],vhi[8]; u32x4 pw0,pw1,pw2,pw3;
  #define PKW(P,B) cvtpk_s(P[B],P[B+1])
  #define PAF(k) __builtin_bit_cast(bf16x8,pw##k)
  #define VFR(i) (bf16x8){vlo[i][0],vlo[i][1],vlo[i][2],vlo[i][3],vhi[i][0],vhi[i][1],vhi[i][2],vhi[i][3]}
  #define PIN(x) asm volatile("":"+v"(x))
  #define MX3(a,b,c) __builtin_fmaxf(__builtin_fmaxf((a),(b)),(c))
  #define GAPA(MF,A0,A1,A2,A3,W0,W1,PW) do{ MF; sacc+=A0; sacc+=A1; sacc+=A2; sacc+=A3; PIN(sacc); W0; W1; PIN(PW); SBAR(); }while(0)
  #define EX(v) __builtin_amdgcn_exp2f(v)
  #define GAPB(MF,X,B) do{ MF; X[B]=EX(X[B]); X[B+1]=EX(X[B+1]); X[B+2]=EX(X[B+2]); X[B+3]=EX(X[B+3]); PIN(X); SBAR(); }while(0)
  #define VRD(i) do{ vlo[i]=vtr(vp_+(((i)>>2)*4096+((i)&3)*1024)); vhi[i]=vtr(vp_+(((i)>>2)*4096+((i)&3)*1024+512)); }while(0)
  #define KRD(G,j) do{ if(G){ kload2(kf,kp0+sl_next,j); SBAR(); } }while(0)
  #define STEP(C0,C1,P0,P1,t,GK,GV,GL) do{ SBAR(); \
    const lds_cptr vp_=vp0+sl_prev; \
    VRD(0); SBAR(); float sacc=(P0[0]+P0[1]); \
    GAPA(C0=__builtin_amdgcn_mfma_f32_32x32x16_bf16(kf[0],qr[0],negm,0,0,0), P0[2],P0[3],P0[4],P0[5],     pw0[0]=PKW(P0,0), pw0[1]=PKW(P0,2), pw0); \
    VRD(4); SBAR(); GAPA(C1=__builtin_amdgcn_mfma_f32_32x32x16_bf16(kf[1],qr[0],negm,0,0,0), P0[6],P0[7],P0[8],P0[9],     pw0[2]=PKW(P0,4), pw0[3]=PKW(P0,6), pw0); \
    VRD(1); SBAR(); GAPA(C0=__builtin_amdgcn_mfma_f32_32x32x16_bf16(kf[2],qr[1],C0,0,0,0),   P0[10],P0[11],P0[12],P0[13], pw1[0]=PKW(P0,8), pw1[1]=PKW(P0,10), pw1); \
    VRD(5); SBAR(); GAPA(C1=__builtin_amdgcn_mfma_f32_32x32x16_bf16(kf[3],qr[1],C1,0,0,0),   P0[14],P0[15],P1[0],P1[1],   pw1[2]=PKW(P0,12),pw1[3]=PKW(P0,14), pw1); \
    VRD(2); SBAR(); GAPA(C0=__builtin_amdgcn_mfma_f32_32x32x16_bf16(kf[4],qr[2],C0,0,0,0),   P1[2],P1[3],P1[4],P1[5],     pw2[0]=PKW(P1,0), pw2[1]=PKW(P1,2), pw2); \
    VRD(6); SBAR(); GAPA(C1=__builtin_amdgcn_mfma_f32_32x32x16_bf16(kf[5],qr[2],C1,0,0,0),   P1[6],P1[7],P1[8],P1[9],     pw2[2]=PKW(P1,4), pw2[3]=PKW(P1,6), pw2); \
    VRD(3); SBAR(); GAPA(C0=__builtin_amdgcn_mfma_f32_32x32x16_bf16(kf[6],qr[3],C0,0,0,0),   P1[10],P1[11],P1[12],P1[13], pw3[0]=PKW(P1,8), pw3[1]=PKW(P1,10), pw3); \
    VRD(7); SBAR(); GAPA(C1=__builtin_amdgcn_mfma_f32_32x32x16_bf16(kf[7],qr[3],C1,0,0,0),   P1[14],P1[15],0.f,0.f,       pw3[2]=PKW(P1,12),pw3[3]=PKW(P1,14), pw3); \
    l_reg+=sacc; \
    if(GK){DMA_K((t)+3,sl_cur);} if(GV){DMA_V((t)+1,sl_next);} \
    CMASK(C0,C1,t); \
    { float a=MX3(C0[0],C0[1],C1[0]),b=MX3(C0[2],C0[3],C1[1]); a=MX3(a,C1[2],C1[3]); \
      _Pragma("unroll") for(int r=4;r<16;r+=4){a=MX3(a,C0[r],C0[r+1]);b=MX3(b,C0[r+2],C0[r+3]);a=MX3(a,C1[r],C1[r+1]);b=MX3(b,C1[r+2],C1[r+3]);} \
      float rm=__builtin_fmaxf(a,b); { auto rr=__builtin_amdgcn_permlane32_swap(__float_as_uint(rm),__float_as_uint(rm),false,false); rm=__builtin_fmaxf(__uint_as_float(rr[0]),__uint_as_float(rr[1])); } \
      resc=false; \
      if(__builtin_expect(__any(rm>(float)THRL),0)){ const float dl=__builtin_fmaxf(rm,0.f); mhat+=dl; \
        _Pragma("unroll") for(int r=0;r<16;++r){C0[r]-=dl;C1[r]-=dl;} \
        _Pragma("unroll") for(int r=0;r<16;++r)negm[r]=-mhat; asm volatile("":"+v"(negm)); \
        const float f=__builtin_amdgcn_exp2f(-dl); l_reg*=f; if(hi==0)wsf[r32]=f; resc=true; } } \
    SBAR(); \
    GAPB(o[0]=__builtin_amdgcn_mfma_f32_32x32x16_bf16(PAF(0),VFR(0),o[0],0,0,0), C0,0); \
    GAPB(o[1]=__builtin_amdgcn_mfma_f32_32x32x16_bf16(PAF(0),VFR(4),o[1],0,0,0), C0,4); \
    KRD(GL,0); GAPB(o[0]=__builtin_amdgcn_mfma_f32_32x32x16_bf16(PAF(1),VFR(1),o[0],0,0,0), C0,8); \
    KRD(GL,1); GAPB(o[1]=__builtin_amdgcn_mfma_f32_32x32x16_bf16(PAF(1),VFR(5),o[1],0,0,0), C0,12); \
    KRD(GL,2); GAPB(o[0]=__builtin_amdgcn_mfma_f32_32x32x16_bf16(PAF(2),VFR(2),o[0],0,0,0), C1,0); \
    KRD(GL,3); GAPB(o[1]=__builtin_amdgcn_mfma_f32_32x32x16_bf16(PAF(2),VFR(6),o[1],0,0,0), C1,4); \
    GAPB(o[0]=__builtin_amdgcn_mfma_f32_32x32x16_bf16(PAF(3),VFR(3),o[0],0,0,0), C1,8); \
    GAPB(o[1]=__builtin_amdgcn_mfma_f32_32x32x16_bf16(PAF(3),VFR(7),o[1],0,0,0), C1,12); \
    }while(0)
  int t=1;
  #undef CMASK
  #define CMASK(P0,P1,t) do{}while(0)
  for(;t+5<NT;t+=2){
    STEP(pB0,pB1,pA0,pA1,t,true,true,true);     WAIT_BAR(2); RESC(); ROT();
    STEP(pA0,pA1,pB0,pB1,t+1,true,true,true);   WAIT_BAR(2); RESC(); ROT();
  }
  #undef CMASK
  #define CMASK(P0,P1,t) do{int jb_=(t)-(NT-4); if(BAND||jb_>=0)cmask<BAND>(P0,P1,64*(t)-moff,qrel,hi);}while(0)
  #define ENDW(tt) do{ if((tt)+3<NT){WAIT_BAR(2);} else if((tt)+2<NT){WAIT_BAR(1);} else {WAIT_BAR(0);} }while(0)
  for(;t+1<NT;t+=2){
    STEP(pB0,pB1,pA0,pA1,t,(t+3<NT),(t+1<NT),(t+1<NT));       ENDW(t);   RESC(); ROT();
    STEP(pA0,pA1,pB0,pB1,t+1,(t+4<NT),(t+2<NT),(t+2<NT));     ENDW(t+1); RESC(); ROT();
  }
  STEP(pB0,pB1,pA0,pA1,NT-1,false,false,false); RESC();
  { float sacc=pB0[0]+pB0[1]; _Pragma("unroll") for(int r=2;r<16;++r)sacc+=pB0[r]; _Pragma("unroll") for(int r=0;r<16;++r)sacc+=pB1[r]; l_reg+=sacc;
    pw0=(u32x4){PKW(pB0,0),PKW(pB0,2),PKW(pB0,4),PKW(pB0,6)};pw1=(u32x4){PKW(pB0,8),PKW(pB0,10),PKW(pB0,12),PKW(pB0,14)};pw2=(u32x4){PKW(pB1,0),PKW(pB1,2),PKW(pB1,4),PKW(pB1,6)};pw3=(u32x4){PKW(pB1,8),PKW(pB1,10),PKW(pB1,12),PKW(pB1,14)};
    SBAR(); pv(o,vb0+sl_cur,PAF(0),PAF(1),PAF(2),PAF(3)); }
  #undef PKW
  #undef PAF
  #undef VFR
  #undef PIN
  #undef MX3
  #undef GAPA
  #undef GAPB
  #undef EX
  #undef VRD
  #undef KRD
  #undef STEP
  #undef ENDW
  {auto rr=__builtin_amdgcn_permlane32_swap(__float_as_uint(l_reg),__float_as_uint(l_reg),false,false);l_reg=__uint_as_float(rr[0])+__uint_as_float(rr[1]);}
  if(hi==0)wsf[32+r32]=l_reg;asm volatile("s_waitcnt lgkmcnt(0)":::"memory");
  float rli[16];
  #pragma unroll
  for(int r=0;r<16;++r)rli[r]=__builtin_amdgcn_rcpf(wsf[32+crow(r,hi)]);
  bf16*Ow=Ob+(long)(wid*QBLK)*ors;
  if(BAND){ if(hi==0) lse[(long)(wid*QBLK+r32)*lrs]=mhat+__builtin_amdgcn_logf(l_reg); }
  { bf16*stg=(bf16*)(shm+LDS_OST)+wid*2048;
    #pragma unroll
    for(int r=0;r<16;++r){const int orow=crow(r,hi);
      #pragma unroll
      for(int d0=0;d0<2;++d0)stg[orow*64+d0*32+r32]=__float2bfloat16(o[d0][r]*rli[r]);}
    asm volatile("s_waitcnt lgkmcnt(0)":::"memory");
    #pragma unroll
    for(int i=0;i<4;++i){const int row=i*8+(lane>>3),ch=lane&7; const u32x4 v=*(const u32x4*)(stg+row*64+ch*8); ATTN_STORE16(Ow+(long)row*ors+ch*8,v);} }
  asm volatile("s_waitcnt lgkmcnt(0)\n\ts_barrier":::"memory");
  #undef DMA_K
  #undef DMA_V
  #undef CMASK
  #undef START
  #undef RESC
  #undef ROT
}
constexpr int ATTN_LDS_BYTES=LDS_BYTES;
struct AttnUnit { const bf16* Q; const bf16* K; const bf16* V; bf16* O; float* lse; long rs, ors, lrs; int NT, moff; };
template<class Sched,int THRL,bool BAND> __device__ __forceinline__ void attn_phase(char*lds,const Sched&S){
  AttnUnit u;
  for(int i=0;S.next(i,u);++i){ attn_unit<THRL,BAND>(u.Q,u.K,u.V,u.O,u.rs,u.ors,u.NT,u.moff,u.lse,u.lrs,lds); }
}
#undef SBAR
#undef WAIT_BAR
}
#define GAS __attribute__((address_space(1)))
#define LAS __attribute__((address_space(3)))
typedef unsigned short bf16;
typedef unsigned v4u __attribute__((ext_vector_type(4)));
typedef float f32x4 __attribute__((ext_vector_type(4)));
typedef short bf16x8 __attribute__((ext_vector_type(8)));
typedef GAS unsigned gu32;
typedef GAS unsigned long long gu64;
#define RLX_AGENT __ATOMIC_RELAXED, __HIP_MEMORY_SCOPE_AGENT
#define LDS_WAIT() asm volatile("s_waitcnt lgkmcnt(0)" ::: "memory")
#define VM_WAIT() asm volatile("s_waitcnt vmcnt(0)" ::: "memory")
__device__ __forceinline__ unsigned long long rt() { return __builtin_amdgcn_s_memrealtime(); }

#define XB_TMO      128
#define XB_XCNT(j)  (256  + 64 * (j))
#define XB_XSUB(j)  (1280 + 64 * (j))
#define XB_XGEN(j)  (2304 + 64 * (j))
#define XB_TOP      3328
#define XB_TOPGEN   3392
#define XCD_BAR_WORDS 3456
#define XB_SPIN_CAP (1u << 18)

__device__ __forceinline__ unsigned xb_ld(unsigned* p)              { return __hip_atomic_load(p, __ATOMIC_RELAXED, __HIP_MEMORY_SCOPE_AGENT); }
__device__ __forceinline__ unsigned xb_add(unsigned* p, unsigned v) { return __hip_atomic_fetch_add(p, v, __ATOMIC_RELAXED, __HIP_MEMORY_SCOPE_AGENT); }
__device__ __forceinline__ unsigned xb_xcc_id() { return (unsigned)__builtin_amdgcn_s_getreg((3 << 11) | 20) & 0xFu; }
#define XB_SPIN(cond, bar) do { unsigned _sp = 0; while (cond) { __builtin_amdgcn_s_sleep(1); \
    if ((++_sp & 255u) == 0u) { if (xb_ld(&(bar)[XB_TMO])) break; if (_sp > XB_SPIN_CAP) { atomicAdd(&(bar)[XB_TMO], 1u); break; } } } } while (0)

struct XcdBarrier {
    unsigned* bar; unsigned x;
    volatile LAS unsigned* st;
};

__device__ __forceinline__ XcdBarrier xcd_barrier_post(unsigned* bar, volatile LAS unsigned* st) {
    XcdBarrier b; b.bar = bar; b.x = xb_xcc_id(); b.st = st;
    if (threadIdx.x == 0) (void)xb_add(&bar[XB_XCNT(b.x)], 1u);
    return b;
}
__device__ __forceinline__ void xcd_barrier_complete(unsigned* bar, unsigned x, unsigned& nloc, unsigned& nx) {
    const unsigned G = gridDim.x * gridDim.y * gridDim.z;
    unsigned sum, cnt, mine, sp = 0u;
    for (;;) {
        sum = 0u; cnt = 0u; mine = 0u;
#pragma unroll
        for (unsigned j = 0; j < 16; ++j) { const unsigned c = xb_ld(&bar[XB_XCNT(j)]); sum += c; cnt += (c > 0u) ? 1u : 0u; mine = (j == x) ? c : mine; }
        if (sum == G) break;
        __builtin_amdgcn_s_sleep(1);
        if ((++sp & 255u) == 0u) { if (xb_ld(&bar[XB_TMO])) break; if (sp > XB_SPIN_CAP) { atomicAdd(&bar[XB_TMO], 1u); break; } }
    }
    nloc = mine > 0u ? mine : 1u; nx = cnt > 0u ? cnt : 1u;
}

__device__ __forceinline__ void xcd_barrier(const XcdBarrier& b) {
    asm volatile("s_waitcnt vmcnt(0)" ::: "memory");
    __syncthreads();
    if (threadIdx.x == 0) {
        unsigned* bar = b.bar;
        __builtin_amdgcn_s_waitcnt(0);
        unsigned nloc = b.st[0], nx = b.st[1];
        if (nloc == 0u) { xcd_barrier_complete(bar, b.x, nloc, nx); b.st[0] = nloc; b.st[1] = nx; }
        const unsigned old = xb_add(&bar[XB_XSUB(b.x)], 1u);
        const unsigned gen = old / nloc;
        if (old + 1u == (gen + 1u) * nloc) {
            __builtin_amdgcn_fence(__ATOMIC_RELEASE, "agent");
            asm volatile("s_waitcnt vmcnt(0)" ::: "memory");
            const unsigned og = xb_add(&bar[XB_TOP], 1u);
            const unsigned tg = og / nx;
            if (og + 1u == (tg + 1u) * nx) xb_add(&bar[XB_TOPGEN], 1u);
            else XB_SPIN(xb_ld(&bar[XB_TOPGEN]) == tg, bar);
            __builtin_amdgcn_fence(__ATOMIC_ACQUIRE, "agent");
            xb_add(&bar[XB_XGEN(b.x)], 1u);
            asm volatile("s_waitcnt vmcnt(0)" ::: "memory");
        } else {
            XB_SPIN(xb_ld(&bar[XB_XGEN(b.x)]) == gen, bar);
            __builtin_amdgcn_fence(__ATOMIC_ACQUIRE, "agent");
            asm volatile("s_waitcnt vmcnt(0)" ::: "memory");
        }
    }
    __syncthreads();
}

constexpr int NWAVES = 8;
constexpr int RING_OFF = 0, RING_BYTES = 131072;
constexpr int LDSCTL_OFF = RING_BYTES, MISC_OFF = LDSCTL_OFF + 320;
constexpr int LDS_BYTES = 147456;
constexpr int CW_TMO = 0, CW_CODE = 1, CW_BAR = 4096;

__device__ __forceinline__ int lane_id() { int l = (int)(threadIdx.x & 63u); asm volatile("" : "+v"(l)); return l; }
__device__ __forceinline__ int tid_id() { int t = (int)threadIdx.x; asm volatile("" : "+v"(t)); return t; }
struct Frame {
    LAS unsigned char* lds;
    volatile LAS unsigned* MISC;
    gu32* ctl;
    int wave, vcu, G;
};

__device__ __forceinline__ void p0_transpose_item(const float* W, int K, int N, bf16_t* WT, int k0, int n0, int drow0, LAS float* scr, int lane, const float* gain) {
#pragma unroll 8
    for (int i = 0; i < 32; ++i) { const int kk = 2 * i + (lane >> 5); const float gk = gain ? gain[k0 + kk] : 1.f; scr[kk * 33 + (lane & 31)] = W[(size_t)(k0 + kk) * N + n0 + (lane & 31)] * gk; }
    LDS_WAIT(); asm volatile("" ::: "memory");
    const int c = lane & 7;
#pragma unroll
    for (int j = 0; j < 4; ++j) { const int n = (lane >> 3) + 8 * j; const LAS float* s = scr + (8 * c) * 33 + n;
        v4u o; o.x = pk2bf(s[0 * 33], s[1 * 33]); o.y = pk2bf(s[2 * 33], s[3 * 33]); o.z = pk2bf(s[4 * 33], s[5 * 33]); o.w = pk2bf(s[6 * 33], s[7 * 33]);
        *(GAS v4u*)(WT + (size_t)(drow0 + n) * K + k0 + 8 * c) = o; }
    LDS_WAIT(); asm volatile("" ::: "memory");
}
__device__ __forceinline__ void rms_row_to_bf16(const float* xrow, const float* g, bf16_t* orow, int lane) {
    const f32x4* xr = (const f32x4*)xrow + lane;
    f32x4 v[4]; float s = 0.f;
#pragma unroll
    for (int j = 0; j < 4; ++j) { v[j] = xr[64 * j]; s += (v[j].x * v[j].x + v[j].y * v[j].y) + (v[j].z * v[j].z + v[j].w * v[j].w); }
    const float r = rsqrtf(wave_sum(s) * (1.f / DM) + EPS);
    unsigned long long* o8 = (unsigned long long*)orow + lane;
#pragma unroll
    for (int j = 0; j < 4; ++j) { const f32x4 gg = *((const f32x4*)g + lane + 64 * j);
        o8[64 * j] = (unsigned long long)pk2bf(v[j].x * r * gg.x, v[j].y * r * gg.y) | ((unsigned long long)pk2bf(v[j].z * r * gg.z, v[j].w * r * gg.w) << 32); }
}
__device__ __forceinline__ void row_to_bf16_sq(const float* xrow, bf16_t* orow, float* rsq16, int lane) {
    const f32x4* xr = (const f32x4*)xrow + lane;
    f32x4 v[4]; float s = 0.f;
#pragma unroll
    for (int j = 0; j < 4; ++j) { v[j] = xr[64 * j]; s += (v[j].x * v[j].x + v[j].y * v[j].y) + (v[j].z * v[j].z + v[j].w * v[j].w); }
    s = wave_sum(s);
    unsigned long long* o8 = (unsigned long long*)orow + lane;
#pragma unroll
    for (int j = 0; j < 4; ++j) o8[64 * j] = (unsigned long long)pk2bf(v[j].x, v[j].y) | ((unsigned long long)pk2bf(v[j].z, v[j].w) << 32);
    if (lane < 4) rsq16[lane] = (lane == 0) ? s : 0.f;
}
__device__ __forceinline__ void rms_row_inplace_rsq(float* xrow, const float* g, const float* rsq16, int lane) {
    f32x4* xr = (f32x4*)xrow + lane;
    float s = (lane < 4) ? rsq16[lane] : 0.f;
    s = wave_sum(s);
    const float r = rsqrtf(s * (1.f / DM) + EPS);
#pragma unroll
    for (int j = 0; j < 4; ++j) { const f32x4 gg = *((const f32x4*)g + lane + 64 * j); xr[64 * j] = xr[64 * j] * r * gg; }
}
__device__ __forceinline__ void rms_row_inplace(float* xrow, const float* g, int lane) {
    f32x4* xr = (f32x4*)xrow + lane;
    f32x4 v[4]; float s = 0.f;
#pragma unroll
    for (int j = 0; j < 4; ++j) { v[j] = xr[64 * j]; s += (v[j].x * v[j].x + v[j].y * v[j].y) + (v[j].z * v[j].z + v[j].w * v[j].w); }
    const float r = rsqrtf(wave_sum(s) * (1.f / DM) + EPS);
#pragma unroll
    for (int j = 0; j < 4; ++j) { const f32x4 gg = *((const f32x4*)g + lane + 64 * j); xr[64 * j] = v[j] * r * gg; }
}

struct Args { const float* in[23]; float* out; unsigned char* ws; int ph_lo, ph_hi; };

struct WDesc { const float* W; int K, N; bf16_t* WT; int mode; int items; };

__device__ __forceinline__ void p0_prologue(Frame& F, const Args& a) {
    LAS float* scr = (LAS float*)(F.lds + RING_OFF + F.wave * 16384);
    const int lane = lane_id(), tid = tid_id();
    const int gw = F.vcu * NWAVES + F.wave, NGW = F.G * NWAVES;
    unsigned char* ws = a.ws;
    constexpr int I0 = (DM / 64) * (N_IN0 / 32), I1 = (DM / 64) * (DM / 32), I2 = (DM / 64) * (N_QKV / 32), I3 = I1, I4 = (DM / 64) * (NUP / 32), I6 = (DFF / 64) * (DM / 32);
    constexpr int I8 = (128 / 64) * (128 / 32);
    constexpr int NITEMS = I0 + I1 + I2 + I3 + 2 * I4 + 2 * I6 + 4 * I8;
    for (int it = gw; it < NITEMS; it += NGW) {
        int r = it; const float* W; int K, N; bf16_t* WT; int mode = 0; const float* gain = nullptr;
        if (r < I0) { W = a.in[5]; K = DM; N = N_IN0; WT = (bf16_t*)(ws + WS_W_IN0); gain = a.in[2]; }
        else if ((r -= I0) < I1) { W = a.in[11]; K = DM; N = DM; WT = (bf16_t*)(ws + WS_W_OUT0); }
        else if ((r -= I1) < I2) { W = a.in[12]; K = DM; N = N_QKV; WT = (bf16_t*)(ws + WS_W_QKV); gain = a.in[2] + DM; }
        else if ((r -= I2) < I3) { W = a.in[18]; K = DM; N = DM; WT = (bf16_t*)(ws + WS_W_OUT1); }
        else if ((r -= I3) < 2 * I4) { const int l = r / I4; r -= l * I4; W = a.in[19] + (size_t)l * DM * NUP; K = DM; N = NUP; WT = (bf16_t*)(ws + WS_W_UP) + (size_t)l * NUP * DM; mode = 1; gain = a.in[3] + l * DM; }
        else if ((r -= 2 * I4) < 2 * I6) { const int l = r / I6; r -= l * I6; W = a.in[22] + (size_t)l * DFF * DM; K = DFF; N = DM; WT = (bf16_t*)(ws + WS_W_DN) + (size_t)l * DM * DFF; }
        else { r -= 2 * I6; const int g = r / I8; r -= g * I8; W = a.in[9] + (size_t)g * 128 * 128; K = 128; N = 128; WT = (bf16_t*)(ws + WS_PWT) + (size_t)g * 128 * 128; }
        const int nblk = N / 32, kb = r / nblk, nb = r % nblk, k0 = 64 * kb, n0 = 32 * nb;
        int d0 = n0;
        if (mode == 1) { if (n0 < DFF) d0 = 256 * (n0 / 128) + (n0 % 128); else { const int q = n0 - DFF; d0 = 256 * (q / 128) + 128 + (q % 128); } }
        p0_transpose_item(W, K, N, WT, k0, n0, d0, scr, lane, gain);
    }
    { const float* w_s = a.in[7]; bf16_t* Wb = (bf16_t*)(ws + WS_WSB);
      for (int idx = (F.vcu * NWAVES * 64) + tid; idx < 4 * 128 * 128; idx += F.G * NWAVES * 64) { const int t = (idx >> 7) & 127, sidx = idx & 127; Wb[idx] = (sidx <= t) ? f2bf(w_s[idx]) : (bf16_t)0; } }
    { const int* pos = (const int*)a.in[1]; float* tab = (float*)(ws + WS_ROPE);
      for (int idx = (F.vcu * NWAVES * 64) + tid; idx < M * 8; idx += F.G * NWAVES * 64) {
          const int row = idx >> 3, i = idx & 7;
          const double inv = exp2(-(double)(2 * i) / 16.0 * 18.931568569324174);
          const float ang = (float)pos[row] * (float)inv;
          const double rev = (double)ang * 0.15915494309189535;
          const double fr = rev - floor(rev);
          const float aa = (float)(fr * 6.283185307179586);
          tab[row * 16 + i] = cosf(aa); tab[row * 16 + 8 + i] = sinf(aa); } }
    { bf16_t* XN = (bf16_t*)(ws + WS_XN); float* rsq = (float*)(ws + WS_RSQ);
      for (int m = gw; m < M; m += NGW) row_to_bf16_sq(a.in[0] + (size_t)m * DM, XN + (size_t)m * DM, rsq + (size_t)m * 4, lane); }
}

#ifndef PG8_SP2
#define PG8_SP2 true
#endif
#ifndef PG8_ALIGN
#define PG8_ALIGN true
#endif

struct SchedC {
    int vcu, G; attn_body::bf16* QKV; attn_body::bf16* OCA;
    __device__ __forceinline__ bool next(int it, attn_body::AttnUnit& u) const {
        constexpr long P = attn_body::PITCH;
        const int per = 6, s = vcu + (it / per) * G, k = (it % per) >> 1, pass = it & 1;
        if (s >= 256) return false;
        const int x = s >> 5, l = s & 31, i = l & 15, hl = (l >> 4) * 3 + k;
        const int qb = (k == 0) ? i : (k == 1) ? ((i + 8) & 15) : (i < 8 ? 14 - 2 * i : 31 - 2 * i);
        const int bj = x * 6 + hl, b = bj / 12, j = bj % 12, h = j >> 1;
        const long rowbase = (long)b * SEQ, q0 = (long)qb * 256;
        u.Q = QKV + (rowbase + q0) * P + j * 64; u.K = QKV + rowbase * P + 768 + j * 64; u.V = QKV + rowbase * P + 1536 + h * 128 + pass * 64;
        u.O = pass ? QKV + (rowbase + q0) * P + j * 64 : OCA + (rowbase + q0) * 768 + j * 64; u.ors = pass ? P : 768; u.rs = P;
        u.NT = 4 * qb + 4; u.moff = (int)q0; u.lse = nullptr; u.lrs = 0;
        return true;
    }
};
struct SchedD {
    int vcu, G; attn_body::bf16* QKV; float* LSE;
    __device__ __forceinline__ bool next(int it, attn_body::AttnUnit& u) const {
        constexpr long P = attn_body::PITCH;
        const int ud = vcu + it * G; if (ud >= 768) return false;
        const int b = ud / 192, rem = ud % 192, head = rem >> 4, idx = rem & 15, g = head >> 2;
        const int dl = (g == 0) ? 1 : (g == 1 ? 4 : 16), nb = 16 / dl, r = idx / nb, qb = idx % nb;
        const long rowbase = (long)b * SEQ + r; const int q0 = 256 * qb, kstart = (q0 >= 128) ? q0 - 128 : 0;
        u.rs = (long)dl * P; u.ors = u.rs; u.lrs = (long)dl * 12;
        u.Q = QKV + (rowbase + (long)q0 * dl) * P + 2304 + head * 64; u.O = QKV + (rowbase + (long)q0 * dl) * P + 2304 + head * 64;
        u.K = QKV + (rowbase + (long)kstart * dl) * P + 3072 + head * 64; u.V = QKV + (rowbase + (long)kstart * dl) * P + 3840 + head * 64;
        u.NT = (q0 + 256 - kstart) / 64; u.moff = q0 - kstart; u.lse = LSE + (rowbase + (long)q0 * dl) * 12 + head;
        return true;
    }
};
__device__ __forceinline__ void post_attention_phase(Frame& F, const Args& a, unsigned char* ws) {
    const bf16_t* QKV = (const bf16_t*)(ws + WS_QKV); const bf16_t* OCA = (const bf16_t*)(ws + WS_OCA); const float* LSE = (const float*)(ws + WS_LSE);
    bf16_t* Y1 = (bf16_t*)(ws + WS_XN);
    const int lane = lane_id(), gw = F.vcu * NWAVES + F.wave, NGW = F.G * NWAVES;
    const float lam = __expf(wave_sum(a.in[13][lane] * a.in[14][lane])) - __expf(wave_sum(a.in[15][lane] * a.in[16][lane])) + LAMBDA_INIT;
    const float g0 = a.in[17][lane] * (1.f - LAMBDA_INIT), g1 = a.in[17][64 + lane] * (1.f - LAMBDA_INIT);
    for (int row = gw; row < M; row += NGW) {
        const bf16_t* qa = OCA + (size_t)row * 768; const bf16_t* qb = QKV + (size_t)row * N_QKV;
        bf16_t* y = Y1 + (size_t)row * DM;
#pragma unroll
        for (int h = 0; h < 6; ++h) {
            const float c0 = bf2f(qa[(2 * h) * 64 + lane]) - lam * bf2f(qa[(2 * h + 1) * 64 + lane]);
            const float c1 = bf2f(qb[(2 * h) * 64 + lane]) - lam * bf2f(qb[(2 * h + 1) * 64 + lane]);
            const float r = rsqrtf(wave_sum(c0 * c0 + c1 * c1) * (1.f / 128.f) + EPS);
            y[h * 128 + lane] = f2bf(c0 * r * g0); y[h * 128 + 64 + lane] = f2bf(c1 * r * g1);
        }
#pragma unroll
        for (int hh = 0; hh < 4; ++hh) {
            const float l0 = LSE[(size_t)row * 12 + hh], l1 = LSE[(size_t)row * 12 + 4 + hh], l2 = LSE[(size_t)row * 12 + 8 + hh];
            const float mx = fmaxf(l0, fmaxf(l1, l2));
            const float w0 = __builtin_amdgcn_exp2f(l0 - mx), w1 = __builtin_amdgcn_exp2f(l1 - mx), w2 = __builtin_amdgcn_exp2f(l2 - mx);
            const float o = w0 * bf2f(qb[2304 + hh * 64 + lane]) + w1 * bf2f(qb[2304 + (4 + hh) * 64 + lane]) + w2 * bf2f(qb[2304 + (8 + hh) * 64 + lane]);
            y[768 + hh * 64 + lane] = f2bf(o / (w0 + w1 + w2));
        }
    }
}

constexpr int MXP = 136;
__device__ __forceinline__ void mixer_phase(Frame& F, const Args& a, unsigned char* ws) {
    const bf16_t* P = (const bf16_t*)(ws + WS_P); bf16_t* Y = (bf16_t*)(ws + WS_Y);
    const bf16_t* Wb = (const bf16_t*)(ws + WS_WSB); const bf16_t* PWt = (const bf16_t*)(ws + WS_PWT);
    const float* v_gain = a.in[6]; const float* b_s = a.in[8]; const float* pool_scale = a.in[10];
    LAS bf16_t* T = (LAS bf16_t*)(F.lds + RING_OFF);
    LAS float* rs = (LAS float*)(F.lds + RING_OFF + 128 * MXP * 2);
    const int tid = tid_id(), wid = tid >> 6, lane = tid & 63, fr = lane & 15, fq = lane >> 4;
    for (int u = F.vcu; u < 1024; u += F.G) {
        const bool isA = u < 512; const int blk = (u & 511) >> 2, g = u & 3, row0 = blk * 128;
        f32x4 acc[8];
#pragma unroll
        for (int j = 0; j < 8; ++j) acc[j] = (f32x4){0.f, 0.f, 0.f, 0.f};
        if (isA) {
            for (int i = 0; i < 16; ++i) { const int sr = wid * 16 + i;
                const bf16x8 x = *(const bf16x8*)(P + (size_t)(row0 + sr) * N_IN0 + 512 + lane * 8);
                float q = 0.f;
#pragma unroll
                for (int e = 0; e < 8; ++e) { const float f = bf2f((bf16_t)x[e]); q += f * f; }
                q = wave_sum(q);
                if (lane == 0) rs[sr] = rsqrtf(q * (1.f / 512.f) + EPS); }
            __syncthreads();
            for (int it = tid; it < 128 * 16; it += 512) { const int sr = it >> 4, cc = it & 15;
                const bf16x8 x = *(const bf16x8*)(P + (size_t)(row0 + sr) * N_IN0 + 512 + g * 128 + cc * 8);
                const float r = rs[sr];
#pragma unroll
                for (int e = 0; e < 8; ++e) T[(cc * 8 + e) * MXP + sr] = f2bf(bf2f((bf16_t)x[e]) * r * v_gain[g * 128 + cc * 8 + e]); }
            __syncthreads();
            const bf16_t* wrow = Wb + ((size_t)g * 128 + wid * 16 + fr) * 128 + fq * 8;
            const int nks = (wid >> 1) + 1;
            for (int ks = 0; ks < nks; ++ks) {
                const bf16x8 af = *(const bf16x8*)(wrow + ks * 32);
#pragma unroll
                for (int j = 0; j < 8; ++j) { const bf16x8 bfr = *(const LAS bf16x8*)(T + (j * 16 + fr) * MXP + ks * 32 + fq * 8);
                    acc[j] = __builtin_amdgcn_mfma_f32_16x16x32_bf16(bfr, af, acc[j], 0, 0, 0); }
            }
            const int t = wid * 16 + fr; const float bias = b_s[g * 128 + t];
#pragma unroll
            for (int j = 0; j < 8; ++j) { const int col = g * 128 + j * 16 + fq * 4;
                const u32x2 uu = *(const u32x2*)(P + (size_t)(row0 + t) * N_IN0 + col);
                const float u0 = __uint_as_float(uu.x << 16), u1 = __uint_as_float(uu.x & 0xffff0000u), u2 = __uint_as_float(uu.y << 16), u3 = __uint_as_float(uu.y & 0xffff0000u);
                u32x2 o; o.x = pk2bf(u0 * (acc[j][0] + bias), u1 * (acc[j][1] + bias)); o.y = pk2bf(u2 * (acc[j][2] + bias), u3 * (acc[j][3] + bias));
                *(u32x2*)(Y + (size_t)(row0 + t) * DM + col) = o; }
        } else {
            const int w = 2 << g; const float inv_w = 1.f / (float)w;
            { const int cc = tid & 15, rg = tid >> 4, r0 = row0 + rg * 4;
              const bf16_t* xp = P + 1024 + g * 128 + cc * 8;
              float sum[8];
#pragma unroll
              for (int e = 0; e < 8; ++e) sum[e] = 0.f;
              const int t0 = r0 & (SEQ - 1);
              for (int jj = 1; jj < w; ++jj) { if (t0 - jj >= 0) { const bf16x8 x = *(const bf16x8*)(xp + (size_t)(r0 - jj) * N_IN0);
#pragma unroll
                      for (int e = 0; e < 8; ++e) sum[e] += bf2f((bf16_t)x[e]); } }
#pragma unroll
              for (int i = 0; i < 4; ++i) { const int row = r0 + i, ts = t0 + i;
                  const bf16x8 x = *(const bf16x8*)(xp + (size_t)row * N_IN0);
                  float xv[8];
#pragma unroll
                  for (int e = 0; e < 8; ++e) { xv[e] = bf2f((bf16_t)x[e]); sum[e] += xv[e]; }
                  const float ic = (ts + 1 < w) ? 1.f / (float)(ts + 1) : inv_w;
                  u32x4 o; o.x = pk2bf(sum[0] * ic - xv[0], sum[1] * ic - xv[1]); o.y = pk2bf(sum[2] * ic - xv[2], sum[3] * ic - xv[3]);
                  o.z = pk2bf(sum[4] * ic - xv[4], sum[5] * ic - xv[5]); o.w = pk2bf(sum[6] * ic - xv[6], sum[7] * ic - xv[7]);
                  *(LAS u32x4*)(T + (rg * 4 + i) * MXP + cc * 8) = o;
                  if (ts - (w - 1) >= 0) { const bf16x8 xo = *(const bf16x8*)(xp + (size_t)(row - (w - 1)) * N_IN0);
#pragma unroll
                      for (int e = 0; e < 8; ++e) sum[e] -= bf2f((bf16_t)xo[e]); } } }
            __syncthreads();
            const bf16_t* prow = PWt + ((size_t)g * 128 + fr) * 128 + fq * 8;
#pragma unroll
            for (int ks = 0; ks < 4; ++ks) {
                const bf16x8 af = *(const LAS bf16x8*)(T + (wid * 16 + fr) * MXP + ks * 32 + fq * 8);
#pragma unroll
                for (int j = 0; j < 8; ++j) { const bf16x8 bfr = *(const bf16x8*)(prow + (size_t)(j * 16) * 128 + ks * 32);
                    acc[j] = __builtin_amdgcn_mfma_f32_16x16x32_bf16(bfr, af, acc[j], 0, 0, 0); }
            }
            const int t = wid * 16 + fr;
#pragma unroll
            for (int j = 0; j < 8; ++j) { const int d = g * 128 + j * 16 + fq * 4; const f32x4 sc = *(const f32x4*)(pool_scale + d);
                u32x2 o; o.x = pk2bf(acc[j][0] * sc[0], acc[j][1] * sc[1]); o.y = pk2bf(acc[j][2] * sc[2], acc[j][3] * sc[3]);
                *(u32x2*)(Y + (size_t)(row0 + t) * DM + 512 + d) = o; }
        }
        __syncthreads();
    }
}

__device__ __forceinline__ void ffn_fix_phase(Frame& F, const Args& a, unsigned char* ws, int layer) {
    bf16_t* HM = (bf16_t*)(ws + WS_HMID);
    const float* halo = (const float*)(ws + WS_HALO); const float* tops = (const float*)(ws + WS_TOPS); const float* topg = (const float*)(ws + WS_TOPG);
    const float* cw = a.in[20] + (size_t)layer * 3 * DFF;
    const int tid = tid_id();
    constexpr int CPR = DFF / 4;
    for (int it = F.vcu * (NWAVES * 64) + tid; it < 64 * 2 * CPR; it += F.G * NWAVES * 64) {
        const int pm = it / (2 * CPR), rem = it % (2 * CPR), rr = rem / CPR, c = (rem % CPR) * 4;
        if ((pm & 15) == 0) continue;
        const size_t off = ((size_t)pm * 2 + rr) * DFF + c;
        f32x4 sv = *(const f32x4*)(tops + off); const f32x4 g = *(const f32x4*)(topg + off);
        const f32x4 h1 = *(const f32x4*)(halo + ((size_t)(pm - 1) * 2 + 1) * DFF + c), h0 = *(const f32x4*)(halo + ((size_t)(pm - 1) * 2 + 0) * DFF + c);
        const f32x4 w0 = *(const f32x4*)(cw + c), w1 = *(const f32x4*)(cw + DFF + c);
        if (rr == 0) sv = sv + w1 * h1 + w0 * h0; else sv = sv + w0 * h1;
        u32x2 o; o.x = pk2bf(gelu_tanh(sv[0]) * g[0], gelu_tanh(sv[1]) * g[1]); o.y = pk2bf(gelu_tanh(sv[2]) * g[2], gelu_tanh(sv[3]) * g[3]);
        *(u32x2*)(HM + (size_t)(pm * 256 + rr) * DFF + c) = o;
    }
}

#define OPQ_S(x) asm volatile("" : "+s"(x))
__device__ __forceinline__ Frame make_frame(unsigned char* ws) {
    extern __shared__ __attribute__((aligned(16))) unsigned char lds_[];
    Frame F;
    F.lds = (LAS unsigned char*)lds_;
    F.MISC = (volatile LAS unsigned*)(F.lds + MISC_OFF);
    F.wave = __builtin_amdgcn_readfirstlane((int)threadIdx.x >> 6);
    int G = gridDim.x, bx = blockIdx.x; OPQ_S(G); OPQ_S(bx);
    F.G = G; F.vcu = (G % 8 == 0) ? (bx % 8) * (G / 8) + bx / 8 : bx;
    F.ctl = (gu32*)(ws + WS_CTL);
    return F;
}
__global__ void __launch_bounds__(NWAVES * 64, 2) mk_fwd(Args args) {
    extern __shared__ __attribute__((aligned(16))) unsigned char lds[];
    for (int u = threadIdx.x; u < (LDS_BYTES - LDSCTL_OFF) / 4; u += NWAVES * 64) ((LAS unsigned*)((LAS unsigned char*)lds + LDSCTL_OFF))[u] = 0u;
    __syncthreads();
    const int lo = args.ph_lo, hi = args.ph_hi;
    if (hi - lo > 1) { unsigned char* ws = args.ws; (void)xcd_barrier_post((unsigned*)((gu32*)(ws + WS_CTL) + CW_BAR), (volatile LAS unsigned*)((LAS unsigned char*)lds + MISC_OFF) + 8); }
#ifdef MK_DIAG
    if (blockIdx.x == 0 && threadIdx.x == 0) ((unsigned long long*)(args.ws + WS_CTL + 524288))[31] = __builtin_amdgcn_s_memrealtime();
#endif
    int pc = 0;
#define PHASE_BEGIN if (pc >= lo && pc < hi) { size_t z_ = 0; OPQ_S(z_); unsigned char* ws = args.ws + z_; float* out = args.out + z_; Frame F = make_frame(ws); bf16_t* XN = (bf16_t*)(ws + WS_XN); (void)XN; (void)out;
#ifdef MK_DIAG
#define DIAG_STAMP(k) do { if (blockIdx.x == 0 && threadIdx.x == 0) ((unsigned long long*)(ws + WS_CTL + 524288))[(k)] = __builtin_amdgcn_s_memrealtime(); } while (0)
#else
#define DIAG_STAMP(k) do { } while (0)
#endif
#define PHASE_END if (pc + 1 < hi) { XcdBarrier bar; bar.bar = (unsigned*)(F.ctl + CW_BAR); bar.x = xb_xcc_id(); bar.st = F.MISC + 8; xcd_barrier(bar); } DIAG_STAMP(pc); } ++pc;

    PHASE_BEGIN p0_prologue(F, args); PHASE_END
    PHASE_BEGIN
        pg8::Gemm g{XN, (const bf16_t*)(ws + WS_W_IN0), M, N_IN0, DM}; pg8::StaticOrder S; S.init(M, N_IN0, F.G, (int)blockIdx.x);
        pg8::EpiBf16G E{(bf16_t*)(ws + WS_P), N_IN0, 4, (const float*)(ws + WS_RSQ)};
        pg8::gemm_phase<pg8::EpiBf16G, pg8::StaticOrder, PG8_ALIGN, PG8_SP2>(F.lds + RING_OFF, g, S, E);
    PHASE_END
    PHASE_BEGIN mixer_phase(F, args, ws); PHASE_END
    PHASE_BEGIN
        pg8::Gemm g{(const bf16_t*)(ws + WS_Y), (const bf16_t*)(ws + WS_W_OUT0), M, DM, DM}; pg8::StaticOrder S; S.init(M, DM, F.G, (int)blockIdx.x);
        pg8::EpiRes E{args.in[0], out, XN, (float*)(ws + WS_RSQ)};
        pg8::gemm_phase<pg8::EpiRes, pg8::StaticOrder, PG8_ALIGN, PG8_SP2>(F.lds + RING_OFF, g, S, E);
    PHASE_END
#define RMS_PHASE(gain_ptr) PHASE_BEGIN { const float* gain = (gain_ptr); const int lane = lane_id(); const int gw = F.vcu * NWAVES + F.wave, NGW = F.G * NWAVES; \
        for (int m = gw; m < M; m += NGW) rms_row_to_bf16(out + (size_t)m * DM, gain, XN + (size_t)m * DM, lane); } PHASE_END
#define UP_PHASE(layer) PHASE_BEGIN { pg8::Gemm g{XN, (const bf16_t*)(ws + WS_W_UP) + (size_t)(layer) * NUP * DM, M, NUP, DM}; pg8::StaticOrder S; S.init(M, NUP, F.G, (int)blockIdx.x); \
        pg8::EpiUpConv E{(bf16_t*)(ws + WS_HMID), args.in[20] + (size_t)(layer) * 3 * DFF, args.in[21] + (size_t)(layer) * DFF, (float*)(ws + WS_HALO), (float*)(ws + WS_TOPS), (float*)(ws + WS_TOPG), (const float*)(ws + WS_RSQ)}; \
        pg8::gemm_phase<pg8::EpiUpConv, pg8::StaticOrder, true, PG8_SP2>(F.lds + RING_OFF, g, S, E); } PHASE_END
#define DOWN_PHASE(layer) PHASE_BEGIN { pg8::Gemm g{(const bf16_t*)(ws + WS_HMID), (const bf16_t*)(ws + WS_W_DN) + (size_t)(layer) * DM * DFF, M, DM, DFF}; pg8::StaticOrder S; S.init(M, DM, F.G, (int)blockIdx.x); \
        pg8::EpiRes E{out, out, XN, (float*)(ws + WS_RSQ)}; \
        pg8::gemm_phase<pg8::EpiRes, pg8::StaticOrder, PG8_ALIGN, PG8_SP2>(F.lds + RING_OFF, g, S, E); } PHASE_END
    UP_PHASE(0)
    PHASE_BEGIN ffn_fix_phase(F, args, ws, 0); PHASE_END
    DOWN_PHASE(0)
    PHASE_BEGIN
        pg8::Gemm g{XN, (const bf16_t*)(ws + WS_W_QKV), M, N_QKV, DM}; pg8::StaticOrder S; S.init(M, N_QKV, F.G, (int)blockIdx.x);
        pg8::EpiQKV E{(bf16_t*)(ws + WS_QKV), (const float*)(ws + WS_ROPE), (const float*)(ws + WS_RSQ)};
        pg8::gemm_phase<pg8::EpiQKV, pg8::StaticOrder, PG8_ALIGN, PG8_SP2>(F.lds + RING_OFF, g, S, E);
    PHASE_END
    PHASE_BEGIN
        { const SchedC SC{F.vcu, F.G, (attn_body::bf16*)(ws + WS_QKV), (attn_body::bf16*)(ws + WS_OCA)};
          attn_body::attn_phase<SchedC, 8, false>((char*)lds + RING_OFF, SC); }
        { const SchedD SD{F.vcu, F.G, (attn_body::bf16*)(ws + WS_QKV), (float*)(ws + WS_LSE)};
          attn_body::attn_phase<SchedD, 8, true>((char*)lds + RING_OFF, SD); }
    PHASE_END
    PHASE_BEGIN post_attention_phase(F, args, ws); PHASE_END
    PHASE_BEGIN
        pg8::Gemm g{XN, (const bf16_t*)(ws + WS_W_OUT1), M, DM, DM}; pg8::StaticOrder S; S.init(M, DM, F.G, (int)blockIdx.x);
        pg8::EpiRes E{out, out, XN, (float*)(ws + WS_RSQ)};
        pg8::gemm_phase<pg8::EpiRes, pg8::StaticOrder, PG8_ALIGN, PG8_SP2>(F.lds + RING_OFF, g, S, E);
    PHASE_END
    UP_PHASE(1)
    PHASE_BEGIN ffn_fix_phase(F, args, ws, 1); PHASE_END
    DOWN_PHASE(1)
    PHASE_BEGIN
        const int lane = lane_id(); const int gw = F.vcu * NWAVES + F.wave, NGW = F.G * NWAVES;
        for (int m = gw; m < M; m += NGW) rms_row_inplace_rsq(out + (size_t)m * DM, args.in[4], (const float*)(ws + WS_RSQ) + (size_t)m * 4, lane);
    PHASE_END
#ifdef MK_DIAG
    __syncthreads();
    if (blockIdx.x == 0 && threadIdx.x < 64) {
        asm volatile("s_waitcnt vmcnt(0)" ::: "memory");
        const unsigned long long* st = (const unsigned long long*)(args.ws + WS_CTL + 524288);
        const unsigned long long a1 = __hip_atomic_load(st + MK_DIAG_SEL1, __ATOMIC_RELAXED, __HIP_MEMORY_SCOPE_AGENT), b1 = __hip_atomic_load(st + (MK_DIAG_SEL1 == 0 ? 31 : MK_DIAG_SEL1 - 1), __ATOMIC_RELAXED, __HIP_MEMORY_SCOPE_AGENT);
        const unsigned long long a2 = __hip_atomic_load(st + MK_DIAG_SEL2, __ATOMIC_RELAXED, __HIP_MEMORY_SCOPE_AGENT), b2 = __hip_atomic_load(st + (MK_DIAG_SEL2 == 0 ? 31 : MK_DIAG_SEL2 - 1), __ATOMIC_RELAXED, __HIP_MEMORY_SCOPE_AGENT);
        const float d1 = (float)(long long)(a1 - b1) * 0.01f, d2 = (float)(long long)(a2 - b2) * 0.01f;
        for (int i = threadIdx.x; i <= 4096; i += 64) args.out[i] = (i == 0) ? d1 : d2;
    }
#endif
#undef PHASE_BEGIN
#undef PHASE_END
}
constexpr int N_PHASES = 15;

#ifndef MK_N_LAUNCHES
#define MK_N_LAUNCHES 1
#endif
extern "C" void kernel_launch(void* const* d_in, const int* in_sizes, int n_in, void* d_out, int out_size, void* d_ws, size_t ws_size, hipStream_t stream) {
    static int grid = 0;
    if (grid == 0) {
        int dev = 0, cus = 0;
        if (hipGetDevice(&dev) != hipSuccess || hipDeviceGetAttribute(&cus, hipDeviceAttributeMultiprocessorCount, dev) != hipSuccess) { fprintf(stderr, "kernel_launch: device query failed\n"); grid = -1; return; }
        if (hipFuncSetAttribute((const void*)mk_fwd, hipFuncAttributeMaxDynamicSharedMemorySize, LDS_BYTES) != hipSuccess) { fprintf(stderr, "kernel_launch: hipFuncSetAttribute failed\n"); grid = -1; return; }
        int per_cu = 0;
        if (hipOccupancyMaxActiveBlocksPerMultiprocessor(&per_cu, (const void*)mk_fwd, NWAVES * 64, LDS_BYTES) != hipSuccess || per_cu < 1) fprintf(stderr, "kernel_launch: occupancy query reports %d workgroups per CU\n", per_cu);
        (void)hipGetLastError();
        grid = cus > 0 ? cus : 256;
    }
    if (grid < 0) return;
    unsigned char* ws = (unsigned char*)d_ws;
    (void)hipMemsetAsync(ws + WS_CTL, 0, CTL_ZERO_BYTES, stream);
    Args a{};
    for (int i = 0; i < 23; ++i) a.in[i] = (const float*)d_in[i];
    a.out = (float*)d_out; a.ws = ws;
    if (MK_N_LAUNCHES == 1) {
        a.ph_lo = 0; a.ph_hi = N_PHASES;
        hipLaunchKernelGGL(mk_fwd, dim3(grid), dim3(NWAVES * 64), LDS_BYTES, stream, a);
    } else {
        for (int p = 0; p < N_PHASES; ++p) { a.ph_lo = p; a.ph_hi = p + 1; hipLaunchKernelGGL(mk_fwd, dim3(grid), dim3(NWAVES * 64), LDS_BYTES, stream, a); }
    }
}
```

```cpp
#include <hip/hip_runtime.h>
#include <cstdint>
#include <cstdio>

typedef unsigned short bf16_t;
typedef short bf16x8 __attribute__((ext_vector_type(8)));
typedef float f32x4 __attribute__((ext_vector_type(4)));
typedef float f32x2 __attribute__((ext_vector_type(2)));
typedef unsigned u32x4 __attribute__((ext_vector_type(4)));
typedef unsigned u32x2 __attribute__((ext_vector_type(2)));

constexpr int BATCH = 4, SEQ = 4096, DM = 1024, M = BATCH * SEQ;
constexpr int DFF = 2816, NUP = 2 * DFF;
constexpr int N_IN0 = 1536, N_QKV = 4608;
constexpr float EPS = 1e-6f;
constexpr float LAMBDA_INIT = 0.35550906759f;

__device__ __forceinline__ float bf2f(bf16_t v) { return __uint_as_float(((unsigned)v) << 16); }
__device__ __forceinline__ bf16_t f2bf(float f) { unsigned u = __float_as_uint(f); return (bf16_t)((u + 0x7fffu + ((u >> 16) & 1u)) >> 16); }
__device__ __forceinline__ unsigned pk2bf(float lo, float hi) { return (unsigned)f2bf(lo) | ((unsigned)f2bf(hi) << 16); }
__device__ __forceinline__ float gelu_tanh(float x) {
    const float y = x * (0.7978845608028654f + 0.035677408136300125f * x * x);
    return x * __builtin_amdgcn_rcpf(1.0f + __builtin_amdgcn_exp2f(-2.8853900817779268f * y));
}
template <int CTRL> __device__ __forceinline__ float dpp_f(float v) { return __int_as_float(__builtin_amdgcn_update_dpp(0, __float_as_int(v), CTRL, 0xf, 0xf, true)); }
__device__ __forceinline__ float swz_xor16(float v) { return __int_as_float(__builtin_amdgcn_ds_swizzle(__float_as_int(v), 0x401F)); }
__device__ __forceinline__ float wave_sum(float v) {
    v += dpp_f<0xB1>(v);
    v += dpp_f<0x4E>(v);
    v += dpp_f<0x141>(v);
    v += dpp_f<0x140>(v);
    v += swz_xor16(v);
    const auto rr = __builtin_amdgcn_permlane32_swap(__float_as_uint(v), __float_as_uint(v), false, false);
    return __uint_as_float(rr[0]) + __uint_as_float(rr[1]);
}

constexpr size_t MiB = 1u << 20;
constexpr size_t WS_CTL = 0, CTL_ZERO_BYTES = 1 * MiB;
constexpr size_t WS_W_IN0 = 1 * MiB;
constexpr size_t WS_W_OUT0 = 4 * MiB;
constexpr size_t WS_W_QKV = 6 * MiB;
constexpr size_t WS_W_OUT1 = 15 * MiB;
constexpr size_t WS_W_UP = 17 * MiB;
constexpr size_t WS_W_DN = 39 * MiB;
constexpr size_t WS_ROPE = 50 * MiB;
constexpr size_t WS_WSB = 51 * MiB;
constexpr size_t WS_PWT = 51 * MiB + 256 * 1024;
constexpr size_t WS_XN = 52 * MiB;
constexpr size_t WS_BUF = 84 * MiB;
constexpr size_t WS_P = WS_BUF, WS_Y = 132 * MiB;
constexpr size_t WS_HB2 = WS_BUF;
constexpr size_t WS_HMID = 116 * MiB;
constexpr size_t WS_HALO = 204 * MiB, WS_TOPS = 206 * MiB, WS_TOPG = 208 * MiB;
constexpr size_t WS_QKV = WS_BUF;
constexpr size_t WS_OCA = 228 * MiB;
constexpr size_t WS_RSQ = 253 * MiB;
constexpr size_t WS_LSE = 252 * MiB;
namespace pg8 {
#define PG8_LAS __attribute__((address_space(3)))
typedef unsigned short bf16_t;
typedef short bf16x8 __attribute__((ext_vector_type(8)));
typedef float f32x4 __attribute__((ext_vector_type(4)));
typedef unsigned u32x4 __attribute__((ext_vector_type(4)));
constexpr int BM = 256, BK = 64, HALF = 128, HTB = HALF * BK * 2  , STAGE_BYTES = 8 * HTB, NXCD = 8, WGM = 8;

__host__ __device__ __forceinline__ int lds_byte(int r, int c) { const int st = (r >> 4) * 2 + (c >> 5), rr = r & 15, cc = c & 31, ob = rr * 64 + cc * 2; return st * 1024 + (ob ^ (((ob >> 9) & 1) << 5)); }
__host__ __device__ __forceinline__ void stage_rc(int b, int& R, int& C) { const int st = b / 1024, sb = b % 1024, swz = sb ^ (((sb >> 9) & 1) << 5); R = (st >> 1) * 16 + swz / 64; C = (st & 1) * 32 + (swz % 64) / 2; }
__host__ __device__ __forceinline__ int perm32(int rho) { const int n = rho >> 4, i = rho & 15; return 8 * (i >> 2) + 4 * n + (i & 3); }

struct Unit { int pm, pn; };
struct Gemm { const bf16_t* A; const bf16_t* Bt; int M, N, K; };

struct StaticOrder {
    int nM, nN, nwg, G, c;
    __host__ __device__ void init(int M, int N, int G_, int c_) { nM = M / BM; nN = N / BM; nwg = nM * nN; G = G_; c = c_; }
    __host__ __device__ bool next(int i, Unit& u) const {
        const long L = (long)i * G + c; if (L >= nwg) return false;
        int wgid = (int)L; { const int q = nwg / NXCD, r = nwg % NXCD, xcd = wgid % NXCD, off = wgid / NXCD; wgid = (xcd < r ? xcd * (q + 1) : r * (q + 1) + (xcd - r) * q) + off; }
        const int nig = WGM * nN, gid = wgid / nig, fm = gid * WGM, gsz = (nM - fm) < WGM ? (nM - fm) : WGM;
        u.pm = fm + ((wgid % nig) % gsz); u.pn = (wgid % nig) / gsz; return true;
    }
    __device__ __forceinline__ void a_ready(const Unit&) const {}
    __device__ __forceinline__ void done(const Unit&) const {}
};


__device__ __forceinline__ unsigned cvt_pk_bf16(float lo, float hi) { unsigned r; asm volatile("v_cvt_pk_bf16_f32 %0, %1, %2" : "=v"(r) : "v"(lo), "v"(hi)); return r; }

__device__ __forceinline__ float rstd_of(const f32x4 p) { return rsqrtf(((p[0] + p[1]) + (p[2] + p[3])) * (1.f / 1024.f) + 1e-6f); }
struct EpiBf16G {
    static constexpr bool PERM = true, AFTER_DRAIN = false;
    bf16_t* O; int ldc; int gelu_tiles; const float* rsq;
    __device__ __forceinline__ void operator()(const f32x4 (&acc)[2][2][4][2], const Unit& u, int wr, int wc, int fr, int fq) const {
        const int row0 = u.pm * BM + wr * 64 + fr, col0 = u.pn * BM + wc * 32 + 8 * fq;
        const bool g = u.pn < gelu_tiles;
        f32x4 pr[2][4];
#pragma unroll
        for (int ai = 0; ai < 2; ++ai)
#pragma unroll
            for (int m = 0; m < 4; ++m) pr[ai][m] = *(const f32x4*)(rsq + (size_t)(row0 + ai * HALF + m * 16) * 4);
#pragma unroll
        for (int ai = 0; ai < 2; ++ai)
#pragma unroll
            for (int m = 0; m < 4; ++m) { bf16_t* rowp = O + (size_t)(row0 + ai * HALF + m * 16) * ldc + col0; const float rstd = rstd_of(pr[ai][m]);
#pragma unroll
                for (int bj = 0; bj < 2; ++bj) { f32x4 v0 = acc[ai][bj][m][0] * rstd, v1 = acc[ai][bj][m][1] * rstd;
                    if (g) { v0 = (f32x4){gelu_tanh(v0[0]), gelu_tanh(v0[1]), gelu_tanh(v0[2]), gelu_tanh(v0[3])}; v1 = (f32x4){gelu_tanh(v1[0]), gelu_tanh(v1[1]), gelu_tanh(v1[2]), gelu_tanh(v1[3])}; }
                    u32x4 w; w.x = cvt_pk_bf16(v0[0], v0[1]); w.y = cvt_pk_bf16(v0[2], v0[3]); w.z = cvt_pk_bf16(v1[0], v1[1]); w.w = cvt_pk_bf16(v1[2], v1[3]);
                    *(u32x4*)(rowp + bj * HALF) = w; } }
    }
};
constexpr int XCH_LDS_OFF = 132096;
struct EpiRes {
    static constexpr bool PERM = false, AFTER_DRAIN = false;
    const float* base; float* out; bf16_t* hb; float* rsq;
    __device__ __forceinline__ void operator()(const f32x4 (&acc)[2][2][4][2], const Unit& u, int wr, int wc, int fr, int fq) const {
        extern __shared__ __attribute__((aligned(16))) unsigned char lds_all_[];
        PG8_LAS float* S = (PG8_LAS float*)((PG8_LAS unsigned char*)lds_all_ + XCH_LDS_OFF);
        const int row0 = u.pm * BM + wr * 64 + fr, col0 = u.pn * BM + wc * 32 + 4 * fq;
#pragma unroll
        for (int ai = 0; ai < 2; ++ai)
#pragma unroll
            for (int m = 0; m < 4; ++m) { const int row = row0 + ai * HALF + m * 16; const size_t off = (size_t)row * 1024 + col0; float q = 0.f;
#pragma unroll
                for (int bj = 0; bj < 2; ++bj)
#pragma unroll
                    for (int n = 0; n < 2; ++n) { const f32x4 b = *(const f32x4*)(base + off + bj * HALF + n * 16); const f32x4 h = b + acc[ai][bj][m][n];
                        *(f32x4*)(out + off + bj * HALF + n * 16) = h; q += (h[0] * h[0] + h[1] * h[1]) + (h[2] * h[2] + h[3] * h[3]);
                        if (hb) { u32x2 w; w.x = cvt_pk_bf16(h[0], h[1]); w.y = cvt_pk_bf16(h[2], h[3]); *(u32x2*)(hb + off + bj * HALF + n * 16) = w; } }
                q += swz_xor16(q);
                { const auto rr = __builtin_amdgcn_permlane32_swap(__float_as_uint(q), __float_as_uint(q), false, false); q = __uint_as_float(rr[0]) + __uint_as_float(rr[1]); }
                if (fq == 0) S[(ai * HALF + wr * 64 + m * 16 + fr) * 4 + wc] = q; }
        asm volatile("s_waitcnt lgkmcnt(0)" ::: "memory"); __builtin_amdgcn_s_barrier(); asm volatile("" ::: "memory");
        const int t = (int)threadIdx.x;
        if (t < 256) { const f32x4 p = *(const PG8_LAS f32x4*)(S + t * 4); rsq[(size_t)(u.pm * BM + t) * 4 + u.pn] = (p[0] + p[1]) + (p[2] + p[3]); }
    }
};
constexpr float ATT_C2 = 0.125f * 1.4426950408889634f;
struct EpiQKV {
    static constexpr bool PERM = true, AFTER_DRAIN = false;
    bf16_t* O; const float* rope; const float* rsq;
    __device__ __forceinline__ void operator()(const f32x4 (&acc)[2][2][4][2], const Unit& u, int wr, int wc, int fr, int fq) const {
        const int row0 = u.pm * BM + wr * 64 + fr, col0 = u.pn * BM + wc * 32 + 8 * fq;
        const int pn = u.pn;
        const bool is_rope = (pn < 6) || (pn >= 9 && pn < 15);
        const bool is_q = (pn < 3) || (pn >= 9 && pn < 12);
        const float sc = is_q ? ATT_C2 : 1.f;
        const bool do_rot = is_rope && ((wc & 1) == 0);
        const float sgn = (fq == 0) ? -1.f : 1.f;
        f32x4 pr[2][4];
#pragma unroll
        for (int ai = 0; ai < 2; ++ai)
#pragma unroll
            for (int m = 0; m < 4; ++m) pr[ai][m] = *(const f32x4*)(rsq + (size_t)(row0 + ai * HALF + m * 16) * 4);
#pragma unroll
        for (int ai = 0; ai < 2; ++ai)
#pragma unroll
            for (int m = 0; m < 4; ++m) { const int row = row0 + ai * HALF + m * 16; bf16_t* rowp = O + (size_t)row * 4608 + col0;
                f32x4 cs0 = {1.f, 1.f, 1.f, 1.f}, cs1 = cs0, sn0 = {0.f, 0.f, 0.f, 0.f}, sn1 = sn0;
                if (do_rot) { const f32x4* t = (const f32x4*)(rope + (size_t)row * 16); cs0 = t[0]; cs1 = t[1]; sn0 = t[2] * sgn; sn1 = t[3] * sgn; }
                const float rstd = rstd_of(pr[ai][m]) * sc;
#pragma unroll
                for (int bj = 0; bj < 2; ++bj) { f32x4 v0 = acc[ai][bj][m][0] * rstd, v1 = acc[ai][bj][m][1] * rstd;
                    if (do_rot) {
                        f32x4 p0, p1;
#pragma unroll
                        for (int e = 0; e < 4; ++e) { p0[e] = swz_xor16(v0[e]); p1[e] = swz_xor16(v1[e]); }
                        if (fq < 2) { v0 = v0 * cs0 + p0 * sn0; v1 = v1 * cs1 + p1 * sn1; }
                    }
                    u32x4 w; w.x = cvt_pk_bf16(v0[0], v0[1]); w.y = cvt_pk_bf16(v0[2], v0[3]); w.z = cvt_pk_bf16(v1[0], v1[1]); w.w = cvt_pk_bf16(v1[2], v1[3]);
                    *(u32x4*)(rowp + bj * HALF) = w; } }
    }
};

template <int CTRL> __device__ __forceinline__ f32x4 dpp4(f32x4 v) { return (f32x4){dpp_f<CTRL>(v[0]), dpp_f<CTRL>(v[1]), dpp_f<CTRL>(v[2]), dpp_f<CTRL>(v[3])}; }
struct EpiUpConv {
    static constexpr bool PERM = true, AFTER_DRAIN = false;
    bf16_t* HM; const float* cw; const float* cb; float* halo; float* tops; float* topg; const float* rsq;
    __device__ __forceinline__ void operator()(const f32x4 (&acc)[2][2][4][2], const Unit& u, int wr_, int wc_, int fr_, int fq_) const {
        int tid_ = threadIdx.x; asm volatile("" : "+v"(tid_));
        const int wid_ = __builtin_amdgcn_readfirstlane(tid_ >> 6), wr = wid_ >> 2, wc = wid_ & 3, fr = tid_ & 15, fq = (tid_ >> 4) & 3; (void)wr_; (void)wc_; (void)fr_; (void)fq_;
        extern __shared__ __attribute__((aligned(16))) unsigned char lds_all_[];
        PG8_LAS float* X = (PG8_LAS float*)((PG8_LAS unsigned char*)lds_all_ + XCH_LDS_OFF);
        const int cl = wc * 32 + 8 * fq, hc = u.pn * 128 + cl;
        float rstd[2][4];
        { f32x4 pr[2][4];
#pragma unroll
          for (int ai = 0; ai < 2; ++ai)
#pragma unroll
              for (int m = 0; m < 4; ++m) pr[ai][m] = *(const f32x4*)(rsq + (size_t)(u.pm * BM + ai * HALF + wr * 64 + m * 16 + fr) * 4);
#pragma unroll
          for (int ai = 0; ai < 2; ++ai)
#pragma unroll
              for (int m = 0; m < 4; ++m) rstd[ai][m] = rstd_of(pr[ai][m]); }
        if (fr >= 14) {
#pragma unroll
            for (int ai = 0; ai < 2; ++ai) { PG8_LAS float* xp = X + (((ai * 2 + wr) * 2 + (fr - 14)) * 128 + cl);
                *(PG8_LAS f32x4*)xp = acc[ai][0][3][0] * rstd[ai][3]; *(PG8_LAS f32x4*)(xp + 4) = acc[ai][0][3][1] * rstd[ai][3]; }
            if (wr == 1) { float* hp = halo + ((size_t)u.pm * 2 + (fr - 14)) * 2816 + hc; *(f32x4*)hp = acc[1][0][3][0] * rstd[1][3]; *(f32x4*)(hp + 4) = acc[1][0][3][1] * rstd[1][3]; }
        }
        asm volatile("s_waitcnt lgkmcnt(0)" ::: "memory"); __builtin_amdgcn_s_barrier(); asm volatile("" ::: "memory");
        const bool needs_fix = (u.pm & 15) != 0;
#pragma unroll
        for (int n = 0; n < 2; ++n) {
            const f32x4 w0 = *(const f32x4*)(cw + hc + 4 * n), w1 = *(const f32x4*)(cw + 2816 + hc + 4 * n), w2 = *(const f32x4*)(cw + 2 * 2816 + hc + 4 * n), bb = *(const f32x4*)(cb + hc + 4 * n);
#pragma unroll
            for (int ai = 0; ai < 2; ++ai) {
                f32x4 pa, pb;
                const bool has_pred = !(ai == 0 && wr == 0);
                const int pblk = (wr == 1) ? (ai * 2) : 1;
                if (has_pred) { pa = *(const PG8_LAS f32x4*)(X + ((pblk * 2 + 1) * 128 + cl + 4 * n)); pb = *(const PG8_LAS f32x4*)(X + ((pblk * 2 + 0) * 128 + cl + 4 * n)); }
                else { pa = (f32x4){0.f, 0.f, 0.f, 0.f}; pb = pa; }
                f32x4 r1p = pa, r2p = (fr == 1) ? pa : pb;
                size_t ho = (size_t)(u.pm * BM + ai * HALF + wr * 64 + fr) * 2816 + hc + 4 * n; asm volatile("" : "+v"(ho));
#pragma unroll
                for (int m = 0; m < 4; ++m) {
                    const f32x4 x = acc[ai][0][m][n] * rstd[ai][m];
                    const f32x4 R1 = dpp4<0x121>(x), R2 = dpp4<0x122>(x);
                    const f32x4 p1 = (fr >= 1) ? R1 : r1p;
                    const f32x4 p2 = (fr >= 2) ? R2 : r2p;
                    const f32x4 sv = w2 * x + w1 * p1 + w0 * p2 + bb;
                    r1p = R1; r2p = R2;
                    const f32x4 g = acc[ai][1][m][n] * rstd[ai][m];
                    if (ai == 0 && m == 0) { if (wr == 0 && fr < 2 && needs_fix) { const size_t off = ((size_t)u.pm * 2 + fr) * 2816 + hc + 4 * n; *(f32x4*)(tops + off) = sv; *(f32x4*)(topg + off) = g; } }
                    u32x2 w; w.x = cvt_pk_bf16(gelu_tanh(sv[0]) * g[0], gelu_tanh(sv[1]) * g[1]); w.y = cvt_pk_bf16(gelu_tanh(sv[2]) * g[2], gelu_tanh(sv[3]) * g[3]);
                    *(u32x2*)(HM + ho) = w; ho += 16 * 2816;
                    asm volatile("" : "+v"(ho) :: "memory");
                }
            }
        }
    }
};
template <class Epi, class Sched, bool ALIGN_EPI = false, bool SP2 = false>
__device__ __forceinline__ void gemm_phase(PG8_LAS unsigned char* lds, const Gemm g, const Sched& S, const Epi& E) {
    int tid_ = threadIdx.x; asm volatile("" : "+v"(tid_));
    const int tid = tid_, wid = __builtin_amdgcn_readfirstlane(tid >> 6), lane = tid & 63, wr = wid >> 2, wc = wid & 3, fr = lane & 15, fq = lane >> 4;
    const int K = g.K, nt = K / BK;
    unsigned voffA[2], voffB[2];
#pragma unroll
    for (int i = 0; i < 2; ++i) { int R, C; stage_rc(tid * 16 + i * 8192, R, C); const int Rb = Epi::PERM ? ((R & ~31) + perm32(R & 31)) : R;
        voffA[i] = (unsigned)(R * K + C) * 2u; voffB[i] = (unsigned)(Rb * K + C) * 2u; }
    const size_t kstep = (size_t)(BK * 2);
    const size_t hstep = (size_t)HALF * K * 2;
    const size_t tstep = 2 * hstep;
    const unsigned ldsw = (unsigned)wid * 1024u;
    const int aoff = lds_byte(wr * 64 + fr, fq * 8), boff = lds_byte(wc * 32 + fr, fq * 8);
#define PG8_SA(b, h) (((b) * 2 + (h)) * HTB)
#define PG8_SB(b, h) ((4 + (b) * 2 + (h)) * HTB)
#define PG8_STAGE(bufoff, gbase, voff) do { _Pragma("unroll") for (int _i = 0; _i < 2; ++_i) \
        __builtin_amdgcn_global_load_lds((const unsigned*)((const char*)(gbase) + (voff)[_i]), (PG8_LAS unsigned*)(lds + (bufoff) + ldsw + _i * 8192), 16, 0, 0); } while (0)
#define PG8_LDA(dst, b, h) do { _Pragma("unroll") for (int m = 0; m < 4; ++m) _Pragma("unroll") for (int k = 0; k < 2; ++k) dst[m][k] = *(const PG8_LAS bf16x8*)(lds + PG8_SA(b, h) + aoff + m * 2048 + k * 1024); } while (0)
#define PG8_LDB(dst, b, h) do { _Pragma("unroll") for (int n = 0; n < 2; ++n) _Pragma("unroll") for (int k = 0; k < 2; ++k) dst[n][k] = *(const PG8_LAS bf16x8*)(lds + PG8_SB(b, h) + boff + n * 2048 + k * 1024); } while (0)
#define PG8_MMA(ai, bj, At, Bt) do { __builtin_amdgcn_s_setprio(1); _Pragma("unroll") for (int m = 0; m < 4; ++m) _Pragma("unroll") for (int n = 0; n < 2; ++n) _Pragma("unroll") for (int k = 0; k < 2; ++k) \
        acc[ai][bj][m][n] = __builtin_amdgcn_mfma_f32_16x16x32_bf16(Bt[n][k], At[m][k], acc[ai][bj][m][n], 0, 0, 0); __builtin_amdgcn_s_setprio(0); } while (0)
#define PG8_WAIT_V(n) asm volatile("s_waitcnt vmcnt(" #n ")" ::: "memory")
#define PG8_WAIT_L(n) asm volatile("s_waitcnt lgkmcnt(" #n ")" ::: "memory")
#define PG8_BAR __builtin_amdgcn_s_barrier()
#define PG8_SCHED __builtin_amdgcn_sched_barrier(0)
    Unit cur, nxt; int ui = 0;
    if (!S.next(0, cur)) return;
    f32x4 acc[2][2][4][2];
#pragma unroll
    for (int a = 0; a < 2; ++a)
#pragma unroll
        for (int b = 0; b < 2; ++b)
#pragma unroll
            for (int m = 0; m < 4; ++m)
#pragma unroll
                for (int n = 0; n < 2; ++n) acc[a][b][m][n] = (f32x4){0.f, 0.f, 0.f, 0.f};
    bf16x8 At[4][2], B0[2][2], B1[2][2];
    const char* cA = (const char*)g.A + (size_t)cur.pm * tstep; const char* cB = (const char*)g.Bt + (size_t)cur.pn * tstep;
    S.a_ready(cur);
    if constexpr (SP2) {
        PG8_STAGE(PG8_SB(0, 0), cB, voffB); PG8_STAGE(PG8_SB(0, 1), cB + hstep, voffB); PG8_STAGE(PG8_SA(0, 0), cA, voffA); PG8_STAGE(PG8_SA(0, 1), cA + hstep, voffA);
        if (wr == 1) PG8_BAR;
        PG8_WAIT_V(2); PG8_BAR;
        PG8_STAGE(PG8_SB(1, 0), cB + kstep, voffB); PG8_STAGE(PG8_SA(1, 0), cA + kstep, voffA); PG8_STAGE(PG8_SB(1, 1), cB + hstep + kstep, voffB);
        PG8_WAIT_V(6); PG8_BAR;
    } else {
        PG8_STAGE(PG8_SB(0, 0), cB, voffB); PG8_STAGE(PG8_SA(0, 0), cA, voffA); PG8_STAGE(PG8_SB(0, 1), cB + hstep, voffB); PG8_STAGE(PG8_SA(0, 1), cA + hstep, voffA);
        if (wr == 1) PG8_BAR;
        PG8_WAIT_V(4); PG8_BAR;
        PG8_STAGE(PG8_SB(1, 0), cB + kstep, voffB); PG8_STAGE(PG8_SA(1, 0), cA + kstep, voffA); PG8_STAGE(PG8_SB(1, 1), cB + hstep + kstep, voffB);
        PG8_WAIT_V(6); PG8_BAR;
    }
    for (;;) {
        const bool has_next = S.next(ui + 1, nxt);
        const char* nA = has_next ? (const char*)g.A + (size_t)nxt.pm * tstep : cA; const char* nB = has_next ? (const char*)g.Bt + (size_t)nxt.pn * tstep : cB;
        for (int t = 0; t < nt; t += 2) {
            const bool last = (t == nt - 2);
            const char* a1 = cA + (size_t)(t + 1) * kstep;
            const char* a2 = last ? nA : cA + (size_t)(t + 2) * kstep; const char* b2 = last ? nB : cB + (size_t)(t + 2) * kstep;
            const char* a3 = a2 + kstep; const char* b3 = b2 + kstep;
            if (last && has_next) S.a_ready(nxt);
            if constexpr (SP2) {
            PG8_LDB(B0, 0, 0); PG8_LDB(B1, 0, 1); PG8_SCHED; PG8_LDA(At, 0, 0); PG8_STAGE(PG8_SA(1, 1), a1 + hstep, voffA);
            PG8_WAIT_V(8); PG8_WAIT_L(0); PG8_BAR; PG8_MMA(0, 0, At, B0); PG8_MMA(0, 1, At, B1); PG8_BAR; PG8_SCHED;
            PG8_LDA(At, 0, 1); PG8_STAGE(PG8_SB(0, 0), b2, voffB); PG8_STAGE(PG8_SB(0, 1), b2 + hstep, voffB); PG8_STAGE(PG8_SA(0, 0), a2, voffA);
            PG8_WAIT_V(8); PG8_WAIT_L(0); PG8_BAR; PG8_MMA(1, 0, At, B0); PG8_MMA(1, 1, At, B1); PG8_BAR; PG8_SCHED;
            PG8_LDB(B0, 1, 0); PG8_LDB(B1, 1, 1); PG8_SCHED; PG8_LDA(At, 1, 0); PG8_STAGE(PG8_SA(0, 1), a2 + hstep, voffA);
            PG8_WAIT_V(8); PG8_WAIT_L(0); PG8_BAR; PG8_MMA(0, 0, At, B0); PG8_MMA(0, 1, At, B1); PG8_BAR; PG8_SCHED;
            PG8_LDA(At, 1, 1); PG8_STAGE(PG8_SB(1, 0), b3, voffB); PG8_STAGE(PG8_SB(1, 1), b3 + hstep, voffB); PG8_STAGE(PG8_SA(1, 0), a3, voffA);
            PG8_WAIT_V(8); PG8_WAIT_L(0); PG8_BAR; PG8_MMA(1, 0, At, B0); PG8_MMA(1, 1, At, B1); PG8_BAR; PG8_SCHED;
            } else {
            PG8_LDB(B0, 0, 0); PG8_SCHED; PG8_LDA(At, 0, 0); PG8_STAGE(PG8_SA(1, 1), a1 + hstep, voffA);
            PG8_WAIT_L(8); PG8_BAR; PG8_WAIT_L(0); PG8_MMA(0, 0, At, B0); PG8_BAR; PG8_SCHED;
            PG8_LDB(B1, 0, 1); PG8_STAGE(PG8_SB(0, 0), b2, voffB);
            PG8_BAR; PG8_WAIT_L(0); PG8_MMA(0, 1, At, B1); PG8_BAR;
            PG8_LDA(At, 0, 1); PG8_STAGE(PG8_SA(0, 0), a2, voffA);
            PG8_BAR; PG8_WAIT_L(0); PG8_MMA(1, 0, At, B0); PG8_BAR; PG8_SCHED;
            PG8_STAGE(PG8_SB(0, 1), b2 + hstep, voffB);
            PG8_WAIT_V(6); PG8_BAR; PG8_MMA(1, 1, At, B1); PG8_BAR;
            PG8_LDB(B0, 1, 0); PG8_SCHED; PG8_LDA(At, 1, 0); PG8_STAGE(PG8_SA(0, 1), a2 + hstep, voffA);
            PG8_WAIT_L(8); PG8_BAR; PG8_WAIT_L(0); PG8_MMA(0, 0, At, B0); PG8_BAR; PG8_SCHED;
            PG8_LDB(B1, 1, 1); PG8_STAGE(PG8_SB(1, 0), b3, voffB);
            PG8_BAR; PG8_WAIT_L(0); PG8_MMA(0, 1, At, B1); PG8_BAR;
            PG8_LDA(At, 1, 1); PG8_STAGE(PG8_SA(1, 0), a3, voffA);
            PG8_BAR; PG8_WAIT_L(0); PG8_MMA(1, 0, At, B0); PG8_BAR; PG8_SCHED;
            PG8_STAGE(PG8_SB(1, 1), b3 + hstep, voffB);
            PG8_WAIT_V(6); PG8_BAR; PG8_MMA(1, 1, At, B1); PG8_BAR;
            }
        }
        if constexpr (ALIGN_EPI) { if (wr == 0) PG8_BAR; }
        if constexpr (!Epi::AFTER_DRAIN) { E(acc, cur, wr, wc, fr, fq); S.done(cur); }
        if (!has_next) break;
#pragma unroll
        for (int a = 0; a < 2; ++a)
#pragma unroll
            for (int b = 0; b < 2; ++b)
#pragma unroll
                for (int m = 0; m < 4; ++m)
#pragma unroll
                    for (int n = 0; n < 2; ++n) acc[a][b][m][n] = (f32x4){0.f, 0.f, 0.f, 0.f};
        cur = nxt; cA = nA; cB = nB; ++ui;
        if constexpr (ALIGN_EPI) { if (wr == 1) PG8_BAR; }
    }
    PG8_WAIT_V(0);
    if constexpr (!ALIGN_EPI) { if (wr == 0) PG8_BAR; }
    PG8_BAR;
    if constexpr (Epi::AFTER_DRAIN) { E.fused(acc, cur, wr, wc, fr, fq, lds, wid, lane); S.done(cur); }
#undef PG8_SA
#undef PG8_SB
#undef PG8_STAGE
#undef PG8_LDA
#undef PG8_LDB
#undef PG8_MMA
#undef PG8_WAIT_V
#undef PG8_WAIT_L
#undef PG8_BAR
#undef PG8_SCHED
}
}
#include <hip/hip_bf16.h>
#include <cmath>
namespace attn_body {
using bf16=__hip_bfloat16;
using bf16x8=__attribute__((ext_vector_type(8)))short;
using s16x4=__attribute__((ext_vector_type(4)))short;
using f32x16=__attribute__((ext_vector_type(16)))float;
using u32x4=__attribute__((ext_vector_type(4)))unsigned;
constexpr int D=64,PITCH=4608;
constexpr int NW=8,QBLK=32,QB=QBLK*NW,KVBLK=64;
constexpr int ATTN_UNIT_ROWS=QB;
__device__ __forceinline__ int crow(int r,int hi){return (r&3)+8*(r>>2)+4*hi;}
#define SBAR() __builtin_amdgcn_sched_barrier(0)
template<bool BAND> __device__ __forceinline__ void cmask(f32x16&p0,f32x16&p1,int kvbase,int qrel,int hi){
  const float NEG=-INFINITY; int kb=kvbase+4*hi;
  #pragma unroll
  for(int r=0;r<16;++r){int kv=kb+(r&3)+8*(r>>2); if(kv>qrel||(BAND&&kv<qrel-128))p0[r]=NEG; if(kv+32>qrel||(BAND&&kv+32<qrel-128))p1[r]=NEG;}
}

constexpr int NSLOT=3, SLOTB=8192;
constexpr int LDS_K=0, LDS_V=NSLOT*SLOTB, LDS_WS=2*NSLOT*SLOTB, LDS_OST=LDS_WS+NW*64*4, LDS_BYTES=LDS_OST+NW*4096;
constexpr float C2=0.125f*1.4426950408889634f;
__device__ __forceinline__ void glds16(const void*gsrc,unsigned lds_dst){unsigned keep;
  asm volatile("s_mov_b32 %0, m0\n\ts_mov_b32 m0, %2\n\ts_nop 0\n\tglobal_load_lds_dwordx4 %1, off\n\ts_mov_b32 m0, %0":"=&s"(keep):"v"(gsrc),"s"(lds_dst):"memory");}
__device__ __forceinline__ float max3f(float a,float b,float c){float r;asm("v_max3_f32 %0, %1, %2, %3":"=v"(r):"v"(a),"v"(b),"v"(c));return r;}
__device__ __forceinline__ float max2f(float a,float b){float r;asm("v_max_f32_e32 %0, %1, %2":"=v"(r):"v"(a),"v"(b));return r;}
__device__ __forceinline__ float fadd_s(float a,float b){float r;asm("v_add_f32_e32 %0, %1, %2":"=v"(r):"v"(a),"v"(b));return r;}
__device__ __forceinline__ float fsub_s(float a,float b){float r;asm("v_sub_f32_e32 %0, %1, %2":"=v"(r):"v"(a),"v"(b));return r;}
typedef float f32x2_t __attribute__((ext_vector_type(2))); typedef __bf16 bf16x2_t __attribute__((ext_vector_type(2)));
__device__ __forceinline__ unsigned cvtpk_s(float lo,float hi){f32x2_t v={lo,hi};bf16x2_t b=__builtin_convertvector(v,bf16x2_t);return __builtin_bit_cast(unsigned,b);}
#define WAIT_BAR(N) asm volatile("s_waitcnt vmcnt(" #N ") lgkmcnt(0)\n\ts_barrier":::"memory")

__device__ __forceinline__ void qkt(f32x16&p0,f32x16&p1,const char*Kslot,const bf16x8*qr,const f32x16&negm,int r32,int hi){
  const char*kb=Kslot+hi*1024+r32*16;
  #pragma unroll
  for(int d0=0;d0<4;++d0){
    const bf16x8 b0=*reinterpret_cast<const bf16x8*>(kb+d0*2048);
    const bf16x8 b1=*reinterpret_cast<const bf16x8*>(kb+d0*2048+512);
    if(d0==0){p0=__builtin_amdgcn_mfma_f32_32x32x16_bf16(b0,qr[0],negm,0,0,0);p1=__builtin_amdgcn_mfma_f32_32x32x16_bf16(b1,qr[0],negm,0,0,0);}
    else{p0=__builtin_amdgcn_mfma_f32_32x32x16_bf16(b0,qr[d0],p0,0,0,0);p1=__builtin_amdgcn_mfma_f32_32x32x16_bf16(b1,qr[d0],p1,0,0,0);}}
}
typedef __attribute__((address_space(3))) const char* lds_cptr;
typedef short v4i16_t __attribute__((ext_vector_type(4)));
__device__ __forceinline__ void kload8(bf16x8*kf,lds_cptr kp){
  kf[0]=*(const __attribute__((address_space(3))) bf16x8*)(kp);      kf[1]=*(const __attribute__((address_space(3))) bf16x8*)(kp+512);
  kf[2]=*(const __attribute__((address_space(3))) bf16x8*)(kp+2048); kf[3]=*(const __attribute__((address_space(3))) bf16x8*)(kp+2560);
  kf[4]=*(const __attribute__((address_space(3))) bf16x8*)(kp+4096); kf[5]=*(const __attribute__((address_space(3))) bf16x8*)(kp+4608);
  kf[6]=*(const __attribute__((address_space(3))) bf16x8*)(kp+6144); kf[7]=*(const __attribute__((address_space(3))) bf16x8*)(kp+6656);
}
__device__ __forceinline__ void kload2(bf16x8*kf,lds_cptr kp,int j){ kf[2*j]=*(const __attribute__((address_space(3))) bf16x8*)(kp+j*2048); kf[2*j+1]=*(const __attribute__((address_space(3))) bf16x8*)(kp+j*2048+512); }
__device__ __forceinline__ s16x4 vtr(lds_cptr p){ return __builtin_bit_cast(s16x4,__builtin_amdgcn_ds_read_tr16_b64_v4i16((__attribute__((address_space(3))) v4i16_t*)p)); }
__device__ __forceinline__ float rowmax(const f32x16&p0,const f32x16&p1){
  float a=max3f(p0[0],p0[1],p1[0]),b=max3f(p0[2],p0[3],p1[1]);a=max3f(a,p1[2],p1[3]);
  #pragma unroll
  for(int r=4;r<16;r+=4){a=max3f(a,p0[r],p0[r+1]);b=max3f(b,p0[r+2],p0[r+3]);a=max3f(a,p1[r],p1[r+1]);b=max3f(b,p1[r+2],p1[r+3]);}
  const float m=max2f(a,b);
  auto rr=__builtin_amdgcn_permlane32_swap(__float_as_uint(m),__float_as_uint(m),false,false);
  return max2f(__uint_as_float(rr[0]),__uint_as_float(rr[1]));
}
__device__ __forceinline__ void pv(f32x16*o,int vb,bf16x8 pa0,bf16x8 pa1,bf16x8 pa2,bf16x8 pa3){
  #pragma unroll
  for(int d0=0;d0<2;++d0){s16x4 lo[4],hi[4];
    #pragma unroll
    for(int ks=0;ks<4;++ks){
      asm volatile("ds_read_b64_tr_b16 %0,%1 offset:%c2":"=&v"(lo[ks]):"v"(vb),"i"(d0*4096+ks*1024):"memory");
      asm volatile("ds_read_b64_tr_b16 %0,%1 offset:%c2":"=&v"(hi[ks]):"v"(vb),"i"(d0*4096+ks*1024+512):"memory");}
    asm volatile("s_waitcnt lgkmcnt(0)":::"memory");SBAR();
    #define PK(k) (bf16x8){lo[k][0],lo[k][1],lo[k][2],lo[k][3],hi[k][0],hi[k][1],hi[k][2],hi[k][3]}
    o[d0]=__builtin_amdgcn_mfma_f32_32x32x16_bf16(pa0,PK(0),o[d0],0,0,0);
    o[d0]=__builtin_amdgcn_mfma_f32_32x32x16_bf16(pa1,PK(1),o[d0],0,0,0);
    o[d0]=__builtin_amdgcn_mfma_f32_32x32x16_bf16(pa2,PK(2),o[d0],0,0,0);
    o[d0]=__builtin_amdgcn_mfma_f32_32x32x16_bf16(pa3,PK(3),o[d0],0,0,0);
    #undef PK
  }
}

#ifndef ATTN_STORE16
#define ATTN_STORE16(p,v) (*(u32x4*)(p)=(v))
#endif
template<int THRL,bool BAND> __device__ __forceinline__ void attn_unit(const bf16*Qb,const bf16*__restrict__ Kb,const bf16*__restrict__ Vb,bf16*Ob,const long rs,const long ors,const int NT,const int moff,float*lse,const long lrs,char*shm){
  int tid_=threadIdx.x; asm volatile("":"+v"(tid_));
  const int tid=tid_,lane=tid&63,r32=lane&31,hi=lane>>5; const int wid=__builtin_amdgcn_readfirstlane(tid>>6);
  const bf16*Qw=Qb+(long)(wid*QBLK)*rs;
  const bf16*Kh=Kb,*Vh=Vb;
  const unsigned lds0=(unsigned)(uintptr_t)shm;
  float*wsf=(float*)(shm+LDS_WS)+wid*64;
  const bf16*ksrc=Kh+(long)lane*rs+wid*8;
  const bf16*vsrc=Vh+(long)(16*(wid&3)+(lane>>2))*rs+(wid>>2)*32+(lane&3)*8;
  const unsigned kdst=lds0+LDS_K+wid*1024, vdst=lds0+LDS_V+wid*1024;
  #define DMA_K(t,slot) glds16(ksrc+(long)(t)*KVBLK*rs,(unsigned)__builtin_amdgcn_readfirstlane(kdst+(slot)))
  #define DMA_V(t,slot) glds16(vsrc+(long)(t)*KVBLK*rs,(unsigned)__builtin_amdgcn_readfirstlane(vdst+(slot)))
  const int vb0=(int)(lds0+LDS_V)+((lane>>4)&1)*32+(lane&3)*8+(4*hi+((lane&15)>>2))*64;
  const char*Kbase=shm+LDS_K; bf16x8 kf[8];
  const lds_cptr shm3=(lds_cptr)shm; const lds_cptr kp0=shm3+LDS_K+hi*1024+r32*16; const lds_cptr vp0=shm3+LDS_V+((lane>>4)&1)*32+(lane&3)*8+(4*hi+((lane&15)>>2))*64;
  DMA_K(0,0);DMA_V(0,0);DMA_K(1,SLOTB);
  bf16x8 qr[4];
  #pragma unroll
  for(int d0=0;d0<4;++d0)qr[d0]=*reinterpret_cast<const bf16x8*>(&Qw[(long)r32*rs+d0*16+hi*8]);
  float mhat=0.f,l_reg=0.f;f32x16 o[2];o[0]=f32x16{};o[1]=f32x16{};f32x16 negm=f32x16{};asm volatile("":"+v"(negm));
  const int qrel=wid*QBLK+r32;
  #define CMASK(P0,P1,t) do{int jb_=(t)-(NT-4); if(BAND||jb_>=0)cmask<BAND>(P0,P1,64*(t)-moff,qrel,hi);}while(0)
  bool resc=false;
  #define START(P0,P1) do{ const float rm=BAND?__builtin_fmaxf(rowmax(P0,P1),-64.f):rowmax(P0,P1); resc=false; \
    { const float dl=rm; mhat=fadd_s(mhat,dl); \
      _Pragma("unroll") for(int r=0;r<16;++r){P0[r]=fsub_s(P0[r],dl);P1[r]=fsub_s(P1[r],dl);} \
      _Pragma("unroll") for(int r=0;r<16;++r)negm[r]=-mhat; asm volatile("":"+v"(negm)); } \
    _Pragma("unroll") for(int r=0;r<16;++r)P0[r]=__builtin_amdgcn_exp2f(P0[r]); }while(0)
  #define RESC() do{ if(resc){ asm volatile("s_waitcnt lgkmcnt(0)":::"memory"); \
      _Pragma("unroll") for(int d_=0;d_<2;++d_) _Pragma("unroll") for(int r=0;r<16;++r)o[d_][r]*=wsf[crow(r,hi)]; } }while(0)
  f32x16 pA0,pA1,pB0,pB1;
  int sl_prev=0,sl_cur=0,sl_next=SLOTB;
  #define ROT() do{sl_prev=sl_cur;sl_cur=sl_next;sl_next=(sl_next==(NSLOT-1)*SLOTB)?0:sl_next+SLOTB;}while(0)
  DMA_K(2,2*SLOTB);
  WAIT_BAR(3);
  qkt(pA0,pA1,Kbase,qr,negm,r32,hi);asm volatile("s_nop 15\n\ts_nop 7":"+v"(pA0),"+v"(pA1));CMASK(pA0,pA1,0);
  START(pA0,pA1);
  _Pragma("unroll") for(int r=0;r<16;++r)pA1[r]=__builtin_amdgcn_exp2f(pA1[r]);
  WAIT_BAR(0);
  DMA_K(3,0);DMA_V(1,SLOTB);
  ROT();
  kload8(kf,kp0+sl_cur);
  WAIT_BAR(2);
  s16x4 vlo[8],vhi[8]; u32x4 pw0,pw1,pw2,pw3;
  #define PKW(P,B) cvtpk_s(P[B],P[B+1])
  #define PAF(k) __builtin_bit_cast(bf16x8,pw##k)
  #define VFR(i) (bf16x8){vlo[i][0],vlo[i][1],vlo[i][2],vlo[i][3],vhi[i][0],vhi[i][1],vhi[i][2],vhi[i][3]}
  #define PIN(x) asm volatile("":"+v"(x))
  #define MX3(a,b,c) __builtin_fmaxf(__builtin_fmaxf((a),(b)),(c))
  #define GAPA(MF,A0,A1,A2,A3,W0,W1,PW) do{ MF; sacc+=A0; sacc+=A1; sacc+=A2; sacc+=A3; PIN(sacc); W0; W1; PIN(PW); SBAR(); }while(0)
  #define EX(v) __builtin_amdgcn_exp2f(v)
  #define GAPB(MF,X,B) do{ MF; X[B]=EX(X[B]); X[B+1]=EX(X[B+1]); X[B+2]=EX(X[B+2]); X[B+3]=EX(X[B+3]); PIN(X); SBAR(); }while(0)
  #define VRD(i) do{ vlo[i]=vtr(vp_+(((i)>>2)*4096+((i)&3)*1024)); vhi[i]=vtr(vp_+(((i)>>2)*4096+((i)&3)*1024+512)); }while(0)
  #define KRD(G,j) do{ if(G){ kload2(kf,kp0+sl_next,j); SBAR(); } }while(0)
  #define STEP(C0,C1,P0,P1,t,GK,GV,GL) do{ SBAR(); \
    const lds_cptr vp_=vp0+sl_prev; \
    VRD(0); SBAR(); float sacc=(P0[0]+P0[1]); \
    GAPA(C0=__builtin_amdgcn_mfma_f32_32x32x16_bf16(kf[0],qr[0],negm,0,0,0), P0[2],P0[3],P0[4],P0[5],     pw0[0]=PKW(P0,0), pw0[1]=PKW(P0,2), pw0); \
    VRD(4); SBAR(); GAPA(C1=__builtin_amdgcn_mfma_f32_32x32x16_bf16(kf[1],qr[0],negm,0,0,0), P0[6],P0[7],P0[8],P0[9],     pw0[2]=PKW(P0,4), pw0[3]=PKW(P0,6), pw0); \
    VRD(1); SBAR(); GAPA(C0=__builtin_amdgcn_mfma_f32_32x32x16_bf16(kf[2],qr[1],C0,0,0,0),   P0[10],P0[11],P0[12],P0[13], pw1[0]=PKW(P0,8), pw1[1]=PKW(P0,10), pw1); \
    VRD(5); SBAR(); GAPA(C1=__builtin_amdgcn_mfma_f32_32x32x16_bf16(kf[3],qr[1],C1,0,0,0),   P0[14],P0[15],P1[0],P1[1],   pw1[2]=PKW(P0,12),pw1[3]=PKW(P0,14), pw1); \
    VRD(2); SBAR(); GAPA(C0=__builtin_amdgcn_mfma_f32_32x32x16_bf16(kf[4],qr[2],C0,0,0,0),   P1[2],P1[3],P1[4],P1[5],     pw2[0]=PKW(P1,0), pw2[1]=PKW(P1,2), pw2); \
    VRD(6); SBAR(); GAPA(C1=__builtin_amdgcn_mfma_f32_32x32x16_bf16(kf[5],qr[2],C1,0,0,0),   P1[6],P1[7],P1[8],P1[9],     pw2[2]=PKW(P1,4), pw2[3]=PKW(P1,6), pw2); \
    VRD(3); SBAR(); GAPA(C0=__builtin_amdgcn_mfma_f32_32x32x16_bf16(kf[6],qr[3],C0,0,0,0),   P1[10],P1[11],P1[12],P1[13], pw3[0]=PKW(P1,8), pw3[1]=PKW(P1,10), pw3); \
    VRD(7); SBAR(); GAPA(C1=__builtin_amdgcn_mfma_f32_32x32x16_bf16(kf[7],qr[3],C1,0,0,0),   P1[14],P1[15],0.f,0.f,       pw3[2]=PKW(P1,12),pw3[3]=PKW(P1,14), pw3); \
    l_reg+=sacc; \
    if(GK){DMA_K((t)+3,sl_cur);} if(GV){DMA_V((t)+1,sl_next);} \
    CMASK(C0,C1,t); \
    { float a=MX3(C0[0],C0[1],C1[0]),b=MX3(C0[2],C0[3],C1[1]); a=MX3(a,C1[2],C1[3]); \
      _Pragma("unroll") for(int r=4;r<16;r+=4){a=MX3(a,C0[r],C0[r+1]);b=MX3(b,C0[r+2],C0[r+3]);a=MX3(a,C1[r],C1[r+1]);b=MX3(b,C1[r+2],C1[r+3]);} \
      float rm=__builtin_fmaxf(a,b); { auto rr=__builtin_amdgcn_permlane32_swap(__float_as_uint(rm),__float_as_uint(rm),false,false); rm=__builtin_fmaxf(__uint_as_float(rr[0]),__uint_as_float(rr[1])); } \
      resc=false; \
      if(__builtin_expect(__any(rm>(float)THRL),0)){ const float dl=__builtin_fmaxf(rm,0.f); mhat+=dl; \
        _Pragma("unroll") for(int r=0;r<16;++r){C0[r]-=dl;C1[r]-=dl;} \
        _Pragma("unroll") for(int r=0;r<16;++r)negm[r]=-mhat; asm volatile("":"+v"(negm)); \
        const float f=__builtin_amdgcn_exp2f(-dl); l_reg*=f; if(hi==0)wsf[r32]=f; resc=true; } } \
    SBAR(); \
    GAPB(o[0]=__builtin_amdgcn_mfma_f32_32x32x16_bf16(PAF(0),VFR(0),o[0],0,0,0), C0,0); \
    GAPB(o[1]=__builtin_amdgcn_mfma_f32_32x32x16_bf16(PAF(0),VFR(4),o[1],0,0,0), C0,4); \
    KRD(GL,0); GAPB(o[0]=__builtin_amdgcn_mfma_f32_32x32x16_bf16(PAF(1),VFR(1),o[0],0,0,0), C0,8); \
    KRD(GL,1); GAPB(o[1]=__builtin_amdgcn_mfma_f32_32x32x16_bf16(PAF(1),VFR(5),o[1],0,0,0), C0,12); \
    KRD(GL,2); GAPB(o[0]=__builtin_amdgcn_mfma_f32_32x32x16_bf16(PAF(2),VFR(2),o[0],0,0,0), C1,0); \
    KRD(GL,3); GAPB(o[1]=__builtin_amdgcn_mfma_f32_32x32x16_bf16(PAF(2),VFR(6),o[1],0,0,0), C1,4); \
    GAPB(o[0]=__builtin_amdgcn_mfma_f32_32x32x16_bf16(PAF(3),VFR(3),o[0],0,0,0), C1,8); \
    GAPB(o[1]=__builtin_amdgcn_mfma_f32_32x32x16_bf16(PAF(3),VFR(7),o[1],0,0,0), C1,12); \
    }while(0)
  int t=1;
  #undef CMASK
  #define CMASK(P0,P1,t) do{}while(0)
  for(;t+5<NT;t+=2){
    STEP(pB0,pB1,pA0,pA1,t,true,true,true);     WAIT_BAR(2); RESC(); ROT();
    STEP(pA0,pA1,pB0,pB1,t+1,true,true,true);   WAIT_BAR(2); RESC(); ROT();
  }
  #undef CMASK
  #define CMASK(P0,P1,t) do{int jb_=(t)-(NT-4); if(BAND||jb_>=0)cmask<BAND>(P0,P1,64*(t)-moff,qrel,hi);}while(0)
  #define ENDW(tt) do{ if((tt)+3<NT){WAIT_BAR(2);} else if((tt)+2<NT){WAIT_BAR(1);} else {WAIT_BAR(0);} }while(0)
  for(;t+1<NT;t+=2){
    STEP(pB0,pB1,pA0,pA1,t,(t+3<NT),(t+1<NT),(t+1<NT));       ENDW(t);   RESC(); ROT();
    STEP(pA0,pA1,pB0,pB1,t+1,(t+4<NT),(t+2<NT),(t+2<NT));     ENDW(t+1); RESC(); ROT();
  }
  STEP(pB0,pB1,pA0,pA1,NT-1,false,false,false); RESC();
  { float sacc=pB0[0]+pB0[1]; _Pragma("unroll") for(int r=2;r<16;++r)sacc+=pB0[r]; _Pragma("unroll") for(int r=0;r<16;++r)sacc+=pB1[r]; l_reg+=sacc;
    pw0=(u32x4){PKW(pB0,0),PKW(pB0,2),PKW(pB0,4),PKW(pB0,6)};pw1=(u32x4){PKW(pB0,8),PKW(pB0,10),PKW(pB0,12),PKW(pB0,14)};pw2=(u32x4){PKW(pB1,0),PKW(pB1,2),PKW(pB1,4),PKW(pB1,6)};pw3=(u32x4){PKW(pB1,8),PKW(pB1,10),PKW(pB1,12),PKW(pB1,14)};
    SBAR(); pv(o,vb0+sl_cur,PAF(0),PAF(1),PAF(2),PAF(3)); }
  #undef PKW
  #undef PAF
  #undef VFR
  #undef PIN
  #undef MX3
  #undef GAPA
  #undef GAPB
  #undef EX
  #undef VRD
  #undef KRD
  #undef STEP
  #undef ENDW
  {auto rr=__builtin_amdgcn_permlane32_swap(__float_as_uint(l_reg),__float_as_uint(l_reg),false,false);l_reg=__uint_as_float(rr[0])+__uint_as_float(rr[1]);}
  if(hi==0)wsf[32+r32]=l_reg;asm volatile("s_waitcnt lgkmcnt(0)":::"memory");
  float rli[16];
  #pragma unroll
  for(int r=0;r<16;++r)rli[r]=__builtin_amdgcn_rcpf(wsf[32+crow(r,hi)]);
  bf16*Ow=Ob+(long)(wid*QBLK)*ors;
  if(BAND){ if(hi==0) lse[(long)(wid*QBLK+r32)*lrs]=mhat+__builtin_amdgcn_logf(l_reg); }
  { bf16*stg=(bf16*)(shm+LDS_OST)+wid*2048;
    #pragma unroll
    for(int r=0;r<16;++r){const int orow=crow(r,hi);
      #pragma unroll
      for(int d0=0;d0<2;++d0)stg[orow*64+d0*32+r32]=__float2bfloat16(o[d0][r]*rli[r]);}
    asm volatile("s_waitcnt lgkmcnt(0)":::"memory");
    #pragma unroll
    for(int i=0;i<4;++i){const int row=i*8+(lane>>3),ch=lane&7; const u32x4 v=*(const u32x4*)(stg+row*64+ch*8); ATTN_STORE16(Ow+(long)row*ors+ch*8,v);} }
  asm volatile("s_waitcnt lgkmcnt(0)\n\ts_barrier":::"memory");
  #undef DMA_K
  #undef DMA_V
  #undef CMASK
  #undef START
  #undef RESC
  #undef ROT
}
constexpr int ATTN_LDS_BYTES=LDS_BYTES;
struct AttnUnit { const bf16* Q; const bf16* K; const bf16* V; bf16* O; float* lse; long rs, ors, lrs; int NT, moff; };
template<class Sched,int THRL,bool BAND> __device__ __forceinline__ void attn_phase(char*lds,const Sched&S){
  AttnUnit u;
  for(int i=0;S.next(i,u);++i){ attn_unit<THRL,BAND>(u.Q,u.K,u.V,u.O,u.rs,u.ors,u.NT,u.moff,u.lse,u.lrs,lds); }
}
#undef SBAR
#undef WAIT_BAR
}
#define GAS __attribute__((address_space(1)))
#define LAS __attribute__((address_space(3)))
typedef unsigned short bf16;
typedef unsigned v4u __attribute__((ext_vector_type(4)));
typedef float f32x4 __attribute__((ext_vector_type(4)));
typedef short bf16x8 __attribute__((ext_vector_type(8)));
typedef GAS unsigned gu32;
typedef GAS unsigned long long gu64;
#define RLX_AGENT __ATOMIC_RELAXED, __HIP_MEMORY_SCOPE_AGENT
#define LDS_WAIT() asm volatile("s_waitcnt lgkmcnt(0)" ::: "memory")
#define VM_WAIT() asm volatile("s_waitcnt vmcnt(0)" ::: "memory")
__device__ __forceinline__ unsigned long long rt() { return __builtin_amdgcn_s_memrealtime(); }

#define XB_TMO      128
#define XB_XCNT(j)  (256  + 64 * (j))
#define XB_XSUB(j)  (1280 + 64 * (j))
#define XB_XGEN(j)  (2304 + 64 * (j))
#define XB_TOP      3328
#define XB_TOPGEN   3392
#define XCD_BAR_WORDS 3456
#define XB_SPIN_CAP (1u << 18)

__device__ __forceinline__ unsigned xb_ld(unsigned* p)              { return __hip_atomic_load(p, __ATOMIC_RELAXED, __HIP_MEMORY_SCOPE_AGENT); }
__device__ __forceinline__ unsigned xb_add(unsigned* p, unsigned v) { return __hip_atomic_fetch_add(p, v, __ATOMIC_RELAXED, __HIP_MEMORY_SCOPE_AGENT); }
__device__ __forceinline__ unsigned xb_xcc_id() { return (unsigned)__builtin_amdgcn_s_getreg((3 << 11) | 20) & 0xFu; }
#define XB_SPIN(cond, bar) do { unsigned _sp = 0; while (cond) { __builtin_amdgcn_s_sleep(1); \
    if ((++_sp & 255u) == 0u) { if (xb_ld(&(bar)[XB_TMO])) break; if (_sp > XB_SPIN_CAP) { atomicAdd(&(bar)[XB_TMO], 1u); break; } } } } while (0)

struct XcdBarrier {
    unsigned* bar; unsigned x;
    volatile LAS unsigned* st;
};

__device__ __forceinline__ XcdBarrier xcd_barrier_post(unsigned* bar, volatile LAS unsigned* st) {
    XcdBarrier b; b.bar = bar; b.x = xb_xcc_id(); b.st = st;
    if (threadIdx.x == 0) (void)xb_add(&bar[XB_XCNT(b.x)], 1u);
    return b;
}
__device__ __forceinline__ void xcd_barrier_complete(unsigned* bar, unsigned x, unsigned& nloc, unsigned& nx) {
    const unsigned G = gridDim.x * gridDim.y * gridDim.z;
    unsigned sum, cnt, mine, sp = 0u;
    for (;;) {
        sum = 0u; cnt = 0u; mine = 0u;
#pragma unroll
        for (unsigned j = 0; j < 16; ++j) { const unsigned c = xb_ld(&bar[XB_XCNT(j)]); sum += c; cnt += (c > 0u) ? 1u : 0u; mine = (j == x) ? c : mine; }
        if (sum == G) break;
        __builtin_amdgcn_s_sleep(1);
        if ((++sp & 255u) == 0u) { if (xb_ld(&bar[XB_TMO])) break; if (sp > XB_SPIN_CAP) { atomicAdd(&bar[XB_TMO], 1u); break; } }
    }
    nloc = mine > 0u ? mine : 1u; nx = cnt > 0u ? cnt : 1u;
}

__device__ __forceinline__ void xcd_barrier(const XcdBarrier& b) {
    asm volatile("s_waitcnt vmcnt(0)" ::: "memory");
    __syncthreads();
    if (threadIdx.x == 0) {
        unsigned* bar = b.bar;
        __builtin_amdgcn_s_waitcnt(0);
        unsigned nloc = b.st[0], nx = b.st[1];
        if (nloc == 0u) { xcd_barrier_complete(bar, b.x, nloc, nx); b.st[0] = nloc; b.st[1] = nx; }
        const unsigned old = xb_add(&bar[XB_XSUB(b.x)], 1u);
        const unsigned gen = old / nloc;
        if (old + 1u == (gen + 1u) * nloc) {
            __builtin_amdgcn_fence(__ATOMIC_RELEASE, "agent");
            asm volatile("s_waitcnt vmcnt(0)" ::: "memory");
            const unsigned og = xb_add(&bar[XB_TOP], 1u);
            const unsigned tg = og / nx;
            if (og + 1u == (tg + 1u) * nx) xb_add(&bar[XB_TOPGEN], 1u);
            else XB_SPIN(xb_ld(&bar[XB_TOPGEN]) == tg, bar);
            __builtin_amdgcn_fence(__ATOMIC_ACQUIRE, "agent");
            xb_add(&bar[XB_XGEN(b.x)], 1u);
            asm volatile("s_waitcnt vmcnt(0)" ::: "memory");
        } else {
            XB_SPIN(xb_ld(&bar[XB_XGEN(b.x)]) == gen, bar);
            __builtin_amdgcn_fence(__ATOMIC_ACQUIRE, "agent");
            asm volatile("s_waitcnt vmcnt(0)" ::: "memory");
        }
    }
    __syncthreads();
}

constexpr int NWAVES = 8;
constexpr int RING_OFF = 0, RING_BYTES = 131072;
constexpr int LDSCTL_OFF = RING_BYTES, MISC_OFF = LDSCTL_OFF + 320;
constexpr int LDS_BYTES = 147456;
constexpr int CW_TMO = 0, CW_CODE = 1, CW_BAR = 4096;

__device__ __forceinline__ int lane_id() { int l = (int)(threadIdx.x & 63u); asm volatile("" : "+v"(l)); return l; }
__device__ __forceinline__ int tid_id() { int t = (int)threadIdx.x; asm volatile("" : "+v"(t)); return t; }
struct Frame {
    LAS unsigned char* lds;
    volatile LAS unsigned* MISC;
    gu32* ctl;
    int wave, vcu, G;
};

__device__ __forceinline__ void p0_transpose_item(const float* W, int K, int N, bf16_t* WT, int k0, int n0, int drow0, LAS float* scr, int lane, const float* gain) {
    const float* src = W + (size_t)(k0 + (lane >> 5)) * N + n0 + (lane & 31);
    float v[32];
#pragma unroll
    for (int i = 0; i < 32; ++i) v[i] = src[(size_t)(2 * i) * N];
    const int c = lane & 7;
    f32x4 g0 = {1.f, 1.f, 1.f, 1.f}, g1 = g0;
    if (gain) { g0 = *(const f32x4*)(gain + k0 + 8 * c); g1 = *(const f32x4*)(gain + k0 + 8 * c + 4); }
#pragma unroll
    for (int i = 0; i < 32; ++i) scr[(2 * i + (lane >> 5)) * 33 + (lane & 31)] = v[i];
    LDS_WAIT(); asm volatile("" ::: "memory");
#pragma unroll
    for (int j = 0; j < 4; ++j) { const int n = (lane >> 3) + 8 * j; const LAS float* s = scr + (8 * c) * 33 + n;
        v4u o; o.x = pk2bf(s[0 * 33] * g0[0], s[1 * 33] * g0[1]); o.y = pk2bf(s[2 * 33] * g0[2], s[3 * 33] * g0[3]); o.z = pk2bf(s[4 * 33] * g1[0], s[5 * 33] * g1[1]); o.w = pk2bf(s[6 * 33] * g1[2], s[7 * 33] * g1[3]);
        *(GAS v4u*)(WT + (size_t)(drow0 + n) * K + k0 + 8 * c) = o; }
    LDS_WAIT(); asm volatile("" ::: "memory");
}
__device__ __forceinline__ void rms_row_to_bf16(const float* xrow, const float* g, bf16_t* orow, int lane) {
    const f32x4* xr = (const f32x4*)xrow + lane;
    f32x4 v[4]; float s = 0.f;
#pragma unroll
    for (int j = 0; j < 4; ++j) { v[j] = xr[64 * j]; s += (v[j].x * v[j].x + v[j].y * v[j].y) + (v[j].z * v[j].z + v[j].w * v[j].w); }
    const float r = rsqrtf(wave_sum(s) * (1.f / DM) + EPS);
    unsigned long long* o8 = (unsigned long long*)orow + lane;
#pragma unroll
    for (int j = 0; j < 4; ++j) { const f32x4 gg = *((const f32x4*)g + lane + 64 * j);
        o8[64 * j] = (unsigned long long)pk2bf(v[j].x * r * gg.x, v[j].y * r * gg.y) | ((unsigned long long)pk2bf(v[j].z * r * gg.z, v[j].w * r * gg.w) << 32); }
}
__device__ __forceinline__ void row_to_bf16_sq(const float* xrow, bf16_t* orow, float* rsq16, int lane) {
    const f32x4* xr = (const f32x4*)xrow + lane;
    f32x4 v[4]; float s = 0.f;
#pragma unroll
    for (int j = 0; j < 4; ++j) { v[j] = xr[64 * j]; s += (v[j].x * v[j].x + v[j].y * v[j].y) + (v[j].z * v[j].z + v[j].w * v[j].w); }
    s = wave_sum(s);
    unsigned long long* o8 = (unsigned long long*)orow + lane;
#pragma unroll
    for (int j = 0; j < 4; ++j) o8[64 * j] = (unsigned long long)pk2bf(v[j].x, v[j].y) | ((unsigned long long)pk2bf(v[j].z, v[j].w) << 32);
    if (lane < 4) rsq16[lane] = (lane == 0) ? s : 0.f;
}
__device__ __forceinline__ void rms_row_inplace_rsq(float* xrow, const float* g, const float* rsq16, int lane) {
    f32x4* xr = (f32x4*)xrow + lane;
    float s = (lane < 4) ? rsq16[lane] : 0.f;
    s = wave_sum(s);
    const float r = rsqrtf(s * (1.f / DM) + EPS);
#pragma unroll
    for (int j = 0; j < 4; ++j) { const f32x4 gg = *((const f32x4*)g + lane + 64 * j); xr[64 * j] = xr[64 * j] * r * gg; }
}
__device__ __forceinline__ void rms_row_inplace(float* xrow, const float* g, int lane) {
    f32x4* xr = (f32x4*)xrow + lane;
    f32x4 v[4]; float s = 0.f;
#pragma unroll
    for (int j = 0; j < 4; ++j) { v[j] = xr[64 * j]; s += (v[j].x * v[j].x + v[j].y * v[j].y) + (v[j].z * v[j].z + v[j].w * v[j].w); }
    const float r = rsqrtf(wave_sum(s) * (1.f / DM) + EPS);
#pragma unroll
    for (int j = 0; j < 4; ++j) { const f32x4 gg = *((const f32x4*)g + lane + 64 * j); xr[64 * j] = v[j] * r * gg; }
}

struct Args { const float* in[23]; float* out; unsigned char* ws; int ph_lo, ph_hi, li, pad; };

struct WDesc { const float* W; int K, N; bf16_t* WT; int mode; int items; };

__device__ __forceinline__ void p0_prologue(Frame& F, const Args& a) {
    LAS float* scr = (LAS float*)(F.lds + RING_OFF + F.wave * 16384);
    const int lane = lane_id(), tid = tid_id();
    const int gw = F.vcu * NWAVES + F.wave, NGW = F.G * NWAVES;
    unsigned char* ws = a.ws;
    constexpr int I0 = (DM / 64) * (N_IN0 / 32), I1 = (DM / 64) * (DM / 32), I2 = (DM / 64) * (N_QKV / 32), I3 = I1, I4 = (DM / 64) * (NUP / 32), I6 = (DFF / 64) * (DM / 32);
    constexpr int I8 = (128 / 64) * (128 / 32);
    constexpr int NITEMS = I0 + I1 + I2 + I3 + 2 * I4 + 2 * I6 + 4 * I8;
    for (int it = gw; it < NITEMS; it += NGW) {
        int r = it; const float* W; int K, N; bf16_t* WT; int mode = 0; const float* gain = nullptr;
        if (r < I0) { W = a.in[5]; K = DM; N = N_IN0; WT = (bf16_t*)(ws + WS_W_IN0); gain = a.in[2]; }
        else if ((r -= I0) < I1) { W = a.in[11]; K = DM; N = DM; WT = (bf16_t*)(ws + WS_W_OUT0); }
        else if ((r -= I1) < I2) { W = a.in[12]; K = DM; N = N_QKV; WT = (bf16_t*)(ws + WS_W_QKV); gain = a.in[2] + DM; }
        else if ((r -= I2) < I3) { W = a.in[18]; K = DM; N = DM; WT = (bf16_t*)(ws + WS_W_OUT1); }
        else if ((r -= I3) < 2 * I4) { const int l = r / I4; r -= l * I4; W = a.in[19] + (size_t)l * DM * NUP; K = DM; N = NUP; WT = (bf16_t*)(ws + WS_W_UP) + (size_t)l * NUP * DM; mode = 1; gain = a.in[3] + l * DM; }
        else if ((r -= 2 * I4) < 2 * I6) { const int l = r / I6; r -= l * I6; W = a.in[22] + (size_t)l * DFF * DM; K = DFF; N = DM; WT = (bf16_t*)(ws + WS_W_DN) + (size_t)l * DM * DFF; }
        else { r -= 2 * I6; const int g = r / I8; r -= g * I8; W = a.in[9] + (size_t)g * 128 * 128; K = 128; N = 128; WT = (bf16_t*)(ws + WS_PWT) + (size_t)g * 128 * 128; }
        const int nblk = N / 32, kb = r / nblk, nb = r % nblk, k0 = 64 * kb, n0 = 32 * nb;
        int d0 = n0;
        if (mode == 1) { if (n0 < DFF) d0 = 256 * (n0 / 128) + (n0 % 128); else { const int q = n0 - DFF; d0 = 256 * (q / 128) + 128 + (q % 128); } }
        p0_transpose_item(W, K, N, WT, k0, n0, d0, scr, lane, gain);
    }
    { const float* w_s = a.in[7]; bf16_t* Wb = (bf16_t*)(ws + WS_WSB);
      for (int idx = (F.vcu * NWAVES * 64) + tid; idx < 4 * 128 * 128; idx += F.G * NWAVES * 64) { const int t = (idx >> 7) & 127, sidx = idx & 127; Wb[idx] = (sidx <= t) ? f2bf(w_s[idx]) : (bf16_t)0; } }
    { const int* pos = (const int*)a.in[1]; float* tab = (float*)(ws + WS_ROPE);
      for (int idx = (F.vcu * NWAVES * 64) + tid; idx < M * 8; idx += F.G * NWAVES * 64) {
          const int row = idx >> 3, i = idx & 7;
          const double inv = exp2(-(double)(2 * i) / 16.0 * 18.931568569324174);
          const float ang = (float)pos[row] * (float)inv;
          const double rev = (double)ang * 0.15915494309189535;
          const double fr = rev - floor(rev);
          const float aa = (float)(fr * 6.283185307179586);
          tab[row * 16 + i] = cosf(aa); tab[row * 16 + 8 + i] = sinf(aa); } }
    { bf16_t* XN = (bf16_t*)(ws + WS_XN); float* rsq = (float*)(ws + WS_RSQ); const float* x = a.in[0];
      for (int m0 = gw * 4; m0 < M; m0 += NGW * 4) {
          f32x4 v[4][4];
#pragma unroll
          for (int r = 0; r < 4; ++r)
#pragma unroll
              for (int j = 0; j < 4; ++j) v[r][j] = *((const f32x4*)(x + (size_t)(m0 + r) * DM) + lane + 64 * j);
#pragma unroll
          for (int r = 0; r < 4; ++r) { float sq = 0.f;
#pragma unroll
              for (int j = 0; j < 4; ++j) sq += (v[r][j].x * v[r][j].x + v[r][j].y * v[r][j].y) + (v[r][j].z * v[r][j].z + v[r][j].w * v[r][j].w);
              sq = wave_sum(sq);
              unsigned long long* o8 = (unsigned long long*)(XN + (size_t)(m0 + r) * DM) + lane;
#pragma unroll
              for (int j = 0; j < 4; ++j) o8[64 * j] = (unsigned long long)pk2bf(v[r][j].x, v[r][j].y) | ((unsigned long long)pk2bf(v[r][j].z, v[r][j].w) << 32);
              if (lane < 4) rsq[(size_t)(m0 + r) * 4 + lane] = (lane == 0) ? sq : 0.f; } } }
}

#ifndef PG8_SP2
#define PG8_SP2 true
#endif
#ifndef PG8_ALIGN
#define PG8_ALIGN true
#endif

struct SchedC {
    int vcu, G; attn_body::bf16* QKV; attn_body::bf16* OCA;
    __device__ __forceinline__ bool next(int it, attn_body::AttnUnit& u) const {
        constexpr long P = attn_body::PITCH;
        const int per = 6, s = vcu + (it / per) * G, k = (it % per) >> 1, pass = it & 1;
        if (s >= 256) return false;
        const int x = s >> 5, l = s & 31, i = l & 15, hl = (l >> 4) * 3 + k;
        const int qb = (k == 0) ? i : (k == 1) ? ((i + 8) & 15) : (i < 8 ? 14 - 2 * i : 31 - 2 * i);
        const int bj = x * 6 + hl, b = bj / 12, j = bj % 12, h = j >> 1;
        const long rowbase = (long)b * SEQ, q0 = (long)qb * 256;
        u.Q = QKV + (rowbase + q0) * P + j * 64; u.K = QKV + rowbase * P + 768 + j * 64; u.V = QKV + rowbase * P + 1536 + h * 128 + pass * 64;
        u.O = pass ? QKV + (rowbase + q0) * P + j * 64 : OCA + (rowbase + q0) * 768 + j * 64; u.ors = pass ? P : 768; u.rs = P;
        u.NT = 4 * qb + 4; u.moff = (int)q0; u.lse = nullptr; u.lrs = 0;
        return true;
    }
};
struct SchedD {
    int vcu, G; attn_body::bf16* QKV; float* LSE;
    __device__ __forceinline__ bool next(int it, attn_body::AttnUnit& u) const {
        constexpr long P = attn_body::PITCH;
        const int ud = vcu + it * G; if (ud >= 768) return false;
        const int b = ud / 192, rem = ud % 192, head = rem >> 4, idx = rem & 15, g = head >> 2;
        const int dl = (g == 0) ? 1 : (g == 1 ? 4 : 16), nb = 16 / dl, r = idx / nb, qb = idx % nb;
        const long rowbase = (long)b * SEQ + r; const int q0 = 256 * qb, kstart = (q0 >= 128) ? q0 - 128 : 0;
        u.rs = (long)dl * P; u.ors = u.rs; u.lrs = (long)dl * 12;
        u.Q = QKV + (rowbase + (long)q0 * dl) * P + 2304 + head * 64; u.O = QKV + (rowbase + (long)q0 * dl) * P + 2304 + head * 64;
        u.K = QKV + (rowbase + (long)kstart * dl) * P + 3072 + head * 64; u.V = QKV + (rowbase + (long)kstart * dl) * P + 3840 + head * 64;
        u.NT = (q0 + 256 - kstart) / 64; u.moff = q0 - kstart; u.lse = LSE + (rowbase + (long)q0 * dl) * 12 + head;
        return true;
    }
};
__device__ __forceinline__ f32x4 bf4lo(const u32x4 w) { return (f32x4){__uint_as_float(w.x << 16), __uint_as_float(w.x & 0xffff0000u), __uint_as_float(w.y << 16), __uint_as_float(w.y & 0xffff0000u)}; }
__device__ __forceinline__ f32x4 bf4hi(const u32x4 w) { return (f32x4){__uint_as_float(w.z << 16), __uint_as_float(w.z & 0xffff0000u), __uint_as_float(w.w << 16), __uint_as_float(w.w & 0xffff0000u)}; }
__device__ __forceinline__ u32x4 pack8(const f32x4 a, const f32x4 b) { u32x4 o; o.x = pk2bf(a[0], a[1]); o.y = pk2bf(a[2], a[3]); o.z = pk2bf(b[0], b[1]); o.w = pk2bf(b[2], b[3]); return o; }
__device__ __forceinline__ void post_attention_phase(Frame& F, const Args& a, unsigned char* ws) {
    const bf16_t* QKV = (const bf16_t*)(ws + WS_QKV); const bf16_t* OCA = (const bf16_t*)(ws + WS_OCA); const float* LSE = (const float*)(ws + WS_LSE);
    bf16_t* Y1 = (bf16_t*)(ws + WS_XN);
    const int lane = lane_id(), gw = F.vcu * NWAVES + F.wave, NGW = F.G * NWAVES;
    const float lam = __expf(wave_sum(a.in[13][lane] * a.in[14][lane])) - __expf(wave_sum(a.in[15][lane] * a.in[16][lane])) + LAMBDA_INIT;
    const bool isC = lane < 48;
    const int h = lane >> 3, c = lane & 7, hh = (lane - 48) >> 2, dc = (lane & 3) * 16;
    f32x4 ga0, ga1, gb0, gb1;
    { const float f = 1.f - LAMBDA_INIT; const float* sg = a.in[17] + 8 * c;
      ga0 = *(const f32x4*)sg * f; ga1 = *(const f32x4*)(sg + 4) * f; gb0 = *(const f32x4*)(sg + 64) * f; gb1 = *(const f32x4*)(sg + 68) * f; }
    for (int row = gw; row < M; row += NGW) {
        const bf16_t* qa = OCA + (size_t)row * 768; const bf16_t* qb = QKV + (size_t)row * N_QKV; bf16_t* y = Y1 + (size_t)row * DM;
        if (isC) {
            const u32x4 a0 = *(const u32x4*)(qa + (2 * h) * 64 + 8 * c), a1 = *(const u32x4*)(qa + (2 * h + 1) * 64 + 8 * c);
            const u32x4 b0 = *(const u32x4*)(qb + (2 * h) * 64 + 8 * c), b1 = *(const u32x4*)(qb + (2 * h + 1) * 64 + 8 * c);
            const f32x4 x0 = bf4lo(a0) - lam * bf4lo(a1), x1 = bf4hi(a0) - lam * bf4hi(a1), z0 = bf4lo(b0) - lam * bf4lo(b1), z1 = bf4hi(b0) - lam * bf4hi(b1);
            float q = ((x0[0] * x0[0] + x0[1] * x0[1]) + (x0[2] * x0[2] + x0[3] * x0[3])) + ((x1[0] * x1[0] + x1[1] * x1[1]) + (x1[2] * x1[2] + x1[3] * x1[3]))
                    + ((z0[0] * z0[0] + z0[1] * z0[1]) + (z0[2] * z0[2] + z0[3] * z0[3])) + ((z1[0] * z1[0] + z1[1] * z1[1]) + (z1[2] * z1[2] + z1[3] * z1[3]));
            q += dpp_f<0xB1>(q); q += dpp_f<0x4E>(q); q += dpp_f<0x141>(q);
            const float r = rsqrtf(q * (1.f / 128.f) + EPS);
            *(u32x4*)(y + h * 128 + 8 * c) = pack8(x0 * ga0 * r, x1 * ga1 * r);
            *(u32x4*)(y + h * 128 + 64 + 8 * c) = pack8(z0 * gb0 * r, z1 * gb1 * r);
        } else {
            const float l0 = LSE[(size_t)row * 12 + hh], l1 = LSE[(size_t)row * 12 + 4 + hh], l2 = LSE[(size_t)row * 12 + 8 + hh];
            const float mx = fmaxf(l0, fmaxf(l1, l2));
            float w0 = __builtin_amdgcn_exp2f(l0 - mx), w1 = __builtin_amdgcn_exp2f(l1 - mx), w2 = __builtin_amdgcn_exp2f(l2 - mx);
            const float inv = 1.f / (w0 + w1 + w2); w0 *= inv; w1 *= inv; w2 *= inv;
            const bf16_t* d0 = qb + 2304 + hh * 64 + dc;
#pragma unroll
            for (int k = 0; k < 2; ++k) {
                const u32x4 v0 = *(const u32x4*)(d0 + 8 * k), v1 = *(const u32x4*)(d0 + 256 + 8 * k), v2 = *(const u32x4*)(d0 + 512 + 8 * k);
                *(u32x4*)(y + 768 + hh * 64 + dc + 8 * k) = pack8(w0 * bf4lo(v0) + w1 * bf4lo(v1) + w2 * bf4lo(v2), w0 * bf4hi(v0) + w1 * bf4hi(v1) + w2 * bf4hi(v2));
            }
        }
    }
}

constexpr int MXP = 136;
__device__ __forceinline__ void mixer_phase(Frame& F, const Args& a, unsigned char* ws) {
    const bf16_t* P = (const bf16_t*)(ws + WS_P); bf16_t* Y = (bf16_t*)(ws + WS_Y);
    const bf16_t* Wb = (const bf16_t*)(ws + WS_WSB); const bf16_t* PWt = (const bf16_t*)(ws + WS_PWT);
    const float* v_gain = a.in[6]; const float* b_s = a.in[8]; const float* pool_scale = a.in[10];
    LAS bf16_t* T = (LAS bf16_t*)(F.lds + RING_OFF);
    LAS float* rs = (LAS float*)(F.lds + RING_OFF + 128 * MXP * 2);
    const int tid = tid_id(), wid = tid >> 6, lane = tid & 63, fr = lane & 15, fq = lane >> 4;
    for (int u = F.vcu; u < 1024; u += F.G) {
        const bool isA = u < 512; const int blk = (u & 511) >> 2, g = u & 3, row0 = blk * 128;
        f32x4 acc[8];
#pragma unroll
        for (int j = 0; j < 8; ++j) acc[j] = (f32x4){0.f, 0.f, 0.f, 0.f};
        if (isA) {
            { bf16x8 xr[16];
#pragma unroll
              for (int i = 0; i < 16; ++i) xr[i] = *(const bf16x8*)(P + (size_t)(row0 + wid * 16 + i) * N_IN0 + 512 + lane * 8);
#pragma unroll
              for (int i = 0; i < 16; ++i) { float q = 0.f;
#pragma unroll
                  for (int e = 0; e < 8; ++e) { const float f = bf2f((bf16_t)xr[i][e]); q += f * f; }
                  q = wave_sum(q);
                  if (lane == 0) rs[wid * 16 + i] = rsqrtf(q * (1.f / 512.f) + EPS); } }
            __syncthreads();
            for (int it = tid; it < 128 * 16; it += 512) { const int sr = it >> 4, cc = it & 15;
                const bf16x8 x = *(const bf16x8*)(P + (size_t)(row0 + sr) * N_IN0 + 512 + g * 128 + cc * 8);
                const float r = rs[sr];
#pragma unroll
                for (int e = 0; e < 8; ++e) T[(cc * 8 + e) * MXP + sr] = f2bf(bf2f((bf16_t)x[e]) * r * v_gain[g * 128 + cc * 8 + e]); }
            __syncthreads();
            const bf16_t* wrow = Wb + ((size_t)g * 128 + wid * 16 + fr) * 128 + fq * 8;
            const int nks = (wid >> 1) + 1;
            for (int ks = 0; ks < nks; ++ks) {
                const bf16x8 af = *(const bf16x8*)(wrow + ks * 32);
#pragma unroll
                for (int j = 0; j < 8; ++j) { const bf16x8 bfr = *(const LAS bf16x8*)(T + (j * 16 + fr) * MXP + ks * 32 + fq * 8);
                    acc[j] = __builtin_amdgcn_mfma_f32_16x16x32_bf16(bfr, af, acc[j], 0, 0, 0); }
            }
            const int t = wid * 16 + fr; const float bias = b_s[g * 128 + t];
#pragma unroll
            for (int j = 0; j < 8; ++j) { const int col = g * 128 + j * 16 + fq * 4;
                const u32x2 uu = *(const u32x2*)(P + (size_t)(row0 + t) * N_IN0 + col);
                const float u0 = __uint_as_float(uu.x << 16), u1 = __uint_as_float(uu.x & 0xffff0000u), u2 = __uint_as_float(uu.y << 16), u3 = __uint_as_float(uu.y & 0xffff0000u);
                u32x2 o; o.x = pk2bf(u0 * (acc[j][0] + bias), u1 * (acc[j][1] + bias)); o.y = pk2bf(u2 * (acc[j][2] + bias), u3 * (acc[j][3] + bias));
                *(u32x2*)(Y + (size_t)(row0 + t) * DM + col) = o; }
        } else {
            const int w = 2 << g; const float inv_w = 1.f / (float)w;
            { const int cc = tid & 15, rg = tid >> 4, r0 = row0 + rg * 4;
              const bf16_t* xp = P + 1024 + g * 128 + cc * 8;
              float sum[8];
#pragma unroll
              for (int e = 0; e < 8; ++e) sum[e] = 0.f;
              const int t0 = r0 & (SEQ - 1);
              for (int jj = 1; jj < w; ++jj) { if (t0 - jj >= 0) { const bf16x8 x = *(const bf16x8*)(xp + (size_t)(r0 - jj) * N_IN0);
#pragma unroll
                      for (int e = 0; e < 8; ++e) sum[e] += bf2f((bf16_t)x[e]); } }
#pragma unroll
              for (int i = 0; i < 4; ++i) { const int row = r0 + i, ts = t0 + i;
                  const bf16x8 x = *(const bf16x8*)(xp + (size_t)row * N_IN0);
                  float xv[8];
#pragma unroll
                  for (int e = 0; e < 8; ++e) { xv[e] = bf2f((bf16_t)x[e]); sum[e] += xv[e]; }
                  const float ic = (ts + 1 < w) ? 1.f / (float)(ts + 1) : inv_w;
                  u32x4 o; o.x = pk2bf(sum[0] * ic - xv[0], sum[1] * ic - xv[1]); o.y = pk2bf(sum[2] * ic - xv[2], sum[3] * ic - xv[3]);
                  o.z = pk2bf(sum[4] * ic - xv[4], sum[5] * ic - xv[5]); o.w = pk2bf(sum[6] * ic - xv[6], sum[7] * ic - xv[7]);
                  *(LAS u32x4*)(T + (rg * 4 + i) * MXP + cc * 8) = o;
                  if (ts - (w - 1) >= 0) { const bf16x8 xo = *(const bf16x8*)(xp + (size_t)(row - (w - 1)) * N_IN0);
#pragma unroll
                      for (int e = 0; e < 8; ++e) sum[e] -= bf2f((bf16_t)xo[e]); } } }
            __syncthreads();
            const bf16_t* prow = PWt + ((size_t)g * 128 + fr) * 128 + fq * 8;
#pragma unroll
            for (int ks = 0; ks < 4; ++ks) {
                const bf16x8 af = *(const LAS bf16x8*)(T + (wid * 16 + fr) * MXP + ks * 32 + fq * 8);
#pragma unroll
                for (int j = 0; j < 8; ++j) { const bf16x8 bfr = *(const bf16x8*)(prow + (size_t)(j * 16) * 128 + ks * 32);
                    acc[j] = __builtin_amdgcn_mfma_f32_16x16x32_bf16(bfr, af, acc[j], 0, 0, 0); }
            }
            const int t = wid * 16 + fr;
#pragma unroll
            for (int j = 0; j < 8; ++j) { const int d = g * 128 + j * 16 + fq * 4; const f32x4 sc = *(const f32x4*)(pool_scale + d);
                u32x2 o; o.x = pk2bf(acc[j][0] * sc[0], acc[j][1] * sc[1]); o.y = pk2bf(acc[j][2] * sc[2], acc[j][3] * sc[3]);
                *(u32x2*)(Y + (size_t)(row0 + t) * DM + 512 + d) = o; }
        }
        __syncthreads();
    }
}

__device__ __forceinline__ void ffn_fix_phase(Frame& F, const Args& a, unsigned char* ws, int layer) {
    bf16_t* HM = (bf16_t*)(ws + WS_HMID);
    const float* halo = (const float*)(ws + WS_HALO); const float* tops = (const float*)(ws + WS_TOPS); const float* topg = (const float*)(ws + WS_TOPG);
    const float* cw = a.in[20] + (size_t)layer * 3 * DFF;
    const int tid = tid_id();
    constexpr int CPR = DFF / 4;
    for (int it = F.vcu * (NWAVES * 64) + tid; it < 64 * 2 * CPR; it += F.G * NWAVES * 64) {
        const int pm = it / (2 * CPR), rem = it % (2 * CPR), rr = rem / CPR, c = (rem % CPR) * 4;
        if ((pm & 15) == 0) continue;
        const size_t off = ((size_t)pm * 2 + rr) * DFF + c;
        f32x4 sv = *(const f32x4*)(tops + off); const f32x4 g = *(const f32x4*)(topg + off);
        const f32x4 h1 = *(const f32x4*)(halo + ((size_t)(pm - 1) * 2 + 1) * DFF + c), h0 = *(const f32x4*)(halo + ((size_t)(pm - 1) * 2 + 0) * DFF + c);
        const f32x4 w0 = *(const f32x4*)(cw + c), w1 = *(const f32x4*)(cw + DFF + c);
        if (rr == 0) sv = sv + w1 * h1 + w0 * h0; else sv = sv + w0 * h1;
        u32x2 o; o.x = pk2bf(gelu_tanh(sv[0]) * g[0], gelu_tanh(sv[1]) * g[1]); o.y = pk2bf(gelu_tanh(sv[2]) * g[2], gelu_tanh(sv[3]) * g[3]);
        *(u32x2*)(HM + (size_t)(pm * 256 + rr) * DFF + c) = o;
    }
}

#define OPQ_S(x) asm volatile("" : "+s"(x))
__device__ __forceinline__ Frame make_frame(unsigned char* ws) {
    extern __shared__ __attribute__((aligned(16))) unsigned char lds_[];
    Frame F;
    F.lds = (LAS unsigned char*)lds_;
    F.MISC = (volatile LAS unsigned*)(F.lds + MISC_OFF);
    F.wave = __builtin_amdgcn_readfirstlane((int)threadIdx.x >> 6);
    int G = gridDim.x, bx = blockIdx.x; OPQ_S(G); OPQ_S(bx);
    F.G = G; F.vcu = (G % 8 == 0) ? (bx % 8) * (G / 8) + bx / 8 : bx;
    F.ctl = (gu32*)(ws + WS_CTL);
    return F;
}
__global__ void __launch_bounds__(NWAVES * 64, 2) mk_fwd(Args args) {
    extern __shared__ __attribute__((aligned(16))) unsigned char lds[];
    for (int u = threadIdx.x; u < (LDS_BYTES - LDSCTL_OFF) / 4; u += NWAVES * 64) ((LAS unsigned*)((LAS unsigned char*)lds + LDSCTL_OFF))[u] = 0u;
    __syncthreads();
    const int lo = args.ph_lo, hi = args.ph_hi;
    if (hi - lo > 1) { unsigned char* ws = args.ws; (void)xcd_barrier_post((unsigned*)((gu32*)(ws + WS_CTL) + CW_BAR) + args.li * XCD_BAR_WORDS, (volatile LAS unsigned*)((LAS unsigned char*)lds + MISC_OFF) + 8); }
#ifdef MK_DIAG
    if (blockIdx.x == 0 && threadIdx.x == 0) ((unsigned long long*)(args.ws + WS_CTL + 524288))[31] = __builtin_amdgcn_s_memrealtime();
#endif
    int pc = 0;
#define PHASE_BEGIN if (pc >= lo && pc < hi) { size_t z_ = 0; OPQ_S(z_); unsigned char* ws = args.ws + z_; float* out = args.out + z_; Frame F = make_frame(ws); bf16_t* XN = (bf16_t*)(ws + WS_XN); (void)XN; (void)out;
#ifdef MK_DIAG
#define DIAG_STAMP(k) do { if (blockIdx.x == 0 && threadIdx.x == 0) ((unsigned long long*)(ws + WS_CTL + 524288))[(k)] = __builtin_amdgcn_s_memrealtime(); } while (0)
#else
#define DIAG_STAMP(k) do { } while (0)
#endif
#define PHASE_END if (pc + 1 < hi) { XcdBarrier bar; bar.bar = (unsigned*)(F.ctl + CW_BAR) + args.li * XCD_BAR_WORDS; bar.x = xb_xcc_id(); bar.st = F.MISC + 8; xcd_barrier(bar); } DIAG_STAMP(pc); } ++pc;

    PHASE_BEGIN p0_prologue(F, args); PHASE_END
    PHASE_BEGIN
        pg8::Gemm g{XN, (const bf16_t*)(ws + WS_W_IN0), M, N_IN0, DM}; pg8::StaticOrder S; S.init(M, N_IN0, F.G, (int)blockIdx.x);
        pg8::EpiBf16G E{(bf16_t*)(ws + WS_P), N_IN0, 4, (const float*)(ws + WS_RSQ)};
        pg8::gemm_phase<pg8::EpiBf16G, pg8::StaticOrder, PG8_ALIGN, PG8_SP2>(F.lds + RING_OFF, g, S, E);
    PHASE_END
    PHASE_BEGIN mixer_phase(F, args, ws); PHASE_END
    PHASE_BEGIN
        pg8::Gemm g{(const bf16_t*)(ws + WS_Y), (const bf16_t*)(ws + WS_W_OUT0), M, DM, DM}; pg8::StaticOrder S; S.init(M, DM, F.G, (int)blockIdx.x);
        pg8::EpiRes E{args.in[0], out, XN, (float*)(ws + WS_RSQ)};
        pg8::gemm_phase<pg8::EpiRes, pg8::StaticOrder, PG8_ALIGN, PG8_SP2>(F.lds + RING_OFF, g, S, E);
    PHASE_END
#define RMS_PHASE(gain_ptr) PHASE_BEGIN { const float* gain = (gain_ptr); const int lane = lane_id(); const int gw = F.vcu * NWAVES + F.wave, NGW = F.G * NWAVES; \
        for (int m = gw; m < M; m += NGW) rms_row_to_bf16(out + (size_t)m * DM, gain, XN + (size_t)m * DM, lane); } PHASE_END
#define UP_PHASE(layer, abuf) PHASE_BEGIN { pg8::Gemm g{(const bf16_t*)(ws + (abuf)), (const bf16_t*)(ws + WS_W_UP) + (size_t)(layer) * NUP * DM, M, NUP, DM}; pg8::StaticOrder S; S.init(M, NUP, F.G, (int)blockIdx.x); \
        pg8::EpiUpConv E{(bf16_t*)(ws + WS_HMID), args.in[20] + (size_t)(layer) * 3 * DFF, args.in[21] + (size_t)(layer) * DFF, (float*)(ws + WS_HALO), (float*)(ws + WS_TOPS), (float*)(ws + WS_TOPG), (const float*)(ws + WS_RSQ)}; \
        pg8::gemm_phase<pg8::EpiUpConv, pg8::StaticOrder, true, PG8_SP2>(F.lds + RING_OFF, g, S, E); } PHASE_END
#define DOWN_PHASE(layer, hbptr) PHASE_BEGIN { pg8::Gemm g{(const bf16_t*)(ws + WS_HMID), (const bf16_t*)(ws + WS_W_DN) + (size_t)(layer) * DM * DFF, M, DM, DFF}; pg8::StaticOrder S; S.init(M, DM, F.G, (int)blockIdx.x); \
        pg8::EpiRes E{out, out, (hbptr), (float*)(ws + WS_RSQ)}; \
        pg8::gemm_phase<pg8::EpiRes, pg8::StaticOrder, PG8_ALIGN, PG8_SP2>(F.lds + RING_OFF, g, S, E); } PHASE_END
    UP_PHASE(0, WS_XN)
    PHASE_BEGIN ffn_fix_phase(F, args, ws, 0); PHASE_END
    DOWN_PHASE(0, XN)
    PHASE_BEGIN
        pg8::Gemm g{XN, (const bf16_t*)(ws + WS_W_QKV), M, N_QKV, DM}; pg8::StaticOrder S; S.init(M, N_QKV, F.G, (int)blockIdx.x);
        pg8::EpiQKV E{(bf16_t*)(ws + WS_QKV), (const float*)(ws + WS_ROPE), (const float*)(ws + WS_RSQ)};
        pg8::gemm_phase<pg8::EpiQKV, pg8::StaticOrder, PG8_ALIGN, PG8_SP2>(F.lds + RING_OFF, g, S, E);
    PHASE_END
    PHASE_BEGIN
        { const SchedC SC{F.vcu, F.G, (attn_body::bf16*)(ws + WS_QKV), (attn_body::bf16*)(ws + WS_OCA)};
          attn_body::attn_phase<SchedC, 8, false>((char*)lds + RING_OFF, SC); }
        { const SchedD SD{F.vcu, F.G, (attn_body::bf16*)(ws + WS_QKV), (float*)(ws + WS_LSE)};
          attn_body::attn_phase<SchedD, 8, true>((char*)lds + RING_OFF, SD); }
    PHASE_END
    PHASE_BEGIN post_attention_phase(F, args, ws); PHASE_END
    PHASE_BEGIN
        pg8::Gemm g{XN, (const bf16_t*)(ws + WS_W_OUT1), M, DM, DM}; pg8::StaticOrder S; S.init(M, DM, F.G, (int)blockIdx.x);
        pg8::EpiRes E{out, out, (bf16_t*)(ws + WS_HB2), (float*)(ws + WS_RSQ)};
        pg8::gemm_phase<pg8::EpiRes, pg8::StaticOrder, PG8_ALIGN, PG8_SP2>(F.lds + RING_OFF, g, S, E);
    PHASE_END
    UP_PHASE(1, WS_HB2)
    PHASE_BEGIN ffn_fix_phase(F, args, ws, 1); PHASE_END
    DOWN_PHASE(1, (bf16_t*)nullptr)
    PHASE_BEGIN
        const int lane = lane_id(); const int gw = F.vcu * NWAVES + F.wave, NGW = F.G * NWAVES;
        for (int m = gw; m < M; m += NGW) rms_row_inplace_rsq(out + (size_t)m * DM, args.in[4], (const float*)(ws + WS_RSQ) + (size_t)m * 4, lane);
    PHASE_END
#ifdef MK_DIAG
    __syncthreads();
    if (blockIdx.x == 0 && threadIdx.x < 64) {
        asm volatile("s_waitcnt vmcnt(0)" ::: "memory");
        const unsigned long long* st = (const unsigned long long*)(args.ws + WS_CTL + 524288);
        const unsigned long long a1 = __hip_atomic_load(st + MK_DIAG_SEL1, __ATOMIC_RELAXED, __HIP_MEMORY_SCOPE_AGENT), b1 = __hip_atomic_load(st + (MK_DIAG_SEL1 == 0 ? 31 : MK_DIAG_SEL1 - 1), __ATOMIC_RELAXED, __HIP_MEMORY_SCOPE_AGENT);
        const unsigned long long a2 = __hip_atomic_load(st + MK_DIAG_SEL2, __ATOMIC_RELAXED, __HIP_MEMORY_SCOPE_AGENT), b2 = __hip_atomic_load(st + (MK_DIAG_SEL2 == 0 ? 31 : MK_DIAG_SEL2 - 1), __ATOMIC_RELAXED, __HIP_MEMORY_SCOPE_AGENT);
        const float d1 = (float)(long long)(a1 - b1) * 0.01f, d2 = (float)(long long)(a2 - b2) * 0.01f;
        for (int i = threadIdx.x; i <= 4096; i += 64) args.out[i] = (i == 0) ? d1 : d2;
    }
#endif
#undef PHASE_BEGIN
#undef PHASE_END
}
constexpr int N_PHASES = 15;

#ifndef MK_N_LAUNCHES
#define MK_N_LAUNCHES 1
#endif
extern "C" void kernel_launch(void* const* d_in, const int* in_sizes, int n_in, void* d_out, int out_size, void* d_ws, size_t ws_size, hipStream_t stream) {
    static int grid = 0;
    if (grid == 0) {
        int dev = 0, cus = 0;
        if (hipGetDevice(&dev) != hipSuccess || hipDeviceGetAttribute(&cus, hipDeviceAttributeMultiprocessorCount, dev) != hipSuccess) { fprintf(stderr, "kernel_launch: device query failed\n"); grid = -1; return; }
        if (hipFuncSetAttribute((const void*)mk_fwd, hipFuncAttributeMaxDynamicSharedMemorySize, LDS_BYTES) != hipSuccess) { fprintf(stderr, "kernel_launch: hipFuncSetAttribute failed\n"); grid = -1; return; }
        int per_cu = 0;
        if (hipOccupancyMaxActiveBlocksPerMultiprocessor(&per_cu, (const void*)mk_fwd, NWAVES * 64, LDS_BYTES) != hipSuccess || per_cu < 1) fprintf(stderr, "kernel_launch: occupancy query reports %d workgroups per CU\n", per_cu);
        (void)hipGetLastError();
        grid = cus > 0 ? cus : 256;
    }
    if (grid < 0) return;
    unsigned char* ws = (unsigned char*)d_ws;
    (void)hipMemsetAsync(ws + WS_CTL, 0, CTL_ZERO_BYTES, stream);
    Args a{};
    for (int i = 0; i < 23; ++i) a.in[i] = (const float*)d_in[i];
    a.out = (float*)d_out; a.ws = ws;
#ifdef MK_DUP_PHASE
    if (true) {
        a.li = 0; a.ph_lo = 0; a.ph_hi = MK_DUP_PHASE + 1; hipLaunchKernelGGL(mk_fwd, dim3(grid), dim3(NWAVES * 64), LDS_BYTES, stream, a);
        a.li = 1; a.ph_lo = MK_DUP_PHASE; a.ph_hi = MK_DUP_PHASE + 1; hipLaunchKernelGGL(mk_fwd, dim3(grid), dim3(NWAVES * 64), LDS_BYTES, stream, a);
        a.li = 2; a.ph_lo = MK_DUP_PHASE + 1; a.ph_hi = N_PHASES; hipLaunchKernelGGL(mk_fwd, dim3(grid), dim3(NWAVES * 64), LDS_BYTES, stream, a);
    } else
#endif
    if (MK_N_LAUNCHES == 1) {
        a.ph_lo = 0; a.ph_hi = N_PHASES;
        hipLaunchKernelGGL(mk_fwd, dim3(grid), dim3(NWAVES * 64), LDS_BYTES, stream, a);
    } else {
        for (int p = 0; p < N_PHASES; ++p) { a.ph_lo = p; a.ph_hi = p + 1; hipLaunchKernelGGL(mk_fwd, dim3(grid), dim3(NWAVES * 64), LDS_BYTES, stream, a); }
    }
}
```

```cpp
#include <hip/hip_runtime.h>
#include <cstdint>
#include <cstdio>

typedef unsigned short bf16_t;
typedef short bf16x8 __attribute__((ext_vector_type(8)));
typedef float f32x4 __attribute__((ext_vector_type(4)));
typedef float f32x2 __attribute__((ext_vector_type(2)));
typedef unsigned u32x4 __attribute__((ext_vector_type(4)));
typedef unsigned u32x2 __attribute__((ext_vector_type(2)));

constexpr int BATCH = 4, SEQ = 4096, DM = 1024, M = BATCH * SEQ;
constexpr int DFF = 2816, NUP = 2 * DFF;
constexpr int N_IN0 = 1536, N_QKV = 4608;
constexpr float EPS = 1e-6f;
constexpr float LAMBDA_INIT = 0.35550906759f;

__device__ __forceinline__ float bf2f(bf16_t v) { return __uint_as_float(((unsigned)v) << 16); }
__device__ __forceinline__ bf16_t f2bf(float f) { unsigned u = __float_as_uint(f); return (bf16_t)((u + 0x7fffu + ((u >> 16) & 1u)) >> 16); }
__device__ __forceinline__ unsigned pk2bf(float lo, float hi) { return (unsigned)f2bf(lo) | ((unsigned)f2bf(hi) << 16); }
__device__ __forceinline__ float gelu_tanh(float x) {
    const float y = x * (0.7978845608028654f + 0.035677408136300125f * x * x);
    return x * __builtin_amdgcn_rcpf(1.0f + __builtin_amdgcn_exp2f(-2.8853900817779268f * y));
}
template <int CTRL> __device__ __forceinline__ float dpp_f(float v) { return __int_as_float(__builtin_amdgcn_update_dpp(0, __float_as_int(v), CTRL, 0xf, 0xf, true)); }
__device__ __forceinline__ float swz_xor16(float v) { return __int_as_float(__builtin_amdgcn_ds_swizzle(__float_as_int(v), 0x401F)); }
__device__ __forceinline__ float wave_sum(float v) {
    v += dpp_f<0xB1>(v);
    v += dpp_f<0x4E>(v);
    v += dpp_f<0x141>(v);
    v += dpp_f<0x140>(v);
    v += swz_xor16(v);
    const auto rr = __builtin_amdgcn_permlane32_swap(__float_as_uint(v), __float_as_uint(v), false, false);
    return __uint_as_float(rr[0]) + __uint_as_float(rr[1]);
}

constexpr size_t MiB = 1u << 20;
constexpr size_t WS_CTL = 0, CTL_ZERO_BYTES = 1 * MiB;
constexpr size_t WS_W_IN0 = 1 * MiB;
constexpr size_t WS_W_OUT0 = 4 * MiB;
constexpr size_t WS_W_QKV = 6 * MiB;
constexpr size_t WS_W_OUT1 = 15 * MiB;
constexpr size_t WS_W_UP = 17 * MiB;
constexpr size_t WS_W_DN = 39 * MiB;
constexpr size_t WS_ROPE = 50 * MiB;
constexpr size_t WS_WSB = 51 * MiB;
constexpr size_t WS_PWT = 51 * MiB + 256 * 1024;
constexpr size_t WS_XN = 52 * MiB;
constexpr size_t WS_BUF = 84 * MiB;
constexpr size_t WS_P = WS_BUF, WS_Y = 132 * MiB;
constexpr size_t WS_HMID = 116 * MiB;
constexpr size_t WS_HALO = 204 * MiB, WS_TOPS = 206 * MiB, WS_TOPG = 208 * MiB;
constexpr size_t WS_QKV = WS_BUF;
constexpr int Y1_COL = 768;
constexpr size_t WS_OCA = 228 * MiB;
constexpr size_t WS_RSQ = 253 * MiB;
constexpr size_t WS_LSE = 252 * MiB;
namespace pg8 {
#define PG8_LAS __attribute__((address_space(3)))
typedef unsigned short bf16_t;
typedef short bf16x8 __attribute__((ext_vector_type(8)));
typedef float f32x4 __attribute__((ext_vector_type(4)));
typedef unsigned u32x4 __attribute__((ext_vector_type(4)));
constexpr int BM = 256, BK = 64, HALF = 128, HTB = HALF * BK * 2  , STAGE_BYTES = 8 * HTB, NXCD = 8, WGM = 8;

__host__ __device__ __forceinline__ int lds_byte(int r, int c) { const int st = (r >> 4) * 2 + (c >> 5), rr = r & 15, cc = c & 31, ob = rr * 64 + cc * 2; return st * 1024 + (ob ^ (((ob >> 9) & 1) << 5)); }
__host__ __device__ __forceinline__ void stage_rc(int b, int& R, int& C) { const int st = b / 1024, sb = b % 1024, swz = sb ^ (((sb >> 9) & 1) << 5); R = (st >> 1) * 16 + swz / 64; C = (st & 1) * 32 + (swz % 64) / 2; }
__host__ __device__ __forceinline__ int perm32(int rho) { const int n = rho >> 4, i = rho & 15; return 8 * (i >> 2) + 4 * n + (i & 3); }

struct Unit { int pm, pn; };
struct Gemm { const bf16_t* A; const bf16_t* Bt; int M, N, K, lda; };

struct StaticOrder {
    int nM, nN, nwg, G, c;
    __host__ __device__ void init(int M, int N, int G_, int c_) { nM = M / BM; nN = N / BM; nwg = nM * nN; G = G_; c = c_; }
    __host__ __device__ bool next(int i, Unit& u) const {
        const long L = (long)i * G + c; if (L >= nwg) return false;
        int wgid = (int)L; { const int q = nwg / NXCD, r = nwg % NXCD, xcd = wgid % NXCD, off = wgid / NXCD; wgid = (xcd < r ? xcd * (q + 1) : r * (q + 1) + (xcd - r) * q) + off; }
        const int nig = WGM * nN, gid = wgid / nig, fm = gid * WGM, gsz = (nM - fm) < WGM ? (nM - fm) : WGM;
        u.pm = fm + ((wgid % nig) % gsz); u.pn = (wgid % nig) / gsz; return true;
    }
    __device__ __forceinline__ void a_ready(const Unit&) const {}
    __device__ __forceinline__ void done(const Unit&) const {}
};


__device__ __forceinline__ unsigned cvt_pk_bf16(float lo, float hi) { unsigned r; asm volatile("v_cvt_pk_bf16_f32 %0, %1, %2" : "=v"(r) : "v"(lo), "v"(hi)); return r; }

__device__ __forceinline__ float rstd_of(const f32x4 p) { return rsqrtf(((p[0] + p[1]) + (p[2] + p[3])) * (1.f / 1024.f) + 1e-6f); }
struct EpiBf16G {
    static constexpr bool PERM = true, AFTER_DRAIN = false;
    bf16_t* O; int ldc; int gelu_tiles; const float* rsq;
    __device__ __forceinline__ void operator()(const f32x4 (&acc)[2][2][4][2], const Unit& u, int wr, int wc, int fr, int fq) const {
        const int row0 = u.pm * BM + wr * 64 + fr, col0 = u.pn * BM + wc * 32 + 8 * fq;
        const bool g = u.pn < gelu_tiles;
        f32x4 pr[2][4];
#pragma unroll
        for (int ai = 0; ai < 2; ++ai)
#pragma unroll
            for (int m = 0; m < 4; ++m) pr[ai][m] = *(const f32x4*)(rsq + (size_t)(row0 + ai * HALF + m * 16) * 4);
#pragma unroll
        for (int ai = 0; ai < 2; ++ai)
#pragma unroll
            for (int m = 0; m < 4; ++m) { bf16_t* rowp = O + (size_t)(row0 + ai * HALF + m * 16) * ldc + col0; const float rstd = rstd_of(pr[ai][m]);
#pragma unroll
                for (int bj = 0; bj < 2; ++bj) { f32x4 v0 = acc[ai][bj][m][0] * rstd, v1 = acc[ai][bj][m][1] * rstd;
                    if (g) { v0 = (f32x4){gelu_tanh(v0[0]), gelu_tanh(v0[1]), gelu_tanh(v0[2]), gelu_tanh(v0[3])}; v1 = (f32x4){gelu_tanh(v1[0]), gelu_tanh(v1[1]), gelu_tanh(v1[2]), gelu_tanh(v1[3])}; }
                    u32x4 w; w.x = cvt_pk_bf16(v0[0], v0[1]); w.y = cvt_pk_bf16(v0[2], v0[3]); w.z = cvt_pk_bf16(v1[0], v1[1]); w.w = cvt_pk_bf16(v1[2], v1[3]);
                    *(u32x4*)(rowp + bj * HALF) = w; } }
    }
};
constexpr int XCH_LDS_OFF = 132096;
struct EpiRes {
    static constexpr bool PERM = false, AFTER_DRAIN = false;
    bf16_t* hb; float* rsq;
    __device__ __forceinline__ void operator()(const f32x4 (&acc)[2][2][4][2], const Unit& u, int wr, int wc, int fr, int fq) const {
        extern __shared__ __attribute__((aligned(16))) unsigned char lds_all_[];
        PG8_LAS float* S = (PG8_LAS float*)((PG8_LAS unsigned char*)lds_all_ + XCH_LDS_OFF);
        const int row0 = u.pm * BM + wr * 64 + fr, col0 = u.pn * BM + wc * 32 + 4 * fq;
#pragma unroll
        for (int ai = 0; ai < 2; ++ai) {
            u32x2 bs[4][2][2];
#pragma unroll
            for (int m = 0; m < 4; ++m)
#pragma unroll
                for (int bj = 0; bj < 2; ++bj)
#pragma unroll
                    for (int n = 0; n < 2; ++n) bs[m][bj][n] = *(const u32x2*)(hb + (size_t)(row0 + ai * HALF + m * 16) * 1024 + col0 + bj * HALF + n * 16);
#pragma unroll
            for (int m = 0; m < 4; ++m) { const int row = row0 + ai * HALF + m * 16; const size_t off = (size_t)row * 1024 + col0; float q = 0.f;
#pragma unroll
                for (int bj = 0; bj < 2; ++bj)
#pragma unroll
                    for (int n = 0; n < 2; ++n) { const u32x2 b = bs[m][bj][n];
                        const f32x4 h = (f32x4){__uint_as_float(b.x << 16), __uint_as_float(b.x & 0xffff0000u), __uint_as_float(b.y << 16), __uint_as_float(b.y & 0xffff0000u)} + acc[ai][bj][m][n];
                        q += (h[0] * h[0] + h[1] * h[1]) + (h[2] * h[2] + h[3] * h[3]);
                        u32x2 w; w.x = cvt_pk_bf16(h[0], h[1]); w.y = cvt_pk_bf16(h[2], h[3]); *(u32x2*)(hb + off + bj * HALF + n * 16) = w; }
                q += swz_xor16(q);
                { const auto rr = __builtin_amdgcn_permlane32_swap(__float_as_uint(q), __float_as_uint(q), false, false); q = __uint_as_float(rr[0]) + __uint_as_float(rr[1]); }
                if (fq == 0) S[(ai * HALF + wr * 64 + m * 16 + fr) * 4 + wc] = q; }
        }
        asm volatile("s_waitcnt lgkmcnt(0)" ::: "memory"); __builtin_amdgcn_s_barrier(); asm volatile("" ::: "memory");
        const int t = (int)threadIdx.x;
        if (t < 256) { const f32x4 p = *(const PG8_LAS f32x4*)(S + t * 4); rsq[(size_t)(u.pm * BM + t) * 4 + u.pn] = (p[0] + p[1]) + (p[2] + p[3]); }
    }
};
constexpr float ATT_C2 = 0.125f * 1.4426950408889634f;
struct EpiQKV {
    static constexpr bool PERM = true, AFTER_DRAIN = false;
    bf16_t* O; const float* rope; const float* rsq;
    __device__ __forceinline__ void operator()(const f32x4 (&acc)[2][2][4][2], const Unit& u, int wr, int wc, int fr, int fq) const {
        const int row0 = u.pm * BM + wr * 64 + fr, col0 = u.pn * BM + wc * 32 + 8 * fq;
        const int pn = u.pn;
        const bool is_rope = (pn < 6) || (pn >= 9 && pn < 15);
        const bool is_q = (pn < 3) || (pn >= 9 && pn < 12);
        const float sc = is_q ? ATT_C2 : 1.f;
        const bool do_rot = is_rope && ((wc & 1) == 0);
        const float sgn = (fq == 0) ? -1.f : 1.f;
        f32x4 pr[2][4];
#pragma unroll
        for (int ai = 0; ai < 2; ++ai)
#pragma unroll
            for (int m = 0; m < 4; ++m) pr[ai][m] = *(const f32x4*)(rsq + (size_t)(row0 + ai * HALF + m * 16) * 4);
#pragma unroll
        for (int ai = 0; ai < 2; ++ai)
#pragma unroll
            for (int m = 0; m < 4; ++m) { const int row = row0 + ai * HALF + m * 16; bf16_t* rowp = O + (size_t)row * 4608 + col0;
                f32x4 cs0 = {1.f, 1.f, 1.f, 1.f}, cs1 = cs0, sn0 = {0.f, 0.f, 0.f, 0.f}, sn1 = sn0;
                if (do_rot) { const f32x4* t = (const f32x4*)(rope + (size_t)row * 16); cs0 = t[0]; cs1 = t[1]; sn0 = t[2] * sgn; sn1 = t[3] * sgn; }
                const float rstd = rstd_of(pr[ai][m]) * sc;
#pragma unroll
                for (int bj = 0; bj < 2; ++bj) { f32x4 v0 = acc[ai][bj][m][0] * rstd, v1 = acc[ai][bj][m][1] * rstd;
                    if (do_rot) {
                        f32x4 p0, p1;
#pragma unroll
                        for (int e = 0; e < 4; ++e) { p0[e] = swz_xor16(v0[e]); p1[e] = swz_xor16(v1[e]); }
                        if (fq < 2) { v0 = v0 * cs0 + p0 * sn0; v1 = v1 * cs1 + p1 * sn1; }
                    }
                    u32x4 w; w.x = cvt_pk_bf16(v0[0], v0[1]); w.y = cvt_pk_bf16(v0[2], v0[3]); w.z = cvt_pk_bf16(v1[0], v1[1]); w.w = cvt_pk_bf16(v1[2], v1[3]);
                    *(u32x4*)(rowp + bj * HALF) = w; } }
    }
};

template <int CTRL> __device__ __forceinline__ f32x4 dpp4(f32x4 v) { return (f32x4){dpp_f<CTRL>(v[0]), dpp_f<CTRL>(v[1]), dpp_f<CTRL>(v[2]), dpp_f<CTRL>(v[3])}; }
struct EpiUpConv {
    static constexpr bool PERM = true, AFTER_DRAIN = false;
    bf16_t* HM; const float* cw; const float* cb; float* halo; float* tops; float* topg; const float* rsq;
    __device__ __forceinline__ void operator()(const f32x4 (&acc)[2][2][4][2], const Unit& u, int wr_, int wc_, int fr_, int fq_) const {
        int tid_ = threadIdx.x; asm volatile("" : "+v"(tid_));
        const int wid_ = __builtin_amdgcn_readfirstlane(tid_ >> 6), wr = wid_ >> 2, wc = wid_ & 3, fr = tid_ & 15, fq = (tid_ >> 4) & 3; (void)wr_; (void)wc_; (void)fr_; (void)fq_;
        extern __shared__ __attribute__((aligned(16))) unsigned char lds_all_[];
        PG8_LAS float* X = (PG8_LAS float*)((PG8_LAS unsigned char*)lds_all_ + XCH_LDS_OFF);
        const int cl = wc * 32 + 8 * fq, hc = u.pn * 128 + cl;
        float rstd[2][4];
        { f32x4 pr[2][4];
#pragma unroll
          for (int ai = 0; ai < 2; ++ai)
#pragma unroll
              for (int m = 0; m < 4; ++m) pr[ai][m] = *(const f32x4*)(rsq + (size_t)(u.pm * BM + ai * HALF + wr * 64 + m * 16 + fr) * 4);
#pragma unroll
          for (int ai = 0; ai < 2; ++ai)
#pragma unroll
              for (int m = 0; m < 4; ++m) rstd[ai][m] = rstd_of(pr[ai][m]); }
        if (fr >= 14) {
#pragma unroll
            for (int ai = 0; ai < 2; ++ai) { PG8_LAS float* xp = X + (((ai * 2 + wr) * 2 + (fr - 14)) * 128 + cl);
                *(PG8_LAS f32x4*)xp = acc[ai][0][3][0] * rstd[ai][3]; *(PG8_LAS f32x4*)(xp + 4) = acc[ai][0][3][1] * rstd[ai][3]; }
            if (wr == 1) { float* hp = halo + ((size_t)u.pm * 2 + (fr - 14)) * 2816 + hc; *(f32x4*)hp = acc[1][0][3][0] * rstd[1][3]; *(f32x4*)(hp + 4) = acc[1][0][3][1] * rstd[1][3]; }
        }
        asm volatile("s_waitcnt lgkmcnt(0)" ::: "memory"); __builtin_amdgcn_s_barrier(); asm volatile("" ::: "memory");
        const bool needs_fix = (u.pm & 15) != 0;
#pragma unroll
        for (int n = 0; n < 2; ++n) {
            const f32x4 w0 = *(const f32x4*)(cw + hc + 4 * n), w1 = *(const f32x4*)(cw + 2816 + hc + 4 * n), w2 = *(const f32x4*)(cw + 2 * 2816 + hc + 4 * n), bb = *(const f32x4*)(cb + hc + 4 * n);
#pragma unroll
            for (int ai = 0; ai < 2; ++ai) {
                f32x4 pa, pb;
                const bool has_pred = !(ai == 0 && wr == 0);
                const int pblk = (wr == 1) ? (ai * 2) : 1;
                if (has_pred) { pa = *(const PG8_LAS f32x4*)(X + ((pblk * 2 + 1) * 128 + cl + 4 * n)); pb = *(const PG8_LAS f32x4*)(X + ((pblk * 2 + 0) * 128 + cl + 4 * n)); }
                else { pa = (f32x4){0.f, 0.f, 0.f, 0.f}; pb = pa; }
                f32x4 r1p = pa, r2p = (fr == 1) ? pa : pb;
                size_t ho = (size_t)(u.pm * BM + ai * HALF + wr * 64 + fr) * 2816 + hc + 4 * n; asm volatile("" : "+v"(ho));
#pragma unroll
                for (int m = 0; m < 4; ++m) {
                    const f32x4 x = acc[ai][0][m][n] * rstd[ai][m];
                    const f32x4 R1 = dpp4<0x121>(x), R2 = dpp4<0x122>(x);
                    const f32x4 p1 = (fr >= 1) ? R1 : r1p;
                    const f32x4 p2 = (fr >= 2) ? R2 : r2p;
                    const f32x4 sv = w2 * x + w1 * p1 + w0 * p2 + bb;
                    r1p = R1; r2p = R2;
                    const f32x4 g = acc[ai][1][m][n] * rstd[ai][m];
                    if (ai == 0 && m == 0) { if (wr == 0 && fr < 2 && needs_fix) { const size_t off = ((size_t)u.pm * 2 + fr) * 2816 + hc + 4 * n; *(f32x4*)(tops + off) = sv; *(f32x4*)(topg + off) = g; } }
                    u32x2 w; w.x = cvt_pk_bf16(gelu_tanh(sv[0]) * g[0], gelu_tanh(sv[1]) * g[1]); w.y = cvt_pk_bf16(gelu_tanh(sv[2]) * g[2], gelu_tanh(sv[3]) * g[3]);
                    *(u32x2*)(HM + ho) = w; ho += 16 * 2816;
                    asm volatile("" : "+v"(ho) :: "memory");
                }
            }
        }
    }
};
template <class Epi, class Sched, bool ALIGN_EPI = false, bool SP2 = false>
__device__ __forceinline__ void gemm_phase(PG8_LAS unsigned char* lds, const Gemm g, const Sched& S, const Epi& E) {
    int tid_ = threadIdx.x; asm volatile("" : "+v"(tid_));
    const int tid = tid_, wid = __builtin_amdgcn_readfirstlane(tid >> 6), lane = tid & 63, wr = wid >> 2, wc = wid & 3, fr = lane & 15, fq = lane >> 4;
    const int K = g.K, nt = K / BK, LDA = g.lda ? g.lda : g.K;
    unsigned voffA[2], voffB[2];
#pragma unroll
    for (int i = 0; i < 2; ++i) { int R, C; stage_rc(tid * 16 + i * 8192, R, C); const int Rb = Epi::PERM ? ((R & ~31) + perm32(R & 31)) : R;
        voffA[i] = (unsigned)(R * LDA + C) * 2u; voffB[i] = (unsigned)(Rb * K + C) * 2u; }
    const size_t kstep = (size_t)(BK * 2);
    const size_t hstep = (size_t)HALF * K * 2;
    const size_t tstep = 2 * hstep;
    const size_t hstepA = (size_t)HALF * LDA * 2, tstepA = 2 * hstepA;
    const unsigned ldsw = (unsigned)wid * 1024u;
    const int aoff = lds_byte(wr * 64 + fr, fq * 8), boff = lds_byte(wc * 32 + fr, fq * 8);
#define PG8_SA(b, h) (((b) * 2 + (h)) * HTB)
#define PG8_SB(b, h) ((4 + (b) * 2 + (h)) * HTB)
#define PG8_STAGE(bufoff, gbase, voff) do { _Pragma("unroll") for (int _i = 0; _i < 2; ++_i) \
        __builtin_amdgcn_global_load_lds((const unsigned*)((const char*)(gbase) + (voff)[_i]), (PG8_LAS unsigned*)(lds + (bufoff) + ldsw + _i * 8192), 16, 0, 0); } while (0)
#define PG8_LDA(dst, b, h) do { _Pragma("unroll") for (int m = 0; m < 4; ++m) _Pragma("unroll") for (int k = 0; k < 2; ++k) dst[m][k] = *(const PG8_LAS bf16x8*)(lds + PG8_SA(b, h) + aoff + m * 2048 + k * 1024); } while (0)
#define PG8_LDB(dst, b, h) do { _Pragma("unroll") for (int n = 0; n < 2; ++n) _Pragma("unroll") for (int k = 0; k < 2; ++k) dst[n][k] = *(const PG8_LAS bf16x8*)(lds + PG8_SB(b, h) + boff + n * 2048 + k * 1024); } while (0)
#define PG8_MMA(ai, bj, At, Bt) do { __builtin_amdgcn_s_setprio(1); _Pragma("unroll") for (int m = 0; m < 4; ++m) _Pragma("unroll") for (int n = 0; n < 2; ++n) _Pragma("unroll") for (int k = 0; k < 2; ++k) \
        acc[ai][bj][m][n] = __builtin_amdgcn_mfma_f32_16x16x32_bf16(Bt[n][k], At[m][k], acc[ai][bj][m][n], 0, 0, 0); __builtin_amdgcn_s_setprio(0); } while (0)
#define PG8_WAIT_V(n) asm volatile("s_waitcnt vmcnt(" #n ")" ::: "memory")
#define PG8_WAIT_L(n) asm volatile("s_waitcnt lgkmcnt(" #n ")" ::: "memory")
#define PG8_BAR __builtin_amdgcn_s_barrier()
#define PG8_SCHED __builtin_amdgcn_sched_barrier(0)
    Unit cur, nxt; int ui = 0;
    if (!S.next(0, cur)) return;
    f32x4 acc[2][2][4][2];
#pragma unroll
    for (int a = 0; a < 2; ++a)
#pragma unroll
        for (int b = 0; b < 2; ++b)
#pragma unroll
            for (int m = 0; m < 4; ++m)
#pragma unroll
                for (int n = 0; n < 2; ++n) acc[a][b][m][n] = (f32x4){0.f, 0.f, 0.f, 0.f};
    bf16x8 At[4][2], B0[2][2], B1[2][2];
    const char* cA = (const char*)g.A + (size_t)cur.pm * tstepA; const char* cB = (const char*)g.Bt + (size_t)cur.pn * tstep;
    S.a_ready(cur);
    if constexpr (SP2) {
        PG8_STAGE(PG8_SB(0, 0), cB, voffB); PG8_STAGE(PG8_SB(0, 1), cB + hstep, voffB); PG8_STAGE(PG8_SA(0, 0), cA, voffA); PG8_STAGE(PG8_SA(0, 1), cA + hstepA, voffA);
        if (wr == 1) PG8_BAR;
        PG8_WAIT_V(2); PG8_BAR;
        PG8_STAGE(PG8_SB(1, 0), cB + kstep, voffB); PG8_STAGE(PG8_SA(1, 0), cA + kstep, voffA); PG8_STAGE(PG8_SB(1, 1), cB + hstep + kstep, voffB);
        PG8_WAIT_V(6); PG8_BAR;
    } else {
        PG8_STAGE(PG8_SB(0, 0), cB, voffB); PG8_STAGE(PG8_SA(0, 0), cA, voffA); PG8_STAGE(PG8_SB(0, 1), cB + hstep, voffB); PG8_STAGE(PG8_SA(0, 1), cA + hstepA, voffA);
        if (wr == 1) PG8_BAR;
        PG8_WAIT_V(4); PG8_BAR;
        PG8_STAGE(PG8_SB(1, 0), cB + kstep, voffB); PG8_STAGE(PG8_SA(1, 0), cA + kstep, voffA); PG8_STAGE(PG8_SB(1, 1), cB + hstep + kstep, voffB);
        PG8_WAIT_V(6); PG8_BAR;
    }
    for (;;) {
        const bool has_next = S.next(ui + 1, nxt);
        const char* nA = has_next ? (const char*)g.A + (size_t)nxt.pm * tstepA : cA; const char* nB = has_next ? (const char*)g.Bt + (size_t)nxt.pn * tstep : cB;
        for (int t = 0; t < nt; t += 2) {
            const bool last = (t == nt - 2);
            const char* a1 = cA + (size_t)(t + 1) * kstep;
            const char* a2 = last ? nA : cA + (size_t)(t + 2) * kstep; const char* b2 = last ? nB : cB + (size_t)(t + 2) * kstep;
            const char* a3 = a2 + kstep; const char* b3 = b2 + kstep;
            if (last && has_next) S.a_ready(nxt);
            if constexpr (SP2) {
            PG8_LDB(B0, 0, 0); PG8_LDB(B1, 0, 1); PG8_SCHED; PG8_LDA(At, 0, 0); PG8_STAGE(PG8_SA(1, 1), a1 + hstepA, voffA);
            PG8_WAIT_V(8); PG8_WAIT_L(0); PG8_BAR; PG8_MMA(0, 0, At, B0); PG8_MMA(0, 1, At, B1); PG8_BAR; PG8_SCHED;
            PG8_LDA(At, 0, 1); PG8_STAGE(PG8_SB(0, 0), b2, voffB); PG8_STAGE(PG8_SB(0, 1), b2 + hstep, voffB); PG8_STAGE(PG8_SA(0, 0), a2, voffA);
            PG8_WAIT_V(8); PG8_WAIT_L(0); PG8_BAR; PG8_MMA(1, 0, At, B0); PG8_MMA(1, 1, At, B1); PG8_BAR; PG8_SCHED;
            PG8_LDB(B0, 1, 0); PG8_LDB(B1, 1, 1); PG8_SCHED; PG8_LDA(At, 1, 0); PG8_STAGE(PG8_SA(0, 1), a2 + hstepA, voffA);
            PG8_WAIT_V(8); PG8_WAIT_L(0); PG8_BAR; PG8_MMA(0, 0, At, B0); PG8_MMA(0, 1, At, B1); PG8_BAR; PG8_SCHED;
            PG8_LDA(At, 1, 1); PG8_STAGE(PG8_SB(1, 0), b3, voffB); PG8_STAGE(PG8_SB(1, 1), b3 + hstep, voffB); PG8_STAGE(PG8_SA(1, 0), a3, voffA);
            PG8_WAIT_V(8); PG8_WAIT_L(0); PG8_BAR; PG8_MMA(1, 0, At, B0); PG8_MMA(1, 1, At, B1); PG8_BAR; PG8_SCHED;
            } else {
            PG8_LDB(B0, 0, 0); PG8_SCHED; PG8_LDA(At, 0, 0); PG8_STAGE(PG8_SA(1, 1), a1 + hstepA, voffA);
            PG8_WAIT_L(8); PG8_BAR; PG8_WAIT_L(0); PG8_MMA(0, 0, At, B0); PG8_BAR; PG8_SCHED;
            PG8_LDB(B1, 0, 1); PG8_STAGE(PG8_SB(0, 0), b2, voffB);
            PG8_BAR; PG8_WAIT_L(0); PG8_MMA(0, 1, At, B1); PG8_BAR;
            PG8_LDA(At, 0, 1); PG8_STAGE(PG8_SA(0, 0), a2, voffA);
            PG8_BAR; PG8_WAIT_L(0); PG8_MMA(1, 0, At, B0); PG8_BAR; PG8_SCHED;
            PG8_STAGE(PG8_SB(0, 1), b2 + hstep, voffB);
            PG8_WAIT_V(6); PG8_BAR; PG8_MMA(1, 1, At, B1); PG8_BAR;
            PG8_LDB(B0, 1, 0); PG8_SCHED; PG8_LDA(At, 1, 0); PG8_STAGE(PG8_SA(0, 1), a2 + hstepA, voffA);
            PG8_WAIT_L(8); PG8_BAR; PG8_WAIT_L(0); PG8_MMA(0, 0, At, B0); PG8_BAR; PG8_SCHED;
            PG8_LDB(B1, 1, 1); PG8_STAGE(PG8_SB(1, 0), b3, voffB);
            PG8_BAR; PG8_WAIT_L(0); PG8_MMA(0, 1, At, B1); PG8_BAR;
            PG8_LDA(At, 1, 1); PG8_STAGE(PG8_SA(1, 0), a3, voffA);
            PG8_BAR; PG8_WAIT_L(0); PG8_MMA(1, 0, At, B0); PG8_BAR; PG8_SCHED;
            PG8_STAGE(PG8_SB(1, 1), b3 + hstep, voffB);
            PG8_WAIT_V(6); PG8_BAR; PG8_MMA(1, 1, At, B1); PG8_BAR;
            }
        }
        if constexpr (ALIGN_EPI) { if (wr == 0) PG8_BAR; }
        if constexpr (!Epi::AFTER_DRAIN) { E(acc, cur, wr, wc, fr, fq); S.done(cur); }
        if (!has_next) break;
#pragma unroll
        for (int a = 0; a < 2; ++a)
#pragma unroll
            for (int b = 0; b < 2; ++b)
#pragma unroll
                for (int m = 0; m < 4; ++m)
#pragma unroll
                    for (int n = 0; n < 2; ++n) acc[a][b][m][n] = (f32x4){0.f, 0.f, 0.f, 0.f};
        cur = nxt; cA = nA; cB = nB; ++ui;
        if constexpr (ALIGN_EPI) { if (wr == 1) PG8_BAR; }
    }
    PG8_WAIT_V(0);
    if constexpr (!ALIGN_EPI) { if (wr == 0) PG8_BAR; }
    PG8_BAR;
    if constexpr (Epi::AFTER_DRAIN) { E.fused(acc, cur, wr, wc, fr, fq, lds, wid, lane); S.done(cur); }
#undef PG8_SA
#undef PG8_SB
#undef PG8_STAGE
#undef PG8_LDA
#undef PG8_LDB
#undef PG8_MMA
#undef PG8_WAIT_V
#undef PG8_WAIT_L
#undef PG8_BAR
#undef PG8_SCHED
}
}
#include <hip/hip_bf16.h>
#include <cmath>
namespace attn_body {
using bf16=__hip_bfloat16;
using bf16x8=__attribute__((ext_vector_type(8)))short;
using s16x4=__attribute__((ext_vector_type(4)))short;
using f32x16=__attribute__((ext_vector_type(16)))float;
using u32x4=__attribute__((ext_vector_type(4)))unsigned;
constexpr int D=64,PITCH=4608;
constexpr int NW=8,QBLK=32,QB=QBLK*NW,KVBLK=64;
constexpr int ATTN_UNIT_ROWS=QB;
__device__ __forceinline__ int crow(int r,int hi){return (r&3)+8*(r>>2)+4*hi;}
#define SBAR() __builtin_amdgcn_sched_barrier(0)
template<bool BAND> __device__ __forceinline__ void cmask(f32x16&p0,f32x16&p1,int kvbase,int qrel,int hi){
  const float NEG=-INFINITY; int kb=kvbase+4*hi;
  #pragma unroll
  for(int r=0;r<16;++r){int kv=kb+(r&3)+8*(r>>2); if(kv>qrel||(BAND&&kv<qrel-128))p0[r]=NEG; if(kv+32>qrel||(BAND&&kv+32<qrel-128))p1[r]=NEG;}
}

constexpr int NSLOT=3, SLOTB=8192;
constexpr int LDS_K=0, LDS_V=NSLOT*SLOTB, LDS_WS=2*NSLOT*SLOTB, LDS_OST=LDS_WS+NW*64*4, LDS_BYTES=LDS_OST+NW*4096;
constexpr float C2=0.125f*1.4426950408889634f;
__device__ __forceinline__ void glds16(const void*gsrc,unsigned lds_dst){unsigned keep;
  asm volatile("s_mov_b32 %0, m0\n\ts_mov_b32 m0, %2\n\ts_nop 0\n\tglobal_load_lds_dwordx4 %1, off\n\ts_mov_b32 m0, %0":"=&s"(keep):"v"(gsrc),"s"(lds_dst):"memory");}
__device__ __forceinline__ float max3f(float a,float b,float c){float r;asm("v_max3_f32 %0, %1, %2, %3":"=v"(r):"v"(a),"v"(b),"v"(c));return r;}
__device__ __forceinline__ float max2f(float a,float b){float r;asm("v_max_f32_e32 %0, %1, %2":"=v"(r):"v"(a),"v"(b));return r;}
__device__ __forceinline__ float fadd_s(float a,float b){float r;asm("v_add_f32_e32 %0, %1, %2":"=v"(r):"v"(a),"v"(b));return r;}
__device__ __forceinline__ float fsub_s(float a,float b){float r;asm("v_sub_f32_e32 %0, %1, %2":"=v"(r):"v"(a),"v"(b));return r;}
typedef float f32x2_t __attribute__((ext_vector_type(2))); typedef __bf16 bf16x2_t __attribute__((ext_vector_type(2)));
__device__ __forceinline__ unsigned cvtpk_s(float lo,float hi){f32x2_t v={lo,hi};bf16x2_t b=__builtin_convertvector(v,bf16x2_t);return __builtin_bit_cast(unsigned,b);}
#define WAIT_BAR(N) asm volatile("s_waitcnt vmcnt(" #N ") lgkmcnt(0)\n\ts_barrier":::"memory")

__device__ __forceinline__ void qkt(f32x16&p0,f32x16&p1,const char*Kslot,const bf16x8*qr,const f32x16&negm,int r32,int hi){
  const char*kb=Kslot+hi*1024+r32*16;
  #pragma unroll
  for(int d0=0;d0<4;++d0){
    const bf16x8 b0=*reinterpret_cast<const bf16x8*>(kb+d0*2048);
    const bf16x8 b1=*reinterpret_cast<const bf16x8*>(kb+d0*2048+512);
    if(d0==0){p0=__builtin_amdgcn_mfma_f32_32x32x16_bf16(b0,qr[0],negm,0,0,0);p1=__builtin_amdgcn_mfma_f32_32x32x16_bf16(b1,qr[0],negm,0,0,0);}
    else{p0=__builtin_amdgcn_mfma_f32_32x32x16_bf16(b0,qr[d0],p0,0,0,0);p1=__builtin_amdgcn_mfma_f32_32x32x16_bf16(b1,qr[d0],p1,0,0,0);}}
}
typedef __attribute__((address_space(3))) const char* lds_cptr;
typedef short v4i16_t __attribute__((ext_vector_type(4)));
__device__ __forceinline__ void kload8(bf16x8*kf,lds_cptr kp){
  kf[0]=*(const __attribute__((address_space(3))) bf16x8*)(kp);      kf[1]=*(const __attribute__((address_space(3))) bf16x8*)(kp+512);
  kf[2]=*(const __attribute__((address_space(3))) bf16x8*)(kp+2048); kf[3]=*(const __attribute__((address_space(3))) bf16x8*)(kp+2560);
  kf[4]=*(const __attribute__((address_space(3))) bf16x8*)(kp+4096); kf[5]=*(const __attribute__((address_space(3))) bf16x8*)(kp+4608);
  kf[6]=*(const __attribute__((address_space(3))) bf16x8*)(kp+6144); kf[7]=*(const __attribute__((address_space(3))) bf16x8*)(kp+6656);
}
__device__ __forceinline__ void kload2(bf16x8*kf,lds_cptr kp,int j){ kf[2*j]=*(const __attribute__((address_space(3))) bf16x8*)(kp+j*2048); kf[2*j+1]=*(const __attribute__((address_space(3))) bf16x8*)(kp+j*2048+512); }
__device__ __forceinline__ s16x4 vtr(lds_cptr p){ return __builtin_bit_cast(s16x4,__builtin_amdgcn_ds_read_tr16_b64_v4i16((__attribute__((address_space(3))) v4i16_t*)p)); }
__device__ __forceinline__ float rowmax(const f32x16&p0,const f32x16&p1){
  float a=max3f(p0[0],p0[1],p1[0]),b=max3f(p0[2],p0[3],p1[1]);a=max3f(a,p1[2],p1[3]);
  #pragma unroll
  for(int r=4;r<16;r+=4){a=max3f(a,p0[r],p0[r+1]);b=max3f(b,p0[r+2],p0[r+3]);a=max3f(a,p1[r],p1[r+1]);b=max3f(b,p1[r+2],p1[r+3]);}
  const float m=max2f(a,b);
  auto rr=__builtin_amdgcn_permlane32_swap(__float_as_uint(m),__float_as_uint(m),false,false);
  return max2f(__uint_as_float(rr[0]),__uint_as_float(rr[1]));
}
__device__ __forceinline__ void pv(f32x16*o,int vb,bf16x8 pa0,bf16x8 pa1,bf16x8 pa2,bf16x8 pa3){
  #pragma unroll
  for(int d0=0;d0<2;++d0){s16x4 lo[4],hi[4];
    #pragma unroll
    for(int ks=0;ks<4;++ks){
      asm volatile("ds_read_b64_tr_b16 %0,%1 offset:%c2":"=&v"(lo[ks]):"v"(vb),"i"(d0*4096+ks*1024):"memory");
      asm volatile("ds_read_b64_tr_b16 %0,%1 offset:%c2":"=&v"(hi[ks]):"v"(vb),"i"(d0*4096+ks*1024+512):"memory");}
    asm volatile("s_waitcnt lgkmcnt(0)":::"memory");SBAR();
    #define PK(k) (bf16x8){lo[k][0],lo[k][1],lo[k][2],lo[k][3],hi[k][0],hi[k][1],hi[k][2],hi[k][3]}
    o[d0]=__builtin_amdgcn_mfma_f32_32x32x16_bf16(pa0,PK(0),o[d0],0,0,0);
    o[d0]=__builtin_amdgcn_mfma_f32_32x32x16_bf16(pa1,PK(1),o[d0],0,0,0);
    o[d0]=__builtin_amdgcn_mfma_f32_32x32x16_bf16(pa2,PK(2),o[d0],0,0,0);
    o[d0]=__builtin_amdgcn_mfma_f32_32x32x16_bf16(pa3,PK(3),o[d0],0,0,0);
    #undef PK
  }
}

#ifndef ATTN_STORE16
#define ATTN_STORE16(p,v) (*(u32x4*)(p)=(v))
#endif
template<int THRL,bool BAND> __device__ __forceinline__ void attn_unit(const bf16*Qb,const bf16*__restrict__ Kb,const bf16*__restrict__ Vb,bf16*Ob,const long rs,const long ors,const int NT,const int moff,float*lse,const long lrs,char*shm){
  int tid_=threadIdx.x; asm volatile("":"+v"(tid_));
  const int tid=tid_,lane=tid&63,r32=lane&31,hi=lane>>5; const int wid=__builtin_amdgcn_readfirstlane(tid>>6);
  const bf16*Qw=Qb+(long)(wid*QBLK)*rs;
  const bf16*Kh=Kb,*Vh=Vb;
  const unsigned lds0=(unsigned)(uintptr_t)shm;
  float*wsf=(float*)(shm+LDS_WS)+wid*64;
  const bf16*ksrc=Kh+(long)lane*rs+wid*8;
  const bf16*vsrc=Vh+(long)(16*(wid&3)+(lane>>2))*rs+(wid>>2)*32+(lane&3)*8;
  const unsigned kdst=lds0+LDS_K+wid*1024, vdst=lds0+LDS_V+wid*1024;
  #define DMA_K(t,slot) glds16(ksrc+(long)(t)*KVBLK*rs,(unsigned)__builtin_amdgcn_readfirstlane(kdst+(slot)))
  #define DMA_V(t,slot) glds16(vsrc+(long)(t)*KVBLK*rs,(unsigned)__builtin_amdgcn_readfirstlane(vdst+(slot)))
  const int vb0=(int)(lds0+LDS_V)+((lane>>4)&1)*32+(lane&3)*8+(4*hi+((lane&15)>>2))*64;
  const char*Kbase=shm+LDS_K; bf16x8 kf[8];
  const lds_cptr shm3=(lds_cptr)shm; const lds_cptr kp0=shm3+LDS_K+hi*1024+r32*16; const lds_cptr vp0=shm3+LDS_V+((lane>>4)&1)*32+(lane&3)*8+(4*hi+((lane&15)>>2))*64;
  DMA_K(0,0);DMA_V(0,0);DMA_K(1,SLOTB);
  bf16x8 qr[4];
  #pragma unroll
  for(int d0=0;d0<4;++d0)qr[d0]=*reinterpret_cast<const bf16x8*>(&Qw[(long)r32*rs+d0*16+hi*8]);
  float mhat=0.f,l_reg=0.f;f32x16 o[2];o[0]=f32x16{};o[1]=f32x16{};f32x16 negm=f32x16{};asm volatile("":"+v"(negm));
  const int qrel=wid*QBLK+r32;
  #define CMASK(P0,P1,t) do{int jb_=(t)-(NT-4); if(BAND||jb_>=0)cmask<BAND>(P0,P1,64*(t)-moff,qrel,hi);}while(0)
  bool resc=false;
  #define START(P0,P1) do{ const float rm=BAND?__builtin_fmaxf(rowmax(P0,P1),-64.f):rowmax(P0,P1); resc=false; \
    { const float dl=rm; mhat=fadd_s(mhat,dl); \
      _Pragma("unroll") for(int r=0;r<16;++r){P0[r]=fsub_s(P0[r],dl);P1[r]=fsub_s(P1[r],dl);} \
      _Pragma("unroll") for(int r=0;r<16;++r)negm[r]=-mhat; asm volatile("":"+v"(negm)); } \
    _Pragma("unroll") for(int r=0;r<16;++r)P0[r]=__builtin_amdgcn_exp2f(P0[r]); }while(0)
  #define RESC() do{ if(resc){ asm volatile("s_waitcnt lgkmcnt(0)":::"memory"); \
      _Pragma("unroll") for(int d_=0;d_<2;++d_) _Pragma("unroll") for(int r=0;r<16;++r)o[d_][r]*=wsf[crow(r,hi)]; } }while(0)
  f32x16 pA0,pA1,pB0,pB1;
  int sl_prev=0,sl_cur=0,sl_next=SLOTB;
  #define ROT() do{sl_prev=sl_cur;sl_cur=sl_next;sl_next=(sl_next==(NSLOT-1)*SLOTB)?0:sl_next+SLOTB;}while(0)
  DMA_K(2,2*SLOTB);
  WAIT_BAR(3);
  qkt(pA0,pA1,Kbase,qr,negm,r32,hi);asm volatile("s_nop 15\n\ts_nop 7":"+v"(pA0),"+v"(pA1));CMASK(pA0,pA1,0);
  START(pA0,pA1);
  _Pragma("unroll") for(int r=0;r<16;++r)pA1[r]=__builtin_amdgcn_exp2f(pA1[r]);
  WAIT_BAR(0);
  DMA_K(3,0);DMA_V(1,SLOTB);
  ROT();
  kload8(kf,kp0+sl_cur);
  WAIT_BAR(2);
  s16x4 vlo[8],vhi[8]; u32x4 pw0,pw1,pw2,pw3;
  #define PKW(P,B) cvtpk_s(P[B],P[B+1])
  #define PAF(k) __builtin_bit_cast(bf16x8,pw##k)
  #define VFR(i) (bf16x8){vlo[i][0],vlo[i][1],vlo[i][2],vlo[i][3],vhi[i][0],vhi[i][1],vhi[i][2],vhi[i][3]}
  #define PIN(x) asm volatile("":"+v"(x))
  #define MX3(a,b,c) __builtin_fmaxf(__builtin_fmaxf((a),(b)),(c))
  #define GAPA(MF,A0,A1,A2,A3,W0,W1,PW) do{ MF; sacc+=A0; sacc+=A1; sacc+=A2; sacc+=A3; PIN(sacc); W0; W1; PIN(PW); SBAR(); }while(0)
  #define EX(v) __builtin_amdgcn_exp2f(v)
  #define GAPB(MF,X,B) do{ MF; X[B]=EX(X[B]); X[B+1]=EX(X[B+1]); X[B+2]=EX(X[B+2]); X[B+3]=EX(X[B+3]); PIN(X); SBAR(); }while(0)
  #define VRD(i) do{ vlo[i]=vtr(vp_+(((i)>>2)*4096+((i)&3)*1024)); vhi[i]=vtr(vp_+(((i)>>2)*4096+((i)&3)*1024+512)); }while(0)
  #define KRD(G,j) do{ if(G){ kload2(kf,kp0+sl_next,j); SBAR(); } }while(0)
  #define STEP(C0,C1,P0,P1,t,GK,GV,GL) do{ SBAR(); \
    const lds_cptr vp_=vp0+sl_prev; \
    VRD(0); SBAR(); float sacc=(P0[0]+P0[1]); \
    GAPA(C0=__builtin_amdgcn_mfma_f32_32x32x16_bf16(kf[0],qr[0],negm,0,0,0), P0[2],P0[3],P0[4],P0[5],     pw0[0]=PKW(P0,0), pw0[1]=PKW(P0,2), pw0); \
    VRD(4); SBAR(); GAPA(C1=__builtin_amdgcn_mfma_f32_32x32x16_bf16(kf[1],qr[0],negm,0,0,0), P0[6],P0[7],P0[8],P0[9],     pw0[2]=PKW(P0,4), pw0[3]=PKW(P0,6), pw0); \
    VRD(1); SBAR(); GAPA(C0=__builtin_amdgcn_mfma_f32_32x32x16_bf16(kf[2],qr[1],C0,0,0,0),   P0[10],P0[11],P0[12],P0[13], pw1[0]=PKW(P0,8), pw1[1]=PKW(P0,10), pw1); \
    VRD(5); SBAR(); GAPA(C1=__builtin_amdgcn_mfma_f32_32x32x16_bf16(kf[3],qr[1],C1,0,0,0),   P0[14],P0[15],P1[0],P1[1],   pw1[2]=PKW(P0,12),pw1[3]=PKW(P0,14), pw1); \
    VRD(2); SBAR(); GAPA(C0=__builtin_amdgcn_mfma_f32_32x32x16_bf16(kf[4],qr[2],C0,0,0,0),   P1[2],P1[3],P1[4],P1[5],     pw2[0]=PKW(P1,0), pw2[1]=PKW(P1,2), pw2); \
    VRD(6); SBAR(); GAPA(C1=__builtin_amdgcn_mfma_f32_32x32x16_bf16(kf[5],qr[2],C1,0,0,0),   P1[6],P1[7],P1[8],P1[9],     pw2[2]=PKW(P1,4), pw2[3]=PKW(P1,6), pw2); \
    VRD(3); SBAR(); GAPA(C0=__builtin_amdgcn_mfma_f32_32x32x16_bf16(kf[6],qr[3],C0,0,0,0),   P1[10],P1[11],P1[12],P1[13], pw3[0]=PKW(P1,8), pw3[1]=PKW(P1,10), pw3); \
    VRD(7); SBAR(); GAPA(C1=__builtin_amdgcn_mfma_f32_32x32x16_bf16(kf[7],qr[3],C1,0,0,0),   P1[14],P1[15],0.f,0.f,       pw3[2]=PKW(P1,12),pw3[3]=PKW(P1,14), pw3); \
    l_reg+=sacc; \
    if(GK){DMA_K((t)+3,sl_cur);} if(GV){DMA_V((t)+1,sl_next);} \
    CMASK(C0,C1,t); \
    { float a=MX3(C0[0],C0[1],C1[0]),b=MX3(C0[2],C0[3],C1[1]); a=MX3(a,C1[2],C1[3]); \
      _Pragma("unroll") for(int r=4;r<16;r+=4){a=MX3(a,C0[r],C0[r+1]);b=MX3(b,C0[r+2],C0[r+3]);a=MX3(a,C1[r],C1[r+1]);b=MX3(b,C1[r+2],C1[r+3]);} \
      float rm=__builtin_fmaxf(a,b); { auto rr=__builtin_amdgcn_permlane32_swap(__float_as_uint(rm),__float_as_uint(rm),false,false); rm=__builtin_fmaxf(__uint_as_float(rr[0]),__uint_as_float(rr[1])); } \
      resc=false; \
      if(__builtin_expect(__any(rm>(float)THRL),0)){ const float dl=__builtin_fmaxf(rm,0.f); mhat+=dl; \
        _Pragma("unroll") for(int r=0;r<16;++r){C0[r]-=dl;C1[r]-=dl;} \
        _Pragma("unroll") for(int r=0;r<16;++r)negm[r]=-mhat; asm volatile("":"+v"(negm)); \
        const float f=__builtin_amdgcn_exp2f(-dl); l_reg*=f; if(hi==0)wsf[r32]=f; resc=true; } } \
    SBAR(); \
    GAPB(o[0]=__builtin_amdgcn_mfma_f32_32x32x16_bf16(PAF(0),VFR(0),o[0],0,0,0), C0,0); \
    GAPB(o[1]=__builtin_amdgcn_mfma_f32_32x32x16_bf16(PAF(0),VFR(4),o[1],0,0,0), C0,4); \
    KRD(GL,0); GAPB(o[0]=__builtin_amdgcn_mfma_f32_32x32x16_bf16(PAF(1),VFR(1),o[0],0,0,0), C0,8); \
    KRD(GL,1); GAPB(o[1]=__builtin_amdgcn_mfma_f32_32x32x16_bf16(PAF(1),VFR(5),o[1],0,0,0), C0,12); \
    KRD(GL,2); GAPB(o[0]=__builtin_amdgcn_mfma_f32_32x32x16_bf16(PAF(2),VFR(2),o[0],0,0,0), C1,0); \
    KRD(GL,3); GAPB(o[1]=__builtin_amdgcn_mfma_f32_32x32x16_bf16(PAF(2),VFR(6),o[1],0,0,0), C1,4); \
    GAPB(o[0]=__builtin_amdgcn_mfma_f32_32x32x16_bf16(PAF(3),VFR(3),o[0],0,0,0), C1,8); \
    GAPB(o[1]=__builtin_amdgcn_mfma_f32_32x32x16_bf16(PAF(3),VFR(7),o[1],0,0,0), C1,12); \
    }while(0)
  int t=1;
  #undef CMASK
  #define CMASK(P0,P1,t) do{}while(0)
  for(;t+5<NT;t+=2){
    STEP(pB0,pB1,pA0,pA1,t,true,true,true);     WAIT_BAR(2); RESC(); ROT();
    STEP(pA0,pA1,pB0,pB1,t+1,true,true,true);   WAIT_BAR(2); RESC(); ROT();
  }
  #undef CMASK
  #define CMASK(P0,P1,t) do{int jb_=(t)-(NT-4); if(BAND||jb_>=0)cmask<BAND>(P0,P1,64*(t)-moff,qrel,hi);}while(0)
  #define ENDW(tt) do{ if((tt)+3<NT){WAIT_BAR(2);} else if((tt)+2<NT){WAIT_BAR(1);} else {WAIT_BAR(0);} }while(0)
  for(;t+1<NT;t+=2){
    STEP(pB0,pB1,pA0,pA1,t,(t+3<NT),(t+1<NT),(t+1<NT));       ENDW(t);   RESC(); ROT();
    STEP(pA0,pA1,pB0,pB1,t+1,(t+4<NT),(t+2<NT),(t+2<NT));     ENDW(t+1); RESC(); ROT();
  }
  STEP(pB0,pB1,pA0,pA1,NT-1,false,false,false); RESC();
  { float sacc=pB0[0]+pB0[1]; _Pragma("unroll") for(int r=2;r<16;++r)sacc+=pB0[r]; _Pragma("unroll") for(int r=0;r<16;++r)sacc+=pB1[r]; l_reg+=sacc;
    pw0=(u32x4){PKW(pB0,0),PKW(pB0,2),PKW(pB0,4),PKW(pB0,6)};pw1=(u32x4){PKW(pB0,8),PKW(pB0,10),PKW(pB0,12),PKW(pB0,14)};pw2=(u32x4){PKW(pB1,0),PKW(pB1,2),PKW(pB1,4),PKW(pB1,6)};pw3=(u32x4){PKW(pB1,8),PKW(pB1,10),PKW(pB1,12),PKW(pB1,14)};
    SBAR(); pv(o,vb0+sl_cur,PAF(0),PAF(1),PAF(2),PAF(3)); }
  #undef PKW
  #undef PAF
  #undef VFR
  #undef PIN
  #undef MX3
  #undef GAPA
  #undef GAPB
  #undef EX
  #undef VRD
  #undef KRD
  #undef STEP
  #undef ENDW
  {auto rr=__builtin_amdgcn_permlane32_swap(__float_as_uint(l_reg),__float_as_uint(l_reg),false,false);l_reg=__uint_as_float(rr[0])+__uint_as_float(rr[1]);}
  if(hi==0)wsf[32+r32]=l_reg;asm volatile("s_waitcnt lgkmcnt(0)":::"memory");
  float rli[16];
  #pragma unroll
  for(int r=0;r<16;++r)rli[r]=__builtin_amdgcn_rcpf(wsf[32+crow(r,hi)]);
  bf16*Ow=Ob+(long)(wid*QBLK)*ors;
  if(BAND){ if(hi==0) lse[(long)(wid*QBLK+r32)*lrs]=mhat+__builtin_amdgcn_logf(l_reg); }
  { bf16*stg=(bf16*)(shm+LDS_OST)+wid*2048;
    #pragma unroll
    for(int r=0;r<16;++r){const int orow=crow(r,hi);
      #pragma unroll
      for(int d0=0;d0<2;++d0)stg[orow*64+d0*32+r32]=__float2bfloat16(o[d0][r]*rli[r]);}
    asm volatile("s_waitcnt lgkmcnt(0)":::"memory");
    #pragma unroll
    for(int i=0;i<4;++i){const int row=i*8+(lane>>3),ch=lane&7; const u32x4 v=*(const u32x4*)(stg+row*64+ch*8); ATTN_STORE16(Ow+(long)row*ors+ch*8,v);} }
  asm volatile("s_waitcnt lgkmcnt(0)\n\ts_barrier":::"memory");
  #undef DMA_K
  #undef DMA_V
  #undef CMASK
  #undef START
  #undef RESC
  #undef ROT
}
constexpr int ATTN_LDS_BYTES=LDS_BYTES;
struct AttnUnit { const bf16* Q; const bf16* K; const bf16* V; bf16* O; float* lse; long rs, ors, lrs; int NT, moff; };
template<class Sched,int THRL,bool BAND> __device__ __forceinline__ void attn_phase(char*lds,const Sched&S){
  AttnUnit u;
  for(int i=0;S.next(i,u);++i){ attn_unit<THRL,BAND>(u.Q,u.K,u.V,u.O,u.rs,u.ors,u.NT,u.moff,u.lse,u.lrs,lds); }
}
#undef SBAR
#undef WAIT_BAR
}
#define GAS __attribute__((address_space(1)))
#define LAS __attribute__((address_space(3)))
typedef unsigned short bf16;
typedef unsigned v4u __attribute__((ext_vector_type(4)));
typedef float f32x4 __attribute__((ext_vector_type(4)));
typedef short bf16x8 __attribute__((ext_vector_type(8)));
typedef GAS unsigned gu32;
typedef GAS unsigned long long gu64;
#define RLX_AGENT __ATOMIC_RELAXED, __HIP_MEMORY_SCOPE_AGENT
#define LDS_WAIT() asm volatile("s_waitcnt lgkmcnt(0)" ::: "memory")
#define VM_WAIT() asm volatile("s_waitcnt vmcnt(0)" ::: "memory")
__device__ __forceinline__ unsigned long long rt() { return __builtin_amdgcn_s_memrealtime(); }

#define XB_TMO      128
#define XB_XCNT(j)  (256  + 64 * (j))
#define XB_XSUB(j)  (1280 + 64 * (j))
#define XB_XGEN(j)  (2304 + 64 * (j))
#define XB_TOP      3328
#define XB_TOPGEN   3392
#define XCD_BAR_WORDS 3456
#define XB_SPIN_CAP (1u << 18)

__device__ __forceinline__ unsigned xb_ld(unsigned* p)              { return __hip_atomic_load(p, __ATOMIC_RELAXED, __HIP_MEMORY_SCOPE_AGENT); }
__device__ __forceinline__ unsigned xb_add(unsigned* p, unsigned v) { return __hip_atomic_fetch_add(p, v, __ATOMIC_RELAXED, __HIP_MEMORY_SCOPE_AGENT); }
__device__ __forceinline__ unsigned xb_xcc_id() { return (unsigned)__builtin_amdgcn_s_getreg((3 << 11) | 20) & 0xFu; }
#define XB_SPIN(cond, bar) do { unsigned _sp = 0; while (cond) { __builtin_amdgcn_s_sleep(1); \
    if ((++_sp & 255u) == 0u) { if (xb_ld(&(bar)[XB_TMO])) break; if (_sp > XB_SPIN_CAP) { atomicAdd(&(bar)[XB_TMO], 1u); break; } } } } while (0)

struct XcdBarrier {
    unsigned* bar; unsigned x;
    volatile LAS unsigned* st;
};

__device__ __forceinline__ XcdBarrier xcd_barrier_post(unsigned* bar, volatile LAS unsigned* st) {
    XcdBarrier b; b.bar = bar; b.x = xb_xcc_id(); b.st = st;
    if (threadIdx.x == 0) (void)xb_add(&bar[XB_XCNT(b.x)], 1u);
    return b;
}
__device__ __forceinline__ void xcd_barrier_complete(unsigned* bar, unsigned x, unsigned& nloc, unsigned& nx) {
    const unsigned G = gridDim.x * gridDim.y * gridDim.z;
    unsigned sum, cnt, mine, sp = 0u;
    for (;;) {
        sum = 0u; cnt = 0u; mine = 0u;
#pragma unroll
        for (unsigned j = 0; j < 16; ++j) { const unsigned c = xb_ld(&bar[XB_XCNT(j)]); sum += c; cnt += (c > 0u) ? 1u : 0u; mine = (j == x) ? c : mine; }
        if (sum == G) break;
        __builtin_amdgcn_s_sleep(1);
        if ((++sp & 255u) == 0u) { if (xb_ld(&bar[XB_TMO])) break; if (sp > XB_SPIN_CAP) { atomicAdd(&bar[XB_TMO], 1u); break; } }
    }
    nloc = mine > 0u ? mine : 1u; nx = cnt > 0u ? cnt : 1u;
}

__device__ __forceinline__ void xcd_barrier(const XcdBarrier& b) {
    asm volatile("s_waitcnt vmcnt(0)" ::: "memory");
    __syncthreads();
    if (threadIdx.x == 0) {
        unsigned* bar = b.bar;
        __builtin_amdgcn_s_waitcnt(0);
        unsigned nloc = b.st[0], nx = b.st[1];
        if (nloc == 0u) { xcd_barrier_complete(bar, b.x, nloc, nx); b.st[0] = nloc; b.st[1] = nx; }
        const unsigned old = xb_add(&bar[XB_XSUB(b.x)], 1u);
        const unsigned gen = old / nloc;
        if (old + 1u == (gen + 1u) * nloc) {
            __builtin_amdgcn_fence(__ATOMIC_RELEASE, "agent");
            asm volatile("s_waitcnt vmcnt(0)" ::: "memory");
            const unsigned og = xb_add(&bar[XB_TOP], 1u);
            const unsigned tg = og / nx;
            if (og + 1u == (tg + 1u) * nx) xb_add(&bar[XB_TOPGEN], 1u);
            else XB_SPIN(xb_ld(&bar[XB_TOPGEN]) == tg, bar);
            __builtin_amdgcn_fence(__ATOMIC_ACQUIRE, "agent");
            xb_add(&bar[XB_XGEN(b.x)], 1u);
            asm volatile("s_waitcnt vmcnt(0)" ::: "memory");
        } else {
            XB_SPIN(xb_ld(&bar[XB_XGEN(b.x)]) == gen, bar);
            __builtin_amdgcn_fence(__ATOMIC_ACQUIRE, "agent");
            asm volatile("s_waitcnt vmcnt(0)" ::: "memory");
        }
    }
    __syncthreads();
}

constexpr int NWAVES = 8;
constexpr int RING_OFF = 0, RING_BYTES = 131072;
constexpr int LDSCTL_OFF = RING_BYTES, MISC_OFF = LDSCTL_OFF + 320;
constexpr int LDS_BYTES = 147456;
constexpr int CW_TMO = 0, CW_CODE = 1, CW_BAR = 4096;

__device__ __forceinline__ int lane_id() { int l = (int)(threadIdx.x & 63u); asm volatile("" : "+v"(l)); return l; }
__device__ __forceinline__ int tid_id() { int t = (int)threadIdx.x; asm volatile("" : "+v"(t)); return t; }
struct Frame {
    LAS unsigned char* lds;
    volatile LAS unsigned* MISC;
    gu32* ctl;
    int wave, vcu, G;
};

__device__ __forceinline__ void p0_transpose_item(const float* W, int K, int N, bf16_t* WT, int k0, int n0, int drow0, LAS float* scr, int lane, const float* gain) {
    const float* src = W + (size_t)(k0 + (lane >> 5)) * N + n0 + (lane & 31);
    float v[32];
#pragma unroll
    for (int i = 0; i < 32; ++i) v[i] = src[(size_t)(2 * i) * N];
    const int c = lane & 7;
    f32x4 g0 = {1.f, 1.f, 1.f, 1.f}, g1 = g0;
    if (gain) { g0 = *(const f32x4*)(gain + k0 + 8 * c); g1 = *(const f32x4*)(gain + k0 + 8 * c + 4); }
#pragma unroll
    for (int i = 0; i < 32; ++i) scr[(2 * i + (lane >> 5)) * 33 + (lane & 31)] = v[i];
    LDS_WAIT(); asm volatile("" ::: "memory");
#pragma unroll
    for (int j = 0; j < 4; ++j) { const int n = (lane >> 3) + 8 * j; const LAS float* s = scr + (8 * c) * 33 + n;
        v4u o; o.x = pk2bf(s[0 * 33] * g0[0], s[1 * 33] * g0[1]); o.y = pk2bf(s[2 * 33] * g0[2], s[3 * 33] * g0[3]); o.z = pk2bf(s[4 * 33] * g1[0], s[5 * 33] * g1[1]); o.w = pk2bf(s[6 * 33] * g1[2], s[7 * 33] * g1[3]);
        *(GAS v4u*)(WT + (size_t)(drow0 + n) * K + k0 + 8 * c) = o; }
    LDS_WAIT(); asm volatile("" ::: "memory");
}
__device__ __forceinline__ void rms_row_to_bf16(const float* xrow, const float* g, bf16_t* orow, int lane) {
    const f32x4* xr = (const f32x4*)xrow + lane;
    f32x4 v[4]; float s = 0.f;
#pragma unroll
    for (int j = 0; j < 4; ++j) { v[j] = xr[64 * j]; s += (v[j].x * v[j].x + v[j].y * v[j].y) + (v[j].z * v[j].z + v[j].w * v[j].w); }
    const float r = rsqrtf(wave_sum(s) * (1.f / DM) + EPS);
    unsigned long long* o8 = (unsigned long long*)orow + lane;
#pragma unroll
    for (int j = 0; j < 4; ++j) { const f32x4 gg = *((const f32x4*)g + lane + 64 * j);
        o8[64 * j] = (unsigned long long)pk2bf(v[j].x * r * gg.x, v[j].y * r * gg.y) | ((unsigned long long)pk2bf(v[j].z * r * gg.z, v[j].w * r * gg.w) << 32); }
}
__device__ __forceinline__ void row_to_bf16_sq(const float* xrow, bf16_t* orow, float* rsq16, int lane) {
    const f32x4* xr = (const f32x4*)xrow + lane;
    f32x4 v[4]; float s = 0.f;
#pragma unroll
    for (int j = 0; j < 4; ++j) { v[j] = xr[64 * j]; s += (v[j].x * v[j].x + v[j].y * v[j].y) + (v[j].z * v[j].z + v[j].w * v[j].w); }
    s = wave_sum(s);
    unsigned long long* o8 = (unsigned long long*)orow + lane;
#pragma unroll
    for (int j = 0; j < 4; ++j) o8[64 * j] = (unsigned long long)pk2bf(v[j].x, v[j].y) | ((unsigned long long)pk2bf(v[j].z, v[j].w) << 32);
    if (lane < 4) rsq16[lane] = (lane == 0) ? s : 0.f;
}
__device__ __forceinline__ void rms_row_final(const bf16_t* hrow, float* orow, const float* g, const float* rsq4, int lane) {
    float s = (lane < 4) ? rsq4[lane] : 0.f;
    const unsigned long long* h8 = (const unsigned long long*)hrow + lane;
    unsigned long long hv[4];
#pragma unroll
    for (int j = 0; j < 4; ++j) hv[j] = h8[64 * j];
    s = wave_sum(s);
    const float r = rsqrtf(s * (1.f / DM) + EPS);
    f32x4* o = (f32x4*)orow + lane;
#pragma unroll
    for (int j = 0; j < 4; ++j) { const f32x4 gg = *((const f32x4*)g + lane + 64 * j); const unsigned lo = (unsigned)hv[j], hi = (unsigned)(hv[j] >> 32);
        o[64 * j] = (f32x4){__uint_as_float(lo << 16), __uint_as_float(lo & 0xffff0000u), __uint_as_float(hi << 16), __uint_as_float(hi & 0xffff0000u)} * r * gg; }
}
__device__ __forceinline__ void rms_row_inplace_rsq(float* xrow, const float* g, const float* rsq16, int lane) {
    f32x4* xr = (f32x4*)xrow + lane;
    float s = (lane < 4) ? rsq16[lane] : 0.f;
    s = wave_sum(s);
    const float r = rsqrtf(s * (1.f / DM) + EPS);
#pragma unroll
    for (int j = 0; j < 4; ++j) { const f32x4 gg = *((const f32x4*)g + lane + 64 * j); xr[64 * j] = xr[64 * j] * r * gg; }
}
__device__ __forceinline__ void rms_row_inplace(float* xrow, const float* g, int lane) {
    f32x4* xr = (f32x4*)xrow + lane;
    f32x4 v[4]; float s = 0.f;
#pragma unroll
    for (int j = 0; j < 4; ++j) { v[j] = xr[64 * j]; s += (v[j].x * v[j].x + v[j].y * v[j].y) + (v[j].z * v[j].z + v[j].w * v[j].w); }
    const float r = rsqrtf(wave_sum(s) * (1.f / DM) + EPS);
#pragma unroll
    for (int j = 0; j < 4; ++j) { const f32x4 gg = *((const f32x4*)g + lane + 64 * j); xr[64 * j] = v[j] * r * gg; }
}

struct Args { const float* in[23]; float* out; unsigned char* ws; int ph_lo, ph_hi, li, pad; };

struct WDesc { const float* W; int K, N; bf16_t* WT; int mode; int items; };

__device__ __forceinline__ void p0_prologue(Frame& F, const Args& a) {
    LAS float* scr = (LAS float*)(F.lds + RING_OFF + F.wave * 16384);
    const int lane = lane_id(), tid = tid_id();
    const int gw = F.vcu * NWAVES + F.wave, NGW = F.G * NWAVES;
    unsigned char* ws = a.ws;
    constexpr int I0 = (DM / 64) * (N_IN0 / 32), I1 = (DM / 64) * (DM / 32), I2 = (DM / 64) * (N_QKV / 32), I3 = I1, I4 = (DM / 64) * (NUP / 32), I6 = (DFF / 64) * (DM / 32);
    constexpr int I8 = (128 / 64) * (128 / 32);
    constexpr int NITEMS = I0 + I1 + I2 + I3 + 2 * I4 + 2 * I6 + 4 * I8;
    for (int it = gw; it < NITEMS; it += NGW) {
        int r = it; const float* W; int K, N; bf16_t* WT; int mode = 0; const float* gain = nullptr;
        if (r < I0) { W = a.in[5]; K = DM; N = N_IN0; WT = (bf16_t*)(ws + WS_W_IN0); gain = a.in[2]; }
        else if ((r -= I0) < I1) { W = a.in[11]; K = DM; N = DM; WT = (bf16_t*)(ws + WS_W_OUT0); }
        else if ((r -= I1) < I2) { W = a.in[12]; K = DM; N = N_QKV; WT = (bf16_t*)(ws + WS_W_QKV); gain = a.in[2] + DM; }
        else if ((r -= I2) < I3) { W = a.in[18]; K = DM; N = DM; WT = (bf16_t*)(ws + WS_W_OUT1); }
        else if ((r -= I3) < 2 * I4) { const int l = r / I4; r -= l * I4; W = a.in[19] + (size_t)l * DM * NUP; K = DM; N = NUP; WT = (bf16_t*)(ws + WS_W_UP) + (size_t)l * NUP * DM; mode = 1; gain = a.in[3] + l * DM; }
        else if ((r -= 2 * I4) < 2 * I6) { const int l = r / I6; r -= l * I6; W = a.in[22] + (size_t)l * DFF * DM; K = DFF; N = DM; WT = (bf16_t*)(ws + WS_W_DN) + (size_t)l * DM * DFF; }
        else { r -= 2 * I6; const int g = r / I8; r -= g * I8; W = a.in[9] + (size_t)g * 128 * 128; K = 128; N = 128; WT = (bf16_t*)(ws + WS_PWT) + (size_t)g * 128 * 128; }
        const int nblk = N / 32, kb = r / nblk, nb = r % nblk, k0 = 64 * kb, n0 = 32 * nb;
        int d0 = n0;
        if (mode == 1) { if (n0 < DFF) d0 = 256 * (n0 / 128) + (n0 % 128); else { const int q = n0 - DFF; d0 = 256 * (q / 128) + 128 + (q % 128); } }
        p0_transpose_item(W, K, N, WT, k0, n0, d0, scr, lane, gain);
    }
    { const float* w_s = a.in[7]; bf16_t* Wb = (bf16_t*)(ws + WS_WSB);
      for (int idx = (F.vcu * NWAVES * 64) + tid; idx < 4 * 128 * 128; idx += F.G * NWAVES * 64) { const int t = (idx >> 7) & 127, sidx = idx & 127; Wb[idx] = (sidx <= t) ? f2bf(w_s[idx]) : (bf16_t)0; } }
    { const int* pos = (const int*)a.in[1]; float* tab = (float*)(ws + WS_ROPE);
      for (int idx = (F.vcu * NWAVES * 64) + tid; idx < M * 8; idx += F.G * NWAVES * 64) {
          const int row = idx >> 3, i = idx & 7;
          const double inv = exp2(-(double)(2 * i) / 16.0 * 18.931568569324174);
          const float ang = (float)pos[row] * (float)inv;
          const double rev = (double)ang * 0.15915494309189535;
          const double fr = rev - floor(rev);
          const float aa = (float)(fr * 6.283185307179586);
          tab[row * 16 + i] = cosf(aa); tab[row * 16 + 8 + i] = sinf(aa); } }
    { bf16_t* XN = (bf16_t*)(ws + WS_XN); float* rsq = (float*)(ws + WS_RSQ); const float* x = a.in[0];
      for (int m0 = gw * 4; m0 < M; m0 += NGW * 4) {
          f32x4 v[4][4];
#pragma unroll
          for (int r = 0; r < 4; ++r)
#pragma unroll
              for (int j = 0; j < 4; ++j) v[r][j] = *((const f32x4*)(x + (size_t)(m0 + r) * DM) + lane + 64 * j);
#pragma unroll
          for (int r = 0; r < 4; ++r) { float sq = 0.f;
#pragma unroll
              for (int j = 0; j < 4; ++j) sq += (v[r][j].x * v[r][j].x + v[r][j].y * v[r][j].y) + (v[r][j].z * v[r][j].z + v[r][j].w * v[r][j].w);
              sq = wave_sum(sq);
              unsigned long long* o8 = (unsigned long long*)(XN + (size_t)(m0 + r) * DM) + lane;
#pragma unroll
              for (int j = 0; j < 4; ++j) o8[64 * j] = (unsigned long long)pk2bf(v[r][j].x, v[r][j].y) | ((unsigned long long)pk2bf(v[r][j].z, v[r][j].w) << 32);
              if (lane < 4) rsq[(size_t)(m0 + r) * 4 + lane] = (lane == 0) ? sq : 0.f; } } }
}

#ifndef PG8_SP2
#define PG8_SP2 true
#endif
#ifndef PG8_ALIGN
#define PG8_ALIGN true
#endif

struct SchedC {
    int vcu, G; attn_body::bf16* QKV; attn_body::bf16* OCA;
    __device__ __forceinline__ bool next(int it, attn_body::AttnUnit& u) const {
        constexpr long P = attn_body::PITCH;
        const int per = 6, s = vcu + (it / per) * G, k = (it % per) >> 1, pass = it & 1;
        if (s >= 256) return false;
        const int x = s >> 5, l = s & 31, i = l & 15, hl = (l >> 4) * 3 + k;
        const int qb = (k == 0) ? i : (k == 1) ? ((i + 8) & 15) : (i < 8 ? 14 - 2 * i : 31 - 2 * i);
        const int bj = x * 6 + hl, b = bj / 12, j = bj % 12, h = j >> 1;
        const long rowbase = (long)b * SEQ, q0 = (long)qb * 256;
        u.Q = QKV + (rowbase + q0) * P + j * 64; u.K = QKV + rowbase * P + 768 + j * 64; u.V = QKV + rowbase * P + 1536 + h * 128 + pass * 64;
        u.O = pass ? QKV + (rowbase + q0) * P + j * 64 : OCA + (rowbase + q0) * 768 + j * 64; u.ors = pass ? P : 768; u.rs = P;
        u.NT = 4 * qb + 4; u.moff = (int)q0; u.lse = nullptr; u.lrs = 0;
        return true;
    }
};
struct SchedD {
    int vcu, G; attn_body::bf16* QKV; float* LSE;
    __device__ __forceinline__ bool next(int it, attn_body::AttnUnit& u) const {
        constexpr long P = attn_body::PITCH;
        const int ud = vcu + it * G; if (ud >= 768) return false;
        const int b = ud / 192, rem = ud % 192, head = rem >> 4, idx = rem & 15, g = head >> 2;
        const int dl = (g == 0) ? 1 : (g == 1 ? 4 : 16), nb = 16 / dl, r = idx / nb, qb = idx % nb;
        const long rowbase = (long)b * SEQ + r; const int q0 = 256 * qb, kstart = (q0 >= 128) ? q0 - 128 : 0;
        u.rs = (long)dl * P; u.ors = u.rs; u.lrs = (long)dl * 12;
        u.Q = QKV + (rowbase + (long)q0 * dl) * P + 2304 + head * 64; u.O = QKV + (rowbase + (long)q0 * dl) * P + 2304 + head * 64;
        u.K = QKV + (rowbase + (long)kstart * dl) * P + 3072 + head * 64; u.V = QKV + (rowbase + (long)kstart * dl) * P + 3840 + head * 64;
        u.NT = (q0 + 256 - kstart) / 64; u.moff = q0 - kstart; u.lse = LSE + (rowbase + (long)q0 * dl) * 12 + head;
        return true;
    }
};
__device__ __forceinline__ f32x4 bf4lo(const u32x4 w) { return (f32x4){__uint_as_float(w.x << 16), __uint_as_float(w.x & 0xffff0000u), __uint_as_float(w.y << 16), __uint_as_float(w.y & 0xffff0000u)}; }
__device__ __forceinline__ f32x4 bf4hi(const u32x4 w) { return (f32x4){__uint_as_float(w.z << 16), __uint_as_float(w.z & 0xffff0000u), __uint_as_float(w.w << 16), __uint_as_float(w.w & 0xffff0000u)}; }
__device__ __forceinline__ u32x4 pack8(const f32x4 a, const f32x4 b) { u32x4 o; o.x = pk2bf(a[0], a[1]); o.y = pk2bf(a[2], a[3]); o.z = pk2bf(b[0], b[1]); o.w = pk2bf(b[2], b[3]); return o; }
__device__ __forceinline__ void post_attention_phase(Frame& F, const Args& a, unsigned char* ws) {
    const bf16_t* QKV = (const bf16_t*)(ws + WS_QKV); const bf16_t* OCA = (const bf16_t*)(ws + WS_OCA); const float* LSE = (const float*)(ws + WS_LSE);
    bf16_t* Y1 = (bf16_t*)(ws + WS_QKV) + Y1_COL;
    const int lane = lane_id(), gw = F.vcu * NWAVES + F.wave, NGW = F.G * NWAVES;
    const float lam = __expf(wave_sum(a.in[13][lane] * a.in[14][lane])) - __expf(wave_sum(a.in[15][lane] * a.in[16][lane])) + LAMBDA_INIT;
    const bool isC = lane < 48;
    const int h = lane >> 3, c = lane & 7, hh = (lane - 48) >> 2, dc = (lane & 3) * 16;
    f32x4 ga0, ga1, gb0, gb1;
    { const float f = 1.f - LAMBDA_INIT; const float* sg = a.in[17] + 8 * c;
      ga0 = *(const f32x4*)sg * f; ga1 = *(const f32x4*)(sg + 4) * f; gb0 = *(const f32x4*)(sg + 64) * f; gb1 = *(const f32x4*)(sg + 68) * f; }
    for (int row = gw; row < M; row += NGW) {
        const bf16_t* qa = OCA + (size_t)row * 768; const bf16_t* qb = QKV + (size_t)row * N_QKV; bf16_t* y = Y1 + (size_t)row * N_QKV;
        if (isC) {
            const u32x4 a0 = *(const u32x4*)(qa + (2 * h) * 64 + 8 * c), a1 = *(const u32x4*)(qa + (2 * h + 1) * 64 + 8 * c);
            const u32x4 b0 = *(const u32x4*)(qb + (2 * h) * 64 + 8 * c), b1 = *(const u32x4*)(qb + (2 * h + 1) * 64 + 8 * c);
            const f32x4 x0 = bf4lo(a0) - lam * bf4lo(a1), x1 = bf4hi(a0) - lam * bf4hi(a1), z0 = bf4lo(b0) - lam * bf4lo(b1), z1 = bf4hi(b0) - lam * bf4hi(b1);
            float q = ((x0[0] * x0[0] + x0[1] * x0[1]) + (x0[2] * x0[2] + x0[3] * x0[3])) + ((x1[0] * x1[0] + x1[1] * x1[1]) + (x1[2] * x1[2] + x1[3] * x1[3]))
                    + ((z0[0] * z0[0] + z0[1] * z0[1]) + (z0[2] * z0[2] + z0[3] * z0[3])) + ((z1[0] * z1[0] + z1[1] * z1[1]) + (z1[2] * z1[2] + z1[3] * z1[3]));
            q += dpp_f<0xB1>(q); q += dpp_f<0x4E>(q); q += dpp_f<0x141>(q);
            const float r = rsqrtf(q * (1.f / 128.f) + EPS);
            *(u32x4*)(y + h * 128 + 8 * c) = pack8(x0 * ga0 * r, x1 * ga1 * r);
            *(u32x4*)(y + h * 128 + 64 + 8 * c) = pack8(z0 * gb0 * r, z1 * gb1 * r);
        } else {
            const float l0 = LSE[(size_t)row * 12 + hh], l1 = LSE[(size_t)row * 12 + 4 + hh], l2 = LSE[(size_t)row * 12 + 8 + hh];
            const float mx = fmaxf(l0, fmaxf(l1, l2));
            float w0 = __builtin_amdgcn_exp2f(l0 - mx), w1 = __builtin_amdgcn_exp2f(l1 - mx), w2 = __builtin_amdgcn_exp2f(l2 - mx);
            const float inv = 1.f / (w0 + w1 + w2); w0 *= inv; w1 *= inv; w2 *= inv;
            const bf16_t* d0 = qb + 2304 + hh * 64 + dc;
#pragma unroll
            for (int k = 0; k < 2; ++k) {
                const u32x4 v0 = *(const u32x4*)(d0 + 8 * k), v1 = *(const u32x4*)(d0 + 256 + 8 * k), v2 = *(const u32x4*)(d0 + 512 + 8 * k);
                *(u32x4*)(y + 768 + hh * 64 + dc + 8 * k) = pack8(w0 * bf4lo(v0) + w1 * bf4lo(v1) + w2 * bf4lo(v2), w0 * bf4hi(v0) + w1 * bf4hi(v1) + w2 * bf4hi(v2));
            }
        }
    }
}

constexpr int MXP = 136;
__device__ __forceinline__ void mixer_phase(Frame& F, const Args& a, unsigned char* ws) {
    const bf16_t* P = (const bf16_t*)(ws + WS_P); bf16_t* Y = (bf16_t*)(ws + WS_Y);
    const bf16_t* Wb = (const bf16_t*)(ws + WS_WSB); const bf16_t* PWt = (const bf16_t*)(ws + WS_PWT);
    const float* v_gain = a.in[6]; const float* b_s = a.in[8]; const float* pool_scale = a.in[10];
    LAS bf16_t* T = (LAS bf16_t*)(F.lds + RING_OFF);
    LAS float* rs = (LAS float*)(F.lds + RING_OFF + 128 * MXP * 2);
    const int tid = tid_id(), wid = tid >> 6, lane = tid & 63, fr = lane & 15, fq = lane >> 4;
    for (int u = F.vcu; u < 1024; u += F.G) {
        const bool isA = u < 512; const int blk = (u & 511) >> 2, g = u & 3, row0 = blk * 128;
        f32x4 acc[8];
#pragma unroll
        for (int j = 0; j < 8; ++j) acc[j] = (f32x4){0.f, 0.f, 0.f, 0.f};
        if (isA) {
            { bf16x8 xr[16];
#pragma unroll
              for (int i = 0; i < 16; ++i) xr[i] = *(const bf16x8*)(P + (size_t)(row0 + wid * 16 + i) * N_IN0 + 512 + lane * 8);
#pragma unroll
              for (int i = 0; i < 16; ++i) { float q = 0.f;
#pragma unroll
                  for (int e = 0; e < 8; ++e) { const float f = bf2f((bf16_t)xr[i][e]); q += f * f; }
                  q = wave_sum(q);
                  if (lane == 0) rs[wid * 16 + i] = rsqrtf(q * (1.f / 512.f) + EPS); } }
            __syncthreads();
            for (int it = tid; it < 128 * 16; it += 512) { const int sr = it >> 4, cc = it & 15;
                const bf16x8 x = *(const bf16x8*)(P + (size_t)(row0 + sr) * N_IN0 + 512 + g * 128 + cc * 8);
                const float r = rs[sr];
#pragma unroll
                for (int e = 0; e < 8; ++e) T[(cc * 8 + e) * MXP + sr] = f2bf(bf2f((bf16_t)x[e]) * r * v_gain[g * 128 + cc * 8 + e]); }
            __syncthreads();
            const bf16_t* wrow = Wb + ((size_t)g * 128 + wid * 16 + fr) * 128 + fq * 8;
            const int nks = (wid >> 1) + 1;
            for (int ks = 0; ks < nks; ++ks) {
                const bf16x8 af = *(const bf16x8*)(wrow + ks * 32);
#pragma unroll
                for (int j = 0; j < 8; ++j) { const bf16x8 bfr = *(const LAS bf16x8*)(T + (j * 16 + fr) * MXP + ks * 32 + fq * 8);
                    acc[j] = __builtin_amdgcn_mfma_f32_16x16x32_bf16(bfr, af, acc[j], 0, 0, 0); }
            }
            const int t = wid * 16 + fr; const float bias = b_s[g * 128 + t];
#pragma unroll
            for (int j = 0; j < 8; ++j) { const int col = g * 128 + j * 16 + fq * 4;
                const u32x2 uu = *(const u32x2*)(P + (size_t)(row0 + t) * N_IN0 + col);
                const float u0 = __uint_as_float(uu.x << 16), u1 = __uint_as_float(uu.x & 0xffff0000u), u2 = __uint_as_float(uu.y << 16), u3 = __uint_as_float(uu.y & 0xffff0000u);
                u32x2 o; o.x = pk2bf(u0 * (acc[j][0] + bias), u1 * (acc[j][1] + bias)); o.y = pk2bf(u2 * (acc[j][2] + bias), u3 * (acc[j][3] + bias));
                *(u32x2*)(Y + (size_t)(row0 + t) * DM + col) = o; }
        } else {
            const int w = 2 << g; const float inv_w = 1.f / (float)w;
            { const int cc = tid & 15, rg = tid >> 4, r0 = row0 + rg * 4;
              const bf16_t* xp = P + 1024 + g * 128 + cc * 8;
              float sum[8];
#pragma unroll
              for (int e = 0; e < 8; ++e) sum[e] = 0.f;
              const int t0 = r0 & (SEQ - 1);
              for (int jj = 1; jj < w; ++jj) { if (t0 - jj >= 0) { const bf16x8 x = *(const bf16x8*)(xp + (size_t)(r0 - jj) * N_IN0);
#pragma unroll
                      for (int e = 0; e < 8; ++e) sum[e] += bf2f((bf16_t)x[e]); } }
#pragma unroll
              for (int i = 0; i < 4; ++i) { const int row = r0 + i, ts = t0 + i;
                  const bf16x8 x = *(const bf16x8*)(xp + (size_t)row * N_IN0);
                  float xv[8];
#pragma unroll
                  for (int e = 0; e < 8; ++e) { xv[e] = bf2f((bf16_t)x[e]); sum[e] += xv[e]; }
                  const float ic = (ts + 1 < w) ? 1.f / (float)(ts + 1) : inv_w;
                  u32x4 o; o.x = pk2bf(sum[0] * ic - xv[0], sum[1] * ic - xv[1]); o.y = pk2bf(sum[2] * ic - xv[2], sum[3] * ic - xv[3]);
                  o.z = pk2bf(sum[4] * ic - xv[4], sum[5] * ic - xv[5]); o.w = pk2bf(sum[6] * ic - xv[6], sum[7] * ic - xv[7]);
                  *(LAS u32x4*)(T + (rg * 4 + i) * MXP + cc * 8) = o;
                  if (ts - (w - 1) >= 0) { const bf16x8 xo = *(const bf16x8*)(xp + (size_t)(row - (w - 1)) * N_IN0);
#pragma unroll
                      for (int e = 0; e < 8; ++e) sum[e] -= bf2f((bf16_t)xo[e]); } } }
            __syncthreads();
            const bf16_t* prow = PWt + ((size_t)g * 128 + fr) * 128 + fq * 8;
#pragma unroll
            for (int ks = 0; ks < 4; ++ks) {
                const bf16x8 af = *(const LAS bf16x8*)(T + (wid * 16 + fr) * MXP + ks * 32 + fq * 8);
#pragma unroll
                for (int j = 0; j < 8; ++j) { const bf16x8 bfr = *(const bf16x8*)(prow + (size_t)(j * 16) * 128 + ks * 32);
                    acc[j] = __builtin_amdgcn_mfma_f32_16x16x32_bf16(bfr, af, acc[j], 0, 0, 0); }
            }
            const int t = wid * 16 + fr;
#pragma unroll
            for (int j = 0; j < 8; ++j) { const int d = g * 128 + j * 16 + fq * 4; const f32x4 sc = *(const f32x4*)(pool_scale + d);
                u32x2 o; o.x = pk2bf(acc[j][0] * sc[0], acc[j][1] * sc[1]); o.y = pk2bf(acc[j][2] * sc[2], acc[j][3] * sc[3]);
                *(u32x2*)(Y + (size_t)(row0 + t) * DM + 512 + d) = o; }
        }
        __syncthreads();
    }
}

__device__ __forceinline__ void ffn_fix_phase(Frame& F, const Args& a, unsigned char* ws, int layer) {
    bf16_t* HM = (bf16_t*)(ws + WS_HMID);
    const float* halo = (const float*)(ws + WS_HALO); const float* tops = (const float*)(ws + WS_TOPS); const float* topg = (const float*)(ws + WS_TOPG);
    const float* cw = a.in[20] + (size_t)layer * 3 * DFF;
    const int tid = tid_id();
    constexpr int CPR = DFF / 4;
    for (int it = F.vcu * (NWAVES * 64) + tid; it < 64 * 2 * CPR; it += F.G * NWAVES * 64) {
        const int pm = it / (2 * CPR), rem = it % (2 * CPR), rr = rem / CPR, c = (rem % CPR) * 4;
        if ((pm & 15) == 0) continue;
        const size_t off = ((size_t)pm * 2 + rr) * DFF + c;
        f32x4 sv = *(const f32x4*)(tops + off); const f32x4 g = *(const f32x4*)(topg + off);
        const f32x4 h1 = *(const f32x4*)(halo + ((size_t)(pm - 1) * 2 + 1) * DFF + c), h0 = *(const f32x4*)(halo + ((size_t)(pm - 1) * 2 + 0) * DFF + c);
        const f32x4 w0 = *(const f32x4*)(cw + c), w1 = *(const f32x4*)(cw + DFF + c);
        if (rr == 0) sv = sv + w1 * h1 + w0 * h0; else sv = sv + w0 * h1;
        u32x2 o; o.x = pk2bf(gelu_tanh(sv[0]) * g[0], gelu_tanh(sv[1]) * g[1]); o.y = pk2bf(gelu_tanh(sv[2]) * g[2], gelu_tanh(sv[3]) * g[3]);
        *(u32x2*)(HM + (size_t)(pm * 256 + rr) * DFF + c) = o;
    }
}

#define OPQ_S(x) asm volatile("" : "+s"(x))
__device__ __forceinline__ Frame make_frame(unsigned char* ws) {
    extern __shared__ __attribute__((aligned(16))) unsigned char lds_[];
    Frame F;
    F.lds = (LAS unsigned char*)lds_;
    F.MISC = (volatile LAS unsigned*)(F.lds + MISC_OFF);
    F.wave = __builtin_amdgcn_readfirstlane((int)threadIdx.x >> 6);
    int G = gridDim.x, bx = blockIdx.x; OPQ_S(G); OPQ_S(bx);
    F.G = G; F.vcu = (G % 8 == 0) ? (bx % 8) * (G / 8) + bx / 8 : bx;
    F.ctl = (gu32*)(ws + WS_CTL);
    return F;
}
__global__ void __launch_bounds__(NWAVES * 64, 2) mk_fwd(Args args) {
    extern __shared__ __attribute__((aligned(16))) unsigned char lds[];
    for (int u = threadIdx.x; u < (LDS_BYTES - LDSCTL_OFF) / 4; u += NWAVES * 64) ((LAS unsigned*)((LAS unsigned char*)lds + LDSCTL_OFF))[u] = 0u;
    __syncthreads();
    const int lo = args.ph_lo, hi = args.ph_hi;
    if (hi - lo > 1) { unsigned char* ws = args.ws; (void)xcd_barrier_post((unsigned*)((gu32*)(ws + WS_CTL) + CW_BAR) + args.li * XCD_BAR_WORDS, (volatile LAS unsigned*)((LAS unsigned char*)lds + MISC_OFF) + 8); }
#ifdef MK_DIAG
    if (blockIdx.x == 0 && threadIdx.x == 0) ((unsigned long long*)(args.ws + WS_CTL + 524288))[31] = __builtin_amdgcn_s_memrealtime();
#endif
    int pc = 0;
#define PHASE_BEGIN if (pc >= lo && pc < hi) { size_t z_ = 0; OPQ_S(z_); unsigned char* ws = args.ws + z_; float* out = args.out + z_; Frame F = make_frame(ws); bf16_t* XN = (bf16_t*)(ws + WS_XN); (void)XN; (void)out;
#ifdef MK_DIAG
#define DIAG_STAMP(k) do { if (blockIdx.x == 0 && threadIdx.x == 0) ((unsigned long long*)(ws + WS_CTL + 524288))[(k)] = __builtin_amdgcn_s_memrealtime(); } while (0)
#else
#define DIAG_STAMP(k) do { } while (0)
#endif
#define PHASE_END if (pc + 1 < hi) { XcdBarrier bar; bar.bar = (unsigned*)(F.ctl + CW_BAR) + args.li * XCD_BAR_WORDS; bar.x = xb_xcc_id(); bar.st = F.MISC + 8; xcd_barrier(bar); } DIAG_STAMP(pc); } ++pc;

    PHASE_BEGIN p0_prologue(F, args); PHASE_END
    PHASE_BEGIN
        pg8::Gemm g{XN, (const bf16_t*)(ws + WS_W_IN0), M, N_IN0, DM}; pg8::StaticOrder S; S.init(M, N_IN0, F.G, (int)blockIdx.x);
        pg8::EpiBf16G E{(bf16_t*)(ws + WS_P), N_IN0, 4, (const float*)(ws + WS_RSQ)};
        pg8::gemm_phase<pg8::EpiBf16G, pg8::StaticOrder, PG8_ALIGN, PG8_SP2>(F.lds + RING_OFF, g, S, E);
    PHASE_END
    PHASE_BEGIN mixer_phase(F, args, ws); PHASE_END
    PHASE_BEGIN
        pg8::Gemm g{(const bf16_t*)(ws + WS_Y), (const bf16_t*)(ws + WS_W_OUT0), M, DM, DM}; pg8::StaticOrder S; S.init(M, DM, F.G, (int)blockIdx.x);
        pg8::EpiRes E{XN, (float*)(ws + WS_RSQ)};
        pg8::gemm_phase<pg8::EpiRes, pg8::StaticOrder, PG8_ALIGN, PG8_SP2>(F.lds + RING_OFF, g, S, E);
    PHASE_END
#define RMS_PHASE(gain_ptr) PHASE_BEGIN { const float* gain = (gain_ptr); const int lane = lane_id(); const int gw = F.vcu * NWAVES + F.wave, NGW = F.G * NWAVES; \
        for (int m = gw; m < M; m += NGW) rms_row_to_bf16(out + (size_t)m * DM, gain, XN + (size_t)m * DM, lane); } PHASE_END
#define UP_PHASE(layer, abuf) PHASE_BEGIN { pg8::Gemm g{(const bf16_t*)(ws + (abuf)), (const bf16_t*)(ws + WS_W_UP) + (size_t)(layer) * NUP * DM, M, NUP, DM}; pg8::StaticOrder S; S.init(M, NUP, F.G, (int)blockIdx.x); \
        pg8::EpiUpConv E{(bf16_t*)(ws + WS_HMID), args.in[20] + (size_t)(layer) * 3 * DFF, args.in[21] + (size_t)(layer) * DFF, (float*)(ws + WS_HALO), (float*)(ws + WS_TOPS), (float*)(ws + WS_TOPG), (const float*)(ws + WS_RSQ)}; \
        pg8::gemm_phase<pg8::EpiUpConv, pg8::StaticOrder, true, PG8_SP2>(F.lds + RING_OFF, g, S, E); } PHASE_END
#define DOWN_PHASE(layer) PHASE_BEGIN { pg8::Gemm g{(const bf16_t*)(ws + WS_HMID), (const bf16_t*)(ws + WS_W_DN) + (size_t)(layer) * DM * DFF, M, DM, DFF}; pg8::StaticOrder S; S.init(M, DM, F.G, (int)blockIdx.x); \
        pg8::EpiRes E{XN, (float*)(ws + WS_RSQ)}; \
        pg8::gemm_phase<pg8::EpiRes, pg8::StaticOrder, PG8_ALIGN, PG8_SP2>(F.lds + RING_OFF, g, S, E); } PHASE_END
    UP_PHASE(0, WS_XN)
    PHASE_BEGIN ffn_fix_phase(F, args, ws, 0); PHASE_END
    DOWN_PHASE(0)
    PHASE_BEGIN
        pg8::Gemm g{XN, (const bf16_t*)(ws + WS_W_QKV), M, N_QKV, DM}; pg8::StaticOrder S; S.init(M, N_QKV, F.G, (int)blockIdx.x);
        pg8::EpiQKV E{(bf16_t*)(ws + WS_QKV), (const float*)(ws + WS_ROPE), (const float*)(ws + WS_RSQ)};
        pg8::gemm_phase<pg8::EpiQKV, pg8::StaticOrder, PG8_ALIGN, PG8_SP2>(F.lds + RING_OFF, g, S, E);
    PHASE_END
    PHASE_BEGIN
        { const SchedC SC{F.vcu, F.G, (attn_body::bf16*)(ws + WS_QKV), (attn_body::bf16*)(ws + WS_OCA)};
          attn_body::attn_phase<SchedC, 8, false>((char*)lds + RING_OFF, SC); }
        { const SchedD SD{F.vcu, F.G, (attn_body::bf16*)(ws + WS_QKV), (float*)(ws + WS_LSE)};
          attn_body::attn_phase<SchedD, 8, true>((char*)lds + RING_OFF, SD); }
    PHASE_END
    PHASE_BEGIN post_attention_phase(F, args, ws); PHASE_END
    PHASE_BEGIN
        pg8::Gemm g{(const bf16_t*)(ws + WS_QKV) + Y1_COL, (const bf16_t*)(ws + WS_W_OUT1), M, DM, DM, N_QKV}; pg8::StaticOrder S; S.init(M, DM, F.G, (int)blockIdx.x);
        pg8::EpiRes E{XN, (float*)(ws + WS_RSQ)};
        pg8::gemm_phase<pg8::EpiRes, pg8::StaticOrder, PG8_ALIGN, PG8_SP2>(F.lds + RING_OFF, g, S, E);
    PHASE_END
    UP_PHASE(1, WS_XN)
    PHASE_BEGIN ffn_fix_phase(F, args, ws, 1); PHASE_END
    DOWN_PHASE(1)
    PHASE_BEGIN
        const int lane = lane_id(); const int gw = F.vcu * NWAVES + F.wave, NGW = F.G * NWAVES;
        for (int m = gw; m < M; m += NGW) rms_row_final(XN + (size_t)m * DM, out + (size_t)m * DM, args.in[4], (const float*)(ws + WS_RSQ) + (size_t)m * 4, lane);
    PHASE_END
#ifdef MK_DIAG
    __syncthreads();
    if (blockIdx.x == 0 && threadIdx.x < 64) {
        asm volatile("s_waitcnt vmcnt(0)" ::: "memory");
        const unsigned long long* st = (const unsigned long long*)(args.ws + WS_CTL + 524288);
        const unsigned long long a1 = __hip_atomic_load(st + MK_DIAG_SEL1, __ATOMIC_RELAXED, __HIP_MEMORY_SCOPE_AGENT), b1 = __hip_atomic_load(st + (MK_DIAG_SEL1 == 0 ? 31 : MK_DIAG_SEL1 - 1), __ATOMIC_RELAXED, __HIP_MEMORY_SCOPE_AGENT);
        const unsigned long long a2 = __hip_atomic_load(st + MK_DIAG_SEL2, __ATOMIC_RELAXED, __HIP_MEMORY_SCOPE_AGENT), b2 = __hip_atomic_load(st + (MK_DIAG_SEL2 == 0 ? 31 : MK_DIAG_SEL2 - 1), __ATOMIC_RELAXED, __HIP_MEMORY_SCOPE_AGENT);
        const float d1 = (float)(long long)(a1 - b1) * 0.01f, d2 = (float)(long long)(a2 - b2) * 0.01f;
        for (int i = threadIdx.x; i <= 4096; i += 64) args.out[i] = (i == 0) ? d1 : d2;
    }
#endif
#undef PHASE_BEGIN
#undef PHASE_END
}
constexpr int N_PHASES = 15;

#ifndef MK_N_LAUNCHES
#define MK_N_LAUNCHES 1
#endif
extern "C" void kernel_launch(void* const* d_in, const int* in_sizes, int n_in, void* d_out, int out_size, void* d_ws, size_t ws_size, hipStream_t stream) {
    static int grid = 0;
    if (grid == 0) {
        int dev = 0, cus = 0;
        if (hipGetDevice(&dev) != hipSuccess || hipDeviceGetAttribute(&cus, hipDeviceAttributeMultiprocessorCount, dev) != hipSuccess) { fprintf(stderr, "kernel_launch: device query failed\n"); grid = -1; return; }
        if (hipFuncSetAttribute((const void*)mk_fwd, hipFuncAttributeMaxDynamicSharedMemorySize, LDS_BYTES) != hipSuccess) { fprintf(stderr, "kernel_launch: hipFuncSetAttribute failed\n"); grid = -1; return; }
        int per_cu = 0;
        if (hipOccupancyMaxActiveBlocksPerMultiprocessor(&per_cu, (const void*)mk_fwd, NWAVES * 64, LDS_BYTES) != hipSuccess || per_cu < 1) fprintf(stderr, "kernel_launch: occupancy query reports %d workgroups per CU\n", per_cu);
        (void)hipGetLastError();
        grid = cus > 0 ? cus : 256;
    }
    if (grid < 0) return;
    unsigned char* ws = (unsigned char*)d_ws;
    (void)hipMemsetAsync(ws + WS_CTL, 0, CTL_ZERO_BYTES, stream);
    Args a{};
    for (int i = 0; i < 23; ++i) a.in[i] = (const float*)d_in[i];
    a.out = (float*)d_out; a.ws = ws;
#ifdef MK_DUP_PHASE
    if (true) {
        a.li = 0; a.ph_lo = 0; a.ph_hi = MK_DUP_PHASE + 1; hipLaunchKernelGGL(mk_fwd, dim3(grid), dim3(NWAVES * 64), LDS_BYTES, stream, a);
        a.li = 1; a.ph_lo = MK_DUP_PHASE; a.ph_hi = MK_DUP_PHASE + 1; hipLaunchKernelGGL(mk_fwd, dim3(grid), dim3(NWAVES * 64), LDS_BYTES, stream, a);
        a.li = 2; a.ph_lo = MK_DUP_PHASE + 1; a.ph_hi = N_PHASES; hipLaunchKernelGGL(mk_fwd, dim3(grid), dim3(NWAVES * 64), LDS_BYTES, stream, a);
    } else
#endif
    if (MK_N_LAUNCHES == 1) {
        a.ph_lo = 0; a.ph_hi = N_PHASES;
        hipLaunchKernelGGL(mk_fwd, dim3(grid), dim3(NWAVES * 64), LDS_BYTES, stream, a);
    } else {
        for (int p = 0; p < N_PHASES; ++p) { a.ph_lo = p; a.ph_hi = p + 1; hipLaunchKernelGGL(mk_fwd, dim3(grid), dim3(NWAVES * 64), LDS_BYTES, stream, a); }
    }
}
```

```cpp
#include <hip/hip_runtime.h>
#include <cstdint>
#include <cstdio>

typedef unsigned short bf16_t;
typedef short bf16x8 __attribute__((ext_vector_type(8)));
typedef float f32x4 __attribute__((ext_vector_type(4)));
typedef float f32x2 __attribute__((ext_vector_type(2)));
typedef unsigned u32x4 __attribute__((ext_vector_type(4)));
typedef unsigned u32x2 __attribute__((ext_vector_type(2)));

constexpr int BATCH = 4, SEQ = 4096, DM = 1024, M = BATCH * SEQ;
constexpr int DFF = 2816, NUP = 2 * DFF;
constexpr int N_IN0 = 1536, N_QKV = 4608;
constexpr float EPS = 1e-6f;
constexpr float LAMBDA_INIT = 0.35550906759f;

__device__ __forceinline__ float bf2f(bf16_t v) { return __uint_as_float(((unsigned)v) << 16); }
__device__ __forceinline__ bf16_t f2bf(float f) { unsigned u = __float_as_uint(f); return (bf16_t)((u + 0x7fffu + ((u >> 16) & 1u)) >> 16); }
__device__ __forceinline__ unsigned pk2bf(float lo, float hi) { return (unsigned)f2bf(lo) | ((unsigned)f2bf(hi) << 16); }
__device__ __forceinline__ float gelu_tanh(float x) {
    const float y = x * (0.7978845608028654f + 0.035677408136300125f * x * x);
    return x * __builtin_amdgcn_rcpf(1.0f + __builtin_amdgcn_exp2f(-2.8853900817779268f * y));
}
template <int CTRL> __device__ __forceinline__ float dpp_f(float v) { return __int_as_float(__builtin_amdgcn_update_dpp(0, __float_as_int(v), CTRL, 0xf, 0xf, true)); }
__device__ __forceinline__ float swz_xor16(float v) { return __int_as_float(__builtin_amdgcn_ds_swizzle(__float_as_int(v), 0x401F)); }
__device__ __forceinline__ float wave_sum(float v) {
    v += dpp_f<0xB1>(v);
    v += dpp_f<0x4E>(v);
    v += dpp_f<0x141>(v);
    v += dpp_f<0x140>(v);
    v += swz_xor16(v);
    const auto rr = __builtin_amdgcn_permlane32_swap(__float_as_uint(v), __float_as_uint(v), false, false);
    return __uint_as_float(rr[0]) + __uint_as_float(rr[1]);
}

constexpr size_t MiB = 1u << 20;
constexpr size_t WS_CTL = 0, CTL_ZERO_BYTES = 1 * MiB;
constexpr size_t WS_W_IN0 = 1 * MiB;
constexpr size_t WS_W_OUT0 = 4 * MiB;
constexpr size_t WS_W_QKV = 6 * MiB;
constexpr size_t WS_W_OUT1 = 15 * MiB;
constexpr size_t WS_W_UP = 17 * MiB;
constexpr size_t WS_W_DN = 39 * MiB;
constexpr size_t WS_ROPE = 50 * MiB;
constexpr size_t WS_WSB = 51 * MiB;
constexpr size_t WS_PWT = 51 * MiB + 256 * 1024;
constexpr size_t WS_XN = 52 * MiB;
constexpr size_t WS_BUF = 84 * MiB;
constexpr size_t WS_P = WS_BUF, WS_Y = 132 * MiB;
constexpr size_t WS_HMID = 116 * MiB;
constexpr size_t WS_HALO = 204 * MiB, WS_TOPS = 206 * MiB, WS_TOPG = 208 * MiB;
constexpr size_t WS_QKV = WS_BUF;
constexpr int Y1_COL = 768;
constexpr size_t WS_OCA = 228 * MiB;
constexpr size_t WS_RSQ = 253 * MiB;
constexpr size_t WS_LSE = 252 * MiB;
namespace pg8 {
#define PG8_LAS __attribute__((address_space(3)))
typedef unsigned short bf16_t;
typedef short bf16x8 __attribute__((ext_vector_type(8)));
typedef float f32x4 __attribute__((ext_vector_type(4)));
typedef unsigned u32x4 __attribute__((ext_vector_type(4)));
constexpr int BM = 256, BK = 64, HALF = 128, HTB = HALF * BK * 2  , STAGE_BYTES = 8 * HTB, NXCD = 8, WGM = 8;

__host__ __device__ __forceinline__ int lds_byte(int r, int c) { const int st = (r >> 4) * 2 + (c >> 5), rr = r & 15, cc = c & 31, ob = rr * 64 + cc * 2; return st * 1024 + (ob ^ (((ob >> 9) & 1) << 5)); }
__host__ __device__ __forceinline__ void stage_rc(int b, int& R, int& C) { const int st = b / 1024, sb = b % 1024, swz = sb ^ (((sb >> 9) & 1) << 5); R = (st >> 1) * 16 + swz / 64; C = (st & 1) * 32 + (swz % 64) / 2; }
__host__ __device__ __forceinline__ int perm32(int rho) { const int n = rho >> 4, i = rho & 15; return 8 * (i >> 2) + 4 * n + (i & 3); }

struct Unit { int pm, pn; };
struct Gemm { const bf16_t* A; const bf16_t* Bt; int M, N, K, lda; };

struct StaticOrder {
    int nM, nN, nwg, G, c;
    __host__ __device__ void init(int M, int N, int G_, int c_) { nM = M / BM; nN = N / BM; nwg = nM * nN; G = G_; c = c_; }
    __host__ __device__ bool next(int i, Unit& u) const {
        const long L = (long)i * G + c; if (L >= nwg) return false;
        int wgid = (int)L; { const int q = nwg / NXCD, r = nwg % NXCD, xcd = wgid % NXCD, off = wgid / NXCD; wgid = (xcd < r ? xcd * (q + 1) : r * (q + 1) + (xcd - r) * q) + off; }
        const int nig = WGM * nN, gid = wgid / nig, fm = gid * WGM, gsz = (nM - fm) < WGM ? (nM - fm) : WGM;
        u.pm = fm + ((wgid % nig) % gsz); u.pn = (wgid % nig) / gsz; return true;
    }
    __device__ __forceinline__ void a_ready(const Unit&) const {}
    __device__ __forceinline__ void done(const Unit&) const {}
};


__device__ __forceinline__ unsigned cvt_pk_bf16(float lo, float hi) { unsigned r; asm volatile("v_cvt_pk_bf16_f32 %0, %1, %2" : "=v"(r) : "v"(lo), "v"(hi)); return r; }

__device__ __forceinline__ float rstd_of(const f32x4 p) { return rsqrtf(((p[0] + p[1]) + (p[2] + p[3])) * (1.f / 1024.f) + 1e-6f); }
struct EpiBf16G {
    static constexpr bool PERM = true, AFTER_DRAIN = false;
    bf16_t* O; int ldc; int gelu_tiles; const float* rsq;
    __device__ __forceinline__ void operator()(const f32x4 (&acc)[2][2][4][2], const Unit& u, int wr, int wc, int fr, int fq) const {
        const int row0 = u.pm * BM + wr * 64 + fr, col0 = u.pn * BM + wc * 32 + 8 * fq;
        const bool g = u.pn < gelu_tiles;
        f32x4 pr[2][4];
#pragma unroll
        for (int ai = 0; ai < 2; ++ai)
#pragma unroll
            for (int m = 0; m < 4; ++m) pr[ai][m] = *(const f32x4*)(rsq + (size_t)(row0 + ai * HALF + m * 16) * 4);
#pragma unroll
        for (int ai = 0; ai < 2; ++ai)
#pragma unroll
            for (int m = 0; m < 4; ++m) { bf16_t* rowp = O + (size_t)(row0 + ai * HALF + m * 16) * ldc + col0; const float rstd = rstd_of(pr[ai][m]);
#pragma unroll
                for (int bj = 0; bj < 2; ++bj) { f32x4 v0 = acc[ai][bj][m][0] * rstd, v1 = acc[ai][bj][m][1] * rstd;
                    if (g) { v0 = (f32x4){gelu_tanh(v0[0]), gelu_tanh(v0[1]), gelu_tanh(v0[2]), gelu_tanh(v0[3])}; v1 = (f32x4){gelu_tanh(v1[0]), gelu_tanh(v1[1]), gelu_tanh(v1[2]), gelu_tanh(v1[3])}; }
                    u32x4 w; w.x = cvt_pk_bf16(v0[0], v0[1]); w.y = cvt_pk_bf16(v0[2], v0[3]); w.z = cvt_pk_bf16(v1[0], v1[1]); w.w = cvt_pk_bf16(v1[2], v1[3]);
                    *(u32x4*)(rowp + bj * HALF) = w; } }
    }
};
constexpr int XCH_LDS_OFF = 132096;
struct EpiRes {
    static constexpr bool PERM = false, AFTER_DRAIN = false;
    bf16_t* hb; float* rsq;
    __device__ __forceinline__ void operator()(const f32x4 (&acc)[2][2][4][2], const Unit& u, int wr, int wc, int fr, int fq) const {
        extern __shared__ __attribute__((aligned(16))) unsigned char lds_all_[];
        PG8_LAS float* S = (PG8_LAS float*)((PG8_LAS unsigned char*)lds_all_ + XCH_LDS_OFF);
        const int row0 = u.pm * BM + wr * 64 + fr, col0 = u.pn * BM + wc * 32 + 4 * fq;
#pragma unroll
        for (int ai = 0; ai < 2; ++ai) {
            u32x2 bs[4][2][2];
#pragma unroll
            for (int m = 0; m < 4; ++m)
#pragma unroll
                for (int bj = 0; bj < 2; ++bj)
#pragma unroll
                    for (int n = 0; n < 2; ++n) bs[m][bj][n] = *(const u32x2*)(hb + (size_t)(row0 + ai * HALF + m * 16) * 1024 + col0 + bj * HALF + n * 16);
#pragma unroll
            for (int m = 0; m < 4; ++m) { const int row = row0 + ai * HALF + m * 16; const size_t off = (size_t)row * 1024 + col0; float q = 0.f;
#pragma unroll
                for (int bj = 0; bj < 2; ++bj)
#pragma unroll
                    for (int n = 0; n < 2; ++n) { const u32x2 b = bs[m][bj][n];
                        const f32x4 h = (f32x4){__uint_as_float(b.x << 16), __uint_as_float(b.x & 0xffff0000u), __uint_as_float(b.y << 16), __uint_as_float(b.y & 0xffff0000u)} + acc[ai][bj][m][n];
                        q += (h[0] * h[0] + h[1] * h[1]) + (h[2] * h[2] + h[3] * h[3]);
                        u32x2 w; w.x = cvt_pk_bf16(h[0], h[1]); w.y = cvt_pk_bf16(h[2], h[3]); *(u32x2*)(hb + off + bj * HALF + n * 16) = w; }
                q += swz_xor16(q);
                { const auto rr = __builtin_amdgcn_permlane32_swap(__float_as_uint(q), __float_as_uint(q), false, false); q = __uint_as_float(rr[0]) + __uint_as_float(rr[1]); }
                if (fq == 0) S[(ai * HALF + wr * 64 + m * 16 + fr) * 4 + wc] = q; }
        }
        asm volatile("s_waitcnt lgkmcnt(0)" ::: "memory"); __builtin_amdgcn_s_barrier(); asm volatile("" ::: "memory");
        const int t = (int)threadIdx.x;
        if (t < 256) { const f32x4 p = *(const PG8_LAS f32x4*)(S + t * 4); rsq[(size_t)(u.pm * BM + t) * 4 + u.pn] = (p[0] + p[1]) + (p[2] + p[3]); }
    }
};
constexpr float ATT_C2 = 0.125f * 1.4426950408889634f;
struct EpiQKV {
    static constexpr bool PERM = true, AFTER_DRAIN = false;
    bf16_t* O; const float* rope; const float* rsq;
    __device__ __forceinline__ void operator()(const f32x4 (&acc)[2][2][4][2], const Unit& u, int wr, int wc, int fr, int fq) const {
        const int row0 = u.pm * BM + wr * 64 + fr, col0 = u.pn * BM + wc * 32 + 8 * fq;
        const int pn = u.pn;
        const bool is_rope = (pn < 6) || (pn >= 9 && pn < 15);
        const bool is_q = (pn < 3) || (pn >= 9 && pn < 12);
        const float sc = is_q ? ATT_C2 : 1.f;
        const bool do_rot = is_rope && ((wc & 1) == 0);
        const float sgn = (fq == 0) ? -1.f : 1.f;
        f32x4 pr[2][4];
#pragma unroll
        for (int ai = 0; ai < 2; ++ai)
#pragma unroll
            for (int m = 0; m < 4; ++m) pr[ai][m] = *(const f32x4*)(rsq + (size_t)(row0 + ai * HALF + m * 16) * 4);
#pragma unroll
        for (int ai = 0; ai < 2; ++ai)
#pragma unroll
            for (int m = 0; m < 4; ++m) { const int row = row0 + ai * HALF + m * 16; bf16_t* rowp = O + (size_t)row * 4608 + col0;
                f32x4 cs0 = {1.f, 1.f, 1.f, 1.f}, cs1 = cs0, sn0 = {0.f, 0.f, 0.f, 0.f}, sn1 = sn0;
                if (do_rot) { const f32x4* t = (const f32x4*)(rope + (size_t)row * 16); cs0 = t[0]; cs1 = t[1]; sn0 = t[2] * sgn; sn1 = t[3] * sgn; }
                const float rstd = rstd_of(pr[ai][m]) * sc;
#pragma unroll
                for (int bj = 0; bj < 2; ++bj) { f32x4 v0 = acc[ai][bj][m][0] * rstd, v1 = acc[ai][bj][m][1] * rstd;
                    if (do_rot) {
                        f32x4 p0, p1;
#pragma unroll
                        for (int e = 0; e < 4; ++e) { p0[e] = swz_xor16(v0[e]); p1[e] = swz_xor16(v1[e]); }
                        if (fq < 2) { v0 = v0 * cs0 + p0 * sn0; v1 = v1 * cs1 + p1 * sn1; }
                    }
                    u32x4 w; w.x = cvt_pk_bf16(v0[0], v0[1]); w.y = cvt_pk_bf16(v0[2], v0[3]); w.z = cvt_pk_bf16(v1[0], v1[1]); w.w = cvt_pk_bf16(v1[2], v1[3]);
                    *(u32x4*)(rowp + bj * HALF) = w; } }
    }
};

template <int CTRL> __device__ __forceinline__ f32x4 dpp4(f32x4 v) { return (f32x4){dpp_f<CTRL>(v[0]), dpp_f<CTRL>(v[1]), dpp_f<CTRL>(v[2]), dpp_f<CTRL>(v[3])}; }
struct EpiUpConv {
    static constexpr bool PERM = true, AFTER_DRAIN = false;
    bf16_t* HM; const float* cw; const float* cb; float* halo; float* tops; float* topg; const float* rsq;
    __device__ __forceinline__ void operator()(const f32x4 (&acc)[2][2][4][2], const Unit& u, int wr_, int wc_, int fr_, int fq_) const {
        int tid_ = threadIdx.x; asm volatile("" : "+v"(tid_));
        const int wid_ = __builtin_amdgcn_readfirstlane(tid_ >> 6), wr = wid_ >> 2, wc = wid_ & 3, fr = tid_ & 15, fq = (tid_ >> 4) & 3; (void)wr_; (void)wc_; (void)fr_; (void)fq_;
        extern __shared__ __attribute__((aligned(16))) unsigned char lds_all_[];
        PG8_LAS float* X = (PG8_LAS float*)((PG8_LAS unsigned char*)lds_all_ + XCH_LDS_OFF);
        const int cl = wc * 32 + 8 * fq, hc = u.pn * 128 + cl;
        float rstd[2][4];
        { f32x4 pr[2][4];
#pragma unroll
          for (int ai = 0; ai < 2; ++ai)
#pragma unroll
              for (int m = 0; m < 4; ++m) pr[ai][m] = *(const f32x4*)(rsq + (size_t)(u.pm * BM + ai * HALF + wr * 64 + m * 16 + fr) * 4);
#pragma unroll
          for (int ai = 0; ai < 2; ++ai)
#pragma unroll
              for (int m = 0; m < 4; ++m) rstd[ai][m] = rstd_of(pr[ai][m]); }
        if (fr >= 14) {
#pragma unroll
            for (int ai = 0; ai < 2; ++ai) { PG8_LAS float* xp = X + (((ai * 2 + wr) * 2 + (fr - 14)) * 128 + cl);
                *(PG8_LAS f32x4*)xp = acc[ai][0][3][0] * rstd[ai][3]; *(PG8_LAS f32x4*)(xp + 4) = acc[ai][0][3][1] * rstd[ai][3]; }
            if (wr == 1) { float* hp = halo + ((size_t)u.pm * 2 + (fr - 14)) * 2816 + hc; *(f32x4*)hp = acc[1][0][3][0] * rstd[1][3]; *(f32x4*)(hp + 4) = acc[1][0][3][1] * rstd[1][3]; }
        }
        asm volatile("s_waitcnt lgkmcnt(0)" ::: "memory"); __builtin_amdgcn_s_barrier(); asm volatile("" ::: "memory");
        const bool needs_fix = (u.pm & 15) != 0;
#pragma unroll
        for (int n = 0; n < 2; ++n) {
            const f32x4 w0 = *(const f32x4*)(cw + hc + 4 * n), w1 = *(const f32x4*)(cw + 2816 + hc + 4 * n), w2 = *(const f32x4*)(cw + 2 * 2816 + hc + 4 * n), bb = *(const f32x4*)(cb + hc + 4 * n);
#pragma unroll
            for (int ai = 0; ai < 2; ++ai) {
                f32x4 pa, pb;
                const bool has_pred = !(ai == 0 && wr == 0);
                const int pblk = (wr == 1) ? (ai * 2) : 1;
                if (has_pred) { pa = *(const PG8_LAS f32x4*)(X + ((pblk * 2 + 1) * 128 + cl + 4 * n)); pb = *(const PG8_LAS f32x4*)(X + ((pblk * 2 + 0) * 128 + cl + 4 * n)); }
                else { pa = (f32x4){0.f, 0.f, 0.f, 0.f}; pb = pa; }
                f32x4 r1p = pa, r2p = (fr == 1) ? pa : pb;
                size_t ho = (size_t)(u.pm * BM + ai * HALF + wr * 64 + fr) * 2816 + hc + 4 * n; asm volatile("" : "+v"(ho));
#pragma unroll
                for (int m = 0; m < 4; ++m) {
                    const f32x4 x = acc[ai][0][m][n] * rstd[ai][m];
                    const f32x4 R1 = dpp4<0x121>(x), R2 = dpp4<0x122>(x);
                    const f32x4 p1 = (fr >= 1) ? R1 : r1p;
                    const f32x4 p2 = (fr >= 2) ? R2 : r2p;
                    const f32x4 sv = w2 * x + w1 * p1 + w0 * p2 + bb;
                    r1p = R1; r2p = R2;
                    const f32x4 g = acc[ai][1][m][n] * rstd[ai][m];
                    if (ai == 0 && m == 0) { if (wr == 0 && fr < 2 && needs_fix) { const size_t off = ((size_t)u.pm * 2 + fr) * 2816 + hc + 4 * n; *(f32x4*)(tops + off) = sv; *(f32x4*)(topg + off) = g; } }
                    u32x2 w; w.x = cvt_pk_bf16(gelu_tanh(sv[0]) * g[0], gelu_tanh(sv[1]) * g[1]); w.y = cvt_pk_bf16(gelu_tanh(sv[2]) * g[2], gelu_tanh(sv[3]) * g[3]);
                    *(u32x2*)(HM + ho) = w; ho += 16 * 2816;
                    asm volatile("" : "+v"(ho) :: "memory");
                }
            }
        }
    }
};
template <class Epi, class Sched, bool ALIGN_EPI = false, bool SP2 = false>
__device__ __forceinline__ void gemm_phase(PG8_LAS unsigned char* lds, const Gemm g, const Sched& S, const Epi& E) {
    int tid_ = threadIdx.x; asm volatile("" : "+v"(tid_));
    const int tid = tid_, wid = __builtin_amdgcn_readfirstlane(tid >> 6), lane = tid & 63, wr = wid >> 2, wc = wid & 3, fr = lane & 15, fq = lane >> 4;
    const int K = g.K, nt = K / BK, LDA = g.lda ? g.lda : g.K;
    unsigned voffA[2], voffB[2];
#pragma unroll
    for (int i = 0; i < 2; ++i) { int R, C; stage_rc(tid * 16 + i * 8192, R, C); const int Rb = Epi::PERM ? ((R & ~31) + perm32(R & 31)) : R;
        voffA[i] = (unsigned)(R * LDA + C) * 2u; voffB[i] = (unsigned)(Rb * K + C) * 2u; }
    const size_t kstep = (size_t)(BK * 2);
    const size_t hstep = (size_t)HALF * K * 2;
    const size_t tstep = 2 * hstep;
    const size_t hstepA = (size_t)HALF * LDA * 2, tstepA = 2 * hstepA;
    const unsigned ldsw = (unsigned)wid * 1024u;
    const int aoff = lds_byte(wr * 64 + fr, fq * 8), boff = lds_byte(wc * 32 + fr, fq * 8);
#define PG8_SA(b, h) (((b) * 2 + (h)) * HTB)
#define PG8_SB(b, h) ((4 + (b) * 2 + (h)) * HTB)
#define PG8_STAGE(bufoff, gbase, voff) do { _Pragma("unroll") for (int _i = 0; _i < 2; ++_i) \
        __builtin_amdgcn_global_load_lds((const unsigned*)((const char*)(gbase) + (voff)[_i]), (PG8_LAS unsigned*)(lds + (bufoff) + ldsw + _i * 8192), 16, 0, 0); } while (0)
#define PG8_LDA(dst, b, h) do { _Pragma("unroll") for (int m = 0; m < 4; ++m) _Pragma("unroll") for (int k = 0; k < 2; ++k) dst[m][k] = *(const PG8_LAS bf16x8*)(lds + PG8_SA(b, h) + aoff + m * 2048 + k * 1024); } while (0)
#define PG8_LDB(dst, b, h) do { _Pragma("unroll") for (int n = 0; n < 2; ++n) _Pragma("unroll") for (int k = 0; k < 2; ++k) dst[n][k] = *(const PG8_LAS bf16x8*)(lds + PG8_SB(b, h) + boff + n * 2048 + k * 1024); } while (0)
#define PG8_MMA(ai, bj, At, Bt) do { __builtin_amdgcn_s_setprio(1); _Pragma("unroll") for (int m = 0; m < 4; ++m) _Pragma("unroll") for (int n = 0; n < 2; ++n) _Pragma("unroll") for (int k = 0; k < 2; ++k) \
        acc[ai][bj][m][n] = __builtin_amdgcn_mfma_f32_16x16x32_bf16(Bt[n][k], At[m][k], acc[ai][bj][m][n], 0, 0, 0); __builtin_amdgcn_s_setprio(0); } while (0)
#define PG8_WAIT_V(n) asm volatile("s_waitcnt vmcnt(" #n ")" ::: "memory")
#define PG8_WAIT_L(n) asm volatile("s_waitcnt lgkmcnt(" #n ")" ::: "memory")
#define PG8_BAR __builtin_amdgcn_s_barrier()
#define PG8_SCHED __builtin_amdgcn_sched_barrier(0)
    Unit cur, nxt; int ui = 0;
    if (!S.next(0, cur)) return;
    f32x4 acc[2][2][4][2];
#pragma unroll
    for (int a = 0; a < 2; ++a)
#pragma unroll
        for (int b = 0; b < 2; ++b)
#pragma unroll
            for (int m = 0; m < 4; ++m)
#pragma unroll
                for (int n = 0; n < 2; ++n) acc[a][b][m][n] = (f32x4){0.f, 0.f, 0.f, 0.f};
    bf16x8 At[4][2], B0[2][2], B1[2][2];
    const char* cA = (const char*)g.A + (size_t)cur.pm * tstepA; const char* cB = (const char*)g.Bt + (size_t)cur.pn * tstep;
    S.a_ready(cur);
    if constexpr (SP2) {
        PG8_STAGE(PG8_SB(0, 0), cB, voffB); PG8_STAGE(PG8_SB(0, 1), cB + hstep, voffB); PG8_STAGE(PG8_SA(0, 0), cA, voffA); PG8_STAGE(PG8_SA(0, 1), cA + hstepA, voffA);
        if (wr == 1) PG8_BAR;
        PG8_WAIT_V(2); PG8_BAR;
        PG8_STAGE(PG8_SB(1, 0), cB + kstep, voffB); PG8_STAGE(PG8_SA(1, 0), cA + kstep, voffA); PG8_STAGE(PG8_SB(1, 1), cB + hstep + kstep, voffB);
        PG8_WAIT_V(6); PG8_BAR;
    } else {
        PG8_STAGE(PG8_SB(0, 0), cB, voffB); PG8_STAGE(PG8_SA(0, 0), cA, voffA); PG8_STAGE(PG8_SB(0, 1), cB + hstep, voffB); PG8_STAGE(PG8_SA(0, 1), cA + hstepA, voffA);
        if (wr == 1) PG8_BAR;
        PG8_WAIT_V(4); PG8_BAR;
        PG8_STAGE(PG8_SB(1, 0), cB + kstep, voffB); PG8_STAGE(PG8_SA(1, 0), cA + kstep, voffA); PG8_STAGE(PG8_SB(1, 1), cB + hstep + kstep, voffB);
        PG8_WAIT_V(6); PG8_BAR;
    }
    for (;;) {
        const bool has_next = S.next(ui + 1, nxt);
        const char* nA = has_next ? (const char*)g.A + (size_t)nxt.pm * tstepA : cA; const char* nB = has_next ? (const char*)g.Bt + (size_t)nxt.pn * tstep : cB;
        for (int t = 0; t < nt; t += 2) {
            const bool last = (t == nt - 2);
            const char* a1 = cA + (size_t)(t + 1) * kstep;
            const char* a2 = last ? nA : cA + (size_t)(t + 2) * kstep; const char* b2 = last ? nB : cB + (size_t)(t + 2) * kstep;
            const char* a3 = a2 + kstep; const char* b3 = b2 + kstep;
            if (last && has_next) S.a_ready(nxt);
            if constexpr (SP2) {
            PG8_LDB(B0, 0, 0); PG8_LDB(B1, 0, 1); PG8_SCHED; PG8_LDA(At, 0, 0); PG8_STAGE(PG8_SA(1, 1), a1 + hstepA, voffA);
            PG8_WAIT_V(8); PG8_WAIT_L(0); PG8_BAR; PG8_MMA(0, 0, At, B0); PG8_MMA(0, 1, At, B1); PG8_BAR; PG8_SCHED;
            PG8_LDA(At, 0, 1); PG8_STAGE(PG8_SB(0, 0), b2, voffB); PG8_STAGE(PG8_SB(0, 1), b2 + hstep, voffB); PG8_STAGE(PG8_SA(0, 0), a2, voffA);
            PG8_WAIT_V(8); PG8_WAIT_L(0); PG8_BAR; PG8_MMA(1, 0, At, B0); PG8_MMA(1, 1, At, B1); PG8_BAR; PG8_SCHED;
            PG8_LDB(B0, 1, 0); PG8_LDB(B1, 1, 1); PG8_SCHED; PG8_LDA(At, 1, 0); PG8_STAGE(PG8_SA(0, 1), a2 + hstepA, voffA);
            PG8_WAIT_V(8); PG8_WAIT_L(0); PG8_BAR; PG8_MMA(0, 0, At, B0); PG8_MMA(0, 1, At, B1); PG8_BAR; PG8_SCHED;
            PG8_LDA(At, 1, 1); PG8_STAGE(PG8_SB(1, 0), b3, voffB); PG8_STAGE(PG8_SB(1, 1), b3 + hstep, voffB); PG8_STAGE(PG8_SA(1, 0), a3, voffA);
            PG8_WAIT_V(8); PG8_WAIT_L(0); PG8_BAR; PG8_MMA(1, 0, At, B0); PG8_MMA(1, 1, At, B1); PG8_BAR; PG8_SCHED;
            } else {
            PG8_LDB(B0, 0, 0); PG8_SCHED; PG8_LDA(At, 0, 0); PG8_STAGE(PG8_SA(1, 1), a1 + hstepA, voffA);
            PG8_WAIT_L(8); PG8_BAR; PG8_WAIT_L(0); PG8_MMA(0, 0, At, B0); PG8_BAR; PG8_SCHED;
            PG8_LDB(B1, 0, 1); PG8_STAGE(PG8_SB(0, 0), b2, voffB);
            PG8_BAR; PG8_WAIT_L(0); PG8_MMA(0, 1, At, B1); PG8_BAR;
            PG8_LDA(At, 0, 1); PG8_STAGE(PG8_SA(0, 0), a2, voffA);
            PG8_BAR; PG8_WAIT_L(0); PG8_MMA(1, 0, At, B0); PG8_BAR; PG8_SCHED;
            PG8_STAGE(PG8_SB(0, 1), b2 + hstep, voffB);
            PG8_WAIT_V(6); PG8_BAR; PG8_MMA(1, 1, At, B1); PG8_BAR;
            PG8_LDB(B0, 1, 0); PG8_SCHED; PG8_LDA(At, 1, 0); PG8_STAGE(PG8_SA(0, 1), a2 + hstepA, voffA);
            PG8_WAIT_L(8); PG8_BAR; PG8_WAIT_L(0); PG8_MMA(0, 0, At, B0); PG8_BAR; PG8_SCHED;
            PG8_LDB(B1, 1, 1); PG8_STAGE(PG8_SB(1, 0), b3, voffB);
            PG8_BAR; PG8_WAIT_L(0); PG8_MMA(0, 1, At, B1); PG8_BAR;
            PG8_LDA(At, 1, 1); PG8_STAGE(PG8_SA(1, 0), a3, voffA);
            PG8_BAR; PG8_WAIT_L(0); PG8_MMA(1, 0, At, B0); PG8_BAR; PG8_SCHED;
            PG8_STAGE(PG8_SB(1, 1), b3 + hstep, voffB);
            PG8_WAIT_V(6); PG8_BAR; PG8_MMA(1, 1, At, B1); PG8_BAR;
            }
        }
        if constexpr (ALIGN_EPI) { if (wr == 0) PG8_BAR; }
        if constexpr (!Epi::AFTER_DRAIN) { E(acc, cur, wr, wc, fr, fq); S.done(cur); }
        if (!has_next) break;
#pragma unroll
        for (int a = 0; a < 2; ++a)
#pragma unroll
            for (int b = 0; b < 2; ++b)
#pragma unroll
                for (int m = 0; m < 4; ++m)
#pragma unroll
                    for (int n = 0; n < 2; ++n) acc[a][b][m][n] = (f32x4){0.f, 0.f, 0.f, 0.f};
        cur = nxt; cA = nA; cB = nB; ++ui;
        if constexpr (ALIGN_EPI) { if (wr == 1) PG8_BAR; }
    }
    PG8_WAIT_V(0);
    if constexpr (!ALIGN_EPI) { if (wr == 0) PG8_BAR; }
    PG8_BAR;
    if constexpr (Epi::AFTER_DRAIN) { E.fused(acc, cur, wr, wc, fr, fq, lds, wid, lane); S.done(cur); }
#undef PG8_SA
#undef PG8_SB
#undef PG8_STAGE
#undef PG8_LDA
#undef PG8_LDB
#undef PG8_MMA
#undef PG8_WAIT_V
#undef PG8_WAIT_L
#undef PG8_BAR
#undef PG8_SCHED
}
}
#include <hip/hip_bf16.h>
#include <cmath>
namespace attn_body {
using bf16=__hip_bfloat16;
using bf16x8=__attribute__((ext_vector_type(8)))short;
using s16x4=__attribute__((ext_vector_type(4)))short;
using f32x16=__attribute__((ext_vector_type(16)))float;
using u32x4=__attribute__((ext_vector_type(4)))unsigned;
constexpr int D=64,PITCH=4608;
constexpr int NW=8,QBLK=32,QB=QBLK*NW,KVBLK=64;
constexpr int ATTN_UNIT_ROWS=QB;
__device__ __forceinline__ int crow(int r,int hi){return (r&3)+8*(r>>2)+4*hi;}
#define SBAR() __builtin_amdgcn_sched_barrier(0)
template<bool BAND> __device__ __forceinline__ void cmask(f32x16&p0,f32x16&p1,int kvbase,int qrel,int hi){
  const float NEG=-INFINITY; int kb=kvbase+4*hi;
  #pragma unroll
  for(int r=0;r<16;++r){int kv=kb+(r&3)+8*(r>>2); if(kv>qrel||(BAND&&kv<qrel-128))p0[r]=NEG; if(kv+32>qrel||(BAND&&kv+32<qrel-128))p1[r]=NEG;}
}

constexpr int NSLOT=3, SLOTB=8192;
constexpr int LDS_K=0, LDS_V=NSLOT*SLOTB, LDS_WS=2*NSLOT*SLOTB, LDS_OST=LDS_WS+NW*64*4, LDS_BYTES=LDS_OST+NW*4096;
constexpr float C2=0.125f*1.4426950408889634f;
__device__ __forceinline__ void glds16(const void*gsrc,unsigned lds_dst){unsigned keep;
  asm volatile("s_mov_b32 %0, m0\n\ts_mov_b32 m0, %2\n\ts_nop 0\n\tglobal_load_lds_dwordx4 %1, off\n\ts_mov_b32 m0, %0":"=&s"(keep):"v"(gsrc),"s"(lds_dst):"memory");}
__device__ __forceinline__ float max3f(float a,float b,float c){float r;asm("v_max3_f32 %0, %1, %2, %3":"=v"(r):"v"(a),"v"(b),"v"(c));return r;}
__device__ __forceinline__ float max2f(float a,float b){float r;asm("v_max_f32_e32 %0, %1, %2":"=v"(r):"v"(a),"v"(b));return r;}
__device__ __forceinline__ float fadd_s(float a,float b){float r;asm("v_add_f32_e32 %0, %1, %2":"=v"(r):"v"(a),"v"(b));return r;}
__device__ __forceinline__ float fsub_s(float a,float b){float r;asm("v_sub_f32_e32 %0, %1, %2":"=v"(r):"v"(a),"v"(b));return r;}
typedef float f32x2_t __attribute__((ext_vector_type(2))); typedef __bf16 bf16x2_t __attribute__((ext_vector_type(2)));
__device__ __forceinline__ unsigned cvtpk_s(float lo,float hi){f32x2_t v={lo,hi};bf16x2_t b=__builtin_convertvector(v,bf16x2_t);return __builtin_bit_cast(unsigned,b);}
#define WAIT_BAR(N) asm volatile("s_waitcnt vmcnt(" #N ") lgkmcnt(0)\n\ts_barrier":::"memory")

__device__ __forceinline__ void qkt(f32x16&p0,f32x16&p1,const char*Kslot,const bf16x8*qr,const f32x16&negm,int r32,int hi){
  const char*kb=Kslot+hi*1024+r32*16;
  #pragma unroll
  for(int d0=0;d0<4;++d0){
    const bf16x8 b0=*reinterpret_cast<const bf16x8*>(kb+d0*2048);
    const bf16x8 b1=*reinterpret_cast<const bf16x8*>(kb+d0*2048+512);
    if(d0==0){p0=__builtin_amdgcn_mfma_f32_32x32x16_bf16(b0,qr[0],negm,0,0,0);p1=__builtin_amdgcn_mfma_f32_32x32x16_bf16(b1,qr[0],negm,0,0,0);}
    else{p0=__builtin_amdgcn_mfma_f32_32x32x16_bf16(b0,qr[d0],p0,0,0,0);p1=__builtin_amdgcn_mfma_f32_32x32x16_bf16(b1,qr[d0],p1,0,0,0);}}
}
typedef __attribute__((address_space(3))) const char* lds_cptr;
typedef short v4i16_t __attribute__((ext_vector_type(4)));
__device__ __forceinline__ void kload8(bf16x8*kf,lds_cptr kp){
  kf[0]=*(const __attribute__((address_space(3))) bf16x8*)(kp);      kf[1]=*(const __attribute__((address_space(3))) bf16x8*)(kp+512);
  kf[2]=*(const __attribute__((address_space(3))) bf16x8*)(kp+2048); kf[3]=*(const __attribute__((address_space(3))) bf16x8*)(kp+2560);
  kf[4]=*(const __attribute__((address_space(3))) bf16x8*)(kp+4096); kf[5]=*(const __attribute__((address_space(3))) bf16x8*)(kp+4608);
  kf[6]=*(const __attribute__((address_space(3))) bf16x8*)(kp+6144); kf[7]=*(const __attribute__((address_space(3))) bf16x8*)(kp+6656);
}
__device__ __forceinline__ void kload2(bf16x8*kf,lds_cptr kp,int j){ kf[2*j]=*(const __attribute__((address_space(3))) bf16x8*)(kp+j*2048); kf[2*j+1]=*(const __attribute__((address_space(3))) bf16x8*)(kp+j*2048+512); }
__device__ __forceinline__ s16x4 vtr(lds_cptr p){ return __builtin_bit_cast(s16x4,__builtin_amdgcn_ds_read_tr16_b64_v4i16((__attribute__((address_space(3))) v4i16_t*)p)); }
__device__ __forceinline__ float rowmax(const f32x16&p0,const f32x16&p1){
  float a=max3f(p0[0],p0[1],p1[0]),b=max3f(p0[2],p0[3],p1[1]);a=max3f(a,p1[2],p1[3]);
  #pragma unroll
  for(int r=4;r<16;r+=4){a=max3f(a,p0[r],p0[r+1]);b=max3f(b,p0[r+2],p0[r+3]);a=max3f(a,p1[r],p1[r+1]);b=max3f(b,p1[r+2],p1[r+3]);}
  const float m=max2f(a,b);
  auto rr=__builtin_amdgcn_permlane32_swap(__float_as_uint(m),__float_as_uint(m),false,false);
  return max2f(__uint_as_float(rr[0]),__uint_as_float(rr[1]));
}
__device__ __forceinline__ void pv(f32x16*o,int vb,bf16x8 pa0,bf16x8 pa1,bf16x8 pa2,bf16x8 pa3){
  #pragma unroll
  for(int d0=0;d0<2;++d0){s16x4 lo[4],hi[4];
    #pragma unroll
    for(int ks=0;ks<4;++ks){
      asm volatile("ds_read_b64_tr_b16 %0,%1 offset:%c2":"=&v"(lo[ks]):"v"(vb),"i"(d0*4096+ks*1024):"memory");
      asm volatile("ds_read_b64_tr_b16 %0,%1 offset:%c2":"=&v"(hi[ks]):"v"(vb),"i"(d0*4096+ks*1024+512):"memory");}
    asm volatile("s_waitcnt lgkmcnt(0)":::"memory");SBAR();
    #define PK(k) (bf16x8){lo[k][0],lo[k][1],lo[k][2],lo[k][3],hi[k][0],hi[k][1],hi[k][2],hi[k][3]}
    o[d0]=__builtin_amdgcn_mfma_f32_32x32x16_bf16(pa0,PK(0),o[d0],0,0,0);
    o[d0]=__builtin_amdgcn_mfma_f32_32x32x16_bf16(pa1,PK(1),o[d0],0,0,0);
    o[d0]=__builtin_amdgcn_mfma_f32_32x32x16_bf16(pa2,PK(2),o[d0],0,0,0);
    o[d0]=__builtin_amdgcn_mfma_f32_32x32x16_bf16(pa3,PK(3),o[d0],0,0,0);
    #undef PK
  }
}

#ifndef ATTN_STORE16
#define ATTN_STORE16(p,v) (*(u32x4*)(p)=(v))
#endif
template<int THRL,bool BAND> __device__ __forceinline__ void attn_unit(const bf16*Qb,const bf16*__restrict__ Kb,const bf16*__restrict__ Vb,bf16*Ob,const long rs,const long ors,const int NT,const int moff,float*lse,const long lrs,char*shm){
  int tid_=threadIdx.x; asm volatile("":"+v"(tid_));
  const int tid=tid_,lane=tid&63,r32=lane&31,hi=lane>>5; const int wid=__builtin_amdgcn_readfirstlane(tid>>6);
  const bf16*Qw=Qb+(long)(wid*QBLK)*rs;
  const bf16*Kh=Kb,*Vh=Vb;
  const unsigned lds0=(unsigned)(uintptr_t)shm;
  float*wsf=(float*)(shm+LDS_WS)+wid*64;
  const bf16*ksrc=Kh+(long)lane*rs+wid*8;
  const bf16*vsrc=Vh+(long)(16*(wid&3)+(lane>>2))*rs+(wid>>2)*32+(lane&3)*8;
  const unsigned kdst=lds0+LDS_K+wid*1024, vdst=lds0+LDS_V+wid*1024;
  #define DMA_K(t,slot) glds16(ksrc+(long)(t)*KVBLK*rs,(unsigned)__builtin_amdgcn_readfirstlane(kdst+(slot)))
  #define DMA_V(t,slot) glds16(vsrc+(long)(t)*KVBLK*rs,(unsigned)__builtin_amdgcn_readfirstlane(vdst+(slot)))
  const int vb0=(int)(lds0+LDS_V)+((lane>>4)&1)*32+(lane&3)*8+(4*hi+((lane&15)>>2))*64;
  const char*Kbase=shm+LDS_K; bf16x8 kf[8];
  const lds_cptr shm3=(lds_cptr)shm; const lds_cptr kp0=shm3+LDS_K+hi*1024+r32*16; const lds_cptr vp0=shm3+LDS_V+((lane>>4)&1)*32+(lane&3)*8+(4*hi+((lane&15)>>2))*64;
  DMA_K(0,0);DMA_V(0,0);DMA_K(1,SLOTB);
  bf16x8 qr[4];
  #pragma unroll
  for(int d0=0;d0<4;++d0)qr[d0]=*reinterpret_cast<const bf16x8*>(&Qw[(long)r32*rs+d0*16+hi*8]);
  float mhat=0.f,l_reg=0.f;f32x16 o[2];o[0]=f32x16{};o[1]=f32x16{};f32x16 negm=f32x16{};asm volatile("":"+v"(negm));
  const int qrel=wid*QBLK+r32;
  #define CMASK(P0,P1,t) do{int jb_=(t)-(NT-4); if(BAND||jb_>=0)cmask<BAND>(P0,P1,64*(t)-moff,qrel,hi);}while(0)
  bool resc=false;
  #define START(P0,P1) do{ const float rm=BAND?__builtin_fmaxf(rowmax(P0,P1),-64.f):rowmax(P0,P1); resc=false; \
    { const float dl=rm; mhat=fadd_s(mhat,dl); \
      _Pragma("unroll") for(int r=0;r<16;++r){P0[r]=fsub_s(P0[r],dl);P1[r]=fsub_s(P1[r],dl);} \
      _Pragma("unroll") for(int r=0;r<16;++r)negm[r]=-mhat; asm volatile("":"+v"(negm)); } \
    _Pragma("unroll") for(int r=0;r<16;++r)P0[r]=__builtin_amdgcn_exp2f(P0[r]); }while(0)
  #define RESC() do{ if(resc){ asm volatile("s_waitcnt lgkmcnt(0)":::"memory"); \
      _Pragma("unroll") for(int d_=0;d_<2;++d_) _Pragma("unroll") for(int r=0;r<16;++r)o[d_][r]*=wsf[crow(r,hi)]; } }while(0)
  f32x16 pA0,pA1,pB0,pB1;
  int sl_prev=0,sl_cur=0,sl_next=SLOTB;
  #define ROT() do{sl_prev=sl_cur;sl_cur=sl_next;sl_next=(sl_next==(NSLOT-1)*SLOTB)?0:sl_next+SLOTB;}while(0)
  DMA_K(2,2*SLOTB);
  WAIT_BAR(3);
  qkt(pA0,pA1,Kbase,qr,negm,r32,hi);asm volatile("s_nop 15\n\ts_nop 7":"+v"(pA0),"+v"(pA1));CMASK(pA0,pA1,0);
  START(pA0,pA1);
  _Pragma("unroll") for(int r=0;r<16;++r)pA1[r]=__builtin_amdgcn_exp2f(pA1[r]);
  WAIT_BAR(0);
  DMA_K(3,0);DMA_V(1,SLOTB);
  ROT();
  kload8(kf,kp0+sl_cur);
  WAIT_BAR(2);
  s16x4 vlo[8],vhi[8]; u32x4 pw0,pw1,pw2,pw3;
  #define PKW(P,B) cvtpk_s(P[B],P[B+1])
  #define PAF(k) __builtin_bit_cast(bf16x8,pw##k)
  #define VFR(i) (bf16x8){vlo[i][0],vlo[i][1],vlo[i][2],vlo[i][3],vhi[i][0],vhi[i][1],vhi[i][2],vhi[i][3]}
  #define PIN(x) asm volatile("":"+v"(x))
  #define MX3(a,b,c) __builtin_fmaxf(__builtin_fmaxf((a),(b)),(c))
  #define GAPA(MF,A0,A1,A2,A3,W0,W1,PW) do{ MF; sacc+=A0; sacc+=A1; sacc+=A2; sacc+=A3; PIN(sacc); W0; W1; PIN(PW); SBAR(); }while(0)
  #define EX(v) __builtin_amdgcn_exp2f(v)
  #define GAPB(MF,X,B) do{ MF; X[B]=EX(X[B]); X[B+1]=EX(X[B+1]); X[B+2]=EX(X[B+2]); X[B+3]=EX(X[B+3]); PIN(X); SBAR(); }while(0)
  #define VRD(i) do{ vlo[i]=vtr(vp_+(((i)>>2)*4096+((i)&3)*1024)); vhi[i]=vtr(vp_+(((i)>>2)*4096+((i)&3)*1024+512)); }while(0)
  #define KRD(G,j) do{ if(G){ kload2(kf,kp0+sl_next,j); SBAR(); } }while(0)
  #define STEP(C0,C1,P0,P1,t,GK,GV,GL) do{ SBAR(); \
    const lds_cptr vp_=vp0+sl_prev; \
    VRD(0); SBAR(); float sacc=(P0[0]+P0[1]); \
    GAPA(C0=__builtin_amdgcn_mfma_f32_32x32x16_bf16(kf[0],qr[0],negm,0,0,0), P0[2],P0[3],P0[4],P0[5],     pw0[0]=PKW(P0,0), pw0[1]=PKW(P0,2), pw0); \
    VRD(4); SBAR(); GAPA(C1=__builtin_amdgcn_mfma_f32_32x32x16_bf16(kf[1],qr[0],negm,0,0,0), P0[6],P0[7],P0[8],P0[9],     pw0[2]=PKW(P0,4), pw0[3]=PKW(P0,6), pw0); \
    VRD(1); SBAR(); GAPA(C0=__builtin_amdgcn_mfma_f32_32x32x16_bf16(kf[2],qr[1],C0,0,0,0),   P0[10],P0[11],P0[12],P0[13], pw1[0]=PKW(P0,8), pw1[1]=PKW(P0,10), pw1); \
    VRD(5); SBAR(); GAPA(C1=__builtin_amdgcn_mfma_f32_32x32x16_bf16(kf[3],qr[1],C1,0,0,0),   P0[14],P0[15],P1[0],P1[1],   pw1[2]=PKW(P0,12),pw1[3]=PKW(P0,14), pw1); \
    VRD(2); SBAR(); GAPA(C0=__builtin_amdgcn_mfma_f32_32x32x16_bf16(kf[4],qr[2],C0,0,0,0),   P1[2],P1[3],P1[4],P1[5],     pw2[0]=PKW(P1,0), pw2[1]=PKW(P1,2), pw2); \
    VRD(6); SBAR(); GAPA(C1=__builtin_amdgcn_mfma_f32_32x32x16_bf16(kf[5],qr[2],C1,0,0,0),   P1[6],P1[7],P1[8],P1[9],     pw2[2]=PKW(P1,4), pw2[3]=PKW(P1,6), pw2); \
    VRD(3); SBAR(); GAPA(C0=__builtin_amdgcn_mfma_f32_32x32x16_bf16(kf[6],qr[3],C0,0,0,0),   P1[10],P1[11],P1[12],P1[13], pw3[0]=PKW(P1,8), pw3[1]=PKW(P1,10), pw3); \
    VRD(7); SBAR(); GAPA(C1=__builtin_amdgcn_mfma_f32_32x32x16_bf16(kf[7],qr[3],C1,0,0,0),   P1[14],P1[15],0.f,0.f,       pw3[2]=PKW(P1,12),pw3[3]=PKW(P1,14), pw3); \
    l_reg+=sacc; \
    if(GK){DMA_K((t)+3,sl_cur);} if(GV){DMA_V((t)+1,sl_next);} \
    CMASK(C0,C1,t); \
    { float a=MX3(C0[0],C0[1],C1[0]),b=MX3(C0[2],C0[3],C1[1]); a=MX3(a,C1[2],C1[3]); \
      _Pragma("unroll") for(int r=4;r<16;r+=4){a=MX3(a,C0[r],C0[r+1]);b=MX3(b,C0[r+2],C0[r+3]);a=MX3(a,C1[r],C1[r+1]);b=MX3(b,C1[r+2],C1[r+3]);} \
      float rm=__builtin_fmaxf(a,b); { auto rr=__builtin_amdgcn_permlane32_swap(__float_as_uint(rm),__float_as_uint(rm),false,false); rm=__builtin_fmaxf(__uint_as_float(rr[0]),__uint_as_float(rr[1])); } \
      resc=false; \
      if(__builtin_expect(__any(rm>(float)THRL),0)){ const float dl=__builtin_fmaxf(rm,0.f); mhat+=dl; \
        _Pragma("unroll") for(int r=0;r<16;++r){C0[r]-=dl;C1[r]-=dl;} \
        _Pragma("unroll") for(int r=0;r<16;++r)negm[r]=-mhat; asm volatile("":"+v"(negm)); \
        const float f=__builtin_amdgcn_exp2f(-dl); l_reg*=f; if(hi==0)wsf[r32]=f; resc=true; } } \
    SBAR(); \
    GAPB(o[0]=__builtin_amdgcn_mfma_f32_32x32x16_bf16(PAF(0),VFR(0),o[0],0,0,0), C0,0); \
    GAPB(o[1]=__builtin_amdgcn_mfma_f32_32x32x16_bf16(PAF(0),VFR(4),o[1],0,0,0), C0,4); \
    KRD(GL,0); GAPB(o[0]=__builtin_amdgcn_mfma_f32_32x32x16_bf16(PAF(1),VFR(1),o[0],0,0,0), C0,8); \
    KRD(GL,1); GAPB(o[1]=__builtin_amdgcn_mfma_f32_32x32x16_bf16(PAF(1),VFR(5),o[1],0,0,0), C0,12); \
    KRD(GL,2); GAPB(o[0]=__builtin_amdgcn_mfma_f32_32x32x16_bf16(PAF(2),VFR(2),o[0],0,0,0), C1,0); \
    KRD(GL,3); GAPB(o[1]=__builtin_amdgcn_mfma_f32_32x32x16_bf16(PAF(2),VFR(6),o[1],0,0,0), C1,4); \
    GAPB(o[0]=__builtin_amdgcn_mfma_f32_32x32x16_bf16(PAF(3),VFR(3),o[0],0,0,0), C1,8); \
    GAPB(o[1]=__builtin_amdgcn_mfma_f32_32x32x16_bf16(PAF(3),VFR(7),o[1],0,0,0), C1,12); \
    }while(0)
  int t=1;
  #undef CMASK
  #define CMASK(P0,P1,t) do{}while(0)
  for(;t+5<NT;t+=2){
    STEP(pB0,pB1,pA0,pA1,t,true,true,true);     WAIT_BAR(2); RESC(); ROT();
    STEP(pA0,pA1,pB0,pB1,t+1,true,true,true);   WAIT_BAR(2); RESC(); ROT();
  }
  #undef CMASK
  #define CMASK(P0,P1,t) do{int jb_=(t)-(NT-4); if(BAND||jb_>=0)cmask<BAND>(P0,P1,64*(t)-moff,qrel,hi);}while(0)
  #define ENDW(tt) do{ if((tt)+3<NT){WAIT_BAR(2);} else if((tt)+2<NT){WAIT_BAR(1);} else {WAIT_BAR(0);} }while(0)
  for(;t+1<NT;t+=2){
    STEP(pB0,pB1,pA0,pA1,t,(t+3<NT),(t+1<NT),(t+1<NT));       ENDW(t);   RESC(); ROT();
    STEP(pA0,pA1,pB0,pB1,t+1,(t+4<NT),(t+2<NT),(t+2<NT));     ENDW(t+1); RESC(); ROT();
  }
  STEP(pB0,pB1,pA0,pA1,NT-1,false,false,false); RESC();
  { float sacc=pB0[0]+pB0[1]; _Pragma("unroll") for(int r=2;r<16;++r)sacc+=pB0[r]; _Pragma("unroll") for(int r=0;r<16;++r)sacc+=pB1[r]; l_reg+=sacc;
    pw0=(u32x4){PKW(pB0,0),PKW(pB0,2),PKW(pB0,4),PKW(pB0,6)};pw1=(u32x4){PKW(pB0,8),PKW(pB0,10),PKW(pB0,12),PKW(pB0,14)};pw2=(u32x4){PKW(pB1,0),PKW(pB1,2),PKW(pB1,4),PKW(pB1,6)};pw3=(u32x4){PKW(pB1,8),PKW(pB1,10),PKW(pB1,12),PKW(pB1,14)};
    SBAR(); pv(o,vb0+sl_cur,PAF(0),PAF(1),PAF(2),PAF(3)); }
  #undef PKW
  #undef PAF
  #undef VFR
  #undef PIN
  #undef MX3
  #undef GAPA
  #undef GAPB
  #undef EX
  #undef VRD
  #undef KRD
  #undef STEP
  #undef ENDW
  {auto rr=__builtin_amdgcn_permlane32_swap(__float_as_uint(l_reg),__float_as_uint(l_reg),false,false);l_reg=__uint_as_float(rr[0])+__uint_as_float(rr[1]);}
  if(hi==0)wsf[32+r32]=l_reg;asm volatile("s_waitcnt lgkmcnt(0)":::"memory");
  float rli[16];
  #pragma unroll
  for(int r=0;r<16;++r)rli[r]=__builtin_amdgcn_rcpf(wsf[32+crow(r,hi)]);
  bf16*Ow=Ob+(long)(wid*QBLK)*ors;
  if(BAND){ if(hi==0) lse[(long)(wid*QBLK+r32)*lrs]=mhat+__builtin_amdgcn_logf(l_reg); }
  { bf16*stg=(bf16*)(shm+LDS_OST)+wid*2048;
    #pragma unroll
    for(int r=0;r<16;++r){const int orow=crow(r,hi);
      #pragma unroll
      for(int d0=0;d0<2;++d0)stg[orow*64+d0*32+r32]=__float2bfloat16(o[d0][r]*rli[r]);}
    asm volatile("s_waitcnt lgkmcnt(0)":::"memory");
    #pragma unroll
    for(int i=0;i<4;++i){const int row=i*8+(lane>>3),ch=lane&7; const u32x4 v=*(const u32x4*)(stg+row*64+ch*8); ATTN_STORE16(Ow+(long)row*ors+ch*8,v);} }
  asm volatile("s_waitcnt lgkmcnt(0)\n\ts_barrier":::"memory");
  #undef DMA_K
  #undef DMA_V
  #undef CMASK
  #undef START
  #undef RESC
  #undef ROT
}
constexpr int ATTN_LDS_BYTES=LDS_BYTES;
struct AttnUnit { const bf16* Q; const bf16* K; const bf16* V; bf16* O; float* lse; long rs, ors, lrs; int NT, moff; };
template<class Sched,int THRL,bool BAND> __device__ __forceinline__ void attn_phase(char*lds,const Sched&S){
  AttnUnit u;
  for(int i=0;S.next(i,u);++i){ attn_unit<THRL,BAND>(u.Q,u.K,u.V,u.O,u.rs,u.ors,u.NT,u.moff,u.lse,u.lrs,lds); }
}
#undef SBAR
#undef WAIT_BAR
}
#define GAS __attribute__((address_space(1)))
#define LAS __attribute__((address_space(3)))
typedef unsigned short bf16;
typedef unsigned v4u __attribute__((ext_vector_type(4)));
typedef float f32x4 __attribute__((ext_vector_type(4)));
typedef short bf16x8 __attribute__((ext_vector_type(8)));
typedef GAS unsigned gu32;
typedef GAS unsigned long long gu64;
#define RLX_AGENT __ATOMIC_RELAXED, __HIP_MEMORY_SCOPE_AGENT
#define LDS_WAIT() asm volatile("s_waitcnt lgkmcnt(0)" ::: "memory")
#define VM_WAIT() asm volatile("s_waitcnt vmcnt(0)" ::: "memory")
__device__ __forceinline__ unsigned long long rt() { return __builtin_amdgcn_s_memrealtime(); }

#define XB_TMO      128
#define XB_XCNT(j)  (256  + 64 * (j))
#define XB_XSUB(j)  (1280 + 64 * (j))
#define XB_XGEN(j)  (2304 + 64 * (j))
#define XB_TOP      3328
#define XB_TOPGEN   3392
#define XCD_BAR_WORDS 3456
#define XB_SPIN_CAP (1u << 18)

__device__ __forceinline__ unsigned xb_ld(unsigned* p)              { return __hip_atomic_load(p, __ATOMIC_RELAXED, __HIP_MEMORY_SCOPE_AGENT); }
__device__ __forceinline__ unsigned xb_add(unsigned* p, unsigned v) { return __hip_atomic_fetch_add(p, v, __ATOMIC_RELAXED, __HIP_MEMORY_SCOPE_AGENT); }
__device__ __forceinline__ unsigned xb_xcc_id() { return (unsigned)__builtin_amdgcn_s_getreg((3 << 11) | 20) & 0xFu; }
#define XB_SPIN(cond, bar) do { unsigned _sp = 0; while (cond) { __builtin_amdgcn_s_sleep(1); \
    if ((++_sp & 255u) == 0u) { if (xb_ld(&(bar)[XB_TMO])) break; if (_sp > XB_SPIN_CAP) { atomicAdd(&(bar)[XB_TMO], 1u); break; } } } } while (0)

struct XcdBarrier {
    unsigned* bar; unsigned x;
    volatile LAS unsigned* st;
};

__device__ __forceinline__ XcdBarrier xcd_barrier_post(unsigned* bar, volatile LAS unsigned* st) {
    XcdBarrier b; b.bar = bar; b.x = xb_xcc_id(); b.st = st;
    if (threadIdx.x == 0) (void)xb_add(&bar[XB_XCNT(b.x)], 1u);
    return b;
}
__device__ __forceinline__ void xcd_barrier_complete(unsigned* bar, unsigned x, unsigned& nloc, unsigned& nx) {
    const unsigned G = gridDim.x * gridDim.y * gridDim.z;
    unsigned sum, cnt, mine, sp = 0u;
    for (;;) {
        sum = 0u; cnt = 0u; mine = 0u;
#pragma unroll
        for (unsigned j = 0; j < 16; ++j) { const unsigned c = xb_ld(&bar[XB_XCNT(j)]); sum += c; cnt += (c > 0u) ? 1u : 0u; mine = (j == x) ? c : mine; }
        if (sum == G) break;
        __builtin_amdgcn_s_sleep(1);
        if ((++sp & 255u) == 0u) { if (xb_ld(&bar[XB_TMO])) break; if (sp > XB_SPIN_CAP) { atomicAdd(&bar[XB_TMO], 1u); break; } }
    }
    nloc = mine > 0u ? mine : 1u; nx = cnt > 0u ? cnt : 1u;
}

__device__ __forceinline__ void xcd_barrier(const XcdBarrier& b) {
    asm volatile("s_waitcnt vmcnt(0)" ::: "memory");
    __syncthreads();
    if (threadIdx.x == 0) {
        unsigned* bar = b.bar;
        __builtin_amdgcn_s_waitcnt(0);
        unsigned nloc = b.st[0], nx = b.st[1];
        if (nloc == 0u) { xcd_barrier_complete(bar, b.x, nloc, nx); b.st[0] = nloc; b.st[1] = nx; }
        const unsigned old = xb_add(&bar[XB_XSUB(b.x)], 1u);
        const unsigned gen = old / nloc;
        if (old + 1u == (gen + 1u) * nloc) {
            __builtin_amdgcn_fence(__ATOMIC_RELEASE, "agent");
            asm volatile("s_waitcnt vmcnt(0)" ::: "memory");
            const unsigned og = xb_add(&bar[XB_TOP], 1u);
            const unsigned tg = og / nx;
            if (og + 1u == (tg + 1u) * nx) xb_add(&bar[XB_TOPGEN], 1u);
            else XB_SPIN(xb_ld(&bar[XB_TOPGEN]) == tg, bar);
            __builtin_amdgcn_fence(__ATOMIC_ACQUIRE, "agent");
            xb_add(&bar[XB_XGEN(b.x)], 1u);
            asm volatile("s_waitcnt vmcnt(0)" ::: "memory");
        } else {
            XB_SPIN(xb_ld(&bar[XB_XGEN(b.x)]) == gen, bar);
            __builtin_amdgcn_fence(__ATOMIC_ACQUIRE, "agent");
            asm volatile("s_waitcnt vmcnt(0)" ::: "memory");
        }
    }
    __syncthreads();
}

constexpr int NWAVES = 8;
constexpr int RING_OFF = 0, RING_BYTES = 131072;
constexpr int LDSCTL_OFF = RING_BYTES, MISC_OFF = LDSCTL_OFF + 320;
constexpr int LDS_BYTES = 147456;
constexpr int CW_TMO = 0, CW_CODE = 1, CW_BAR = 4096;

__device__ __forceinline__ int lane_id() { int l = (int)(threadIdx.x & 63u); asm volatile("" : "+v"(l)); return l; }
__device__ __forceinline__ int tid_id() { int t = (int)threadIdx.x; asm volatile("" : "+v"(t)); return t; }
struct Frame {
    LAS unsigned char* lds;
    volatile LAS unsigned* MISC;
    gu32* ctl;
    int wave, vcu, G;
};

__device__ __forceinline__ void p0_transpose_item(const float* W, int K, int N, bf16_t* WT, int k0, int n0, int drow0, LAS float* scr, int lane, const float* gain) {
    const float* src = W + (size_t)(k0 + (lane >> 5)) * N + n0 + (lane & 31);
    float v[32];
#pragma unroll
    for (int i = 0; i < 32; ++i) v[i] = src[(size_t)(2 * i) * N];
    const int c = lane & 7;
    f32x4 g0 = {1.f, 1.f, 1.f, 1.f}, g1 = g0;
    if (gain) { g0 = *(const f32x4*)(gain + k0 + 8 * c); g1 = *(const f32x4*)(gain + k0 + 8 * c + 4); }
#pragma unroll
    for (int i = 0; i < 32; ++i) scr[(2 * i + (lane >> 5)) * 33 + (lane & 31)] = v[i];
    LDS_WAIT(); asm volatile("" ::: "memory");
#pragma unroll
    for (int j = 0; j < 4; ++j) { const int n = (lane >> 3) + 8 * j; const LAS float* s = scr + (8 * c) * 33 + n;
        v4u o; o.x = pk2bf(s[0 * 33] * g0[0], s[1 * 33] * g0[1]); o.y = pk2bf(s[2 * 33] * g0[2], s[3 * 33] * g0[3]); o.z = pk2bf(s[4 * 33] * g1[0], s[5 * 33] * g1[1]); o.w = pk2bf(s[6 * 33] * g1[2], s[7 * 33] * g1[3]);
        *(GAS v4u*)(WT + (size_t)(drow0 + n) * K + k0 + 8 * c) = o; }
    LDS_WAIT(); asm volatile("" ::: "memory");
}
__device__ __forceinline__ void rms_row_to_bf16(const float* xrow, const float* g, bf16_t* orow, int lane) {
    const f32x4* xr = (const f32x4*)xrow + lane;
    f32x4 v[4]; float s = 0.f;
#pragma unroll
    for (int j = 0; j < 4; ++j) { v[j] = xr[64 * j]; s += (v[j].x * v[j].x + v[j].y * v[j].y) + (v[j].z * v[j].z + v[j].w * v[j].w); }
    const float r = rsqrtf(wave_sum(s) * (1.f / DM) + EPS);
    unsigned long long* o8 = (unsigned long long*)orow + lane;
#pragma unroll
    for (int j = 0; j < 4; ++j) { const f32x4 gg = *((const f32x4*)g + lane + 64 * j);
        o8[64 * j] = (unsigned long long)pk2bf(v[j].x * r * gg.x, v[j].y * r * gg.y) | ((unsigned long long)pk2bf(v[j].z * r * gg.z, v[j].w * r * gg.w) << 32); }
}
__device__ __forceinline__ void row_to_bf16_sq(const float* xrow, bf16_t* orow, float* rsq16, int lane) {
    const f32x4* xr = (const f32x4*)xrow + lane;
    f32x4 v[4]; float s = 0.f;
#pragma unroll
    for (int j = 0; j < 4; ++j) { v[j] = xr[64 * j]; s += (v[j].x * v[j].x + v[j].y * v[j].y) + (v[j].z * v[j].z + v[j].w * v[j].w); }
    s = wave_sum(s);
    unsigned long long* o8 = (unsigned long long*)orow + lane;
#pragma unroll
    for (int j = 0; j < 4; ++j) o8[64 * j] = (unsigned long long)pk2bf(v[j].x, v[j].y) | ((unsigned long long)pk2bf(v[j].z, v[j].w) << 32);
    if (lane < 4) rsq16[lane] = (lane == 0) ? s : 0.f;
}
__device__ __forceinline__ void rms_row_final(const bf16_t* hrow, float* orow, const float* g, const float* rsq4, int lane) {
    float s = (lane < 4) ? rsq4[lane] : 0.f;
    const unsigned long long* h8 = (const unsigned long long*)hrow + lane;
    unsigned long long hv[4];
#pragma unroll
    for (int j = 0; j < 4; ++j) hv[j] = h8[64 * j];
    s = wave_sum(s);
    const float r = rsqrtf(s * (1.f / DM) + EPS);
    f32x4* o = (f32x4*)orow + lane;
#pragma unroll
    for (int j = 0; j < 4; ++j) { const f32x4 gg = *((const f32x4*)g + lane + 64 * j); const unsigned lo = (unsigned)hv[j], hi = (unsigned)(hv[j] >> 32);
        o[64 * j] = (f32x4){__uint_as_float(lo << 16), __uint_as_float(lo & 0xffff0000u), __uint_as_float(hi << 16), __uint_as_float(hi & 0xffff0000u)} * r * gg; }
}
__device__ __forceinline__ void rms_row_inplace_rsq(float* xrow, const float* g, const float* rsq16, int lane) {
    f32x4* xr = (f32x4*)xrow + lane;
    float s = (lane < 4) ? rsq16[lane] : 0.f;
    s = wave_sum(s);
    const float r = rsqrtf(s * (1.f / DM) + EPS);
#pragma unroll
    for (int j = 0; j < 4; ++j) { const f32x4 gg = *((const f32x4*)g + lane + 64 * j); xr[64 * j] = xr[64 * j] * r * gg; }
}
__device__ __forceinline__ void rms_row_inplace(float* xrow, const float* g, int lane) {
    f32x4* xr = (f32x4*)xrow + lane;
    f32x4 v[4]; float s = 0.f;
#pragma unroll
    for (int j = 0; j < 4; ++j) { v[j] = xr[64 * j]; s += (v[j].x * v[j].x + v[j].y * v[j].y) + (v[j].z * v[j].z + v[j].w * v[j].w); }
    const float r = rsqrtf(wave_sum(s) * (1.f / DM) + EPS);
#pragma unroll
    for (int j = 0; j < 4; ++j) { const f32x4 gg = *((const f32x4*)g + lane + 64 * j); xr[64 * j] = v[j] * r * gg; }
}

struct Args { const float* in[23]; float* out; unsigned char* ws; int ph_lo, ph_hi, li, pad; };

struct WDesc { const float* W; int K, N; bf16_t* WT; int mode; int items; };

__device__ __forceinline__ void p0_prologue(Frame& F, const Args& a) {
    LAS float* scr = (LAS float*)(F.lds + RING_OFF + F.wave * 16384);
    const int lane = lane_id(), tid = tid_id();
    const int gw = F.vcu * NWAVES + F.wave, NGW = F.G * NWAVES;
    unsigned char* ws = a.ws;
    constexpr int I0 = (DM / 64) * (N_IN0 / 32), I1 = (DM / 64) * (DM / 32), I2 = (DM / 64) * (N_QKV / 32), I3 = I1, I4 = (DM / 64) * (NUP / 32), I6 = (DFF / 64) * (DM / 32);
    constexpr int I8 = (128 / 64) * (128 / 32);
    constexpr int NITEMS = I0 + I1 + I2 + I3 + 2 * I4 + 2 * I6 + 4 * I8;
    for (int it = gw; it < NITEMS; it += NGW) {
        int r = it; const float* W; int K, N; bf16_t* WT; int mode = 0; const float* gain = nullptr;
        if (r < I0) { W = a.in[5]; K = DM; N = N_IN0; WT = (bf16_t*)(ws + WS_W_IN0); gain = a.in[2]; }
        else if ((r -= I0) < I1) { W = a.in[11]; K = DM; N = DM; WT = (bf16_t*)(ws + WS_W_OUT0); }
        else if ((r -= I1) < I2) { W = a.in[12]; K = DM; N = N_QKV; WT = (bf16_t*)(ws + WS_W_QKV); gain = a.in[2] + DM; }
        else if ((r -= I2) < I3) { W = a.in[18]; K = DM; N = DM; WT = (bf16_t*)(ws + WS_W_OUT1); }
        else if ((r -= I3) < 2 * I4) { const int l = r / I4; r -= l * I4; W = a.in[19] + (size_t)l * DM * NUP; K = DM; N = NUP; WT = (bf16_t*)(ws + WS_W_UP) + (size_t)l * NUP * DM; mode = 1; gain = a.in[3] + l * DM; }
        else if ((r -= 2 * I4) < 2 * I6) { const int l = r / I6; r -= l * I6; W = a.in[22] + (size_t)l * DFF * DM; K = DFF; N = DM; WT = (bf16_t*)(ws + WS_W_DN) + (size_t)l * DM * DFF; }
        else { r -= 2 * I6; const int g = r / I8; r -= g * I8; W = a.in[9] + (size_t)g * 128 * 128; K = 128; N = 128; WT = (bf16_t*)(ws + WS_PWT) + (size_t)g * 128 * 128; }
        const int nblk = N / 32, kb = r / nblk, nb = r % nblk, k0 = 64 * kb, n0 = 32 * nb;
        int d0 = n0;
        if (mode == 1) { if (n0 < DFF) d0 = 256 * (n0 / 128) + (n0 % 128); else { const int q = n0 - DFF; d0 = 256 * (q / 128) + 128 + (q % 128); } }
        p0_transpose_item(W, K, N, WT, k0, n0, d0, scr, lane, gain);
    }
    { const float* w_s = a.in[7]; bf16_t* Wb = (bf16_t*)(ws + WS_WSB);
      for (int idx = (F.vcu * NWAVES * 64) + tid; idx < 4 * 128 * 128; idx += F.G * NWAVES * 64) { const int t = (idx >> 7) & 127, sidx = idx & 127; Wb[idx] = (sidx <= t) ? f2bf(w_s[idx]) : (bf16_t)0; } }
    { const int* pos = (const int*)a.in[1]; float* tab = (float*)(ws + WS_ROPE);
      for (int idx = (F.vcu * NWAVES * 64) + tid; idx < M * 8; idx += F.G * NWAVES * 64) {
          const int row = idx >> 3, i = idx & 7;
          const double inv = exp2(-(double)(2 * i) / 16.0 * 18.931568569324174);
          const float ang = (float)pos[row] * (float)inv;
          const double rev = (double)ang * 0.15915494309189535;
          const double fr = rev - floor(rev);
          const float aa = (float)(fr * 6.283185307179586);
          tab[row * 16 + i] = cosf(aa); tab[row * 16 + 8 + i] = sinf(aa); } }
    { bf16_t* XN = (bf16_t*)(ws + WS_XN); float* rsq = (float*)(ws + WS_RSQ); const float* x = a.in[0];
      for (int m0 = gw * 4; m0 < M; m0 += NGW * 4) {
          f32x4 v[4][4];
#pragma unroll
          for (int r = 0; r < 4; ++r)
#pragma unroll
              for (int j = 0; j < 4; ++j) v[r][j] = *((const f32x4*)(x + (size_t)(m0 + r) * DM) + lane + 64 * j);
#pragma unroll
          for (int r = 0; r < 4; ++r) { float sq = 0.f;
#pragma unroll
              for (int j = 0; j < 4; ++j) sq += (v[r][j].x * v[r][j].x + v[r][j].y * v[r][j].y) + (v[r][j].z * v[r][j].z + v[r][j].w * v[r][j].w);
              sq = wave_sum(sq);
              unsigned long long* o8 = (unsigned long long*)(XN + (size_t)(m0 + r) * DM) + lane;
#pragma unroll
              for (int j = 0; j < 4; ++j) o8[64 * j] = (unsigned long long)pk2bf(v[r][j].x, v[r][j].y) | ((unsigned long long)pk2bf(v[r][j].z, v[r][j].w) << 32);
              if (lane < 4) rsq[(size_t)(m0 + r) * 4 + lane] = (lane == 0) ? sq : 0.f; } } }
}

#ifndef PG8_SP2
#define PG8_SP2 true
#endif
#ifndef PG8_ALIGN
#define PG8_ALIGN true
#endif

struct SchedC {
    int vcu, G; attn_body::bf16* QKV; attn_body::bf16* OCA;
    __device__ __forceinline__ bool next(int it, attn_body::AttnUnit& u) const {
        constexpr long P = attn_body::PITCH;
        const int per = 6, s = vcu + (it / per) * G, k = (it % per) >> 1, pass = it & 1;
        if (s >= 256) return false;
        const int x = s >> 5, l = s & 31, i = l & 15, hl = (l >> 4) * 3 + k;
        const int qb = (k == 0) ? i : (k == 1) ? ((i + 8) & 15) : (i < 8 ? 14 - 2 * i : 31 - 2 * i);
        const int bj = x * 6 + hl, b = bj / 12, j = bj % 12, h = j >> 1;
        const long rowbase = (long)b * SEQ, q0 = (long)qb * 256;
        u.Q = QKV + (rowbase + q0) * P + j * 64; u.K = QKV + rowbase * P + 768 + j * 64; u.V = QKV + rowbase * P + 1536 + h * 128 + pass * 64;
        u.O = pass ? QKV + (rowbase + q0) * P + j * 64 : OCA + (rowbase + q0) * 768 + j * 64; u.ors = pass ? P : 768; u.rs = P;
        u.NT = 4 * qb + 4; u.moff = (int)q0; u.lse = nullptr; u.lrs = 0;
        return true;
    }
};
struct SchedD {
    int vcu, G; attn_body::bf16* QKV; float* LSE;
    __device__ __forceinline__ bool next(int it, attn_body::AttnUnit& u) const {
        constexpr long P = attn_body::PITCH;
        const int ud = vcu + it * G; if (ud >= 768) return false;
        const int b = ud / 192, rem = ud % 192, head = rem >> 4, idx = rem & 15, g = head >> 2;
        const int dl = (g == 0) ? 1 : (g == 1 ? 4 : 16), nb = 16 / dl, r = idx / nb, qb = idx % nb;
        const long rowbase = (long)b * SEQ + r; const int q0 = 256 * qb, kstart = (q0 >= 128) ? q0 - 128 : 0;
        u.rs = (long)dl * P; u.ors = u.rs; u.lrs = (long)dl * 12;
        u.Q = QKV + (rowbase + (long)q0 * dl) * P + 2304 + head * 64; u.O = QKV + (rowbase + (long)q0 * dl) * P + 2304 + head * 64;
        u.K = QKV + (rowbase + (long)kstart * dl) * P + 3072 + head * 64; u.V = QKV + (rowbase + (long)kstart * dl) * P + 3840 + head * 64;
        u.NT = (q0 + 256 - kstart) / 64; u.moff = q0 - kstart; u.lse = LSE + (rowbase + (long)q0 * dl) * 12 + head;
        return true;
    }
};
__device__ __forceinline__ f32x4 bf4lo(const u32x4 w) { return (f32x4){__uint_as_float(w.x << 16), __uint_as_float(w.x & 0xffff0000u), __uint_as_float(w.y << 16), __uint_as_float(w.y & 0xffff0000u)}; }
__device__ __forceinline__ f32x4 bf4hi(const u32x4 w) { return (f32x4){__uint_as_float(w.z << 16), __uint_as_float(w.z & 0xffff0000u), __uint_as_float(w.w << 16), __uint_as_float(w.w & 0xffff0000u)}; }
__device__ __forceinline__ u32x4 pack8(const f32x4 a, const f32x4 b) { u32x4 o; o.x = pk2bf(a[0], a[1]); o.y = pk2bf(a[2], a[3]); o.z = pk2bf(b[0], b[1]); o.w = pk2bf(b[2], b[3]); return o; }
__device__ __forceinline__ void post_attention_phase(Frame& F, const Args& a, unsigned char* ws) {
    const bf16_t* QKV = (const bf16_t*)(ws + WS_QKV); const bf16_t* OCA = (const bf16_t*)(ws + WS_OCA); const float* LSE = (const float*)(ws + WS_LSE);
    bf16_t* Y1 = (bf16_t*)(ws + WS_QKV) + Y1_COL;
    const int lane = lane_id(), gw = F.vcu * NWAVES + F.wave, NGW = F.G * NWAVES;
    const float lam = __expf(wave_sum(a.in[13][lane] * a.in[14][lane])) - __expf(wave_sum(a.in[15][lane] * a.in[16][lane])) + LAMBDA_INIT;
    const bool isC = lane < 48;
    const int h = lane >> 3, c = lane & 7, hh = (lane - 48) >> 2, dc = (lane & 3) * 16;
    f32x4 ga0, ga1, gb0, gb1;
    { const float f = 1.f - LAMBDA_INIT; const float* sg = a.in[17] + 8 * c;
      ga0 = *(const f32x4*)sg * f; ga1 = *(const f32x4*)(sg + 4) * f; gb0 = *(const f32x4*)(sg + 64) * f; gb1 = *(const f32x4*)(sg + 68) * f; }
    for (int row = gw; row < M; row += NGW) {
        const bf16_t* qa = OCA + (size_t)row * 768; const bf16_t* qb = QKV + (size_t)row * N_QKV; bf16_t* y = Y1 + (size_t)row * N_QKV;
        if (isC) {
            const u32x4 a0 = *(const u32x4*)(qa + (2 * h) * 64 + 8 * c), a1 = *(const u32x4*)(qa + (2 * h + 1) * 64 + 8 * c);
            const u32x4 b0 = *(const u32x4*)(qb + (2 * h) * 64 + 8 * c), b1 = *(const u32x4*)(qb + (2 * h + 1) * 64 + 8 * c);
            const f32x4 x0 = bf4lo(a0) - lam * bf4lo(a1), x1 = bf4hi(a0) - lam * bf4hi(a1), z0 = bf4lo(b0) - lam * bf4lo(b1), z1 = bf4hi(b0) - lam * bf4hi(b1);
            float q = ((x0[0] * x0[0] + x0[1] * x0[1]) + (x0[2] * x0[2] + x0[3] * x0[3])) + ((x1[0] * x1[0] + x1[1] * x1[1]) + (x1[2] * x1[2] + x1[3] * x1[3]))
                    + ((z0[0] * z0[0] + z0[1] * z0[1]) + (z0[2] * z0[2] + z0[3] * z0[3])) + ((z1[0] * z1[0] + z1[1] * z1[1]) + (z1[2] * z1[2] + z1[3] * z1[3]));
            q += dpp_f<0xB1>(q); q += dpp_f<0x4E>(q); q += dpp_f<0x141>(q);
            const float r = rsqrtf(q * (1.f / 128.f) + EPS);
            *(u32x4*)(y + h * 128 + 8 * c) = pack8(x0 * ga0 * r, x1 * ga1 * r);
            *(u32x4*)(y + h * 128 + 64 + 8 * c) = pack8(z0 * gb0 * r, z1 * gb1 * r);
        } else {
            const float l0 = LSE[(size_t)row * 12 + hh], l1 = LSE[(size_t)row * 12 + 4 + hh], l2 = LSE[(size_t)row * 12 + 8 + hh];
            const float mx = fmaxf(l0, fmaxf(l1, l2));
            float w0 = __builtin_amdgcn_exp2f(l0 - mx), w1 = __builtin_amdgcn_exp2f(l1 - mx), w2 = __builtin_amdgcn_exp2f(l2 - mx);
            const float inv = 1.f / (w0 + w1 + w2); w0 *= inv; w1 *= inv; w2 *= inv;
            const bf16_t* d0 = qb + 2304 + hh * 64 + dc;
#pragma unroll
            for (int k = 0; k < 2; ++k) {
                const u32x4 v0 = *(const u32x4*)(d0 + 8 * k), v1 = *(const u32x4*)(d0 + 256 + 8 * k), v2 = *(const u32x4*)(d0 + 512 + 8 * k);
                *(u32x4*)(y + 768 + hh * 64 + dc + 8 * k) = pack8(w0 * bf4lo(v0) + w1 * bf4lo(v1) + w2 * bf4lo(v2), w0 * bf4hi(v0) + w1 * bf4hi(v1) + w2 * bf4hi(v2));
            }
        }
    }
}

constexpr int MXP = 136;
__device__ __forceinline__ void mixer_phase(Frame& F, const Args& a, unsigned char* ws) {
    const bf16_t* P = (const bf16_t*)(ws + WS_P); bf16_t* Y = (bf16_t*)(ws + WS_Y);
    const bf16_t* Wb = (const bf16_t*)(ws + WS_WSB); const bf16_t* PWt = (const bf16_t*)(ws + WS_PWT);
    const float* v_gain = a.in[6]; const float* b_s = a.in[8]; const float* pool_scale = a.in[10];
    LAS bf16_t* T = (LAS bf16_t*)(F.lds + RING_OFF);
    LAS bf16_t* T2 = (LAS bf16_t*)(F.lds + RING_OFF + 128 * MXP * 2);
    LAS float* rs = (LAS float*)(F.lds + RING_OFF + 2 * 128 * MXP * 2);
    const int tid = tid_id(), wid = tid >> 6, lane = tid & 63, fr = lane & 15, fq = lane >> 4;
    for (int u = F.vcu; u < 1024; u += F.G) {
        const bool isA = u < 512; const int blk = (u & 511) >> 2, g = u & 3, row0 = blk * 128;
        f32x4 acc[8];
#pragma unroll
        for (int j = 0; j < 8; ++j) acc[j] = (f32x4){0.f, 0.f, 0.f, 0.f};
        if (isA) {
            bf16x8 xr[16], xv[4], wf[4]; u32x2 ug[8];
#pragma unroll
            for (int i = 0; i < 16; ++i) xr[i] = *(const bf16x8*)(P + (size_t)(row0 + wid * 16 + i) * N_IN0 + 512 + lane * 8);
#pragma unroll
            for (int k = 0; k < 4; ++k) { const int it = tid + 512 * k, sr = it & 127, cc = it >> 7; xv[k] = *(const bf16x8*)(P + (size_t)(row0 + sr) * N_IN0 + 512 + g * 128 + cc * 8); }
            const bf16_t* wrow = Wb + ((size_t)g * 128 + wid * 16 + fr) * 128 + fq * 8;
#pragma unroll
            for (int ks = 0; ks < 4; ++ks) wf[ks] = *(const bf16x8*)(wrow + ks * 32);
            const int t = wid * 16 + fr;
#pragma unroll
            for (int j = 0; j < 8; ++j) ug[j] = *(const u32x2*)(P + (size_t)(row0 + t) * N_IN0 + g * 128 + j * 16 + fq * 4);
            const float bias = b_s[g * 128 + t];
#pragma unroll
            for (int i = 0; i < 16; ++i) { float q = 0.f;
#pragma unroll
                for (int e = 0; e < 8; ++e) { const float f = bf2f((bf16_t)xr[i][e]); q += f * f; }
                q = wave_sum(q);
                if (lane == 0) rs[wid * 16 + i] = rsqrtf(q * (1.f / 512.f) + EPS); }
            __syncthreads();
#pragma unroll
            for (int k = 0; k < 4; ++k) { const int it = tid + 512 * k, sr = it & 127, cc = it >> 7; const float r = rs[sr];
                const f32x4 g0 = *(const f32x4*)(v_gain + g * 128 + cc * 8), g1 = *(const f32x4*)(v_gain + g * 128 + cc * 8 + 4);
#pragma unroll
                for (int e = 0; e < 8; ++e) T[(cc * 8 + e) * MXP + sr] = f2bf(bf2f((bf16_t)xv[k][e]) * r * (e < 4 ? g0[e & 3] : g1[e & 3])); }
            __syncthreads();
            const int nks = (wid >> 1) + 1;
#pragma unroll
            for (int ks = 0; ks < 4; ++ks) if (ks < nks) {
#pragma unroll
                for (int j = 0; j < 8; ++j) { const bf16x8 bfr = *(const LAS bf16x8*)(T + (j * 16 + fr) * MXP + ks * 32 + fq * 8);
                    acc[j] = __builtin_amdgcn_mfma_f32_16x16x32_bf16(bfr, wf[ks], acc[j], 0, 0, 0); }
            }
#pragma unroll
            for (int j = 0; j < 8; ++j) { const int col = g * 128 + j * 16 + fq * 4; const u32x2 uu = ug[j];
                const float u0 = __uint_as_float(uu.x << 16), u1 = __uint_as_float(uu.x & 0xffff0000u), u2 = __uint_as_float(uu.y << 16), u3 = __uint_as_float(uu.y & 0xffff0000u);
                u32x2 o; o.x = pk2bf(u0 * (acc[j][0] + bias), u1 * (acc[j][1] + bias)); o.y = pk2bf(u2 * (acc[j][2] + bias), u3 * (acc[j][3] + bias));
                *(u32x2*)(Y + (size_t)(row0 + t) * DM + col) = o; }
        } else {
            const int w = 2 << g; const float inv_w = 1.f / (float)w;
            const int cc = tid & 15, rg = tid >> 4, r0 = row0 + rg * 4, t0 = r0 & (SEQ - 1);
            const bf16_t* xp = P + 1024 + g * 128 + cc * 8;
            bf16x8 hx[19];
#pragma unroll
            for (int j = 0; j < 19; ++j) { const int dr = j - 15; hx[j] = (bf16x8){0, 0, 0, 0, 0, 0, 0, 0};
                if (dr > -w && t0 + dr >= 0) hx[j] = *(const bf16x8*)(xp + (size_t)(r0 + dr) * N_IN0); }
            bf16x8 pw4[4];
#pragma unroll
            for (int k = 0; k < 4; ++k) { const int it = tid + 512 * k, d = it >> 4, c8 = it & 15; pw4[k] = *(const bf16x8*)(PWt + ((size_t)g * 128 + d) * 128 + c8 * 8); }
#pragma unroll
            for (int k = 0; k < 4; ++k) { const int it = tid + 512 * k, d = it >> 4, c8 = it & 15; *(LAS bf16x8*)(T2 + d * MXP + c8 * 8) = pw4[k]; }
#pragma unroll
            for (int i = 0; i < 4; ++i) { const int ts = t0 + i;
                float sum[8];
#pragma unroll
                for (int e = 0; e < 8; ++e) sum[e] = 0.f;
#pragma unroll
                for (int jj = 0; jj < 16; ++jj) { if (jj < w) {
#pragma unroll
                        for (int e = 0; e < 8; ++e) sum[e] += bf2f((bf16_t)hx[15 + i - jj][e]); } }
                const float ic = (ts + 1 < w) ? 1.f / (float)(ts + 1) : inv_w;
                u32x4 o; unsigned ow[4];
#pragma unroll
                for (int e = 0; e < 8; e += 2) ow[e >> 1] = pk2bf(sum[e] * ic - bf2f((bf16_t)hx[15 + i][e]), sum[e + 1] * ic - bf2f((bf16_t)hx[15 + i][e + 1]));
                o.x = ow[0]; o.y = ow[1]; o.z = ow[2]; o.w = ow[3];
                *(LAS u32x4*)(T + (rg * 4 + i) * MXP + cc * 8) = o; }
            __syncthreads();
#pragma unroll
            for (int ks = 0; ks < 4; ++ks) {
                const bf16x8 af = *(const LAS bf16x8*)(T + (wid * 16 + fr) * MXP + ks * 32 + fq * 8);
#pragma unroll
                for (int j = 0; j < 8; ++j) { const bf16x8 bfr = *(const LAS bf16x8*)(T2 + (j * 16 + fr) * MXP + ks * 32 + fq * 8);
                    acc[j] = __builtin_amdgcn_mfma_f32_16x16x32_bf16(bfr, af, acc[j], 0, 0, 0); }
            }
            const int t = wid * 16 + fr;
#pragma unroll
            for (int j = 0; j < 8; ++j) { const int d = g * 128 + j * 16 + fq * 4; const f32x4 sc = *(const f32x4*)(pool_scale + d);
                u32x2 o; o.x = pk2bf(acc[j][0] * sc[0], acc[j][1] * sc[1]); o.y = pk2bf(acc[j][2] * sc[2], acc[j][3] * sc[3]);
                *(u32x2*)(Y + (size_t)(row0 + t) * DM + 512 + d) = o; }
        }
        __syncthreads();
    }
}

__device__ __forceinline__ void ffn_fix_phase(Frame& F, const Args& a, unsigned char* ws, int layer) {
    bf16_t* HM = (bf16_t*)(ws + WS_HMID);
    const float* halo = (const float*)(ws + WS_HALO); const float* tops = (const float*)(ws + WS_TOPS); const float* topg = (const float*)(ws + WS_TOPG);
    const float* cw = a.in[20] + (size_t)layer * 3 * DFF;
    const int tid = tid_id();
    constexpr int CPR = DFF / 4;
    for (int it = F.vcu * (NWAVES * 64) + tid; it < 64 * 2 * CPR; it += F.G * NWAVES * 64) {
        const int pm = it / (2 * CPR), rem = it % (2 * CPR), rr = rem / CPR, c = (rem % CPR) * 4;
        if ((pm & 15) == 0) continue;
        const size_t off = ((size_t)pm * 2 + rr) * DFF + c;
        f32x4 sv = *(const f32x4*)(tops + off); const f32x4 g = *(const f32x4*)(topg + off);
        const f32x4 h1 = *(const f32x4*)(halo + ((size_t)(pm - 1) * 2 + 1) * DFF + c), h0 = *(const f32x4*)(halo + ((size_t)(pm - 1) * 2 + 0) * DFF + c);
        const f32x4 w0 = *(const f32x4*)(cw + c), w1 = *(const f32x4*)(cw + DFF + c);
        if (rr == 0) sv = sv + w1 * h1 + w0 * h0; else sv = sv + w0 * h1;
        u32x2 o; o.x = pk2bf(gelu_tanh(sv[0]) * g[0], gelu_tanh(sv[1]) * g[1]); o.y = pk2bf(gelu_tanh(sv[2]) * g[2], gelu_tanh(sv[3]) * g[3]);
        *(u32x2*)(HM + (size_t)(pm * 256 + rr) * DFF + c) = o;
    }
}

#define OPQ_S(x) asm volatile("" : "+s"(x))
__device__ __forceinline__ Frame make_frame(unsigned char* ws) {
    extern __shared__ __attribute__((aligned(16))) unsigned char lds_[];
    Frame F;
    F.lds = (LAS unsigned char*)lds_;
    F.MISC = (volatile LAS unsigned*)(F.lds + MISC_OFF);
    F.wave = __builtin_amdgcn_readfirstlane((int)threadIdx.x >> 6);
    int G = gridDim.x, bx = blockIdx.x; OPQ_S(G); OPQ_S(bx);
    F.G = G; F.vcu = (G % 8 == 0) ? (bx % 8) * (G / 8) + bx / 8 : bx;
    F.ctl = (gu32*)(ws + WS_CTL);
    return F;
}
__global__ void __launch_bounds__(NWAVES * 64, 2) mk_fwd(Args args) {
    extern __shared__ __attribute__((aligned(16))) unsigned char lds[];
    for (int u = threadIdx.x; u < (LDS_BYTES - LDSCTL_OFF) / 4; u += NWAVES * 64) ((LAS unsigned*)((LAS unsigned char*)lds + LDSCTL_OFF))[u] = 0u;
    __syncthreads();
    const int lo = args.ph_lo, hi = args.ph_hi;
    if (hi - lo > 1) { unsigned char* ws = args.ws; (void)xcd_barrier_post((unsigned*)((gu32*)(ws + WS_CTL) + CW_BAR) + args.li * XCD_BAR_WORDS, (volatile LAS unsigned*)((LAS unsigned char*)lds + MISC_OFF) + 8); }
#ifdef MK_DIAG
    if (blockIdx.x == 0 && threadIdx.x == 0) ((unsigned long long*)(args.ws + WS_CTL + 524288))[31] = __builtin_amdgcn_s_memrealtime();
#endif
    int pc = 0;
#define PHASE_BEGIN if (pc >= lo && pc < hi) { size_t z_ = 0; OPQ_S(z_); unsigned char* ws = args.ws + z_; float* out = args.out + z_; Frame F = make_frame(ws); bf16_t* XN = (bf16_t*)(ws + WS_XN); (void)XN; (void)out;
#ifdef MK_DIAG
#define DIAG_STAMP(k) do { if (blockIdx.x == 0 && threadIdx.x == 0) ((unsigned long long*)(ws + WS_CTL + 524288))[(k)] = __builtin_amdgcn_s_memrealtime(); } while (0)
#else
#define DIAG_STAMP(k) do { } while (0)
#endif
#define PHASE_END if (pc + 1 < hi) { XcdBarrier bar; bar.bar = (unsigned*)(F.ctl + CW_BAR) + args.li * XCD_BAR_WORDS; bar.x = xb_xcc_id(); bar.st = F.MISC + 8; xcd_barrier(bar); } DIAG_STAMP(pc); } ++pc;

    PHASE_BEGIN p0_prologue(F, args); PHASE_END
    PHASE_BEGIN
        pg8::Gemm g{XN, (const bf16_t*)(ws + WS_W_IN0), M, N_IN0, DM}; pg8::StaticOrder S; S.init(M, N_IN0, F.G, (int)blockIdx.x);
        pg8::EpiBf16G E{(bf16_t*)(ws + WS_P), N_IN0, 4, (const float*)(ws + WS_RSQ)};
        pg8::gemm_phase<pg8::EpiBf16G, pg8::StaticOrder, PG8_ALIGN, PG8_SP2>(F.lds + RING_OFF, g, S, E);
    PHASE_END
    PHASE_BEGIN mixer_phase(F, args, ws); PHASE_END
    PHASE_BEGIN
        pg8::Gemm g{(const bf16_t*)(ws + WS_Y), (const bf16_t*)(ws + WS_W_OUT0), M, DM, DM}; pg8::StaticOrder S; S.init(M, DM, F.G, (int)blockIdx.x);
        pg8::EpiRes E{XN, (float*)(ws + WS_RSQ)};
        pg8::gemm_phase<pg8::EpiRes, pg8::StaticOrder, PG8_ALIGN, PG8_SP2>(F.lds + RING_OFF, g, S, E);
    PHASE_END
#define RMS_PHASE(gain_ptr) PHASE_BEGIN { const float* gain = (gain_ptr); const int lane = lane_id(); const int gw = F.vcu * NWAVES + F.wave, NGW = F.G * NWAVES; \
        for (int m = gw; m < M; m += NGW) rms_row_to_bf16(out + (size_t)m * DM, gain, XN + (size_t)m * DM, lane); } PHASE_END
#define UP_PHASE(layer, abuf) PHASE_BEGIN { pg8::Gemm g{(const bf16_t*)(ws + (abuf)), (const bf16_t*)(ws + WS_W_UP) + (size_t)(layer) * NUP * DM, M, NUP, DM}; pg8::StaticOrder S; S.init(M, NUP, F.G, (int)blockIdx.x); \
        pg8::EpiUpConv E{(bf16_t*)(ws + WS_HMID), args.in[20] + (size_t)(layer) * 3 * DFF, args.in[21] + (size_t)(layer) * DFF, (float*)(ws + WS_HALO), (float*)(ws + WS_TOPS), (float*)(ws + WS_TOPG), (const float*)(ws + WS_RSQ)}; \
        pg8::gemm_phase<pg8::EpiUpConv, pg8::StaticOrder, true, PG8_SP2>(F.lds + RING_OFF, g, S, E); } PHASE_END
#define DOWN_PHASE(layer) PHASE_BEGIN { pg8::Gemm g{(const bf16_t*)(ws + WS_HMID), (const bf16_t*)(ws + WS_W_DN) + (size_t)(layer) * DM * DFF, M, DM, DFF}; pg8::StaticOrder S; S.init(M, DM, F.G, (int)blockIdx.x); \
        pg8::EpiRes E{XN, (float*)(ws + WS_RSQ)}; \
        pg8::gemm_phase<pg8::EpiRes, pg8::StaticOrder, PG8_ALIGN, PG8_SP2>(F.lds + RING_OFF, g, S, E); } PHASE_END
    UP_PHASE(0, WS_XN)
    PHASE_BEGIN ffn_fix_phase(F, args, ws, 0); PHASE_END
    DOWN_PHASE(0)
    PHASE_BEGIN
        pg8::Gemm g{XN, (const bf16_t*)(ws + WS_W_QKV), M, N_QKV, DM}; pg8::StaticOrder S; S.init(M, N_QKV, F.G, (int)blockIdx.x);
        pg8::EpiQKV E{(bf16_t*)(ws + WS_QKV), (const float*)(ws + WS_ROPE), (const float*)(ws + WS_RSQ)};
        pg8::gemm_phase<pg8::EpiQKV, pg8::StaticOrder, PG8_ALIGN, PG8_SP2>(F.lds + RING_OFF, g, S, E);
    PHASE_END
    PHASE_BEGIN
        { const SchedC SC{F.vcu, F.G, (attn_body::bf16*)(ws + WS_QKV), (attn_body::bf16*)(ws + WS_OCA)};
          attn_body::attn_phase<SchedC, 8, false>((char*)lds + RING_OFF, SC); }
        { const SchedD SD{F.vcu, F.G, (attn_body::bf16*)(ws + WS_QKV), (float*)(ws + WS_LSE)};
          attn_body::attn_phase<SchedD, 8, true>((char*)lds + RING_OFF, SD); }
    PHASE_END
    PHASE_BEGIN post_attention_phase(F, args, ws); PHASE_END
    PHASE_BEGIN
        pg8::Gemm g{(const bf16_t*)(ws + WS_QKV) + Y1_COL, (const bf16_t*)(ws + WS_W_OUT1), M, DM, DM, N_QKV}; pg8::StaticOrder S; S.init(M, DM, F.G, (int)blockIdx.x);
        pg8::EpiRes E{XN, (float*)(ws + WS_RSQ)};
        pg8::gemm_phase<pg8::EpiRes, pg8::StaticOrder, PG8_ALIGN, PG8_SP2>(F.lds + RING_OFF, g, S, E);
    PHASE_END
    UP_PHASE(1, WS_XN)
    PHASE_BEGIN ffn_fix_phase(F, args, ws, 1); PHASE_END
    DOWN_PHASE(1)
    PHASE_BEGIN
        const int lane = lane_id(); const int gw = F.vcu * NWAVES + F.wave, NGW = F.G * NWAVES;
        for (int m = gw; m < M; m += NGW) rms_row_final(XN + (size_t)m * DM, out + (size_t)m * DM, args.in[4], (const float*)(ws + WS_RSQ) + (size_t)m * 4, lane);
    PHASE_END
#ifdef MK_DIAG
    __syncthreads();
    if (blockIdx.x == 0 && threadIdx.x < 64) {
        asm volatile("s_waitcnt vmcnt(0)" ::: "memory");
        const unsigned long long* st = (const unsigned long long*)(args.ws + WS_CTL + 524288);
        const unsigned long long a1 = __hip_atomic_load(st + MK_DIAG_SEL1, __ATOMIC_RELAXED, __HIP_MEMORY_SCOPE_AGENT), b1 = __hip_atomic_load(st + (MK_DIAG_SEL1 == 0 ? 31 : MK_DIAG_SEL1 - 1), __ATOMIC_RELAXED, __HIP_MEMORY_SCOPE_AGENT);
        const unsigned long long a2 = __hip_atomic_load(st + MK_DIAG_SEL2, __ATOMIC_RELAXED, __HIP_MEMORY_SCOPE_AGENT), b2 = __hip_atomic_load(st + (MK_DIAG_SEL2 == 0 ? 31 : MK_DIAG_SEL2 - 1), __ATOMIC_RELAXED, __HIP_MEMORY_SCOPE_AGENT);
        const float d1 = (float)(long long)(a1 - b1) * 0.01f, d2 = (float)(long long)(a2 - b2) * 0.01f;
        for (int i = threadIdx.x; i <= 4096; i += 64) args.out[i] = (i == 0) ? d1 : d2;
    }
#endif
#undef PHASE_BEGIN
#undef PHASE_END
}
constexpr int N_PHASES = 15;

#ifndef MK_N_LAUNCHES
#define MK_N_LAUNCHES 1
#endif
extern "C" void kernel_launch(void* const* d_in, const int* in_sizes, int n_in, void* d_out, int out_size, void* d_ws, size_t ws_size, hipStream_t stream) {
    static int grid = 0;
    if (grid == 0) {
        int dev = 0, cus = 0;
        if (hipGetDevice(&dev) != hipSuccess || hipDeviceGetAttribute(&cus, hipDeviceAttributeMultiprocessorCount, dev) != hipSuccess) { fprintf(stderr, "kernel_launch: device query failed\n"); grid = -1; return; }
        if (hipFuncSetAttribute((const void*)mk_fwd, hipFuncAttributeMaxDynamicSharedMemorySize, LDS_BYTES) != hipSuccess) { fprintf(stderr, "kernel_launch: hipFuncSetAttribute failed\n"); grid = -1; return; }
        int per_cu = 0;
        if (hipOccupancyMaxActiveBlocksPerMultiprocessor(&per_cu, (const void*)mk_fwd, NWAVES * 64, LDS_BYTES) != hipSuccess || per_cu < 1) fprintf(stderr, "kernel_launch: occupancy query reports %d workgroups per CU\n", per_cu);
        (void)hipGetLastError();
        grid = cus > 0 ? cus : 256;
    }
    if (grid < 0) return;
    unsigned char* ws = (unsigned char*)d_ws;
    (void)hipMemsetAsync(ws + WS_CTL, 0, CTL_ZERO_BYTES, stream);
    Args a{};
    for (int i = 0; i < 23; ++i) a.in[i] = (const float*)d_in[i];
    a.out = (float*)d_out; a.ws = ws;
#ifdef MK_DUP_PHASE
    if (true) {
        a.li = 0; a.ph_lo = 0; a.ph_hi = MK_DUP_PHASE + 1; hipLaunchKernelGGL(mk_fwd, dim3(grid), dim3(NWAVES * 64), LDS_BYTES, stream, a);
        a.li = 1; a.ph_lo = MK_DUP_PHASE; a.ph_hi = MK_DUP_PHASE + 1; hipLaunchKernelGGL(mk_fwd, dim3(grid), dim3(NWAVES * 64), LDS_BYTES, stream, a);
        a.li = 2; a.ph_lo = MK_DUP_PHASE + 1; a.ph_hi = N_PHASES; hipLaunchKernelGGL(mk_fwd, dim3(grid), dim3(NWAVES * 64), LDS_BYTES, stream, a);
    } else
#endif
    if (MK_N_LAUNCHES == 1) {
        a.ph_lo = 0; a.ph_hi = N_PHASES;
        hipLaunchKernelGGL(mk_fwd, dim3(grid), dim3(NWAVES * 64), LDS_BYTES, stream, a);
    } else {
        for (int p = 0; p < N_PHASES; ++p) { a.ph_lo = p; a.ph_hi = p + 1; hipLaunchKernelGGL(mk_fwd, dim3(grid), dim3(NWAVES * 64), LDS_BYTES, stream, a); }
    }
}
```

```cpp
#include <hip/hip_runtime.h>
#include <cstdint>
#include <cstdio>

typedef unsigned short bf16_t;
typedef short bf16x8 __attribute__((ext_vector_type(8)));
typedef float f32x4 __attribute__((ext_vector_type(4)));
typedef float f32x2 __attribute__((ext_vector_type(2)));
typedef unsigned u32x4 __attribute__((ext_vector_type(4)));
typedef unsigned u32x2 __attribute__((ext_vector_type(2)));

constexpr int BATCH = 4, SEQ = 4096, DM = 1024, M = BATCH * SEQ;
constexpr int DFF = 2816, NUP = 2 * DFF;
constexpr int N_IN0 = 1536, N_QKV = 4608;
constexpr float EPS = 1e-6f;
constexpr float LAMBDA_INIT = 0.35550906759f;

__device__ __forceinline__ float bf2f(bf16_t v) { return __uint_as_float(((unsigned)v) << 16); }
__device__ __forceinline__ bf16_t f2bf(float f) { unsigned u = __float_as_uint(f); return (bf16_t)((u + 0x7fffu + ((u >> 16) & 1u)) >> 16); }
__device__ __forceinline__ unsigned pk2bf(float lo, float hi) { return (unsigned)f2bf(lo) | ((unsigned)f2bf(hi) << 16); }
__device__ __forceinline__ float gelu_tanh(float x) {
    const float y = x * (0.7978845608028654f + 0.035677408136300125f * x * x);
    return x * __builtin_amdgcn_rcpf(1.0f + __builtin_amdgcn_exp2f(-2.8853900817779268f * y));
}
template <int CTRL> __device__ __forceinline__ float dpp_f(float v) { return __int_as_float(__builtin_amdgcn_update_dpp(0, __float_as_int(v), CTRL, 0xf, 0xf, true)); }
__device__ __forceinline__ float swz_xor16(float v) { return __int_as_float(__builtin_amdgcn_ds_swizzle(__float_as_int(v), 0x401F)); }
__device__ __forceinline__ float wave_sum(float v) {
    v += dpp_f<0xB1>(v);
    v += dpp_f<0x4E>(v);
    v += dpp_f<0x141>(v);
    v += dpp_f<0x140>(v);
    v += swz_xor16(v);
    const auto rr = __builtin_amdgcn_permlane32_swap(__float_as_uint(v), __float_as_uint(v), false, false);
    return __uint_as_float(rr[0]) + __uint_as_float(rr[1]);
}

constexpr size_t MiB = 1u << 20;
constexpr size_t WS_CTL = 0, CTL_ZERO_BYTES = 1 * MiB;
constexpr size_t WS_W_IN0 = 1 * MiB;
constexpr size_t WS_W_OUT0 = 4 * MiB;
constexpr size_t WS_W_QKV = 6 * MiB;
constexpr size_t WS_W_OUT1 = 15 * MiB;
constexpr size_t WS_W_UP = 17 * MiB;
constexpr size_t WS_W_DN = 39 * MiB;
constexpr size_t WS_ROPE = 50 * MiB;
constexpr size_t WS_WSB = 51 * MiB;
constexpr size_t WS_PWT = 51 * MiB + 256 * 1024;
constexpr size_t WS_XN = 52 * MiB;
constexpr size_t WS_BUF = 84 * MiB;
constexpr size_t WS_P = WS_BUF, WS_Y = 132 * MiB;
constexpr size_t WS_HMID = 116 * MiB;
constexpr size_t WS_HALO = 204 * MiB, WS_TOPS = 206 * MiB, WS_TOPG = 208 * MiB;
constexpr size_t WS_QKV = WS_BUF;
constexpr int Y1_COL = 768;
constexpr size_t WS_OCA = 228 * MiB;
constexpr size_t WS_RSQ = 253 * MiB;
constexpr size_t WS_LSE = 252 * MiB;
namespace pg8 {
#define PG8_LAS __attribute__((address_space(3)))
typedef unsigned short bf16_t;
typedef short bf16x8 __attribute__((ext_vector_type(8)));
typedef float f32x4 __attribute__((ext_vector_type(4)));
typedef unsigned u32x4 __attribute__((ext_vector_type(4)));
constexpr int BM = 256, BK = 64, HALF = 128, HTB = HALF * BK * 2  , STAGE_BYTES = 8 * HTB, NXCD = 8, WGM = 8;

__host__ __device__ __forceinline__ int lds_byte(int r, int c) { const int st = (r >> 4) * 2 + (c >> 5), rr = r & 15, cc = c & 31, ob = rr * 64 + cc * 2; return st * 1024 + (ob ^ (((ob >> 9) & 1) << 5)); }
__host__ __device__ __forceinline__ void stage_rc(int b, int& R, int& C) { const int st = b / 1024, sb = b % 1024, swz = sb ^ (((sb >> 9) & 1) << 5); R = (st >> 1) * 16 + swz / 64; C = (st & 1) * 32 + (swz % 64) / 2; }
__host__ __device__ __forceinline__ int perm32(int rho) { const int n = rho >> 4, i = rho & 15; return 8 * (i >> 2) + 4 * n + (i & 3); }

struct Unit { int pm, pn; };
struct Gemm { const bf16_t* A; const bf16_t* Bt; int M, N, K, lda; };

struct StaticOrder {
    int nM, nN, nwg, G, c;
    __host__ __device__ void init(int M, int N, int G_, int c_) { nM = M / BM; nN = N / BM; nwg = nM * nN; G = G_; c = c_; }
    __host__ __device__ bool next(int i, Unit& u) const {
        const long L = (long)i * G + c; if (L >= nwg) return false;
        int wgid = (int)L; { const int q = nwg / NXCD, r = nwg % NXCD, xcd = wgid % NXCD, off = wgid / NXCD; wgid = (xcd < r ? xcd * (q + 1) : r * (q + 1) + (xcd - r) * q) + off; }
        const int nig = WGM * nN, gid = wgid / nig, fm = gid * WGM, gsz = (nM - fm) < WGM ? (nM - fm) : WGM;
        u.pm = fm + ((wgid % nig) % gsz); u.pn = (wgid % nig) / gsz; return true;
    }
    __device__ __forceinline__ void a_ready(const Unit&) const {}
    __device__ __forceinline__ void done(const Unit&) const {}
};


__device__ __forceinline__ unsigned cvt_pk_bf16(float lo, float hi) { unsigned r; asm volatile("v_cvt_pk_bf16_f32 %0, %1, %2" : "=v"(r) : "v"(lo), "v"(hi)); return r; }

__device__ __forceinline__ float rstd_of(const f32x4 p) { return rsqrtf(((p[0] + p[1]) + (p[2] + p[3])) * (1.f / 1024.f) + 1e-6f); }
struct EpiBf16G {
    static constexpr bool PERM = true, AFTER_DRAIN = false;
    bf16_t* O; int ldc; int gelu_tiles; const float* rsq;
    __device__ __forceinline__ void operator()(const f32x4 (&acc)[2][2][4][2], const Unit& u, int wr, int wc, int fr, int fq) const {
        const int row0 = u.pm * BM + wr * 64 + fr, col0 = u.pn * BM + wc * 32 + 8 * fq;
        const bool g = u.pn < gelu_tiles;
        f32x4 pr[2][4];
#pragma unroll
        for (int ai = 0; ai < 2; ++ai)
#pragma unroll
            for (int m = 0; m < 4; ++m) pr[ai][m] = *(const f32x4*)(rsq + (size_t)(row0 + ai * HALF + m * 16) * 4);
#pragma unroll
        for (int ai = 0; ai < 2; ++ai)
#pragma unroll
            for (int m = 0; m < 4; ++m) { bf16_t* rowp = O + (size_t)(row0 + ai * HALF + m * 16) * ldc + col0; const float rstd = rstd_of(pr[ai][m]);
#pragma unroll
                for (int bj = 0; bj < 2; ++bj) { f32x4 v0 = acc[ai][bj][m][0] * rstd, v1 = acc[ai][bj][m][1] * rstd;
                    if (g) { v0 = (f32x4){gelu_tanh(v0[0]), gelu_tanh(v0[1]), gelu_tanh(v0[2]), gelu_tanh(v0[3])}; v1 = (f32x4){gelu_tanh(v1[0]), gelu_tanh(v1[1]), gelu_tanh(v1[2]), gelu_tanh(v1[3])}; }
                    u32x4 w; w.x = cvt_pk_bf16(v0[0], v0[1]); w.y = cvt_pk_bf16(v0[2], v0[3]); w.z = cvt_pk_bf16(v1[0], v1[1]); w.w = cvt_pk_bf16(v1[2], v1[3]);
                    *(u32x4*)(rowp + bj * HALF) = w; } }
    }
};
constexpr int XCH_LDS_OFF = 132096;
struct EpiRes {
    static constexpr bool PERM = false, AFTER_DRAIN = false;
    bf16_t* hb; float* rsq;
    __device__ __forceinline__ void operator()(const f32x4 (&acc)[2][2][4][2], const Unit& u, int wr, int wc, int fr, int fq) const {
        extern __shared__ __attribute__((aligned(16))) unsigned char lds_all_[];
        PG8_LAS float* S = (PG8_LAS float*)((PG8_LAS unsigned char*)lds_all_ + XCH_LDS_OFF);
        const int row0 = u.pm * BM + wr * 64 + fr, col0 = u.pn * BM + wc * 32 + 4 * fq;
#pragma unroll
        for (int ai = 0; ai < 2; ++ai) {
            u32x2 bs[4][2][2];
#pragma unroll
            for (int m = 0; m < 4; ++m)
#pragma unroll
                for (int bj = 0; bj < 2; ++bj)
#pragma unroll
                    for (int n = 0; n < 2; ++n) bs[m][bj][n] = *(const u32x2*)(hb + (size_t)(row0 + ai * HALF + m * 16) * 1024 + col0 + bj * HALF + n * 16);
#pragma unroll
            for (int m = 0; m < 4; ++m) { const int row = row0 + ai * HALF + m * 16; const size_t off = (size_t)row * 1024 + col0; float q = 0.f;
#pragma unroll
                for (int bj = 0; bj < 2; ++bj)
#pragma unroll
                    for (int n = 0; n < 2; ++n) { const u32x2 b = bs[m][bj][n];
                        const f32x4 h = (f32x4){__uint_as_float(b.x << 16), __uint_as_float(b.x & 0xffff0000u), __uint_as_float(b.y << 16), __uint_as_float(b.y & 0xffff0000u)} + acc[ai][bj][m][n];
                        q += (h[0] * h[0] + h[1] * h[1]) + (h[2] * h[2] + h[3] * h[3]);
                        u32x2 w; w.x = cvt_pk_bf16(h[0], h[1]); w.y = cvt_pk_bf16(h[2], h[3]); *(u32x2*)(hb + off + bj * HALF + n * 16) = w; }
                q += swz_xor16(q);
                { const auto rr = __builtin_amdgcn_permlane32_swap(__float_as_uint(q), __float_as_uint(q), false, false); q = __uint_as_float(rr[0]) + __uint_as_float(rr[1]); }
                if (fq == 0) S[(ai * HALF + wr * 64 + m * 16 + fr) * 4 + wc] = q; }
        }
        asm volatile("s_waitcnt lgkmcnt(0)" ::: "memory"); __builtin_amdgcn_s_barrier(); asm volatile("" ::: "memory");
        const int t = (int)threadIdx.x;
        if (t < 256) { const f32x4 p = *(const PG8_LAS f32x4*)(S + t * 4); rsq[(size_t)(u.pm * BM + t) * 4 + u.pn] = (p[0] + p[1]) + (p[2] + p[3]); }
    }
};
constexpr float ATT_C2 = 0.125f * 1.4426950408889634f;
struct EpiQKV {
    static constexpr bool PERM = true, AFTER_DRAIN = false;
    bf16_t* O; const float* rope; const float* rsq;
    __device__ __forceinline__ void operator()(const f32x4 (&acc)[2][2][4][2], const Unit& u, int wr, int wc, int fr, int fq) const {
        const int row0 = u.pm * BM + wr * 64 + fr, col0 = u.pn * BM + wc * 32 + 8 * fq;
        const int pn = u.pn;
        const bool is_rope = (pn < 6) || (pn >= 9 && pn < 15);
        const bool is_q = (pn < 3) || (pn >= 9 && pn < 12);
        const float sc = is_q ? ATT_C2 : 1.f;
        const bool do_rot = is_rope && ((wc & 1) == 0);
        const float sgn = (fq == 0) ? -1.f : 1.f;
        f32x4 pr[2][4];
#pragma unroll
        for (int ai = 0; ai < 2; ++ai)
#pragma unroll
            for (int m = 0; m < 4; ++m) pr[ai][m] = *(const f32x4*)(rsq + (size_t)(row0 + ai * HALF + m * 16) * 4);
#pragma unroll
        for (int ai = 0; ai < 2; ++ai)
#pragma unroll
            for (int m = 0; m < 4; ++m) { const int row = row0 + ai * HALF + m * 16; bf16_t* rowp = O + (size_t)row * 4608 + col0;
                f32x4 cs0 = {1.f, 1.f, 1.f, 1.f}, cs1 = cs0, sn0 = {0.f, 0.f, 0.f, 0.f}, sn1 = sn0;
                if (do_rot) { const f32x4* t = (const f32x4*)(rope + (size_t)row * 16); cs0 = t[0]; cs1 = t[1]; sn0 = t[2] * sgn; sn1 = t[3] * sgn; }
                const float rstd = rstd_of(pr[ai][m]) * sc;
#pragma unroll
                for (int bj = 0; bj < 2; ++bj) { f32x4 v0 = acc[ai][bj][m][0] * rstd, v1 = acc[ai][bj][m][1] * rstd;
                    if (do_rot) {
                        f32x4 p0, p1;
#pragma unroll
                        for (int e = 0; e < 4; ++e) { p0[e] = swz_xor16(v0[e]); p1[e] = swz_xor16(v1[e]); }
                        if (fq < 2) { v0 = v0 * cs0 + p0 * sn0; v1 = v1 * cs1 + p1 * sn1; }
                    }
                    u32x4 w; w.x = cvt_pk_bf16(v0[0], v0[1]); w.y = cvt_pk_bf16(v0[2], v0[3]); w.z = cvt_pk_bf16(v1[0], v1[1]); w.w = cvt_pk_bf16(v1[2], v1[3]);
                    *(u32x4*)(rowp + bj * HALF) = w; } }
    }
};

template <int CTRL> __device__ __forceinline__ f32x4 dpp4(f32x4 v) { return (f32x4){dpp_f<CTRL>(v[0]), dpp_f<CTRL>(v[1]), dpp_f<CTRL>(v[2]), dpp_f<CTRL>(v[3])}; }
struct EpiUpConv {
    static constexpr bool PERM = true, AFTER_DRAIN = false;
    bf16_t* HM; const float* cw; const float* cb; float* halo; float* tops; float* topg; const float* rsq;
    __device__ __forceinline__ void operator()(const f32x4 (&acc)[2][2][4][2], const Unit& u, int wr_, int wc_, int fr_, int fq_) const {
        int tid_ = threadIdx.x; asm volatile("" : "+v"(tid_));
        const int wid_ = __builtin_amdgcn_readfirstlane(tid_ >> 6), wr = wid_ >> 2, wc = wid_ & 3, fr = tid_ & 15, fq = (tid_ >> 4) & 3; (void)wr_; (void)wc_; (void)fr_; (void)fq_;
        extern __shared__ __attribute__((aligned(16))) unsigned char lds_all_[];
        PG8_LAS float* X = (PG8_LAS float*)((PG8_LAS unsigned char*)lds_all_ + XCH_LDS_OFF);
        const int cl = wc * 32 + 8 * fq, hc = u.pn * 128 + cl;
        float rstd[2][4];
        { f32x4 pr[2][4];
#pragma unroll
          for (int ai = 0; ai < 2; ++ai)
#pragma unroll
              for (int m = 0; m < 4; ++m) pr[ai][m] = *(const f32x4*)(rsq + (size_t)(u.pm * BM + ai * HALF + wr * 64 + m * 16 + fr) * 4);
#pragma unroll
          for (int ai = 0; ai < 2; ++ai)
#pragma unroll
              for (int m = 0; m < 4; ++m) rstd[ai][m] = rstd_of(pr[ai][m]); }
        if (fr >= 14) {
#pragma unroll
            for (int ai = 0; ai < 2; ++ai) { PG8_LAS float* xp = X + (((ai * 2 + wr) * 2 + (fr - 14)) * 128 + cl);
                *(PG8_LAS f32x4*)xp = acc[ai][0][3][0] * rstd[ai][3]; *(PG8_LAS f32x4*)(xp + 4) = acc[ai][0][3][1] * rstd[ai][3]; }
            if (wr == 1) { float* hp = halo + ((size_t)u.pm * 2 + (fr - 14)) * 2816 + hc; *(f32x4*)hp = acc[1][0][3][0] * rstd[1][3]; *(f32x4*)(hp + 4) = acc[1][0][3][1] * rstd[1][3]; }
        }
        asm volatile("s_waitcnt lgkmcnt(0)" ::: "memory"); __builtin_amdgcn_s_barrier(); asm volatile("" ::: "memory");
        const bool needs_fix = (u.pm & 15) != 0;
#pragma unroll
        for (int n = 0; n < 2; ++n) {
            const f32x4 w0 = *(const f32x4*)(cw + hc + 4 * n), w1 = *(const f32x4*)(cw + 2816 + hc + 4 * n), w2 = *(const f32x4*)(cw + 2 * 2816 + hc + 4 * n), bb = *(const f32x4*)(cb + hc + 4 * n);
#pragma unroll
            for (int ai = 0; ai < 2; ++ai) {
                f32x4 pa, pb;
                const bool has_pred = !(ai == 0 && wr == 0);
                const int pblk = (wr == 1) ? (ai * 2) : 1;
                if (has_pred) { pa = *(const PG8_LAS f32x4*)(X + ((pblk * 2 + 1) * 128 + cl + 4 * n)); pb = *(const PG8_LAS f32x4*)(X + ((pblk * 2 + 0) * 128 + cl + 4 * n)); }
                else { pa = (f32x4){0.f, 0.f, 0.f, 0.f}; pb = pa; }
                f32x4 r1p = pa, r2p = (fr == 1) ? pa : pb;
                size_t ho = (size_t)(u.pm * BM + ai * HALF + wr * 64 + fr) * 2816 + hc + 4 * n; asm volatile("" : "+v"(ho));
#pragma unroll
                for (int m = 0; m < 4; ++m) {
                    const f32x4 x = acc[ai][0][m][n] * rstd[ai][m];
                    const f32x4 R1 = dpp4<0x121>(x), R2 = dpp4<0x122>(x);
                    const f32x4 p1 = (fr >= 1) ? R1 : r1p;
                    const f32x4 p2 = (fr >= 2) ? R2 : r2p;
                    const f32x4 sv = w2 * x + w1 * p1 + w0 * p2 + bb;
                    r1p = R1; r2p = R2;
                    const f32x4 g = acc[ai][1][m][n] * rstd[ai][m];
                    if (ai == 0 && m == 0) { if (wr == 0 && fr < 2 && needs_fix) { const size_t off = ((size_t)u.pm * 2 + fr) * 2816 + hc + 4 * n; *(f32x4*)(tops + off) = sv; *(f32x4*)(topg + off) = g; } }
                    u32x2 w; w.x = cvt_pk_bf16(gelu_tanh(sv[0]) * g[0], gelu_tanh(sv[1]) * g[1]); w.y = cvt_pk_bf16(gelu_tanh(sv[2]) * g[2], gelu_tanh(sv[3]) * g[3]);
                    *(u32x2*)(HM + ho) = w; ho += 16 * 2816;
                    asm volatile("" : "+v"(ho) :: "memory");
                }
            }
        }
    }
};
template <class Epi, class Sched, bool ALIGN_EPI = false, bool SP2 = false>
__device__ __forceinline__ void gemm_phase(PG8_LAS unsigned char* lds, const Gemm g, const Sched& S, const Epi& E) {
    int tid_ = threadIdx.x; asm volatile("" : "+v"(tid_));
    const int tid = tid_, wid = __builtin_amdgcn_readfirstlane(tid >> 6), lane = tid & 63, wr = wid >> 2, wc = wid & 3, fr = lane & 15, fq = lane >> 4;
    const int K = g.K, nt = K / BK, LDA = g.lda ? g.lda : g.K;
    unsigned voffA[2], voffB[2];
#pragma unroll
    for (int i = 0; i < 2; ++i) { int R, C; stage_rc(tid * 16 + i * 8192, R, C); const int Rb = Epi::PERM ? ((R & ~31) + perm32(R & 31)) : R;
        voffA[i] = (unsigned)(R * LDA + C) * 2u; voffB[i] = (unsigned)(Rb * K + C) * 2u; }
    const size_t kstep = (size_t)(BK * 2);
    const size_t hstep = (size_t)HALF * K * 2;
    const size_t tstep = 2 * hstep;
    const size_t hstepA = (size_t)HALF * LDA * 2, tstepA = 2 * hstepA;
    const unsigned ldsw = (unsigned)wid * 1024u;
    const int aoff = lds_byte(wr * 64 + fr, fq * 8), boff = lds_byte(wc * 32 + fr, fq * 8);
#define PG8_SA(b, h) (((b) * 2 + (h)) * HTB)
#define PG8_SB(b, h) ((4 + (b) * 2 + (h)) * HTB)
#define PG8_STAGE(bufoff, gbase, voff) do { _Pragma("unroll") for (int _i = 0; _i < 2; ++_i) \
        __builtin_amdgcn_global_load_lds((const unsigned*)((const char*)(gbase) + (voff)[_i]), (PG8_LAS unsigned*)(lds + (bufoff) + ldsw + _i * 8192), 16, 0, 0); } while (0)
#define PG8_LDA(dst, b, h) do { _Pragma("unroll") for (int m = 0; m < 4; ++m) _Pragma("unroll") for (int k = 0; k < 2; ++k) dst[m][k] = *(const PG8_LAS bf16x8*)(lds + PG8_SA(b, h) + aoff + m * 2048 + k * 1024); } while (0)
#define PG8_LDB(dst, b, h) do { _Pragma("unroll") for (int n = 0; n < 2; ++n) _Pragma("unroll") for (int k = 0; k < 2; ++k) dst[n][k] = *(const PG8_LAS bf16x8*)(lds + PG8_SB(b, h) + boff + n * 2048 + k * 1024); } while (0)
#define PG8_MMA(ai, bj, At, Bt) do { __builtin_amdgcn_s_setprio(1); _Pragma("unroll") for (int m = 0; m < 4; ++m) _Pragma("unroll") for (int n = 0; n < 2; ++n) _Pragma("unroll") for (int k = 0; k < 2; ++k) \
        acc[ai][bj][m][n] = __builtin_amdgcn_mfma_f32_16x16x32_bf16(Bt[n][k], At[m][k], acc[ai][bj][m][n], 0, 0, 0); __builtin_amdgcn_s_setprio(0); } while (0)
#define PG8_WAIT_V(n) asm volatile("s_waitcnt vmcnt(" #n ")" ::: "memory")
#define PG8_WAIT_L(n) asm volatile("s_waitcnt lgkmcnt(" #n ")" ::: "memory")
#define PG8_BAR __builtin_amdgcn_s_barrier()
#define PG8_SCHED __builtin_amdgcn_sched_barrier(0)
    Unit cur, nxt; int ui = 0;
    if (!S.next(0, cur)) return;
    f32x4 acc[2][2][4][2];
#pragma unroll
    for (int a = 0; a < 2; ++a)
#pragma unroll
        for (int b = 0; b < 2; ++b)
#pragma unroll
            for (int m = 0; m < 4; ++m)
#pragma unroll
                for (int n = 0; n < 2; ++n) acc[a][b][m][n] = (f32x4){0.f, 0.f, 0.f, 0.f};
    bf16x8 At[4][2], B0[2][2], B1[2][2];
    const char* cA = (const char*)g.A + (size_t)cur.pm * tstepA; const char* cB = (const char*)g.Bt + (size_t)cur.pn * tstep;
    S.a_ready(cur);
    if constexpr (SP2) {
        PG8_STAGE(PG8_SB(0, 0), cB, voffB); PG8_STAGE(PG8_SB(0, 1), cB + hstep, voffB); PG8_STAGE(PG8_SA(0, 0), cA, voffA); PG8_STAGE(PG8_SA(0, 1), cA + hstepA, voffA);
        if (wr == 1) PG8_BAR;
        PG8_WAIT_V(2); PG8_BAR;
        PG8_STAGE(PG8_SB(1, 0), cB + kstep, voffB); PG8_STAGE(PG8_SA(1, 0), cA + kstep, voffA); PG8_STAGE(PG8_SB(1, 1), cB + hstep + kstep, voffB);
        PG8_WAIT_V(6); PG8_BAR;
    } else {
        PG8_STAGE(PG8_SB(0, 0), cB, voffB); PG8_STAGE(PG8_SA(0, 0), cA, voffA); PG8_STAGE(PG8_SB(0, 1), cB + hstep, voffB); PG8_STAGE(PG8_SA(0, 1), cA + hstepA, voffA);
        if (wr == 1) PG8_BAR;
        PG8_WAIT_V(4); PG8_BAR;
        PG8_STAGE(PG8_SB(1, 0), cB + kstep, voffB); PG8_STAGE(PG8_SA(1, 0), cA + kstep, voffA); PG8_STAGE(PG8_SB(1, 1), cB + hstep + kstep, voffB);
        PG8_WAIT_V(6); PG8_BAR;
    }
    for (;;) {
        const bool has_next = S.next(ui + 1, nxt);
        const char* nA = has_next ? (const char*)g.A + (size_t)nxt.pm * tstepA : cA; const char* nB = has_next ? (const char*)g.Bt + (size_t)nxt.pn * tstep : cB;
        for (int t = 0; t < nt; t += 2) {
            const bool last = (t == nt - 2);
            const char* a1 = cA + (size_t)(t + 1) * kstep;
            const char* a2 = last ? nA : cA + (size_t)(t + 2) * kstep; const char* b2 = last ? nB : cB + (size_t)(t + 2) * kstep;
            const char* a3 = a2 + kstep; const char* b3 = b2 + kstep;
            if (last && has_next) S.a_ready(nxt);
            if constexpr (SP2) {
            PG8_LDB(B0, 0, 0); PG8_LDB(B1, 0, 1); PG8_SCHED; PG8_LDA(At, 0, 0); PG8_STAGE(PG8_SA(1, 1), a1 + hstepA, voffA);
            PG8_WAIT_V(8); PG8_WAIT_L(0); PG8_BAR; PG8_MMA(0, 0, At, B0); PG8_MMA(0, 1, At, B1); PG8_BAR; PG8_SCHED;
            PG8_LDA(At, 0, 1); PG8_STAGE(PG8_SB(0, 0), b2, voffB); PG8_STAGE(PG8_SB(0, 1), b2 + hstep, voffB); PG8_STAGE(PG8_SA(0, 0), a2, voffA);
            PG8_WAIT_V(8); PG8_WAIT_L(0); PG8_BAR; PG8_MMA(1, 0, At, B0); PG8_MMA(1, 1, At, B1); PG8_BAR; PG8_SCHED;
            PG8_LDB(B0, 1, 0); PG8_LDB(B1, 1, 1); PG8_SCHED; PG8_LDA(At, 1, 0); PG8_STAGE(PG8_SA(0, 1), a2 + hstepA, voffA);
            PG8_WAIT_V(8); PG8_WAIT_L(0); PG8_BAR; PG8_MMA(0, 0, At, B0); PG8_MMA(0, 1, At, B1); PG8_BAR; PG8_SCHED;
            PG8_LDA(At, 1, 1); PG8_STAGE(PG8_SB(1, 0), b3, voffB); PG8_STAGE(PG8_SB(1, 1), b3 + hstep, voffB); PG8_STAGE(PG8_SA(1, 0), a3, voffA);
            PG8_WAIT_V(8); PG8_WAIT_L(0); PG8_BAR; PG8_MMA(1, 0, At, B0); PG8_MMA(1, 1, At, B1); PG8_BAR; PG8_SCHED;
            } else {
            PG8_LDB(B0, 0, 0); PG8_SCHED; PG8_LDA(At, 0, 0); PG8_STAGE(PG8_SA(1, 1), a1 + hstepA, voffA);
            PG8_WAIT_L(8); PG8_BAR; PG8_WAIT_L(0); PG8_MMA(0, 0, At, B0); PG8_BAR; PG8_SCHED;
            PG8_LDB(B1, 0, 1); PG8_STAGE(PG8_SB(0, 0), b2, voffB);
            PG8_BAR; PG8_WAIT_L(0); PG8_MMA(0, 1, At, B1); PG8_BAR;
            PG8_LDA(At, 0, 1); PG8_STAGE(PG8_SA(0, 0), a2, voffA);
            PG8_BAR; PG8_WAIT_L(0); PG8_MMA(1, 0, At, B0); PG8_BAR; PG8_SCHED;
            PG8_STAGE(PG8_SB(0, 1), b2 + hstep, voffB);
            PG8_WAIT_V(6); PG8_BAR; PG8_MMA(1, 1, At, B1); PG8_BAR;
            PG8_LDB(B0, 1, 0); PG8_SCHED; PG8_LDA(At, 1, 0); PG8_STAGE(PG8_SA(0, 1), a2 + hstepA, voffA);
            PG8_WAIT_L(8); PG8_BAR; PG8_WAIT_L(0); PG8_MMA(0, 0, At, B0); PG8_BAR; PG8_SCHED;
            PG8_LDB(B1, 1, 1); PG8_STAGE(PG8_SB(1, 0), b3, voffB);
            PG8_BAR; PG8_WAIT_L(0); PG8_MMA(0, 1, At, B1); PG8_BAR;
            PG8_LDA(At, 1, 1); PG8_STAGE(PG8_SA(1, 0), a3, voffA);
            PG8_BAR; PG8_WAIT_L(0); PG8_MMA(1, 0, At, B0); PG8_BAR; PG8_SCHED;
            PG8_STAGE(PG8_SB(1, 1), b3 + hstep, voffB);
            PG8_WAIT_V(6); PG8_BAR; PG8_MMA(1, 1, At, B1); PG8_BAR;
            }
        }
        if constexpr (ALIGN_EPI) { if (wr == 0) PG8_BAR; }
        if constexpr (!Epi::AFTER_DRAIN) { E(acc, cur, wr, wc, fr, fq); S.done(cur); }
        if (!has_next) break;
#pragma unroll
        for (int a = 0; a < 2; ++a)
#pragma unroll
            for (int b = 0; b < 2; ++b)
#pragma unroll
                for (int m = 0; m < 4; ++m)
#pragma unroll
                    for (int n = 0; n < 2; ++n) acc[a][b][m][n] = (f32x4){0.f, 0.f, 0.f, 0.f};
        cur = nxt; cA = nA; cB = nB; ++ui;
        if constexpr (ALIGN_EPI) { if (wr == 1) PG8_BAR; }
    }
    PG8_WAIT_V(0);
    if constexpr (!ALIGN_EPI) { if (wr == 0) PG8_BAR; }
    PG8_BAR;
    if constexpr (Epi::AFTER_DRAIN) { E.fused(acc, cur, wr, wc, fr, fq, lds, wid, lane); S.done(cur); }
#undef PG8_SA
#undef PG8_SB
#undef PG8_STAGE
#undef PG8_LDA
#undef PG8_LDB
#undef PG8_MMA
#undef PG8_WAIT_V
#undef PG8_WAIT_L
#undef PG8_BAR
#undef PG8_SCHED
}
}
#include <hip/hip_bf16.h>
#include <cmath>
namespace attn_body {
using bf16=__hip_bfloat16;
using bf16x8=__attribute__((ext_vector_type(8)))short;
using s16x4=__attribute__((ext_vector_type(4)))short;
using f32x16=__attribute__((ext_vector_type(16)))float;
using u32x4=__attribute__((ext_vector_type(4)))unsigned;
constexpr int D=64,PITCH=4608;
constexpr int NW=8,QBLK=32,QB=QBLK*NW,KVBLK=64;
constexpr int ATTN_UNIT_ROWS=QB;
__device__ __forceinline__ int crow(int r,int hi){return (r&3)+8*(r>>2)+4*hi;}
#define SBAR() __builtin_amdgcn_sched_barrier(0)
template<bool BAND> __device__ __forceinline__ void cmask(f32x16&p0,f32x16&p1,int kvbase,int qrel,int hi){
  const float NEG=-INFINITY; int kb=kvbase+4*hi;
  #pragma unroll
  for(int r=0;r<16;++r){int kv=kb+(r&3)+8*(r>>2); if(kv>qrel||(BAND&&kv<qrel-128))p0[r]=NEG; if(kv+32>qrel||(BAND&&kv+32<qrel-128))p1[r]=NEG;}
}

constexpr int NSLOT=3, SLOTB=8192;
constexpr int LDS_K=0, LDS_V=NSLOT*SLOTB, LDS_WS=2*NSLOT*SLOTB, LDS_OST=LDS_WS+NW*64*4, LDS_BYTES=LDS_OST+NW*4096;
constexpr float C2=0.125f*1.4426950408889634f;
__device__ __forceinline__ void glds16(const void*gsrc,unsigned lds_dst){unsigned keep;
  asm volatile("s_mov_b32 %0, m0\n\ts_mov_b32 m0, %2\n\ts_nop 0\n\tglobal_load_lds_dwordx4 %1, off\n\ts_mov_b32 m0, %0":"=&s"(keep):"v"(gsrc),"s"(lds_dst):"memory");}
__device__ __forceinline__ float max3f(float a,float b,float c){float r;asm("v_max3_f32 %0, %1, %2, %3":"=v"(r):"v"(a),"v"(b),"v"(c));return r;}
__device__ __forceinline__ float max2f(float a,float b){float r;asm("v_max_f32_e32 %0, %1, %2":"=v"(r):"v"(a),"v"(b));return r;}
__device__ __forceinline__ float fadd_s(float a,float b){float r;asm("v_add_f32_e32 %0, %1, %2":"=v"(r):"v"(a),"v"(b));return r;}
__device__ __forceinline__ float fsub_s(float a,float b){float r;asm("v_sub_f32_e32 %0, %1, %2":"=v"(r):"v"(a),"v"(b));return r;}
typedef float f32x2_t __attribute__((ext_vector_type(2))); typedef __bf16 bf16x2_t __attribute__((ext_vector_type(2)));
__device__ __forceinline__ unsigned cvtpk_s(float lo,float hi){f32x2_t v={lo,hi};bf16x2_t b=__builtin_convertvector(v,bf16x2_t);return __builtin_bit_cast(unsigned,b);}
#define WAIT_BAR(N) asm volatile("s_waitcnt vmcnt(" #N ") lgkmcnt(0)\n\ts_barrier":::"memory")

__device__ __forceinline__ void qkt(f32x16&p0,f32x16&p1,const char*Kslot,const bf16x8*qr,const f32x16&negm,int r32,int hi){
  const char*kb=Kslot+hi*1024+r32*16;
  #pragma unroll
  for(int d0=0;d0<4;++d0){
    const bf16x8 b0=*reinterpret_cast<const bf16x8*>(kb+d0*2048);
    const bf16x8 b1=*reinterpret_cast<const bf16x8*>(kb+d0*2048+512);
    if(d0==0){p0=__builtin_amdgcn_mfma_f32_32x32x16_bf16(b0,qr[0],negm,0,0,0);p1=__builtin_amdgcn_mfma_f32_32x32x16_bf16(b1,qr[0],negm,0,0,0);}
    else{p0=__builtin_amdgcn_mfma_f32_32x32x16_bf16(b0,qr[d0],p0,0,0,0);p1=__builtin_amdgcn_mfma_f32_32x32x16_bf16(b1,qr[d0],p1,0,0,0);}}
}
typedef __attribute__((address_space(3))) const char* lds_cptr;
typedef short v4i16_t __attribute__((ext_vector_type(4)));
__device__ __forceinline__ void kload8(bf16x8*kf,lds_cptr kp){
  kf[0]=*(const __attribute__((address_space(3))) bf16x8*)(kp);      kf[1]=*(const __attribute__((address_space(3))) bf16x8*)(kp+512);
  kf[2]=*(const __attribute__((address_space(3))) bf16x8*)(kp+2048); kf[3]=*(const __attribute__((address_space(3))) bf16x8*)(kp+2560);
  kf[4]=*(const __attribute__((address_space(3))) bf16x8*)(kp+4096); kf[5]=*(const __attribute__((address_space(3))) bf16x8*)(kp+4608);
  kf[6]=*(const __attribute__((address_space(3))) bf16x8*)(kp+6144); kf[7]=*(const __attribute__((address_space(3))) bf16x8*)(kp+6656);
}
__device__ __forceinline__ void kload2(bf16x8*kf,lds_cptr kp,int j){ kf[2*j]=*(const __attribute__((address_space(3))) bf16x8*)(kp+j*2048); kf[2*j+1]=*(const __attribute__((address_space(3))) bf16x8*)(kp+j*2048+512); }
__device__ __forceinline__ s16x4 vtr(lds_cptr p){ return __builtin_bit_cast(s16x4,__builtin_amdgcn_ds_read_tr16_b64_v4i16((__attribute__((address_space(3))) v4i16_t*)p)); }
__device__ __forceinline__ float rowmax(const f32x16&p0,const f32x16&p1){
  float a=max3f(p0[0],p0[1],p1[0]),b=max3f(p0[2],p0[3],p1[1]);a=max3f(a,p1[2],p1[3]);
  #pragma unroll
  for(int r=4;r<16;r+=4){a=max3f(a,p0[r],p0[r+1]);b=max3f(b,p0[r+2],p0[r+3]);a=max3f(a,p1[r],p1[r+1]);b=max3f(b,p1[r+2],p1[r+3]);}
  const float m=max2f(a,b);
  auto rr=__builtin_amdgcn_permlane32_swap(__float_as_uint(m),__float_as_uint(m),false,false);
  return max2f(__uint_as_float(rr[0]),__uint_as_float(rr[1]));
}
__device__ __forceinline__ void pv(f32x16*o,int vb,bf16x8 pa0,bf16x8 pa1,bf16x8 pa2,bf16x8 pa3){
  #pragma unroll
  for(int d0=0;d0<2;++d0){s16x4 lo[4],hi[4];
    #pragma unroll
    for(int ks=0;ks<4;++ks){
      asm volatile("ds_read_b64_tr_b16 %0,%1 offset:%c2":"=&v"(lo[ks]):"v"(vb),"i"(d0*4096+ks*1024):"memory");
      asm volatile("ds_read_b64_tr_b16 %0,%1 offset:%c2":"=&v"(hi[ks]):"v"(vb),"i"(d0*4096+ks*1024+512):"memory");}
    asm volatile("s_waitcnt lgkmcnt(0)":::"memory");SBAR();
    #define PK(k) (bf16x8){lo[k][0],lo[k][1],lo[k][2],lo[k][3],hi[k][0],hi[k][1],hi[k][2],hi[k][3]}
    o[d0]=__builtin_amdgcn_mfma_f32_32x32x16_bf16(pa0,PK(0),o[d0],0,0,0);
    o[d0]=__builtin_amdgcn_mfma_f32_32x32x16_bf16(pa1,PK(1),o[d0],0,0,0);
    o[d0]=__builtin_amdgcn_mfma_f32_32x32x16_bf16(pa2,PK(2),o[d0],0,0,0);
    o[d0]=__builtin_amdgcn_mfma_f32_32x32x16_bf16(pa3,PK(3),o[d0],0,0,0);
    #undef PK
  }
}

#ifndef ATTN_STORE16
#define ATTN_STORE16(p,v) (*(u32x4*)(p)=(v))
#endif
template<int THRL,bool BAND> __device__ __forceinline__ void attn_unit(const bf16*Qb,const bf16*__restrict__ Kb,const bf16*__restrict__ Vb,bf16*Ob,const long rs,const long ors,const int NT,const int moff,float*lse,const long lrs,char*shm){
  int tid_=threadIdx.x; asm volatile("":"+v"(tid_));
  const int tid=tid_,lane=tid&63,r32=lane&31,hi=lane>>5; const int wid=__builtin_amdgcn_readfirstlane(tid>>6);
  const bf16*Qw=Qb+(long)(wid*QBLK)*rs;
  const bf16*Kh=Kb,*Vh=Vb;
  const unsigned lds0=(unsigned)(uintptr_t)shm;
  float*wsf=(float*)(shm+LDS_WS)+wid*64;
  const bf16*ksrc=Kh+(long)lane*rs+wid*8;
  const bf16*vsrc=Vh+(long)(16*(wid&3)+(lane>>2))*rs+(wid>>2)*32+(lane&3)*8;
  const unsigned kdst=lds0+LDS_K+wid*1024, vdst=lds0+LDS_V+wid*1024;
  #define DMA_K(t,slot) glds16(ksrc+(long)(t)*KVBLK*rs,(unsigned)__builtin_amdgcn_readfirstlane(kdst+(slot)))
  #define DMA_V(t,slot) glds16(vsrc+(long)(t)*KVBLK*rs,(unsigned)__builtin_amdgcn_readfirstlane(vdst+(slot)))
  const int vb0=(int)(lds0+LDS_V)+((lane>>4)&1)*32+(lane&3)*8+(4*hi+((lane&15)>>2))*64;
  const char*Kbase=shm+LDS_K; bf16x8 kf[8];
  const lds_cptr shm3=(lds_cptr)shm; const lds_cptr kp0=shm3+LDS_K+hi*1024+r32*16; const lds_cptr vp0=shm3+LDS_V+((lane>>4)&1)*32+(lane&3)*8+(4*hi+((lane&15)>>2))*64;
  DMA_K(0,0);DMA_V(0,0);DMA_K(1,SLOTB);
  bf16x8 qr[4];
  #pragma unroll
  for(int d0=0;d0<4;++d0)qr[d0]=*reinterpret_cast<const bf16x8*>(&Qw[(long)r32*rs+d0*16+hi*8]);
  float mhat=0.f,l_reg=0.f;f32x16 o[2];o[0]=f32x16{};o[1]=f32x16{};f32x16 negm=f32x16{};asm volatile("":"+v"(negm));
  const int qrel=wid*QBLK+r32;
  #define CMASK(P0,P1,t) do{int jb_=(t)-(NT-4); if(BAND||jb_>=0)cmask<BAND>(P0,P1,64*(t)-moff,qrel,hi);}while(0)
  bool resc=false;
  #define START(P0,P1) do{ const float rm=BAND?__builtin_fmaxf(rowmax(P0,P1),-64.f):rowmax(P0,P1); resc=false; \
    { const float dl=rm; mhat=fadd_s(mhat,dl); \
      _Pragma("unroll") for(int r=0;r<16;++r){P0[r]=fsub_s(P0[r],dl);P1[r]=fsub_s(P1[r],dl);} \
      _Pragma("unroll") for(int r=0;r<16;++r)negm[r]=-mhat; asm volatile("":"+v"(negm)); } \
    _Pragma("unroll") for(int r=0;r<16;++r)P0[r]=__builtin_amdgcn_exp2f(P0[r]); }while(0)
  #define RESC() do{ if(resc){ asm volatile("s_waitcnt lgkmcnt(0)":::"memory"); \
      _Pragma("unroll") for(int d_=0;d_<2;++d_) _Pragma("unroll") for(int r=0;r<16;++r)o[d_][r]*=wsf[crow(r,hi)]; } }while(0)
  f32x16 pA0,pA1,pB0,pB1;
  int sl_prev=0,sl_cur=0,sl_next=SLOTB;
  #define ROT() do{sl_prev=sl_cur;sl_cur=sl_next;sl_next=(sl_next==(NSLOT-1)*SLOTB)?0:sl_next+SLOTB;}while(0)
  DMA_K(2,2*SLOTB);
  WAIT_BAR(3);
  qkt(pA0,pA1,Kbase,qr,negm,r32,hi);asm volatile("s_nop 15\n\ts_nop 7":"+v"(pA0),"+v"(pA1));CMASK(pA0,pA1,0);
  START(pA0,pA1);
  _Pragma("unroll") for(int r=0;r<16;++r)pA1[r]=__builtin_amdgcn_exp2f(pA1[r]);
  WAIT_BAR(0);
  DMA_K(3,0);DMA_V(1,SLOTB);
  ROT();
  kload8(kf,kp0+sl_cur);
  WAIT_BAR(2);
  s16x4 vlo[8],vhi[8]; u32x4 pw0,pw1,pw2,pw3;
  #define PKW(P,B) cvtpk_s(P[B],P[B+1])
  #define PAF(k) __builtin_bit_cast(bf16x8,pw##k)
  #define VFR(i) (bf16x8){vlo[i][0],vlo[i][1],vlo[i][2],vlo[i][3],vhi[i][0],vhi[i][1],vhi[i][2],vhi[i][3]}
  #define PIN(x) asm volatile("":"+v"(x))
  #define MX3(a,b,c) __builtin_fmaxf(__builtin_fmaxf((a),(b)),(c))
  #define GAPA(MF,A0,A1,A2,A3,W0,W1,PW) do{ MF; sacc+=A0; sacc+=A1; sacc+=A2; sacc+=A3; PIN(sacc); W0; W1; PIN(PW); SBAR(); }while(0)
  #define EX(v) __builtin_amdgcn_exp2f(v)
  #define GAPB(MF,X,B) do{ MF; X[B]=EX(X[B]); X[B+1]=EX(X[B+1]); X[B+2]=EX(X[B+2]); X[B+3]=EX(X[B+3]); PIN(X); SBAR(); }while(0)
  #define VRD(i) do{ vlo[i]=vtr(vp_+(((i)>>2)*4096+((i)&3)*1024)); vhi[i]=vtr(vp_+(((i)>>2)*4096+((i)&3)*1024+512)); }while(0)
  #define KRD(G,j) do{ if(G){ kload2(kf,kp0+sl_next,j); SBAR(); } }while(0)
  #define STEP(C0,C1,P0,P1,t,GK,GV,GL) do{ SBAR(); \
    const lds_cptr vp_=vp0+sl_prev; \
    VRD(0); SBAR(); float sacc=(P0[0]+P0[1]); \
    GAPA(C0=__builtin_amdgcn_mfma_f32_32x32x16_bf16(kf[0],qr[0],negm,0,0,0), P0[2],P0[3],P0[4],P0[5],     pw0[0]=PKW(P0,0), pw0[1]=PKW(P0,2), pw0); \
    VRD(4); SBAR(); GAPA(C1=__builtin_amdgcn_mfma_f32_32x32x16_bf16(kf[1],qr[0],negm,0,0,0), P0[6],P0[7],P0[8],P0[9],     pw0[2]=PKW(P0,4), pw0[3]=PKW(P0,6), pw0); \
    VRD(1); SBAR(); GAPA(C0=__builtin_amdgcn_mfma_f32_32x32x16_bf16(kf[2],qr[1],C0,0,0,0),   P0[10],P0[11],P0[12],P0[13], pw1[0]=PKW(P0,8), pw1[1]=PKW(P0,10), pw1); \
    VRD(5); SBAR(); GAPA(C1=__builtin_amdgcn_mfma_f32_32x32x16_bf16(kf[3],qr[1],C1,0,0,0),   P0[14],P0[15],P1[0],P1[1],   pw1[2]=PKW(P0,12),pw1[3]=PKW(P0,14), pw1); \
    VRD(2); SBAR(); GAPA(C0=__builtin_amdgcn_mfma_f32_32x32x16_bf16(kf[4],qr[2],C0,0,0,0),   P1[2],P1[3],P1[4],P1[5],     pw2[0]=PKW(P1,0), pw2[1]=PKW(P1,2), pw2); \
    VRD(6); SBAR(); GAPA(C1=__builtin_amdgcn_mfma_f32_32x32x16_bf16(kf[5],qr[2],C1,0,0,0),   P1[6],P1[7],P1[8],P1[9],     pw2[2]=PKW(P1,4), pw2[3]=PKW(P1,6), pw2); \
    VRD(3); SBAR(); GAPA(C0=__builtin_amdgcn_mfma_f32_32x32x16_bf16(kf[6],qr[3],C0,0,0,0),   P1[10],P1[11],P1[12],P1[13], pw3[0]=PKW(P1,8), pw3[1]=PKW(P1,10), pw3); \
    VRD(7); SBAR(); GAPA(C1=__builtin_amdgcn_mfma_f32_32x32x16_bf16(kf[7],qr[3],C1,0,0,0),   P1[14],P1[15],0.f,0.f,       pw3[2]=PKW(P1,12),pw3[3]=PKW(P1,14), pw3); \
    l_reg+=sacc; \
    if(GK){DMA_K((t)+3,sl_cur);} if(GV){DMA_V((t)+1,sl_next);} \
    CMASK(C0,C1,t); \
    { float a=MX3(C0[0],C0[1],C1[0]),b=MX3(C0[2],C0[3],C1[1]); a=MX3(a,C1[2],C1[3]); \
      _Pragma("unroll") for(int r=4;r<16;r+=4){a=MX3(a,C0[r],C0[r+1]);b=MX3(b,C0[r+2],C0[r+3]);a=MX3(a,C1[r],C1[r+1]);b=MX3(b,C1[r+2],C1[r+3]);} \
      float rm=__builtin_fmaxf(a,b); { auto rr=__builtin_amdgcn_permlane32_swap(__float_as_uint(rm),__float_as_uint(rm),false,false); rm=__builtin_fmaxf(__uint_as_float(rr[0]),__uint_as_float(rr[1])); } \
      resc=false; \
      if(__builtin_expect(__any(rm>(float)THRL),0)){ const float dl=__builtin_fmaxf(rm,0.f); mhat+=dl; \
        _Pragma("unroll") for(int r=0;r<16;++r){C0[r]-=dl;C1[r]-=dl;} \
        _Pragma("unroll") for(int r=0;r<16;++r)negm[r]=-mhat; asm volatile("":"+v"(negm)); \
        const float f=__builtin_amdgcn_exp2f(-dl); l_reg*=f; if(hi==0)wsf[r32]=f; resc=true; } } \
    SBAR(); \
    GAPB(o[0]=__builtin_amdgcn_mfma_f32_32x32x16_bf16(PAF(0),VFR(0),o[0],0,0,0), C0,0); \
    GAPB(o[1]=__builtin_amdgcn_mfma_f32_32x32x16_bf16(PAF(0),VFR(4),o[1],0,0,0), C0,4); \
    KRD(GL,0); GAPB(o[0]=__builtin_amdgcn_mfma_f32_32x32x16_bf16(PAF(1),VFR(1),o[0],0,0,0), C0,8); \
    KRD(GL,1); GAPB(o[1]=__builtin_amdgcn_mfma_f32_32x32x16_bf16(PAF(1),VFR(5),o[1],0,0,0), C0,12); \
    KRD(GL,2); GAPB(o[0]=__builtin_amdgcn_mfma_f32_32x32x16_bf16(PAF(2),VFR(2),o[0],0,0,0), C1,0); \
    KRD(GL,3); GAPB(o[1]=__builtin_amdgcn_mfma_f32_32x32x16_bf16(PAF(2),VFR(6),o[1],0,0,0), C1,4); \
    GAPB(o[0]=__builtin_amdgcn_mfma_f32_32x32x16_bf16(PAF(3),VFR(3),o[0],0,0,0), C1,8); \
    GAPB(o[1]=__builtin_amdgcn_mfma_f32_32x32x16_bf16(PAF(3),VFR(7),o[1],0,0,0), C1,12); \
    }while(0)
  int t=1;
  #undef CMASK
  #define CMASK(P0,P1,t) do{}while(0)
  for(;t+5<NT;t+=2){
    STEP(pB0,pB1,pA0,pA1,t,true,true,true);     WAIT_BAR(2); RESC(); ROT();
    STEP(pA0,pA1,pB0,pB1,t+1,true,true,true);   WAIT_BAR(2); RESC(); ROT();
  }
  #undef CMASK
  #define CMASK(P0,P1,t) do{int jb_=(t)-(NT-4); if(BAND||jb_>=0)cmask<BAND>(P0,P1,64*(t)-moff,qrel,hi);}while(0)
  #define ENDW(tt) do{ if((tt)+3<NT){WAIT_BAR(2);} else if((tt)+2<NT){WAIT_BAR(1);} else {WAIT_BAR(0);} }while(0)
  for(;t+1<NT;t+=2){
    STEP(pB0,pB1,pA0,pA1,t,(t+3<NT),(t+1<NT),(t+1<NT));       ENDW(t);   RESC(); ROT();
    STEP(pA0,pA1,pB0,pB1,t+1,(t+4<NT),(t+2<NT),(t+2<NT));     ENDW(t+1); RESC(); ROT();
  }
  STEP(pB0,pB1,pA0,pA1,NT-1,false,false,false); RESC();
  { float sacc=pB0[0]+pB0[1]; _Pragma("unroll") for(int r=2;r<16;++r)sacc+=pB0[r]; _Pragma("unroll") for(int r=0;r<16;++r)sacc+=pB1[r]; l_reg+=sacc;
    pw0=(u32x4){PKW(pB0,0),PKW(pB0,2),PKW(pB0,4),PKW(pB0,6)};pw1=(u32x4){PKW(pB0,8),PKW(pB0,10),PKW(pB0,12),PKW(pB0,14)};pw2=(u32x4){PKW(pB1,0),PKW(pB1,2),PKW(pB1,4),PKW(pB1,6)};pw3=(u32x4){PKW(pB1,8),PKW(pB1,10),PKW(pB1,12),PKW(pB1,14)};
    SBAR(); pv(o,vb0+sl_cur,PAF(0),PAF(1),PAF(2),PAF(3)); }
  #undef PKW
  #undef PAF
  #undef VFR
  #undef PIN
  #undef MX3
  #undef GAPA
  #undef GAPB
  #undef EX
  #undef VRD
  #undef KRD
  #undef STEP
  #undef ENDW
  {auto rr=__builtin_amdgcn_permlane32_swap(__float_as_uint(l_reg),__float_as_uint(l_reg),false,false);l_reg=__uint_as_float(rr[0])+__uint_as_float(rr[1]);}
  if(hi==0)wsf[32+r32]=l_reg;asm volatile("s_waitcnt lgkmcnt(0)":::"memory");
  float rli[16];
  #pragma unroll
  for(int r=0;r<16;++r)rli[r]=__builtin_amdgcn_rcpf(wsf[32+crow(r,hi)]);
  bf16*Ow=Ob+(long)(wid*QBLK)*ors;
  if(BAND){ if(hi==0) lse[(long)(wid*QBLK+r32)*lrs]=mhat+__builtin_amdgcn_logf(l_reg); }
  { bf16*stg=(bf16*)(shm+LDS_OST)+wid*2048;
    #pragma unroll
    for(int r=0;r<16;++r){const int orow=crow(r,hi);
      #pragma unroll
      for(int d0=0;d0<2;++d0)stg[orow*64+d0*32+r32]=__float2bfloat16(o[d0][r]*rli[r]);}
    asm volatile("s_waitcnt lgkmcnt(0)":::"memory");
    #pragma unroll
    for(int i=0;i<4;++i){const int row=i*8+(lane>>3),ch=lane&7; const u32x4 v=*(const u32x4*)(stg+row*64+ch*8); ATTN_STORE16(Ow+(long)row*ors+ch*8,v);} }
  asm volatile("s_waitcnt lgkmcnt(0)\n\ts_barrier":::"memory");
  #undef DMA_K
  #undef DMA_V
  #undef CMASK
  #undef START
  #undef RESC
  #undef ROT
}
constexpr int ATTN_LDS_BYTES=LDS_BYTES;
struct AttnUnit { const bf16* Q; const bf16* K; const bf16* V; bf16* O; float* lse; long rs, ors, lrs; int NT, moff; };
template<class Sched,int THRL,bool BAND> __device__ __forceinline__ void attn_phase(char*lds,const Sched&S){
  AttnUnit u;
  for(int i=0;S.next(i,u);++i){ attn_unit<THRL,BAND>(u.Q,u.K,u.V,u.O,u.rs,u.ors,u.NT,u.moff,u.lse,u.lrs,lds); }
}
#undef SBAR
#undef WAIT_BAR
}
#define GAS __attribute__((address_space(1)))
#define LAS __attribute__((address_space(3)))
typedef unsigned short bf16;
typedef unsigned v4u __attribute__((ext_vector_type(4)));
typedef float f32x4 __attribute__((ext_vector_type(4)));
typedef short bf16x8 __attribute__((ext_vector_type(8)));
typedef GAS unsigned gu32;
typedef GAS unsigned long long gu64;
#define RLX_AGENT __ATOMIC_RELAXED, __HIP_MEMORY_SCOPE_AGENT
#define LDS_WAIT() asm volatile("s_waitcnt lgkmcnt(0)" ::: "memory")
#define VM_WAIT() asm volatile("s_waitcnt vmcnt(0)" ::: "memory")
__device__ __forceinline__ unsigned long long rt() { return __builtin_amdgcn_s_memrealtime(); }

#define XB_TMO      128
#define XB_XCNT(j)  (256  + 64 * (j))
#define XB_XSUB(j)  (1280 + 64 * (j))
#define XB_XGEN(j)  (2304 + 64 * (j))
#define XB_TOP      3328
#define XB_TOPGEN   3392
#define XCD_BAR_WORDS 3456
#define XB_SPIN_CAP (1u << 18)

__device__ __forceinline__ unsigned xb_ld(unsigned* p)              { return __hip_atomic_load(p, __ATOMIC_RELAXED, __HIP_MEMORY_SCOPE_AGENT); }
__device__ __forceinline__ unsigned xb_add(unsigned* p, unsigned v) { return __hip_atomic_fetch_add(p, v, __ATOMIC_RELAXED, __HIP_MEMORY_SCOPE_AGENT); }
__device__ __forceinline__ unsigned xb_xcc_id() { return (unsigned)__builtin_amdgcn_s_getreg((3 << 11) | 20) & 0xFu; }
#define XB_SPIN(cond, bar) do { unsigned _sp = 0; while (cond) { __builtin_amdgcn_s_sleep(1); \
    if ((++_sp & 255u) == 0u) { if (xb_ld(&(bar)[XB_TMO])) break; if (_sp > XB_SPIN_CAP) { atomicAdd(&(bar)[XB_TMO], 1u); break; } } } } while (0)

struct XcdBarrier {
    unsigned* bar; unsigned x;
    volatile LAS unsigned* st;
};

__device__ __forceinline__ XcdBarrier xcd_barrier_post(unsigned* bar, volatile LAS unsigned* st) {
    XcdBarrier b; b.bar = bar; b.x = xb_xcc_id(); b.st = st;
    if (threadIdx.x == 0) (void)xb_add(&bar[XB_XCNT(b.x)], 1u);
    return b;
}
__device__ __forceinline__ void xcd_barrier_complete(unsigned* bar, unsigned x, unsigned& nloc, unsigned& nx) {
    const unsigned G = gridDim.x * gridDim.y * gridDim.z;
    unsigned sum, cnt, mine, sp = 0u;
    for (;;) {
        sum = 0u; cnt = 0u; mine = 0u;
#pragma unroll
        for (unsigned j = 0; j < 16; ++j) { const unsigned c = xb_ld(&bar[XB_XCNT(j)]); sum += c; cnt += (c > 0u) ? 1u : 0u; mine = (j == x) ? c : mine; }
        if (sum == G) break;
        __builtin_amdgcn_s_sleep(1);
        if ((++sp & 255u) == 0u) { if (xb_ld(&bar[XB_TMO])) break; if (sp > XB_SPIN_CAP) { atomicAdd(&bar[XB_TMO], 1u); break; } }
    }
    nloc = mine > 0u ? mine : 1u; nx = cnt > 0u ? cnt : 1u;
}

__device__ __forceinline__ void xcd_barrier(const XcdBarrier& b) {
    asm volatile("s_waitcnt vmcnt(0)" ::: "memory");
    __syncthreads();
    if (threadIdx.x == 0) {
        unsigned* bar = b.bar;
        __builtin_amdgcn_s_waitcnt(0);
        unsigned nloc = b.st[0], nx = b.st[1];
        if (nloc == 0u) { xcd_barrier_complete(bar, b.x, nloc, nx); b.st[0] = nloc; b.st[1] = nx; }
        const unsigned old = xb_add(&bar[XB_XSUB(b.x)], 1u);
        const unsigned gen = old / nloc;
        if (old + 1u == (gen + 1u) * nloc) {
            __builtin_amdgcn_fence(__ATOMIC_RELEASE, "agent");
            asm volatile("s_waitcnt vmcnt(0)" ::: "memory");
            const unsigned og = xb_add(&bar[XB_TOP], 1u);
            const unsigned tg = og / nx;
            if (og + 1u == (tg + 1u) * nx) xb_add(&bar[XB_TOPGEN], 1u);
            else XB_SPIN(xb_ld(&bar[XB_TOPGEN]) == tg, bar);
            __builtin_amdgcn_fence(__ATOMIC_ACQUIRE, "agent");
            xb_add(&bar[XB_XGEN(b.x)], 1u);
            asm volatile("s_waitcnt vmcnt(0)" ::: "memory");
        } else {
            XB_SPIN(xb_ld(&bar[XB_XGEN(b.x)]) == gen, bar);
            __builtin_amdgcn_fence(__ATOMIC_ACQUIRE, "agent");
            asm volatile("s_waitcnt vmcnt(0)" ::: "memory");
        }
    }
    __syncthreads();
}

constexpr int NWAVES = 8;
constexpr int RING_OFF = 0, RING_BYTES = 131072;
constexpr int LDSCTL_OFF = RING_BYTES, MISC_OFF = LDSCTL_OFF + 320;
constexpr int LDS_BYTES = 147456;
constexpr int CW_TMO = 0, CW_CODE = 1, CW_BAR = 4096;

__device__ __forceinline__ int lane_id() { int l = (int)(threadIdx.x & 63u); asm volatile("" : "+v"(l)); return l; }
__device__ __forceinline__ int tid_id() { int t = (int)threadIdx.x; asm volatile("" : "+v"(t)); return t; }
struct Frame {
    LAS unsigned char* lds;
    volatile LAS unsigned* MISC;
    gu32* ctl;
    int wave, vcu, G;
};

__device__ __forceinline__ void p0_transpose_item(const float* W, int K, int N, bf16_t* WT, int k0, int n0, int drow0, LAS float* scr, int lane, const float* gain) {
    const float* src = W + (size_t)(k0 + (lane >> 5)) * N + n0 + (lane & 31);
    float v[32];
#pragma unroll
    for (int i = 0; i < 32; ++i) v[i] = src[(size_t)(2 * i) * N];
    const int c = lane & 7;
    f32x4 g0 = {1.f, 1.f, 1.f, 1.f}, g1 = g0;
    if (gain) { g0 = *(const f32x4*)(gain + k0 + 8 * c); g1 = *(const f32x4*)(gain + k0 + 8 * c + 4); }
#pragma unroll
    for (int i = 0; i < 32; ++i) scr[(2 * i + (lane >> 5)) * 33 + (lane & 31)] = v[i];
    LDS_WAIT(); asm volatile("" ::: "memory");
#pragma unroll
    for (int j = 0; j < 4; ++j) { const int n = (lane >> 3) + 8 * j; const LAS float* s = scr + (8 * c) * 33 + n;
        v4u o; o.x = pk2bf(s[0 * 33] * g0[0], s[1 * 33] * g0[1]); o.y = pk2bf(s[2 * 33] * g0[2], s[3 * 33] * g0[3]); o.z = pk2bf(s[4 * 33] * g1[0], s[5 * 33] * g1[1]); o.w = pk2bf(s[6 * 33] * g1[2], s[7 * 33] * g1[3]);
        *(GAS v4u*)(WT + (size_t)(drow0 + n) * K + k0 + 8 * c) = o; }
    LDS_WAIT(); asm volatile("" ::: "memory");
}
__device__ __forceinline__ void rms_row_to_bf16(const float* xrow, const float* g, bf16_t* orow, int lane) {
    const f32x4* xr = (const f32x4*)xrow + lane;
    f32x4 v[4]; float s = 0.f;
#pragma unroll
    for (int j = 0; j < 4; ++j) { v[j] = xr[64 * j]; s += (v[j].x * v[j].x + v[j].y * v[j].y) + (v[j].z * v[j].z + v[j].w * v[j].w); }
    const float r = rsqrtf(wave_sum(s) * (1.f / DM) + EPS);
    unsigned long long* o8 = (unsigned long long*)orow + lane;
#pragma unroll
    for (int j = 0; j < 4; ++j) { const f32x4 gg = *((const f32x4*)g + lane + 64 * j);
        o8[64 * j] = (unsigned long long)pk2bf(v[j].x * r * gg.x, v[j].y * r * gg.y) | ((unsigned long long)pk2bf(v[j].z * r * gg.z, v[j].w * r * gg.w) << 32); }
}
__device__ __forceinline__ void row_to_bf16_sq(const float* xrow, bf16_t* orow, float* rsq16, int lane) {
    const f32x4* xr = (const f32x4*)xrow + lane;
    f32x4 v[4]; float s = 0.f;
#pragma unroll
    for (int j = 0; j < 4; ++j) { v[j] = xr[64 * j]; s += (v[j].x * v[j].x + v[j].y * v[j].y) + (v[j].z * v[j].z + v[j].w * v[j].w); }
    s = wave_sum(s);
    unsigned long long* o8 = (unsigned long long*)orow + lane;
#pragma unroll
    for (int j = 0; j < 4; ++j) o8[64 * j] = (unsigned long long)pk2bf(v[j].x, v[j].y) | ((unsigned long long)pk2bf(v[j].z, v[j].w) << 32);
    if (lane < 4) rsq16[lane] = (lane == 0) ? s : 0.f;
}
__device__ __forceinline__ void rms_row_final(const bf16_t* hrow, float* orow, const float* g, const float* rsq4, int lane) {
    float s = (lane < 4) ? rsq4[lane] : 0.f;
    const unsigned long long* h8 = (const unsigned long long*)hrow + lane;
    unsigned long long hv[4];
#pragma unroll
    for (int j = 0; j < 4; ++j) hv[j] = h8[64 * j];
    s = wave_sum(s);
    const float r = rsqrtf(s * (1.f / DM) + EPS);
    f32x4* o = (f32x4*)orow + lane;
#pragma unroll
    for (int j = 0; j < 4; ++j) { const f32x4 gg = *((const f32x4*)g + lane + 64 * j); const unsigned lo = (unsigned)hv[j], hi = (unsigned)(hv[j] >> 32);
        o[64 * j] = (f32x4){__uint_as_float(lo << 16), __uint_as_float(lo & 0xffff0000u), __uint_as_float(hi << 16), __uint_as_float(hi & 0xffff0000u)} * r * gg; }
}
__device__ __forceinline__ void rms_row_inplace_rsq(float* xrow, const float* g, const float* rsq16, int lane) {
    f32x4* xr = (f32x4*)xrow + lane;
    float s = (lane < 4) ? rsq16[lane] : 0.f;
    s = wave_sum(s);
    const float r = rsqrtf(s * (1.f / DM) + EPS);
#pragma unroll
    for (int j = 0; j < 4; ++j) { const f32x4 gg = *((const f32x4*)g + lane + 64 * j); xr[64 * j] = xr[64 * j] * r * gg; }
}
__device__ __forceinline__ void rms_row_inplace(float* xrow, const float* g, int lane) {
    f32x4* xr = (f32x4*)xrow + lane;
    f32x4 v[4]; float s = 0.f;
#pragma unroll
    for (int j = 0; j < 4; ++j) { v[j] = xr[64 * j]; s += (v[j].x * v[j].x + v[j].y * v[j].y) + (v[j].z * v[j].z + v[j].w * v[j].w); }
    const float r = rsqrtf(wave_sum(s) * (1.f / DM) + EPS);
#pragma unroll
    for (int j = 0; j < 4; ++j) { const f32x4 gg = *((const f32x4*)g + lane + 64 * j); xr[64 * j] = v[j] * r * gg; }
}

struct Args { const float* in[23]; float* out; unsigned char* ws; int ph_lo, ph_hi, li, pad; };

struct WDesc { const float* W; int K, N; bf16_t* WT; int mode; int items; };

constexpr int CI0 = (DM / 64) * (N_IN0 / 32), CI1 = (DM / 64) * (DM / 32), CI2 = (DM / 64) * (N_QKV / 32), CI4 = (DM / 64) * (NUP / 32), CI6 = (DFF / 64) * (DM / 32), CI8 = (128 / 64) * (128 / 32);
constexpr int CB_P0_END = CI0;
constexpr int CB_1_END = CB_P0_END + CI1 + CI4 + CI6 + 4 * CI8;
constexpr int CB_2_END = CB_1_END + CI2 + CI1 + CI4 + CI6;
__device__ __forceinline__ void convert_items(Frame& F, const Args& a, unsigned char* ws, int it_begin, int it_end, int worker, int nworkers) {
    LAS float* scr = (LAS float*)(F.lds + RING_OFF + F.wave * 16384);
    const int lane = lane_id();
    for (int it = it_begin + worker; it < it_end; it += nworkers) {
        int r = it; const float* W; int K, N; bf16_t* WT; int mode = 0; const float* gain = nullptr;
        if (r < CI0) { W = a.in[5]; K = DM; N = N_IN0; WT = (bf16_t*)(ws + WS_W_IN0); gain = a.in[2]; }
        else if ((r -= CI0) < CI1) { W = a.in[11]; K = DM; N = DM; WT = (bf16_t*)(ws + WS_W_OUT0); }
        else if ((r -= CI1) < CI4) { W = a.in[19]; K = DM; N = NUP; WT = (bf16_t*)(ws + WS_W_UP); mode = 1; gain = a.in[3]; }
        else if ((r -= CI4) < CI6) { W = a.in[22]; K = DFF; N = DM; WT = (bf16_t*)(ws + WS_W_DN); }
        else if ((r -= CI6) < 4 * CI8) { const int g = r / CI8; r -= g * CI8; W = a.in[9] + (size_t)g * 128 * 128; K = 128; N = 128; WT = (bf16_t*)(ws + WS_PWT) + (size_t)g * 128 * 128; }
        else if ((r -= 4 * CI8) < CI2) { W = a.in[12]; K = DM; N = N_QKV; WT = (bf16_t*)(ws + WS_W_QKV); gain = a.in[2] + DM; }
        else if ((r -= CI2) < CI1) { W = a.in[18]; K = DM; N = DM; WT = (bf16_t*)(ws + WS_W_OUT1); }
        else if ((r -= CI1) < CI4) { W = a.in[19] + (size_t)DM * NUP; K = DM; N = NUP; WT = (bf16_t*)(ws + WS_W_UP) + (size_t)NUP * DM; mode = 1; gain = a.in[3] + DM; }
        else { r -= CI4; W = a.in[22] + (size_t)DFF * DM; K = DFF; N = DM; WT = (bf16_t*)(ws + WS_W_DN) + (size_t)DM * DFF; }
        const int nblk = N / 32, kb = r / nblk, nb = r % nblk, k0 = 64 * kb, n0 = 32 * nb;
        int d0 = n0;
        if (mode == 1) { if (n0 < DFF) d0 = 256 * (n0 / 128) + (n0 % 128); else { const int q = n0 - DFF; d0 = 256 * (q / 128) + 128 + (q % 128); } }
        p0_transpose_item(W, K, N, WT, k0, n0, d0, scr, lane, gain);
    }
}
__device__ __forceinline__ void convert_in_tail(Frame& F, const Args& a, unsigned char* ws, int nwg, int it_begin, int it_end) {
    const int rem = nwg % F.G, first = rem, nw = (rem > 0) ? F.G - rem : F.G, c = (int)blockIdx.x;
    if (rem > 0 && c < first) return;
    convert_items(F, a, ws, it_begin, it_end, (c - (rem > 0 ? first : 0)) * NWAVES + F.wave, nw * NWAVES);
}
__device__ __forceinline__ void p0_prologue(Frame& F, const Args& a) {
    const int lane = lane_id(), tid = tid_id();
    const int gw = F.vcu * NWAVES + F.wave, NGW = F.G * NWAVES;
    unsigned char* ws = a.ws;
    convert_items(F, a, ws, 0, CB_P0_END, gw, NGW);
    { const float* w_s = a.in[7]; bf16_t* Wb = (bf16_t*)(ws + WS_WSB);
      for (int idx = (F.vcu * NWAVES * 64) + tid; idx < 4 * 128 * 128; idx += F.G * NWAVES * 64) { const int t = (idx >> 7) & 127, sidx = idx & 127; Wb[idx] = (sidx <= t) ? f2bf(w_s[idx]) : (bf16_t)0; } }
    { const int* pos = (const int*)a.in[1]; float* tab = (float*)(ws + WS_ROPE);
      for (int idx = (F.vcu * NWAVES * 64) + tid; idx < M * 8; idx += F.G * NWAVES * 64) {
          const int row = idx >> 3, i = idx & 7;
          const double inv = exp2(-(double)(2 * i) / 16.0 * 18.931568569324174);
          const float ang = (float)pos[row] * (float)inv;
          const double rev = (double)ang * 0.15915494309189535;
          const double fr = rev - floor(rev);
          const float aa = (float)(fr * 6.283185307179586);
          tab[row * 16 + i] = cosf(aa); tab[row * 16 + 8 + i] = sinf(aa); } }
    { bf16_t* XN = (bf16_t*)(ws + WS_XN); float* rsq = (float*)(ws + WS_RSQ); const float* x = a.in[0];
      for (int m0 = gw * 4; m0 < M; m0 += NGW * 4) {
          f32x4 v[4][4];
#pragma unroll
          for (int r = 0; r < 4; ++r)
#pragma unroll
              for (int j = 0; j < 4; ++j) v[r][j] = *((const f32x4*)(x + (size_t)(m0 + r) * DM) + lane + 64 * j);
#pragma unroll
          for (int r = 0; r < 4; ++r) { float sq = 0.f;
#pragma unroll
              for (int j = 0; j < 4; ++j) sq += (v[r][j].x * v[r][j].x + v[r][j].y * v[r][j].y) + (v[r][j].z * v[r][j].z + v[r][j].w * v[r][j].w);
              sq = wave_sum(sq);
              unsigned long long* o8 = (unsigned long long*)(XN + (size_t)(m0 + r) * DM) + lane;
#pragma unroll
              for (int j = 0; j < 4; ++j) o8[64 * j] = (unsigned long long)pk2bf(v[r][j].x, v[r][j].y) | ((unsigned long long)pk2bf(v[r][j].z, v[r][j].w) << 32);
              if (lane < 4) rsq[(size_t)(m0 + r) * 4 + lane] = (lane == 0) ? sq : 0.f; } } }
}

#ifndef PG8_SP2
#define PG8_SP2 true
#endif
#ifndef PG8_ALIGN
#define PG8_ALIGN true
#endif

struct SchedC {
    int vcu, G; attn_body::bf16* QKV; attn_body::bf16* OCA;
    __device__ __forceinline__ bool next(int it, attn_body::AttnUnit& u) const {
        constexpr long P = attn_body::PITCH;
        const int per = 6, s = vcu + (it / per) * G, k = (it % per) >> 1, pass = it & 1;
        if (s >= 256) return false;
        const int x = s >> 5, l = s & 31, i = l & 15, hl = (l >> 4) * 3 + k;
        const int qb = (k == 0) ? i : (k == 1) ? ((i + 8) & 15) : (i < 8 ? 14 - 2 * i : 31 - 2 * i);
        const int bj = x * 6 + hl, b = bj / 12, j = bj % 12, h = j >> 1;
        const long rowbase = (long)b * SEQ, q0 = (long)qb * 256;
        u.Q = QKV + (rowbase + q0) * P + j * 64; u.K = QKV + rowbase * P + 768 + j * 64; u.V = QKV + rowbase * P + 1536 + h * 128 + pass * 64;
        u.O = pass ? QKV + (rowbase + q0) * P + j * 64 : OCA + (rowbase + q0) * 768 + j * 64; u.ors = pass ? P : 768; u.rs = P;
        u.NT = 4 * qb + 4; u.moff = (int)q0; u.lse = nullptr; u.lrs = 0;
        return true;
    }
};
struct SchedD {
    int vcu, G; attn_body::bf16* QKV; float* LSE;
    __device__ __forceinline__ bool next(int it, attn_body::AttnUnit& u) const {
        constexpr long P = attn_body::PITCH;
        const int ud = vcu + it * G; if (ud >= 768) return false;
        const int b = ud / 192, rem = ud % 192, head = rem >> 4, idx = rem & 15, g = head >> 2;
        const int dl = (g == 0) ? 1 : (g == 1 ? 4 : 16), nb = 16 / dl, r = idx / nb, qb = idx % nb;
        const long rowbase = (long)b * SEQ + r; const int q0 = 256 * qb, kstart = (q0 >= 128) ? q0 - 128 : 0;
        u.rs = (long)dl * P; u.ors = u.rs; u.lrs = (long)dl * 12;
        u.Q = QKV + (rowbase + (long)q0 * dl) * P + 2304 + head * 64; u.O = QKV + (rowbase + (long)q0 * dl) * P + 2304 + head * 64;
        u.K = QKV + (rowbase + (long)kstart * dl) * P + 3072 + head * 64; u.V = QKV + (rowbase + (long)kstart * dl) * P + 3840 + head * 64;
        u.NT = (q0 + 256 - kstart) / 64; u.moff = q0 - kstart; u.lse = LSE + (rowbase + (long)q0 * dl) * 12 + head;
        return true;
    }
};
__device__ __forceinline__ f32x4 bf4lo(const u32x4 w) { return (f32x4){__uint_as_float(w.x << 16), __uint_as_float(w.x & 0xffff0000u), __uint_as_float(w.y << 16), __uint_as_float(w.y & 0xffff0000u)}; }
__device__ __forceinline__ f32x4 bf4hi(const u32x4 w) { return (f32x4){__uint_as_float(w.z << 16), __uint_as_float(w.z & 0xffff0000u), __uint_as_float(w.w << 16), __uint_as_float(w.w & 0xffff0000u)}; }
__device__ __forceinline__ u32x4 pack8(const f32x4 a, const f32x4 b) { u32x4 o; o.x = pk2bf(a[0], a[1]); o.y = pk2bf(a[2], a[3]); o.z = pk2bf(b[0], b[1]); o.w = pk2bf(b[2], b[3]); return o; }
__device__ __forceinline__ void post_attention_phase(Frame& F, const Args& a, unsigned char* ws) {
    const bf16_t* QKV = (const bf16_t*)(ws + WS_QKV); const bf16_t* OCA = (const bf16_t*)(ws + WS_OCA); const float* LSE = (const float*)(ws + WS_LSE);
    bf16_t* Y1 = (bf16_t*)(ws + WS_QKV) + Y1_COL;
    const int lane = lane_id(), gw = F.vcu * NWAVES + F.wave, NGW = F.G * NWAVES;
    const float lam = __expf(wave_sum(a.in[13][lane] * a.in[14][lane])) - __expf(wave_sum(a.in[15][lane] * a.in[16][lane])) + LAMBDA_INIT;
    const bool isC = lane < 48;
    const int h = lane >> 3, c = lane & 7, hh = (lane - 48) >> 2, dc = (lane & 3) * 16;
    f32x4 ga0, ga1, gb0, gb1;
    { const float f = 1.f - LAMBDA_INIT; const float* sg = a.in[17] + 8 * c;
      ga0 = *(const f32x4*)sg * f; ga1 = *(const f32x4*)(sg + 4) * f; gb0 = *(const f32x4*)(sg + 64) * f; gb1 = *(const f32x4*)(sg + 68) * f; }
    for (int row = gw; row < M; row += NGW) {
        const bf16_t* qa = OCA + (size_t)row * 768; const bf16_t* qb = QKV + (size_t)row * N_QKV; bf16_t* y = Y1 + (size_t)row * N_QKV;
        if (isC) {
            const u32x4 a0 = *(const u32x4*)(qa + (2 * h) * 64 + 8 * c), a1 = *(const u32x4*)(qa + (2 * h + 1) * 64 + 8 * c);
            const u32x4 b0 = *(const u32x4*)(qb + (2 * h) * 64 + 8 * c), b1 = *(const u32x4*)(qb + (2 * h + 1) * 64 + 8 * c);
            const f32x4 x0 = bf4lo(a0) - lam * bf4lo(a1), x1 = bf4hi(a0) - lam * bf4hi(a1), z0 = bf4lo(b0) - lam * bf4lo(b1), z1 = bf4hi(b0) - lam * bf4hi(b1);
            float q = ((x0[0] * x0[0] + x0[1] * x0[1]) + (x0[2] * x0[2] + x0[3] * x0[3])) + ((x1[0] * x1[0] + x1[1] * x1[1]) + (x1[2] * x1[2] + x1[3] * x1[3]))
                    + ((z0[0] * z0[0] + z0[1] * z0[1]) + (z0[2] * z0[2] + z0[3] * z0[3])) + ((z1[0] * z1[0] + z1[1] * z1[1]) + (z1[2] * z1[2] + z1[3] * z1[3]));
            q += dpp_f<0xB1>(q); q += dpp_f<0x4E>(q); q += dpp_f<0x141>(q);
            const float r = rsqrtf(q * (1.f / 128.f) + EPS);
            *(u32x4*)(y + h * 128 + 8 * c) = pack8(x0 * ga0 * r, x1 * ga1 * r);
            *(u32x4*)(y + h * 128 + 64 + 8 * c) = pack8(z0 * gb0 * r, z1 * gb1 * r);
        } else {
            const float l0 = LSE[(size_t)row * 12 + hh], l1 = LSE[(size_t)row * 12 + 4 + hh], l2 = LSE[(size_t)row * 12 + 8 + hh];
            const float mx = fmaxf(l0, fmaxf(l1, l2));
            float w0 = __builtin_amdgcn_exp2f(l0 - mx), w1 = __builtin_amdgcn_exp2f(l1 - mx), w2 = __builtin_amdgcn_exp2f(l2 - mx);
            const float inv = 1.f / (w0 + w1 + w2); w0 *= inv; w1 *= inv; w2 *= inv;
            const bf16_t* d0 = qb + 2304 + hh * 64 + dc;
#pragma unroll
            for (int k = 0; k < 2; ++k) {
                const u32x4 v0 = *(const u32x4*)(d0 + 8 * k), v1 = *(const u32x4*)(d0 + 256 + 8 * k), v2 = *(const u32x4*)(d0 + 512 + 8 * k);
                *(u32x4*)(y + 768 + hh * 64 + dc + 8 * k) = pack8(w0 * bf4lo(v0) + w1 * bf4lo(v1) + w2 * bf4lo(v2), w0 * bf4hi(v0) + w1 * bf4hi(v1) + w2 * bf4hi(v2));
            }
        }
    }
}

constexpr int MXP = 136;
__device__ __forceinline__ void mixer_phase(Frame& F, const Args& a, unsigned char* ws) {
    const bf16_t* P = (const bf16_t*)(ws + WS_P); bf16_t* Y = (bf16_t*)(ws + WS_Y);
    const bf16_t* Wb = (const bf16_t*)(ws + WS_WSB); const bf16_t* PWt = (const bf16_t*)(ws + WS_PWT);
    const float* v_gain = a.in[6]; const float* b_s = a.in[8]; const float* pool_scale = a.in[10];
    LAS bf16_t* T = (LAS bf16_t*)(F.lds + RING_OFF);
    LAS bf16_t* T2 = (LAS bf16_t*)(F.lds + RING_OFF + 128 * MXP * 2);
    LAS float* rs = (LAS float*)(F.lds + RING_OFF + 2 * 128 * MXP * 2);
    const int tid = tid_id(), wid = tid >> 6, lane = tid & 63, fr = lane & 15, fq = lane >> 4;
    for (int u = F.vcu; u < 1024; u += F.G) {
        const bool isA = u < 512; const int blk = (u & 511) >> 2, g = u & 3, row0 = blk * 128;
        f32x4 acc[8];
#pragma unroll
        for (int j = 0; j < 8; ++j) acc[j] = (f32x4){0.f, 0.f, 0.f, 0.f};
        if (isA) {
            bf16x8 xr[16], xv[4], wf[4]; u32x2 ug[8];
#pragma unroll
            for (int i = 0; i < 16; ++i) xr[i] = *(const bf16x8*)(P + (size_t)(row0 + wid * 16 + i) * N_IN0 + 512 + lane * 8);
#pragma unroll
            for (int k = 0; k < 4; ++k) { const int it = tid + 512 * k, sr = it & 127, cc = it >> 7; xv[k] = *(const bf16x8*)(P + (size_t)(row0 + sr) * N_IN0 + 512 + g * 128 + cc * 8); }
            const bf16_t* wrow = Wb + ((size_t)g * 128 + wid * 16 + fr) * 128 + fq * 8;
#pragma unroll
            for (int ks = 0; ks < 4; ++ks) wf[ks] = *(const bf16x8*)(wrow + ks * 32);
            const int t = wid * 16 + fr;
#pragma unroll
            for (int j = 0; j < 8; ++j) ug[j] = *(const u32x2*)(P + (size_t)(row0 + t) * N_IN0 + g * 128 + j * 16 + fq * 4);
            const float bias = b_s[g * 128 + t];
#pragma unroll
            for (int i = 0; i < 16; ++i) { float q = 0.f;
#pragma unroll
                for (int e = 0; e < 8; ++e) { const float f = bf2f((bf16_t)xr[i][e]); q += f * f; }
                q = wave_sum(q);
                if (lane == 0) rs[wid * 16 + i] = rsqrtf(q * (1.f / 512.f) + EPS); }
            __syncthreads();
#pragma unroll
            for (int k = 0; k < 4; ++k) { const int it = tid + 512 * k, sr = it & 127, cc = it >> 7; const float r = rs[sr];
                const f32x4 g0 = *(const f32x4*)(v_gain + g * 128 + cc * 8), g1 = *(const f32x4*)(v_gain + g * 128 + cc * 8 + 4);
#pragma unroll
                for (int e = 0; e < 8; ++e) T[(cc * 8 + e) * MXP + sr] = f2bf(bf2f((bf16_t)xv[k][e]) * r * (e < 4 ? g0[e & 3] : g1[e & 3])); }
            __syncthreads();
            const int nks = (wid >> 1) + 1;
#pragma unroll
            for (int ks = 0; ks < 4; ++ks) if (ks < nks) {
#pragma unroll
                for (int j = 0; j < 8; ++j) { const bf16x8 bfr = *(const LAS bf16x8*)(T + (j * 16 + fr) * MXP + ks * 32 + fq * 8);
                    acc[j] = __builtin_amdgcn_mfma_f32_16x16x32_bf16(bfr, wf[ks], acc[j], 0, 0, 0); }
            }
#pragma unroll
            for (int j = 0; j < 8; ++j) { const int col = g * 128 + j * 16 + fq * 4; const u32x2 uu = ug[j];
                const float u0 = __uint_as_float(uu.x << 16), u1 = __uint_as_float(uu.x & 0xffff0000u), u2 = __uint_as_float(uu.y << 16), u3 = __uint_as_float(uu.y & 0xffff0000u);
                u32x2 o; o.x = pk2bf(u0 * (acc[j][0] + bias), u1 * (acc[j][1] + bias)); o.y = pk2bf(u2 * (acc[j][2] + bias), u3 * (acc[j][3] + bias));
                *(u32x2*)(Y + (size_t)(row0 + t) * DM + col) = o; }
        } else {
            const int w = 2 << g; const float inv_w = 1.f / (float)w;
            const int cc = tid & 15, rg = tid >> 4, r0 = row0 + rg * 4, t0 = r0 & (SEQ - 1);
            const bf16_t* xp = P + 1024 + g * 128 + cc * 8;
            bf16x8 hx[19];
#pragma unroll
            for (int j = 0; j < 19; ++j) { const int dr = j - 15; hx[j] = (bf16x8){0, 0, 0, 0, 0, 0, 0, 0};
                if (dr > -w && t0 + dr >= 0) hx[j] = *(const bf16x8*)(xp + (size_t)(r0 + dr) * N_IN0); }
            bf16x8 pw4[4];
#pragma unroll
            for (int k = 0; k < 4; ++k) { const int it = tid + 512 * k, d = it >> 4, c8 = it & 15; pw4[k] = *(const bf16x8*)(PWt + ((size_t)g * 128 + d) * 128 + c8 * 8); }
#pragma unroll
            for (int k = 0; k < 4; ++k) { const int it = tid + 512 * k, d = it >> 4, c8 = it & 15; *(LAS bf16x8*)(T2 + d * MXP + c8 * 8) = pw4[k]; }
#pragma unroll
            for (int i = 0; i < 4; ++i) { const int ts = t0 + i;
                float sum[8];
#pragma unroll
                for (int e = 0; e < 8; ++e) sum[e] = 0.f;
#pragma unroll
                for (int jj = 0; jj < 16; ++jj) { if (jj < w) {
#pragma unroll
                        for (int e = 0; e < 8; ++e) sum[e] += bf2f((bf16_t)hx[15 + i - jj][e]); } }
                const float ic = (ts + 1 < w) ? 1.f / (float)(ts + 1) : inv_w;
                u32x4 o; unsigned ow[4];
#pragma unroll
                for (int e = 0; e < 8; e += 2) ow[e >> 1] = pk2bf(sum[e] * ic - bf2f((bf16_t)hx[15 + i][e]), sum[e + 1] * ic - bf2f((bf16_t)hx[15 + i][e + 1]));
                o.x = ow[0]; o.y = ow[1]; o.z = ow[2]; o.w = ow[3];
                *(LAS u32x4*)(T + (rg * 4 + i) * MXP + cc * 8) = o; }
            __syncthreads();
#pragma unroll
            for (int ks = 0; ks < 4; ++ks) {
                const bf16x8 af = *(const LAS bf16x8*)(T + (wid * 16 + fr) * MXP + ks * 32 + fq * 8);
#pragma unroll
                for (int j = 0; j < 8; ++j) { const bf16x8 bfr = *(const LAS bf16x8*)(T2 + (j * 16 + fr) * MXP + ks * 32 + fq * 8);
                    acc[j] = __builtin_amdgcn_mfma_f32_16x16x32_bf16(bfr, af, acc[j], 0, 0, 0); }
            }
            const int t = wid * 16 + fr;
#pragma unroll
            for (int j = 0; j < 8; ++j) { const int d = g * 128 + j * 16 + fq * 4; const f32x4 sc = *(const f32x4*)(pool_scale + d);
                u32x2 o; o.x = pk2bf(acc[j][0] * sc[0], acc[j][1] * sc[1]); o.y = pk2bf(acc[j][2] * sc[2], acc[j][3] * sc[3]);
                *(u32x2*)(Y + (size_t)(row0 + t) * DM + 512 + d) = o; }
        }
        __syncthreads();
    }
}

__device__ __forceinline__ void ffn_fix_phase(Frame& F, const Args& a, unsigned char* ws, int layer) {
    bf16_t* HM = (bf16_t*)(ws + WS_HMID);
    const float* halo = (const float*)(ws + WS_HALO); const float* tops = (const float*)(ws + WS_TOPS); const float* topg = (const float*)(ws + WS_TOPG);
    const float* cw = a.in[20] + (size_t)layer * 3 * DFF;
    const int tid = tid_id();
    constexpr int CPR = DFF / 4;
    for (int it = F.vcu * (NWAVES * 64) + tid; it < 64 * 2 * CPR; it += F.G * NWAVES * 64) {
        const int pm = it / (2 * CPR), rem = it % (2 * CPR), rr = rem / CPR, c = (rem % CPR) * 4;
        if ((pm & 15) == 0) continue;
        const size_t off = ((size_t)pm * 2 + rr) * DFF + c;
        f32x4 sv = *(const f32x4*)(tops + off); const f32x4 g = *(const f32x4*)(topg + off);
        const f32x4 h1 = *(const f32x4*)(halo + ((size_t)(pm - 1) * 2 + 1) * DFF + c), h0 = *(const f32x4*)(halo + ((size_t)(pm - 1) * 2 + 0) * DFF + c);
        const f32x4 w0 = *(const f32x4*)(cw + c), w1 = *(const f32x4*)(cw + DFF + c);
        if (rr == 0) sv = sv + w1 * h1 + w0 * h0; else sv = sv + w0 * h1;
        u32x2 o; o.x = pk2bf(gelu_tanh(sv[0]) * g[0], gelu_tanh(sv[1]) * g[1]); o.y = pk2bf(gelu_tanh(sv[2]) * g[2], gelu_tanh(sv[3]) * g[3]);
        *(u32x2*)(HM + (size_t)(pm * 256 + rr) * DFF + c) = o;
    }
}

#define OPQ_S(x) asm volatile("" : "+s"(x))
__device__ __forceinline__ Frame make_frame(unsigned char* ws) {
    extern __shared__ __attribute__((aligned(16))) unsigned char lds_[];
    Frame F;
    F.lds = (LAS unsigned char*)lds_;
    F.MISC = (volatile LAS unsigned*)(F.lds + MISC_OFF);
    F.wave = __builtin_amdgcn_readfirstlane((int)threadIdx.x >> 6);
    int G = gridDim.x, bx = blockIdx.x; OPQ_S(G); OPQ_S(bx);
    F.G = G; F.vcu = (G % 8 == 0) ? (bx % 8) * (G / 8) + bx / 8 : bx;
    F.ctl = (gu32*)(ws + WS_CTL);
    return F;
}
__global__ void __launch_bounds__(NWAVES * 64, 2) mk_fwd(Args args) {
    extern __shared__ __attribute__((aligned(16))) unsigned char lds[];
    for (int u = threadIdx.x; u < (LDS_BYTES - LDSCTL_OFF) / 4; u += NWAVES * 64) ((LAS unsigned*)((LAS unsigned char*)lds + LDSCTL_OFF))[u] = 0u;
    __syncthreads();
    const int lo = args.ph_lo, hi = args.ph_hi;
    if (hi - lo > 1) { unsigned char* ws = args.ws; (void)xcd_barrier_post((unsigned*)((gu32*)(ws + WS_CTL) + CW_BAR) + args.li * XCD_BAR_WORDS, (volatile LAS unsigned*)((LAS unsigned char*)lds + MISC_OFF) + 8); }
#ifdef MK_DIAG
    if (blockIdx.x == 0 && threadIdx.x == 0) ((unsigned long long*)(args.ws + WS_CTL + 524288))[31] = __builtin_amdgcn_s_memrealtime();
#endif
    int pc = 0;
#define PHASE_BEGIN if (pc >= lo && pc < hi) { size_t z_ = 0; OPQ_S(z_); unsigned char* ws = args.ws + z_; float* out = args.out + z_; Frame F = make_frame(ws); bf16_t* XN = (bf16_t*)(ws + WS_XN); (void)XN; (void)out;
#ifdef MK_DIAG
#define DIAG_STAMP(k) do { if (blockIdx.x == 0 && threadIdx.x == 0) ((unsigned long long*)(ws + WS_CTL + 524288))[(k)] = __builtin_amdgcn_s_memrealtime(); } while (0)
#else
#define DIAG_STAMP(k) do { } while (0)
#endif
#define PHASE_END if (pc + 1 < hi) { XcdBarrier bar; bar.bar = (unsigned*)(F.ctl + CW_BAR) + args.li * XCD_BAR_WORDS; bar.x = xb_xcc_id(); bar.st = F.MISC + 8; xcd_barrier(bar); } DIAG_STAMP(pc); } ++pc;

    PHASE_BEGIN p0_prologue(F, args); PHASE_END
    PHASE_BEGIN
        pg8::Gemm g{XN, (const bf16_t*)(ws + WS_W_IN0), M, N_IN0, DM}; pg8::StaticOrder S; S.init(M, N_IN0, F.G, (int)blockIdx.x);
        pg8::EpiBf16G E{(bf16_t*)(ws + WS_P), N_IN0, 4, (const float*)(ws + WS_RSQ)};
        pg8::gemm_phase<pg8::EpiBf16G, pg8::StaticOrder, PG8_ALIGN, PG8_SP2>(F.lds + RING_OFF, g, S, E);
        convert_in_tail(F, args, ws, (M / 256) * (N_IN0 / 256), CB_P0_END, CB_1_END);
    PHASE_END
    PHASE_BEGIN mixer_phase(F, args, ws); PHASE_END
    PHASE_BEGIN
        pg8::Gemm g{(const bf16_t*)(ws + WS_Y), (const bf16_t*)(ws + WS_W_OUT0), M, DM, DM}; pg8::StaticOrder S; S.init(M, DM, F.G, (int)blockIdx.x);
        pg8::EpiRes E{XN, (float*)(ws + WS_RSQ)};
        pg8::gemm_phase<pg8::EpiRes, pg8::StaticOrder, PG8_ALIGN, PG8_SP2>(F.lds + RING_OFF, g, S, E);
    PHASE_END
#define RMS_PHASE(gain_ptr) PHASE_BEGIN { const float* gain = (gain_ptr); const int lane = lane_id(); const int gw = F.vcu * NWAVES + F.wave, NGW = F.G * NWAVES; \
        for (int m = gw; m < M; m += NGW) rms_row_to_bf16(out + (size_t)m * DM, gain, XN + (size_t)m * DM, lane); } PHASE_END
#define UP_PHASE(layer, abuf) PHASE_BEGIN { pg8::Gemm g{(const bf16_t*)(ws + (abuf)), (const bf16_t*)(ws + WS_W_UP) + (size_t)(layer) * NUP * DM, M, NUP, DM}; pg8::StaticOrder S; S.init(M, NUP, F.G, (int)blockIdx.x); \
        pg8::EpiUpConv E{(bf16_t*)(ws + WS_HMID), args.in[20] + (size_t)(layer) * 3 * DFF, args.in[21] + (size_t)(layer) * DFF, (float*)(ws + WS_HALO), (float*)(ws + WS_TOPS), (float*)(ws + WS_TOPG), (const float*)(ws + WS_RSQ)}; \
        pg8::gemm_phase<pg8::EpiUpConv, pg8::StaticOrder, true, PG8_SP2>(F.lds + RING_OFF, g, S, E); \
        if ((layer) == 0) convert_in_tail(F, args, ws, (M / 256) * (NUP / 256), CB_1_END, CB_2_END); } PHASE_END
#define DOWN_PHASE(layer) PHASE_BEGIN { pg8::Gemm g{(const bf16_t*)(ws + WS_HMID), (const bf16_t*)(ws + WS_W_DN) + (size_t)(layer) * DM * DFF, M, DM, DFF}; pg8::StaticOrder S; S.init(M, DM, F.G, (int)blockIdx.x); \
        pg8::EpiRes E{XN, (float*)(ws + WS_RSQ)}; \
        pg8::gemm_phase<pg8::EpiRes, pg8::StaticOrder, PG8_ALIGN, PG8_SP2>(F.lds + RING_OFF, g, S, E); } PHASE_END
    UP_PHASE(0, WS_XN)
    PHASE_BEGIN ffn_fix_phase(F, args, ws, 0); PHASE_END
    DOWN_PHASE(0)
    PHASE_BEGIN
        pg8::Gemm g{XN, (const bf16_t*)(ws + WS_W_QKV), M, N_QKV, DM}; pg8::StaticOrder S; S.init(M, N_QKV, F.G, (int)blockIdx.x);
        pg8::EpiQKV E{(bf16_t*)(ws + WS_QKV), (const float*)(ws + WS_ROPE), (const float*)(ws + WS_RSQ)};
        pg8::gemm_phase<pg8::EpiQKV, pg8::StaticOrder, PG8_ALIGN, PG8_SP2>(F.lds + RING_OFF, g, S, E);
    PHASE_END
    PHASE_BEGIN
        { const SchedC SC{F.vcu, F.G, (attn_body::bf16*)(ws + WS_QKV), (attn_body::bf16*)(ws + WS_OCA)};
          attn_body::attn_phase<SchedC, 8, false>((char*)lds + RING_OFF, SC); }
        { const SchedD SD{F.vcu, F.G, (attn_body::bf16*)(ws + WS_QKV), (float*)(ws + WS_LSE)};
          attn_body::attn_phase<SchedD, 8, true>((char*)lds + RING_OFF, SD); }
    PHASE_END
    PHASE_BEGIN post_attention_phase(F, args, ws); PHASE_END
    PHASE_BEGIN
        pg8::Gemm g{(const bf16_t*)(ws + WS_QKV) + Y1_COL, (const bf16_t*)(ws + WS_W_OUT1), M, DM, DM, N_QKV}; pg8::StaticOrder S; S.init(M, DM, F.G, (int)blockIdx.x);
        pg8::EpiRes E{XN, (float*)(ws + WS_RSQ)};
        pg8::gemm_phase<pg8::EpiRes, pg8::StaticOrder, PG8_ALIGN, PG8_SP2>(F.lds + RING_OFF, g, S, E);
    PHASE_END
    UP_PHASE(1, WS_XN)
    PHASE_BEGIN ffn_fix_phase(F, args, ws, 1); PHASE_END
    DOWN_PHASE(1)
    PHASE_BEGIN
        const int lane = lane_id(); const int gw = F.vcu * NWAVES + F.wave, NGW = F.G * NWAVES;
        for (int m = gw; m < M; m += NGW) rms_row_final(XN + (size_t)m * DM, out + (size_t)m * DM, args.in[4], (const float*)(ws + WS_RSQ) + (size_t)m * 4, lane);
    PHASE_END
#ifdef MK_DIAG
    __syncthreads();
    if (blockIdx.x == 0 && threadIdx.x < 64) {
        asm volatile("s_waitcnt vmcnt(0)" ::: "memory");
        const unsigned long long* st = (const unsigned long long*)(args.ws + WS_CTL + 524288);
        const unsigned long long a1 = __hip_atomic_load(st + MK_DIAG_SEL1, __ATOMIC_RELAXED, __HIP_MEMORY_SCOPE_AGENT), b1 = __hip_atomic_load(st + (MK_DIAG_SEL1 == 0 ? 31 : MK_DIAG_SEL1 - 1), __ATOMIC_RELAXED, __HIP_MEMORY_SCOPE_AGENT);
        const unsigned long long a2 = __hip_atomic_load(st + MK_DIAG_SEL2, __ATOMIC_RELAXED, __HIP_MEMORY_SCOPE_AGENT), b2 = __hip_atomic_load(st + (MK_DIAG_SEL2 == 0 ? 31 : MK_DIAG_SEL2 - 1), __ATOMIC_RELAXED, __HIP_MEMORY_SCOPE_AGENT);
        const float d1 = (float)(long long)(a1 - b1) * 0.01f, d2 = (float)(long long)(a2 - b2) * 0.01f;
        for (int i = threadIdx.x; i <= 4096; i += 64) args.out[i] = (i == 0) ? d1 : d2;
    }
#endif
#undef PHASE_BEGIN
#undef PHASE_END
}
constexpr int N_PHASES = 15;

#ifndef MK_N_LAUNCHES
#define MK_N_LAUNCHES 1
#endif
extern "C" void kernel_launch(void* const* d_in, const int* in_sizes, int n_in, void* d_out, int out_size, void* d_ws, size_t ws_size, hipStream_t stream) {
    static int grid = 0;
    if (grid == 0) {
        int dev = 0, cus = 0;
        if (hipGetDevice(&dev) != hipSuccess || hipDeviceGetAttribute(&cus, hipDeviceAttributeMultiprocessorCount, dev) != hipSuccess) { fprintf(stderr, "kernel_launch: device query failed\n"); grid = -1; return; }
        if (hipFuncSetAttribute((const void*)mk_fwd, hipFuncAttributeMaxDynamicSharedMemorySize, LDS_BYTES) != hipSuccess) { fprintf(stderr, "kernel_launch: hipFuncSetAttribute failed\n"); grid = -1; return; }
        int per_cu = 0;
        if (hipOccupancyMaxActiveBlocksPerMultiprocessor(&per_cu, (const void*)mk_fwd, NWAVES * 64, LDS_BYTES) != hipSuccess || per_cu < 1) fprintf(stderr, "kernel_launch: occupancy query reports %d workgroups per CU\n", per_cu);
        (void)hipGetLastError();
        grid = cus > 0 ? cus : 256;
    }
    if (grid < 0) return;
    unsigned char* ws = (unsigned char*)d_ws;
    (void)hipMemsetAsync(ws + WS_CTL, 0, CTL_ZERO_BYTES, stream);
    Args a{};
    for (int i = 0; i < 23; ++i) a.in[i] = (const float*)d_in[i];
    a.out = (float*)d_out; a.ws = ws;
#ifdef MK_DUP_PHASE
    if (true) {
        a.li = 0; a.ph_lo = 0; a.ph_hi = MK_DUP_PHASE + 1; hipLaunchKernelGGL(mk_fwd, dim3(grid), dim3(NWAVES * 64), LDS_BYTES, stream, a);
        a.li = 1; a.ph_lo = MK_DUP_PHASE; a.ph_hi = MK_DUP_PHASE + 1; hipLaunchKernelGGL(mk_fwd, dim3(grid), dim3(NWAVES * 64), LDS_BYTES, stream, a);
        a.li = 2; a.ph_lo = MK_DUP_PHASE + 1; a.ph_hi = N_PHASES; hipLaunchKernelGGL(mk_fwd, dim3(grid), dim3(NWAVES * 64), LDS_BYTES, stream, a);
    } else
#endif
    if (MK_N_LAUNCHES == 1) {
        a.ph_lo = 0; a.ph_hi = N_PHASES;
        hipLaunchKernelGGL(mk_fwd, dim3(grid), dim3(NWAVES * 64), LDS_BYTES, stream, a);
    } else {
        for (int p = 0; p < N_PHASES; ++p) { a.ph_lo = p; a.ph_hi = p + 1; hipLaunchKernelGGL(mk_fwd, dim3(grid), dim3(NWAVES * 64), LDS_BYTES, stream, a); }
    }
}
```

```cpp
#include <hip/hip_runtime.h>
#include <cstdint>
#include <cstdio>

typedef unsigned short bf16_t;
typedef short bf16x8 __attribute__((ext_vector_type(8)));
typedef float f32x4 __attribute__((ext_vector_type(4)));
typedef float f32x2 __attribute__((ext_vector_type(2)));
typedef unsigned u32x4 __attribute__((ext_vector_type(4)));
typedef unsigned u32x2 __attribute__((ext_vector_type(2)));

constexpr int BATCH = 4, SEQ = 4096, DM = 1024, M = BATCH * SEQ;
constexpr int DFF = 2816, NUP = 2 * DFF;
constexpr int N_IN0 = 1536, N_QKV = 4608;
constexpr float EPS = 1e-6f;
constexpr float LAMBDA_INIT = 0.35550906759f;

__device__ __forceinline__ float bf2f(bf16_t v) { return __uint_as_float(((unsigned)v) << 16); }
__device__ __forceinline__ bf16_t f2bf(float f) { unsigned u = __float_as_uint(f); return (bf16_t)((u + 0x7fffu + ((u >> 16) & 1u)) >> 16); }
__device__ __forceinline__ unsigned pk2bf(float lo, float hi) { return (unsigned)f2bf(lo) | ((unsigned)f2bf(hi) << 16); }
__device__ __forceinline__ float gelu_tanh(float x) {
    const float y = x * (0.7978845608028654f + 0.035677408136300125f * x * x);
    return x * __builtin_amdgcn_rcpf(1.0f + __builtin_amdgcn_exp2f(-2.8853900817779268f * y));
}
template <int CTRL> __device__ __forceinline__ float dpp_f(float v) { return __int_as_float(__builtin_amdgcn_update_dpp(0, __float_as_int(v), CTRL, 0xf, 0xf, true)); }
__device__ __forceinline__ float swz_xor16(float v) { return __int_as_float(__builtin_amdgcn_ds_swizzle(__float_as_int(v), 0x401F)); }
__device__ __forceinline__ float wave_sum(float v) {
    v += dpp_f<0xB1>(v);
    v += dpp_f<0x4E>(v);
    v += dpp_f<0x141>(v);
    v += dpp_f<0x140>(v);
    v += swz_xor16(v);
    const auto rr = __builtin_amdgcn_permlane32_swap(__float_as_uint(v), __float_as_uint(v), false, false);
    return __uint_as_float(rr[0]) + __uint_as_float(rr[1]);
}

constexpr size_t MiB = 1u << 20;
constexpr size_t WS_CTL = 0, CTL_ZERO_BYTES = 1 * MiB;
constexpr size_t WS_W_IN0 = 1 * MiB;
constexpr size_t WS_W_OUT0 = 4 * MiB;
constexpr size_t WS_W_QKV = 6 * MiB;
constexpr size_t WS_W_OUT1 = 15 * MiB;
constexpr size_t WS_W_UP = 17 * MiB;
constexpr size_t WS_W_DN = 39 * MiB;
constexpr size_t WS_ROPE = 50 * MiB;
constexpr size_t WS_WSB = 51 * MiB;
constexpr size_t WS_PWT = 51 * MiB + 256 * 1024;
constexpr size_t WS_XN = 52 * MiB;
constexpr size_t WS_BUF = 84 * MiB;
constexpr size_t WS_P = WS_BUF, WS_Y = 132 * MiB;
constexpr size_t WS_HMID = 116 * MiB;
constexpr size_t WS_HALO = 204 * MiB, WS_TOPS = 206 * MiB, WS_TOPG = 208 * MiB;
constexpr size_t WS_QKV = WS_BUF;
constexpr int Y1_COL = 768;
constexpr size_t WS_OCA = 228 * MiB;
constexpr size_t WS_RSQ = 253 * MiB;
constexpr size_t WS_LSE = 252 * MiB;
namespace pg8 {
#define PG8_LAS __attribute__((address_space(3)))
typedef unsigned short bf16_t;
typedef short bf16x8 __attribute__((ext_vector_type(8)));
typedef float f32x4 __attribute__((ext_vector_type(4)));
typedef unsigned u32x4 __attribute__((ext_vector_type(4)));
constexpr int BM = 256, BK = 64, HALF = 128, HTB = HALF * BK * 2  , STAGE_BYTES = 8 * HTB, NXCD = 8, WGM = 8;

__host__ __device__ __forceinline__ int lds_byte(int r, int c) { const int st = (r >> 4) * 2 + (c >> 5), rr = r & 15, cc = c & 31, ob = rr * 64 + cc * 2; return st * 1024 + (ob ^ (((ob >> 9) & 1) << 5)); }
__host__ __device__ __forceinline__ void stage_rc(int b, int& R, int& C) { const int st = b / 1024, sb = b % 1024, swz = sb ^ (((sb >> 9) & 1) << 5); R = (st >> 1) * 16 + swz / 64; C = (st & 1) * 32 + (swz % 64) / 2; }
__host__ __device__ __forceinline__ int perm32(int rho) { const int n = rho >> 4, i = rho & 15; return 8 * (i >> 2) + 4 * n + (i & 3); }

struct Unit { int pm, pn; };
struct Gemm { const bf16_t* A; const bf16_t* Bt; int M, N, K, lda; };

struct StaticOrder {
    int nM, nN, nwg, G, c;
    __host__ __device__ void init(int M, int N, int G_, int c_) { nM = M / BM; nN = N / BM; nwg = nM * nN; G = G_; c = c_; }
    __host__ __device__ bool next(int i, Unit& u) const {
        const long L = (long)i * G + c; if (L >= nwg) return false;
        int wgid = (int)L; { const int q = nwg / NXCD, r = nwg % NXCD, xcd = wgid % NXCD, off = wgid / NXCD; wgid = (xcd < r ? xcd * (q + 1) : r * (q + 1) + (xcd - r) * q) + off; }
        const int nig = WGM * nN, gid = wgid / nig, fm = gid * WGM, gsz = (nM - fm) < WGM ? (nM - fm) : WGM;
        u.pm = fm + ((wgid % nig) % gsz); u.pn = (wgid % nig) / gsz; return true;
    }
    __device__ __forceinline__ void a_ready(const Unit&) const {}
    __device__ __forceinline__ void done(const Unit&) const {}
};


__device__ __forceinline__ unsigned cvt_pk_bf16(float lo, float hi) { unsigned r; asm volatile("v_cvt_pk_bf16_f32 %0, %1, %2" : "=v"(r) : "v"(lo), "v"(hi)); return r; }

__device__ __forceinline__ float rstd_of(const f32x4 p) { return rsqrtf(((p[0] + p[1]) + (p[2] + p[3])) * (1.f / 1024.f) + 1e-6f); }
struct EpiBf16G {
    static constexpr bool PERM = true, AFTER_DRAIN = false;
    bf16_t* O; int ldc; int gelu_tiles; const float* rsq;
    __device__ __forceinline__ void operator()(const f32x4 (&acc)[2][2][4][2], const Unit& u, int wr, int wc, int fr, int fq) const {
        const int row0 = u.pm * BM + wr * 64 + fr, col0 = u.pn * BM + wc * 32 + 8 * fq;
        const bool g = u.pn < gelu_tiles;
        f32x4 pr[2][4];
#pragma unroll
        for (int ai = 0; ai < 2; ++ai)
#pragma unroll
            for (int m = 0; m < 4; ++m) pr[ai][m] = *(const f32x4*)(rsq + (size_t)(row0 + ai * HALF + m * 16) * 4);
#pragma unroll
        for (int ai = 0; ai < 2; ++ai)
#pragma unroll
            for (int m = 0; m < 4; ++m) { bf16_t* rowp = O + (size_t)(row0 + ai * HALF + m * 16) * ldc + col0; const float rstd = rstd_of(pr[ai][m]);
#pragma unroll
                for (int bj = 0; bj < 2; ++bj) { f32x4 v0 = acc[ai][bj][m][0] * rstd, v1 = acc[ai][bj][m][1] * rstd;
                    if (g) { v0 = (f32x4){gelu_tanh(v0[0]), gelu_tanh(v0[1]), gelu_tanh(v0[2]), gelu_tanh(v0[3])}; v1 = (f32x4){gelu_tanh(v1[0]), gelu_tanh(v1[1]), gelu_tanh(v1[2]), gelu_tanh(v1[3])}; }
                    u32x4 w; w.x = cvt_pk_bf16(v0[0], v0[1]); w.y = cvt_pk_bf16(v0[2], v0[3]); w.z = cvt_pk_bf16(v1[0], v1[1]); w.w = cvt_pk_bf16(v1[2], v1[3]);
                    *(u32x4*)(rowp + bj * HALF) = w; } }
    }
};
constexpr int XCH_LDS_OFF = 132096;
struct EpiRes {
    static constexpr bool PERM = false, AFTER_DRAIN = false;
    bf16_t* hb; float* rsq;
    __device__ __forceinline__ void operator()(const f32x4 (&acc)[2][2][4][2], const Unit& u, int wr, int wc, int fr, int fq) const {
        extern __shared__ __attribute__((aligned(16))) unsigned char lds_all_[];
        PG8_LAS float* S = (PG8_LAS float*)((PG8_LAS unsigned char*)lds_all_ + XCH_LDS_OFF);
        const int row0 = u.pm * BM + wr * 64 + fr, col0 = u.pn * BM + wc * 32 + 4 * fq;
#pragma unroll
        for (int ai = 0; ai < 2; ++ai) {
            u32x2 bs[4][2][2];
#pragma unroll
            for (int m = 0; m < 4; ++m)
#pragma unroll
                for (int bj = 0; bj < 2; ++bj)
#pragma unroll
                    for (int n = 0; n < 2; ++n) bs[m][bj][n] = *(const u32x2*)(hb + (size_t)(row0 + ai * HALF + m * 16) * 1024 + col0 + bj * HALF + n * 16);
#pragma unroll
            for (int m = 0; m < 4; ++m) { const int row = row0 + ai * HALF + m * 16; const size_t off = (size_t)row * 1024 + col0; float q = 0.f;
#pragma unroll
                for (int bj = 0; bj < 2; ++bj)
#pragma unroll
                    for (int n = 0; n < 2; ++n) { const u32x2 b = bs[m][bj][n];
                        const f32x4 h = (f32x4){__uint_as_float(b.x << 16), __uint_as_float(b.x & 0xffff0000u), __uint_as_float(b.y << 16), __uint_as_float(b.y & 0xffff0000u)} + acc[ai][bj][m][n];
                        q += (h[0] * h[0] + h[1] * h[1]) + (h[2] * h[2] + h[3] * h[3]);
                        u32x2 w; w.x = cvt_pk_bf16(h[0], h[1]); w.y = cvt_pk_bf16(h[2], h[3]); *(u32x2*)(hb + off + bj * HALF + n * 16) = w; }
                q += swz_xor16(q);
                { const auto rr = __builtin_amdgcn_permlane32_swap(__float_as_uint(q), __float_as_uint(q), false, false); q = __uint_as_float(rr[0]) + __uint_as_float(rr[1]); }
                if (fq == 0) S[(ai * HALF + wr * 64 + m * 16 + fr) * 4 + wc] = q; }
        }
        asm volatile("s_waitcnt lgkmcnt(0)" ::: "memory"); __builtin_amdgcn_s_barrier(); asm volatile("" ::: "memory");
        const int t = (int)threadIdx.x;
        if (t < 256) { const f32x4 p = *(const PG8_LAS f32x4*)(S + t * 4); rsq[(size_t)(u.pm * BM + t) * 4 + u.pn] = (p[0] + p[1]) + (p[2] + p[3]); }
    }
};
constexpr float ATT_C2 = 0.125f * 1.4426950408889634f;
struct EpiQKV {
    static constexpr bool PERM = true, AFTER_DRAIN = false;
    bf16_t* O; const int* pos; const float* rsq;
    __device__ __forceinline__ void operator()(const f32x4 (&acc)[2][2][4][2], const Unit& u, int wr, int wc, int fr, int fq) const {
        const int row0 = u.pm * BM + wr * 64 + fr, col0 = u.pn * BM + wc * 32 + 8 * fq;
        const int pn = u.pn;
        const bool is_rope = (pn < 6) || (pn >= 9 && pn < 15);
        const bool is_q = (pn < 3) || (pn >= 9 && pn < 12);
        const float sc = is_q ? ATT_C2 : 1.f;
        const bool do_rot = is_rope && ((wc & 1) == 0);
        const float sgn = (fq == 0) ? -1.f : 1.f;
        f32x4 pr[2][4]; int ps[2][4];
#pragma unroll
        for (int ai = 0; ai < 2; ++ai)
#pragma unroll
            for (int m = 0; m < 4; ++m) { pr[ai][m] = *(const f32x4*)(rsq + (size_t)(row0 + ai * HALF + m * 16) * 4); ps[ai][m] = do_rot ? pos[row0 + ai * HALF + m * 16] : 0; }
        const f32x4 f0 = {0.15915494309189535f, 0.03086376340470123f, 0.005985185712713705f, 0.001160663641240061f};
        const f32x4 f1 = {0.00022507907903927653f, 4.364795279280289e-05f, 8.464330808241401e-06f, 1.6414262627950345e-06f};
#pragma unroll
        for (int ai = 0; ai < 2; ++ai)
#pragma unroll
            for (int m = 0; m < 4; ++m) { const int row = row0 + ai * HALF + m * 16; bf16_t* rowp = O + (size_t)row * 4608 + col0;
                f32x4 cs0 = {1.f, 1.f, 1.f, 1.f}, cs1 = cs0, sn0 = {0.f, 0.f, 0.f, 0.f}, sn1 = sn0;
                if (do_rot) { const float p = (float)ps[ai][m];
#pragma unroll
                    for (int e = 0; e < 4; ++e) { const float r0 = __builtin_amdgcn_fractf(p * f0[e]), r1 = __builtin_amdgcn_fractf(p * f1[e]);
                        cs0[e] = __builtin_amdgcn_cosf(r0); sn0[e] = __builtin_amdgcn_sinf(r0) * sgn; cs1[e] = __builtin_amdgcn_cosf(r1); sn1[e] = __builtin_amdgcn_sinf(r1) * sgn; } }
                const float rstd = rstd_of(pr[ai][m]) * sc;
#pragma unroll
                for (int bj = 0; bj < 2; ++bj) { f32x4 v0 = acc[ai][bj][m][0] * rstd, v1 = acc[ai][bj][m][1] * rstd;
                    if (do_rot) {
                        f32x4 p0, p1;
#pragma unroll
                        for (int e = 0; e < 4; ++e) { p0[e] = swz_xor16(v0[e]); p1[e] = swz_xor16(v1[e]); }
                        if (fq < 2) { v0 = v0 * cs0 + p0 * sn0; v1 = v1 * cs1 + p1 * sn1; }
                    }
                    u32x4 w; w.x = cvt_pk_bf16(v0[0], v0[1]); w.y = cvt_pk_bf16(v0[2], v0[3]); w.z = cvt_pk_bf16(v1[0], v1[1]); w.w = cvt_pk_bf16(v1[2], v1[3]);
                    *(u32x4*)(rowp + bj * HALF) = w; } }
    }
};

template <int CTRL> __device__ __forceinline__ f32x4 dpp4(f32x4 v) { return (f32x4){dpp_f<CTRL>(v[0]), dpp_f<CTRL>(v[1]), dpp_f<CTRL>(v[2]), dpp_f<CTRL>(v[3])}; }
struct EpiUpConv {
    static constexpr bool PERM = true, AFTER_DRAIN = false;
    bf16_t* HM; const float* cw; const float* cb; float* halo; float* tops; float* topg; const float* rsq;
    __device__ __forceinline__ void operator()(const f32x4 (&acc)[2][2][4][2], const Unit& u, int wr_, int wc_, int fr_, int fq_) const {
        int tid_ = threadIdx.x; asm volatile("" : "+v"(tid_));
        const int wid_ = __builtin_amdgcn_readfirstlane(tid_ >> 6), wr = wid_ >> 2, wc = wid_ & 3, fr = tid_ & 15, fq = (tid_ >> 4) & 3; (void)wr_; (void)wc_; (void)fr_; (void)fq_;
        extern __shared__ __attribute__((aligned(16))) unsigned char lds_all_[];
        PG8_LAS float* X = (PG8_LAS float*)((PG8_LAS unsigned char*)lds_all_ + XCH_LDS_OFF);
        const int cl = wc * 32 + 8 * fq, hc = u.pn * 128 + cl;
        float rstd[2][4];
        { f32x4 pr[2][4];
#pragma unroll
          for (int ai = 0; ai < 2; ++ai)
#pragma unroll
              for (int m = 0; m < 4; ++m) pr[ai][m] = *(const f32x4*)(rsq + (size_t)(u.pm * BM + ai * HALF + wr * 64 + m * 16 + fr) * 4);
#pragma unroll
          for (int ai = 0; ai < 2; ++ai)
#pragma unroll
              for (int m = 0; m < 4; ++m) rstd[ai][m] = rstd_of(pr[ai][m]); }
        if (fr >= 14) {
#pragma unroll
            for (int ai = 0; ai < 2; ++ai) { PG8_LAS float* xp = X + (((ai * 2 + wr) * 2 + (fr - 14)) * 128 + cl);
                *(PG8_LAS f32x4*)xp = acc[ai][0][3][0] * rstd[ai][3]; *(PG8_LAS f32x4*)(xp + 4) = acc[ai][0][3][1] * rstd[ai][3]; }
            if (wr == 1) { float* hp = halo + ((size_t)u.pm * 2 + (fr - 14)) * 2816 + hc; *(f32x4*)hp = acc[1][0][3][0] * rstd[1][3]; *(f32x4*)(hp + 4) = acc[1][0][3][1] * rstd[1][3]; }
        }
        asm volatile("s_waitcnt lgkmcnt(0)" ::: "memory"); __builtin_amdgcn_s_barrier(); asm volatile("" ::: "memory");
        const bool needs_fix = (u.pm & 15) != 0;
#pragma unroll
        for (int n = 0; n < 2; ++n) {
            const f32x4 w0 = *(const f32x4*)(cw + hc + 4 * n), w1 = *(const f32x4*)(cw + 2816 + hc + 4 * n), w2 = *(const f32x4*)(cw + 2 * 2816 + hc + 4 * n), bb = *(const f32x4*)(cb + hc + 4 * n);
#pragma unroll
            for (int ai = 0; ai < 2; ++ai) {
                f32x4 pa, pb;
                const bool has_pred = !(ai == 0 && wr == 0);
                const int pblk = (wr == 1) ? (ai * 2) : 1;
                if (has_pred) { pa = *(const PG8_LAS f32x4*)(X + ((pblk * 2 + 1) * 128 + cl + 4 * n)); pb = *(const PG8_LAS f32x4*)(X + ((pblk * 2 + 0) * 128 + cl + 4 * n)); }
                else { pa = (f32x4){0.f, 0.f, 0.f, 0.f}; pb = pa; }
                f32x4 r1p = pa, r2p = (fr == 1) ? pa : pb;
                size_t ho = (size_t)(u.pm * BM + ai * HALF + wr * 64 + fr) * 2816 + hc + 4 * n; asm volatile("" : "+v"(ho));
#pragma unroll
                for (int m = 0; m < 4; ++m) {
                    const f32x4 x = acc[ai][0][m][n] * rstd[ai][m];
                    const f32x4 R1 = dpp4<0x121>(x), R2 = dpp4<0x122>(x);
                    const f32x4 p1 = (fr >= 1) ? R1 : r1p;
                    const f32x4 p2 = (fr >= 2) ? R2 : r2p;
                    const f32x4 sv = w2 * x + w1 * p1 + w0 * p2 + bb;
                    r1p = R1; r2p = R2;
                    const f32x4 g = acc[ai][1][m][n] * rstd[ai][m];
                    if (ai == 0 && m == 0) { if (wr == 0 && fr < 2 && needs_fix) { const size_t off = ((size_t)u.pm * 2 + fr) * 2816 + hc + 4 * n; *(f32x4*)(tops + off) = sv; *(f32x4*)(topg + off) = g; } }
                    u32x2 w; w.x = cvt_pk_bf16(gelu_tanh(sv[0]) * g[0], gelu_tanh(sv[1]) * g[1]); w.y = cvt_pk_bf16(gelu_tanh(sv[2]) * g[2], gelu_tanh(sv[3]) * g[3]);
                    *(u32x2*)(HM + ho) = w; ho += 16 * 2816;
                    asm volatile("" : "+v"(ho) :: "memory");
                }
            }
        }
    }
};
template <class Epi, class Sched, bool ALIGN_EPI = false, bool SP2 = false>
__device__ __forceinline__ void gemm_phase(PG8_LAS unsigned char* lds, const Gemm g, const Sched& S, const Epi& E) {
    int tid_ = threadIdx.x; asm volatile("" : "+v"(tid_));
    const int tid = tid_, wid = __builtin_amdgcn_readfirstlane(tid >> 6), lane = tid & 63, wr = wid >> 2, wc = wid & 3, fr = lane & 15, fq = lane >> 4;
    const int K = g.K, nt = K / BK, LDA = g.lda ? g.lda : g.K;
    unsigned voffA[2], voffB[2];
#pragma unroll
    for (int i = 0; i < 2; ++i) { int R, C; stage_rc(tid * 16 + i * 8192, R, C); const int Rb = Epi::PERM ? ((R & ~31) + perm32(R & 31)) : R;
        voffA[i] = (unsigned)(R * LDA + C) * 2u; voffB[i] = (unsigned)(Rb * K + C) * 2u; }
    const size_t kstep = (size_t)(BK * 2);
    const size_t hstep = (size_t)HALF * K * 2;
    const size_t tstep = 2 * hstep;
    const size_t hstepA = (size_t)HALF * LDA * 2, tstepA = 2 * hstepA;
    const unsigned ldsw = (unsigned)wid * 1024u;
    const int aoff = lds_byte(wr * 64 + fr, fq * 8), boff = lds_byte(wc * 32 + fr, fq * 8);
#define PG8_SA(b, h) (((b) * 2 + (h)) * HTB)
#define PG8_SB(b, h) ((4 + (b) * 2 + (h)) * HTB)
#define PG8_STAGE(bufoff, gbase, voff) do { _Pragma("unroll") for (int _i = 0; _i < 2; ++_i) \
        __builtin_amdgcn_global_load_lds((const unsigned*)((const char*)(gbase) + (voff)[_i]), (PG8_LAS unsigned*)(lds + (bufoff) + ldsw + _i * 8192), 16, 0, 0); } while (0)
#define PG8_LDA(dst, b, h) do { _Pragma("unroll") for (int m = 0; m < 4; ++m) _Pragma("unroll") for (int k = 0; k < 2; ++k) dst[m][k] = *(const PG8_LAS bf16x8*)(lds + PG8_SA(b, h) + aoff + m * 2048 + k * 1024); } while (0)
#define PG8_LDB(dst, b, h) do { _Pragma("unroll") for (int n = 0; n < 2; ++n) _Pragma("unroll") for (int k = 0; k < 2; ++k) dst[n][k] = *(const PG8_LAS bf16x8*)(lds + PG8_SB(b, h) + boff + n * 2048 + k * 1024); } while (0)
#define PG8_MMA(ai, bj, At, Bt) do { __builtin_amdgcn_s_setprio(1); _Pragma("unroll") for (int m = 0; m < 4; ++m) _Pragma("unroll") for (int n = 0; n < 2; ++n) _Pragma("unroll") for (int k = 0; k < 2; ++k) \
        acc[ai][bj][m][n] = __builtin_amdgcn_mfma_f32_16x16x32_bf16(Bt[n][k], At[m][k], acc[ai][bj][m][n], 0, 0, 0); __builtin_amdgcn_s_setprio(0); } while (0)
#define PG8_WAIT_V(n) asm volatile("s_waitcnt vmcnt(" #n ")" ::: "memory")
#define PG8_WAIT_L(n) asm volatile("s_waitcnt lgkmcnt(" #n ")" ::: "memory")
#define PG8_BAR __builtin_amdgcn_s_barrier()
#define PG8_SCHED __builtin_amdgcn_sched_barrier(0)
    Unit cur, nxt; int ui = 0;
    if (!S.next(0, cur)) return;
    f32x4 acc[2][2][4][2];
#pragma unroll
    for (int a = 0; a < 2; ++a)
#pragma unroll
        for (int b = 0; b < 2; ++b)
#pragma unroll
            for (int m = 0; m < 4; ++m)
#pragma unroll
                for (int n = 0; n < 2; ++n) acc[a][b][m][n] = (f32x4){0.f, 0.f, 0.f, 0.f};
    bf16x8 At[4][2], B0[2][2], B1[2][2];
    const char* cA = (const char*)g.A + (size_t)cur.pm * tstepA; const char* cB = (const char*)g.Bt + (size_t)cur.pn * tstep;
    S.a_ready(cur);
    if constexpr (SP2) {
        PG8_STAGE(PG8_SB(0, 0), cB, voffB); PG8_STAGE(PG8_SB(0, 1), cB + hstep, voffB); PG8_STAGE(PG8_SA(0, 0), cA, voffA); PG8_STAGE(PG8_SA(0, 1), cA + hstepA, voffA);
        if (wr == 1) PG8_BAR;
        PG8_WAIT_V(2); PG8_BAR;
        PG8_STAGE(PG8_SB(1, 0), cB + kstep, voffB); PG8_STAGE(PG8_SA(1, 0), cA + kstep, voffA); PG8_STAGE(PG8_SB(1, 1), cB + hstep + kstep, voffB);
        PG8_WAIT_V(6); PG8_BAR;
    } else {
        PG8_STAGE(PG8_SB(0, 0), cB, voffB); PG8_STAGE(PG8_SA(0, 0), cA, voffA); PG8_STAGE(PG8_SB(0, 1), cB + hstep, voffB); PG8_STAGE(PG8_SA(0, 1), cA + hstepA, voffA);
        if (wr == 1) PG8_BAR;
        PG8_WAIT_V(4); PG8_BAR;
        PG8_STAGE(PG8_SB(1, 0), cB + kstep, voffB); PG8_STAGE(PG8_SA(1, 0), cA + kstep, voffA); PG8_STAGE(PG8_SB(1, 1), cB + hstep + kstep, voffB);
        PG8_WAIT_V(6); PG8_BAR;
    }
    for (;;) {
        const bool has_next = S.next(ui + 1, nxt);
        const char* nA = has_next ? (const char*)g.A + (size_t)nxt.pm * tstepA : cA; const char* nB = has_next ? (const char*)g.Bt + (size_t)nxt.pn * tstep : cB;
        for (int t = 0; t < nt; t += 2) {
            const bool last = (t == nt - 2);
            const char* a1 = cA + (size_t)(t + 1) * kstep;
            const char* a2 = last ? nA : cA + (size_t)(t + 2) * kstep; const char* b2 = last ? nB : cB + (size_t)(t + 2) * kstep;
            const char* a3 = a2 + kstep; const char* b3 = b2 + kstep;
            if (last && has_next) S.a_ready(nxt);
            if constexpr (SP2) {
            PG8_LDB(B0, 0, 0); PG8_LDB(B1, 0, 1); PG8_SCHED; PG8_LDA(At, 0, 0); PG8_STAGE(PG8_SA(1, 1), a1 + hstepA, voffA);
            PG8_WAIT_V(8); PG8_WAIT_L(0); PG8_BAR; PG8_MMA(0, 0, At, B0); PG8_MMA(0, 1, At, B1); PG8_BAR; PG8_SCHED;
            PG8_LDA(At, 0, 1); PG8_STAGE(PG8_SB(0, 0), b2, voffB); PG8_STAGE(PG8_SB(0, 1), b2 + hstep, voffB); PG8_STAGE(PG8_SA(0, 0), a2, voffA);
            PG8_WAIT_V(8); PG8_WAIT_L(0); PG8_BAR; PG8_MMA(1, 0, At, B0); PG8_MMA(1, 1, At, B1); PG8_BAR; PG8_SCHED;
            PG8_LDB(B0, 1, 0); PG8_LDB(B1, 1, 1); PG8_SCHED; PG8_LDA(At, 1, 0); PG8_STAGE(PG8_SA(0, 1), a2 + hstepA, voffA);
            PG8_WAIT_V(8); PG8_WAIT_L(0); PG8_BAR; PG8_MMA(0, 0, At, B0); PG8_MMA(0, 1, At, B1); PG8_BAR; PG8_SCHED;
            PG8_LDA(At, 1, 1); PG8_STAGE(PG8_SB(1, 0), b3, voffB); PG8_STAGE(PG8_SB(1, 1), b3 + hstep, voffB); PG8_STAGE(PG8_SA(1, 0), a3, voffA);
            PG8_WAIT_V(8); PG8_WAIT_L(0); PG8_BAR; PG8_MMA(1, 0, At, B0); PG8_MMA(1, 1, At, B1); PG8_BAR; PG8_SCHED;
            } else {
            PG8_LDB(B0, 0, 0); PG8_SCHED; PG8_LDA(At, 0, 0); PG8_STAGE(PG8_SA(1, 1), a1 + hstepA, voffA);
            PG8_WAIT_L(8); PG8_BAR; PG8_WAIT_L(0); PG8_MMA(0, 0, At, B0); PG8_BAR; PG8_SCHED;
            PG8_LDB(B1, 0, 1); PG8_STAGE(PG8_SB(0, 0), b2, voffB);
            PG8_BAR; PG8_WAIT_L(0); PG8_MMA(0, 1, At, B1); PG8_BAR;
            PG8_LDA(At, 0, 1); PG8_STAGE(PG8_SA(0, 0), a2, voffA);
            PG8_BAR; PG8_WAIT_L(0); PG8_MMA(1, 0, At, B0); PG8_BAR; PG8_SCHED;
            PG8_STAGE(PG8_SB(0, 1), b2 + hstep, voffB);
            PG8_WAIT_V(6); PG8_BAR; PG8_MMA(1, 1, At, B1); PG8_BAR;
            PG8_LDB(B0, 1, 0); PG8_SCHED; PG8_LDA(At, 1, 0); PG8_STAGE(PG8_SA(0, 1), a2 + hstepA, voffA);
            PG8_WAIT_L(8); PG8_BAR; PG8_WAIT_L(0); PG8_MMA(0, 0, At, B0); PG8_BAR; PG8_SCHED;
            PG8_LDB(B1, 1, 1); PG8_STAGE(PG8_SB(1, 0), b3, voffB);
            PG8_BAR; PG8_WAIT_L(0); PG8_MMA(0, 1, At, B1); PG8_BAR;
            PG8_LDA(At, 1, 1); PG8_STAGE(PG8_SA(1, 0), a3, voffA);
            PG8_BAR; PG8_WAIT_L(0); PG8_MMA(1, 0, At, B0); PG8_BAR; PG8_SCHED;
            PG8_STAGE(PG8_SB(1, 1), b3 + hstep, voffB);
            PG8_WAIT_V(6); PG8_BAR; PG8_MMA(1, 1, At, B1); PG8_BAR;
            }
        }
        if constexpr (ALIGN_EPI) { if (wr == 0) PG8_BAR; }
        if constexpr (!Epi::AFTER_DRAIN) { E(acc, cur, wr, wc, fr, fq); S.done(cur); }
        if (!has_next) break;
#pragma unroll
        for (int a = 0; a < 2; ++a)
#pragma unroll
            for (int b = 0; b < 2; ++b)
#pragma unroll
                for (int m = 0; m < 4; ++m)
#pragma unroll
                    for (int n = 0; n < 2; ++n) acc[a][b][m][n] = (f32x4){0.f, 0.f, 0.f, 0.f};
        cur = nxt; cA = nA; cB = nB; ++ui;
        if constexpr (ALIGN_EPI) { if (wr == 1) PG8_BAR; }
    }
    PG8_WAIT_V(0);
    if constexpr (!ALIGN_EPI) { if (wr == 0) PG8_BAR; }
    PG8_BAR;
    if constexpr (Epi::AFTER_DRAIN) { E.fused(acc, cur, wr, wc, fr, fq, lds, wid, lane); S.done(cur); }
#undef PG8_SA
#undef PG8_SB
#undef PG8_STAGE
#undef PG8_LDA
#undef PG8_LDB
#undef PG8_MMA
#undef PG8_WAIT_V
#undef PG8_WAIT_L
#undef PG8_BAR
#undef PG8_SCHED
}
}
#include <hip/hip_bf16.h>
#include <cmath>
namespace attn_body {
using bf16=__hip_bfloat16;
using bf16x8=__attribute__((ext_vector_type(8)))short;
using s16x4=__attribute__((ext_vector_type(4)))short;
using f32x16=__attribute__((ext_vector_type(16)))float;
using u32x4=__attribute__((ext_vector_type(4)))unsigned;
constexpr int D=64,PITCH=4608;
constexpr int NW=8,QBLK=32,QB=QBLK*NW,KVBLK=64;
constexpr int ATTN_UNIT_ROWS=QB;
__device__ __forceinline__ int crow(int r,int hi){return (r&3)+8*(r>>2)+4*hi;}
#define SBAR() __builtin_amdgcn_sched_barrier(0)
template<bool BAND> __device__ __forceinline__ void cmask(f32x16&p0,f32x16&p1,int kvbase,int qrel,int hi){
  const float NEG=-INFINITY; int kb=kvbase+4*hi;
  #pragma unroll
  for(int r=0;r<16;++r){int kv=kb+(r&3)+8*(r>>2); if(kv>qrel||(BAND&&kv<qrel-128))p0[r]=NEG; if(kv+32>qrel||(BAND&&kv+32<qrel-128))p1[r]=NEG;}
}

constexpr int NSLOT=3, SLOTB=8192;
constexpr int LDS_K=0, LDS_V=NSLOT*SLOTB, LDS_WS=2*NSLOT*SLOTB, LDS_OST=LDS_WS+NW*64*4, LDS_BYTES=LDS_OST+NW*4096;
constexpr float C2=0.125f*1.4426950408889634f;
__device__ __forceinline__ void glds16(const void*gsrc,unsigned lds_dst){unsigned keep;
  asm volatile("s_mov_b32 %0, m0\n\ts_mov_b32 m0, %2\n\ts_nop 0\n\tglobal_load_lds_dwordx4 %1, off\n\ts_mov_b32 m0, %0":"=&s"(keep):"v"(gsrc),"s"(lds_dst):"memory");}
__device__ __forceinline__ float max3f(float a,float b,float c){float r;asm("v_max3_f32 %0, %1, %2, %3":"=v"(r):"v"(a),"v"(b),"v"(c));return r;}
__device__ __forceinline__ float max2f(float a,float b){float r;asm("v_max_f32_e32 %0, %1, %2":"=v"(r):"v"(a),"v"(b));return r;}
__device__ __forceinline__ float fadd_s(float a,float b){float r;asm("v_add_f32_e32 %0, %1, %2":"=v"(r):"v"(a),"v"(b));return r;}
__device__ __forceinline__ float fsub_s(float a,float b){float r;asm("v_sub_f32_e32 %0, %1, %2":"=v"(r):"v"(a),"v"(b));return r;}
typedef float f32x2_t __attribute__((ext_vector_type(2))); typedef __bf16 bf16x2_t __attribute__((ext_vector_type(2)));
__device__ __forceinline__ unsigned cvtpk_s(float lo,float hi){f32x2_t v={lo,hi};bf16x2_t b=__builtin_convertvector(v,bf16x2_t);return __builtin_bit_cast(unsigned,b);}
#define WAIT_BAR(N) asm volatile("s_waitcnt vmcnt(" #N ") lgkmcnt(0)\n\ts_barrier":::"memory")

__device__ __forceinline__ void qkt(f32x16&p0,f32x16&p1,const char*Kslot,const bf16x8*qr,const f32x16&negm,int r32,int hi){
  const char*kb=Kslot+hi*1024+r32*16;
  #pragma unroll
  for(int d0=0;d0<4;++d0){
    const bf16x8 b0=*reinterpret_cast<const bf16x8*>(kb+d0*2048);
    const bf16x8 b1=*reinterpret_cast<const bf16x8*>(kb+d0*2048+512);
    if(d0==0){p0=__builtin_amdgcn_mfma_f32_32x32x16_bf16(b0,qr[0],negm,0,0,0);p1=__builtin_amdgcn_mfma_f32_32x32x16_bf16(b1,qr[0],negm,0,0,0);}
    else{p0=__builtin_amdgcn_mfma_f32_32x32x16_bf16(b0,qr[d0],p0,0,0,0);p1=__builtin_amdgcn_mfma_f32_32x32x16_bf16(b1,qr[d0],p1,0,0,0);}}
}
typedef __attribute__((address_space(3))) const char* lds_cptr;
typedef short v4i16_t __attribute__((ext_vector_type(4)));
__device__ __forceinline__ void kload8(bf16x8*kf,lds_cptr kp){
  kf[0]=*(const __attribute__((address_space(3))) bf16x8*)(kp);      kf[1]=*(const __attribute__((address_space(3))) bf16x8*)(kp+512);
  kf[2]=*(const __attribute__((address_space(3))) bf16x8*)(kp+2048); kf[3]=*(const __attribute__((address_space(3))) bf16x8*)(kp+2560);
  kf[4]=*(const __attribute__((address_space(3))) bf16x8*)(kp+4096); kf[5]=*(const __attribute__((address_space(3))) bf16x8*)(kp+4608);
  kf[6]=*(const __attribute__((address_space(3))) bf16x8*)(kp+6144); kf[7]=*(const __attribute__((address_space(3))) bf16x8*)(kp+6656);
}
__device__ __forceinline__ void kload2(bf16x8*kf,lds_cptr kp,int j){ kf[2*j]=*(const __attribute__((address_space(3))) bf16x8*)(kp+j*2048); kf[2*j+1]=*(const __attribute__((address_space(3))) bf16x8*)(kp+j*2048+512); }
__device__ __forceinline__ s16x4 vtr(lds_cptr p){ return __builtin_bit_cast(s16x4,__builtin_amdgcn_ds_read_tr16_b64_v4i16((__attribute__((address_space(3))) v4i16_t*)p)); }
__device__ __forceinline__ float rowmax(const f32x16&p0,const f32x16&p1){
  float a=max3f(p0[0],p0[1],p1[0]),b=max3f(p0[2],p0[3],p1[1]);a=max3f(a,p1[2],p1[3]);
  #pragma unroll
  for(int r=4;r<16;r+=4){a=max3f(a,p0[r],p0[r+1]);b=max3f(b,p0[r+2],p0[r+3]);a=max3f(a,p1[r],p1[r+1]);b=max3f(b,p1[r+2],p1[r+3]);}
  const float m=max2f(a,b);
  auto rr=__builtin_amdgcn_permlane32_swap(__float_as_uint(m),__float_as_uint(m),false,false);
  return max2f(__uint_as_float(rr[0]),__uint_as_float(rr[1]));
}
__device__ __forceinline__ void pv(f32x16*o,int vb,bf16x8 pa0,bf16x8 pa1,bf16x8 pa2,bf16x8 pa3){
  #pragma unroll
  for(int d0=0;d0<2;++d0){s16x4 lo[4],hi[4];
    #pragma unroll
    for(int ks=0;ks<4;++ks){
      asm volatile("ds_read_b64_tr_b16 %0,%1 offset:%c2":"=&v"(lo[ks]):"v"(vb),"i"(d0*4096+ks*1024):"memory");
      asm volatile("ds_read_b64_tr_b16 %0,%1 offset:%c2":"=&v"(hi[ks]):"v"(vb),"i"(d0*4096+ks*1024+512):"memory");}
    asm volatile("s_waitcnt lgkmcnt(0)":::"memory");SBAR();
    #define PK(k) (bf16x8){lo[k][0],lo[k][1],lo[k][2],lo[k][3],hi[k][0],hi[k][1],hi[k][2],hi[k][3]}
    o[d0]=__builtin_amdgcn_mfma_f32_32x32x16_bf16(pa0,PK(0),o[d0],0,0,0);
    o[d0]=__builtin_amdgcn_mfma_f32_32x32x16_bf16(pa1,PK(1),o[d0],0,0,0);
    o[d0]=__builtin_amdgcn_mfma_f32_32x32x16_bf16(pa2,PK(2),o[d0],0,0,0);
    o[d0]=__builtin_amdgcn_mfma_f32_32x32x16_bf16(pa3,PK(3),o[d0],0,0,0);
    #undef PK
  }
}

#ifndef ATTN_STORE16
#define ATTN_STORE16(p,v) (*(u32x4*)(p)=(v))
#endif
template<int THRL,bool BAND> __device__ __forceinline__ void attn_unit(const bf16*Qb,const bf16*__restrict__ Kb,const bf16*__restrict__ Vb,bf16*Ob,const long rs,const long ors,const int NT,const int moff,float*lse,const long lrs,char*shm){
  int tid_=threadIdx.x; asm volatile("":"+v"(tid_));
  const int tid=tid_,lane=tid&63,r32=lane&31,hi=lane>>5; const int wid=__builtin_amdgcn_readfirstlane(tid>>6);
  const bf16*Qw=Qb+(long)(wid*QBLK)*rs;
  const bf16*Kh=Kb,*Vh=Vb;
  const unsigned lds0=(unsigned)(uintptr_t)shm;
  float*wsf=(float*)(shm+LDS_WS)+wid*64;
  const bf16*ksrc=Kh+(long)lane*rs+wid*8;
  const bf16*vsrc=Vh+(long)(16*(wid&3)+(lane>>2))*rs+(wid>>2)*32+(lane&3)*8;
  const unsigned kdst=lds0+LDS_K+wid*1024, vdst=lds0+LDS_V+wid*1024;
  #define DMA_K(t,slot) glds16(ksrc+(long)(t)*KVBLK*rs,(unsigned)__builtin_amdgcn_readfirstlane(kdst+(slot)))
  #define DMA_V(t,slot) glds16(vsrc+(long)(t)*KVBLK*rs,(unsigned)__builtin_amdgcn_readfirstlane(vdst+(slot)))
  const int vb0=(int)(lds0+LDS_V)+((lane>>4)&1)*32+(lane&3)*8+(4*hi+((lane&15)>>2))*64;
  const char*Kbase=shm+LDS_K; bf16x8 kf[8];
  const lds_cptr shm3=(lds_cptr)shm; const lds_cptr kp0=shm3+LDS_K+hi*1024+r32*16; const lds_cptr vp0=shm3+LDS_V+((lane>>4)&1)*32+(lane&3)*8+(4*hi+((lane&15)>>2))*64;
  DMA_K(0,0);DMA_V(0,0);DMA_K(1,SLOTB);
  bf16x8 qr[4];
  #pragma unroll
  for(int d0=0;d0<4;++d0)qr[d0]=*reinterpret_cast<const bf16x8*>(&Qw[(long)r32*rs+d0*16+hi*8]);
  float mhat=0.f,l_reg=0.f;f32x16 o[2];o[0]=f32x16{};o[1]=f32x16{};f32x16 negm=f32x16{};asm volatile("":"+v"(negm));
  const int qrel=wid*QBLK+r32;
  #define CMASK(P0,P1,t) do{int jb_=(t)-(NT-4); if(BAND||jb_>=0)cmask<BAND>(P0,P1,64*(t)-moff,qrel,hi);}while(0)
  bool resc=false;
  #define START(P0,P1) do{ const float rm=BAND?__builtin_fmaxf(rowmax(P0,P1),-64.f):rowmax(P0,P1); resc=false; \
    { const float dl=rm; mhat=fadd_s(mhat,dl); \
      _Pragma("unroll") for(int r=0;r<16;++r){P0[r]=fsub_s(P0[r],dl);P1[r]=fsub_s(P1[r],dl);} \
      _Pragma("unroll") for(int r=0;r<16;++r)negm[r]=-mhat; asm volatile("":"+v"(negm)); } \
    _Pragma("unroll") for(int r=0;r<16;++r)P0[r]=__builtin_amdgcn_exp2f(P0[r]); }while(0)
  #define RESC() do{ if(resc){ asm volatile("s_waitcnt lgkmcnt(0)":::"memory"); \
      _Pragma("unroll") for(int d_=0;d_<2;++d_) _Pragma("unroll") for(int r=0;r<16;++r)o[d_][r]*=wsf[crow(r,hi)]; } }while(0)
  f32x16 pA0,pA1,pB0,pB1;
  int sl_prev=0,sl_cur=0,sl_next=SLOTB;
  #define ROT() do{sl_prev=sl_cur;sl_cur=sl_next;sl_next=(sl_next==(NSLOT-1)*SLOTB)?0:sl_next+SLOTB;}while(0)
  DMA_K(2,2*SLOTB);
  WAIT_BAR(3);
  qkt(pA0,pA1,Kbase,qr,negm,r32,hi);asm volatile("s_nop 15\n\ts_nop 7":"+v"(pA0),"+v"(pA1));CMASK(pA0,pA1,0);
  START(pA0,pA1);
  _Pragma("unroll") for(int r=0;r<16;++r)pA1[r]=__builtin_amdgcn_exp2f(pA1[r]);
  WAIT_BAR(0);
  DMA_K(3,0);DMA_V(1,SLOTB);
  ROT();
  kload8(kf,kp0+sl_cur);
  WAIT_BAR(2);
  s16x4 vlo[8],vhi[8]; u32x4 pw0,pw1,pw2,pw3;
  #define PKW(P,B) cvtpk_s(P[B],P[B+1])
  #define PAF(k) __builtin_bit_cast(bf16x8,pw##k)
  #define VFR(i) (bf16x8){vlo[i][0],vlo[i][1],vlo[i][2],vlo[i][3],vhi[i][0],vhi[i][1],vhi[i][2],vhi[i][3]}
  #define PIN(x) asm volatile("":"+v"(x))
  #define MX3(a,b,c) __builtin_fmaxf(__builtin_fmaxf((a),(b)),(c))
  #define GAPA(MF,A0,A1,A2,A3,W0,W1,PW) do{ MF; sacc+=A0; sacc+=A1; sacc+=A2; sacc+=A3; PIN(sacc); W0; W1; PIN(PW); SBAR(); }while(0)
  #define EX(v) __builtin_amdgcn_exp2f(v)
  #define GAPB(MF,X,B) do{ MF; X[B]=EX(X[B]); X[B+1]=EX(X[B+1]); X[B+2]=EX(X[B+2]); X[B+3]=EX(X[B+3]); PIN(X); SBAR(); }while(0)
  #define VRD(i) do{ vlo[i]=vtr(vp_+(((i)>>2)*4096+((i)&3)*1024)); vhi[i]=vtr(vp_+(((i)>>2)*4096+((i)&3)*1024+512)); }while(0)
  #define KRD(G,j) do{ if(G){ kload2(kf,kp0+sl_next,j); SBAR(); } }while(0)
  #define STEP(C0,C1,P0,P1,t,GK,GV,GL) do{ SBAR(); \
    const lds_cptr vp_=vp0+sl_prev; \
    VRD(0); SBAR(); float sacc=(P0[0]+P0[1]); \
    GAPA(C0=__builtin_amdgcn_mfma_f32_32x32x16_bf16(kf[0],qr[0],negm,0,0,0), P0[2],P0[3],P0[4],P0[5],     pw0[0]=PKW(P0,0), pw0[1]=PKW(P0,2), pw0); \
    VRD(4); SBAR(); GAPA(C1=__builtin_amdgcn_mfma_f32_32x32x16_bf16(kf[1],qr[0],negm,0,0,0), P0[6],P0[7],P0[8],P0[9],     pw0[2]=PKW(P0,4), pw0[3]=PKW(P0,6), pw0); \
    VRD(1); SBAR(); GAPA(C0=__builtin_amdgcn_mfma_f32_32x32x16_bf16(kf[2],qr[1],C0,0,0,0),   P0[10],P0[11],P0[12],P0[13], pw1[0]=PKW(P0,8), pw1[1]=PKW(P0,10), pw1); \
    VRD(5); SBAR(); GAPA(C1=__builtin_amdgcn_mfma_f32_32x32x16_bf16(kf[3],qr[1],C1,0,0,0),   P0[14],P0[15],P1[0],P1[1],   pw1[2]=PKW(P0,12),pw1[3]=PKW(P0,14), pw1); \
    VRD(2); SBAR(); GAPA(C0=__builtin_amdgcn_mfma_f32_32x32x16_bf16(kf[4],qr[2],C0,0,0,0),   P1[2],P1[3],P1[4],P1[5],     pw2[0]=PKW(P1,0), pw2[1]=PKW(P1,2), pw2); \
    VRD(6); SBAR(); GAPA(C1=__builtin_amdgcn_mfma_f32_32x32x16_bf16(kf[5],qr[2],C1,0,0,0),   P1[6],P1[7],P1[8],P1[9],     pw2[2]=PKW(P1,4), pw2[3]=PKW(P1,6), pw2); \
    VRD(3); SBAR(); GAPA(C0=__builtin_amdgcn_mfma_f32_32x32x16_bf16(kf[6],qr[3],C0,0,0,0),   P1[10],P1[11],P1[12],P1[13], pw3[0]=PKW(P1,8), pw3[1]=PKW(P1,10), pw3); \
    VRD(7); SBAR(); GAPA(C1=__builtin_amdgcn_mfma_f32_32x32x16_bf16(kf[7],qr[3],C1,0,0,0),   P1[14],P1[15],0.f,0.f,       pw3[2]=PKW(P1,12),pw3[3]=PKW(P1,14), pw3); \
    l_reg+=sacc; \
    if(GK){DMA_K((t)+3,sl_cur);} if(GV){DMA_V((t)+1,sl_next);} \
    CMASK(C0,C1,t); \
    { float a=MX3(C0[0],C0[1],C1[0]),b=MX3(C0[2],C0[3],C1[1]); a=MX3(a,C1[2],C1[3]); \
      _Pragma("unroll") for(int r=4;r<16;r+=4){a=MX3(a,C0[r],C0[r+1]);b=MX3(b,C0[r+2],C0[r+3]);a=MX3(a,C1[r],C1[r+1]);b=MX3(b,C1[r+2],C1[r+3]);} \
      float rm=__builtin_fmaxf(a,b); { auto rr=__builtin_amdgcn_permlane32_swap(__float_as_uint(rm),__float_as_uint(rm),false,false); rm=__builtin_fmaxf(__uint_as_float(rr[0]),__uint_as_float(rr[1])); } \
      resc=false; \
      if(__builtin_expect(__any(rm>(float)THRL),0)){ const float dl=__builtin_fmaxf(rm,0.f); mhat+=dl; \
        _Pragma("unroll") for(int r=0;r<16;++r){C0[r]-=dl;C1[r]-=dl;} \
        _Pragma("unroll") for(int r=0;r<16;++r)negm[r]=-mhat; asm volatile("":"+v"(negm)); \
        const float f=__builtin_amdgcn_exp2f(-dl); l_reg*=f; if(hi==0)wsf[r32]=f; resc=true; } } \
    SBAR(); \
    GAPB(o[0]=__builtin_amdgcn_mfma_f32_32x32x16_bf16(PAF(0),VFR(0),o[0],0,0,0), C0,0); \
    GAPB(o[1]=__builtin_amdgcn_mfma_f32_32x32x16_bf16(PAF(0),VFR(4),o[1],0,0,0), C0,4); \
    KRD(GL,0); GAPB(o[0]=__builtin_amdgcn_mfma_f32_32x32x16_bf16(PAF(1),VFR(1),o[0],0,0,0), C0,8); \
    KRD(GL,1); GAPB(o[1]=__builtin_amdgcn_mfma_f32_32x32x16_bf16(PAF(1),VFR(5),o[1],0,0,0), C0,12); \
    KRD(GL,2); GAPB(o[0]=__builtin_amdgcn_mfma_f32_32x32x16_bf16(PAF(2),VFR(2),o[0],0,0,0), C1,0); \
    KRD(GL,3); GAPB(o[1]=__builtin_amdgcn_mfma_f32_32x32x16_bf16(PAF(2),VFR(6),o[1],0,0,0), C1,4); \
    GAPB(o[0]=__builtin_amdgcn_mfma_f32_32x32x16_bf16(PAF(3),VFR(3),o[0],0,0,0), C1,8); \
    GAPB(o[1]=__builtin_amdgcn_mfma_f32_32x32x16_bf16(PAF(3),VFR(7),o[1],0,0,0), C1,12); \
    }while(0)
  int t=1;
  #undef CMASK
  #define CMASK(P0,P1,t) do{}while(0)
  for(;t+5<NT;t+=2){
    STEP(pB0,pB1,pA0,pA1,t,true,true,true);     WAIT_BAR(2); RESC(); ROT();
    STEP(pA0,pA1,pB0,pB1,t+1,true,true,true);   WAIT_BAR(2); RESC(); ROT();
  }
  #undef CMASK
  #define CMASK(P0,P1,t) do{int jb_=(t)-(NT-4); if(BAND||jb_>=0)cmask<BAND>(P0,P1,64*(t)-moff,qrel,hi);}while(0)
  #define ENDW(tt) do{ if((tt)+3<NT){WAIT_BAR(2);} else if((tt)+2<NT){WAIT_BAR(1);} else {WAIT_BAR(0);} }while(0)
  for(;t+1<NT;t+=2){
    STEP(pB0,pB1,pA0,pA1,t,(t+3<NT),(t+1<NT),(t+1<NT));       ENDW(t);   RESC(); ROT();
    STEP(pA0,pA1,pB0,pB1,t+1,(t+4<NT),(t+2<NT),(t+2<NT));     ENDW(t+1); RESC(); ROT();
  }
  STEP(pB0,pB1,pA0,pA1,NT-1,false,false,false); RESC();
  { float sacc=pB0[0]+pB0[1]; _Pragma("unroll") for(int r=2;r<16;++r)sacc+=pB0[r]; _Pragma("unroll") for(int r=0;r<16;++r)sacc+=pB1[r]; l_reg+=sacc;
    pw0=(u32x4){PKW(pB0,0),PKW(pB0,2),PKW(pB0,4),PKW(pB0,6)};pw1=(u32x4){PKW(pB0,8),PKW(pB0,10),PKW(pB0,12),PKW(pB0,14)};pw2=(u32x4){PKW(pB1,0),PKW(pB1,2),PKW(pB1,4),PKW(pB1,6)};pw3=(u32x4){PKW(pB1,8),PKW(pB1,10),PKW(pB1,12),PKW(pB1,14)};
    SBAR(); pv(o,vb0+sl_cur,PAF(0),PAF(1),PAF(2),PAF(3)); }
  #undef PKW
  #undef PAF
  #undef VFR
  #undef PIN
  #undef MX3
  #undef GAPA
  #undef GAPB
  #undef EX
  #undef VRD
  #undef KRD
  #undef STEP
  #undef ENDW
  {auto rr=__builtin_amdgcn_permlane32_swap(__float_as_uint(l_reg),__float_as_uint(l_reg),false,false);l_reg=__uint_as_float(rr[0])+__uint_as_float(rr[1]);}
  if(hi==0)wsf[32+r32]=l_reg;asm volatile("s_waitcnt lgkmcnt(0)":::"memory");
  float rli[16];
  #pragma unroll
  for(int r=0;r<16;++r)rli[r]=__builtin_amdgcn_rcpf(wsf[32+crow(r,hi)]);
  bf16*Ow=Ob+(long)(wid*QBLK)*ors;
  if(BAND){ if(hi==0) lse[(long)(wid*QBLK+r32)*lrs]=mhat+__builtin_amdgcn_logf(l_reg); }
  { bf16*stg=(bf16*)(shm+LDS_OST)+wid*2048;
    #pragma unroll
    for(int r=0;r<16;++r){const int orow=crow(r,hi);
      #pragma unroll
      for(int d0=0;d0<2;++d0)stg[orow*64+d0*32+r32]=__float2bfloat16(o[d0][r]*rli[r]);}
    asm volatile("s_waitcnt lgkmcnt(0)":::"memory");
    #pragma unroll
    for(int i=0;i<4;++i){const int row=i*8+(lane>>3),ch=lane&7; const u32x4 v=*(const u32x4*)(stg+row*64+ch*8); ATTN_STORE16(Ow+(long)row*ors+ch*8,v);} }
  asm volatile("s_waitcnt lgkmcnt(0)\n\ts_barrier":::"memory");
  #undef DMA_K
  #undef DMA_V
  #undef CMASK
  #undef START
  #undef RESC
  #undef ROT
}
__device__ __forceinline__ void pv4(f32x16*o,int vb,bf16x8 pa0,bf16x8 pa1,bf16x8 pa2,bf16x8 pa3){
  #pragma unroll
  for(int d0=0;d0<4;++d0){s16x4 lo[4],hi[4];
    #pragma unroll
    for(int ks=0;ks<4;++ks){
      asm volatile("ds_read_b64_tr_b16 %0,%1 offset:%c2":"=&v"(lo[ks]):"v"(vb),"i"(d0*4096+ks*1024):"memory");
      asm volatile("ds_read_b64_tr_b16 %0,%1 offset:%c2":"=&v"(hi[ks]):"v"(vb),"i"(d0*4096+ks*1024+512):"memory");}
    asm volatile("s_waitcnt lgkmcnt(0)":::"memory");SBAR();
    #define PK(k) (bf16x8){lo[k][0],lo[k][1],lo[k][2],lo[k][3],hi[k][0],hi[k][1],hi[k][2],hi[k][3]}
    o[d0]=__builtin_amdgcn_mfma_f32_32x32x16_bf16(pa0,PK(0),o[d0],0,0,0);
    o[d0]=__builtin_amdgcn_mfma_f32_32x32x16_bf16(pa1,PK(1),o[d0],0,0,0);
    o[d0]=__builtin_amdgcn_mfma_f32_32x32x16_bf16(pa2,PK(2),o[d0],0,0,0);
    o[d0]=__builtin_amdgcn_mfma_f32_32x32x16_bf16(pa3,PK(3),o[d0],0,0,0);
    #undef PK
  }
}
template<int THRL> __device__ __forceinline__ void attn_unit_dv(const bf16*Qb,const bf16*__restrict__ Kb,const bf16*__restrict__ Vb,bf16*Oa,const long orsa,bf16*Ob,const long ors,const long rs,const int NT,const int moff,char*shm){
  constexpr bool BAND=false;
  int tid_=threadIdx.x; asm volatile("":"+v"(tid_));
  const int tid=tid_,lane=tid&63,r32=lane&31,hi=lane>>5; const int wid=__builtin_amdgcn_readfirstlane(tid>>6);
  const bf16*Qw=Qb+(long)(wid*QBLK)*rs;
  const bf16*Kh=Kb,*Vh=Vb;
  constexpr int LDS_K=0, LDS_V=NSLOT*SLOTB, SLOTV=2*SLOTB, LDS_WS=LDS_V+NSLOT*SLOTV, LDS_Q=LDS_WS+NW*64*4;
  const unsigned lds0=(unsigned)(uintptr_t)shm;
  float*wsf=(float*)(shm+LDS_WS)+wid*64;
  const bf16*ksrc=Kh+(long)lane*rs+wid*8;
  const bf16*vsrc=Vh+(long)(16*(wid&3)+(lane>>2))*rs+(wid>>2)*32+(lane&3)*8;
  const unsigned kdst=lds0+LDS_K+wid*1024, vdst=lds0+LDS_V+wid*1024;
  #define DMA_K(t,slot) glds16(ksrc+(long)(t)*KVBLK*rs,(unsigned)__builtin_amdgcn_readfirstlane(kdst+(slot)))
  #define DMA_V(t,slot) do{ glds16(vsrc+(long)(t)*KVBLK*rs,(unsigned)__builtin_amdgcn_readfirstlane(vdst+2*(slot))); glds16(vsrc+64+(long)(t)*KVBLK*rs,(unsigned)__builtin_amdgcn_readfirstlane(vdst+8192+2*(slot))); }while(0)
  const int vb0=(int)(lds0+LDS_V)+((lane>>4)&1)*32+(lane&3)*8+(4*hi+((lane&15)>>2))*64;
  const char*Kbase=shm+LDS_K; bf16x8 kf[8];
  const lds_cptr shm3=(lds_cptr)shm; const lds_cptr kp0=shm3+LDS_K+hi*1024+r32*16; const lds_cptr vp0=shm3+LDS_V+((lane>>4)&1)*32+(lane&3)*8+(4*hi+((lane&15)>>2))*64;
  DMA_K(0,0);DMA_V(0,0);DMA_K(1,SLOTB);
  typedef __attribute__((address_space(3))) bf16x8* lds_q8;
  const lds_q8 qlds=(lds_q8)(shm3+LDS_Q+wid*4096)+lane;
  { bf16x8 qr[4];
    #pragma unroll
    for(int d0=0;d0<4;++d0)qr[d0]=*reinterpret_cast<const bf16x8*>(&Qw[(long)r32*rs+d0*16+hi*8]);
    #pragma unroll
    for(int d0=0;d0<4;++d0)qlds[d0*64]=qr[d0]; }
  #define QF(d0) (qlds[(d0)*64])
  float mhat=0.f,l_reg=0.f;f32x16 o[4];o[0]=f32x16{};o[1]=f32x16{};o[2]=f32x16{};o[3]=f32x16{};const f32x16 zero16=f32x16{};
  const int qrel=wid*QBLK+r32;
  #define CMASK(P0,P1,t) do{int jb_=(t)-(NT-4); if(BAND||jb_>=0)cmask<BAND>(P0,P1,64*(t)-moff,qrel,hi);}while(0)
  bool resc=false;
  #define START(P0,P1) do{ const float rm=rowmax(P0,P1); resc=false; mhat=rm; \
    _Pragma("unroll") for(int r=0;r<16;++r)P0[r]=__builtin_amdgcn_exp2f(fsub_s(P0[r],mhat)); }while(0)
  #define RESC() do{ if(resc){ asm volatile("s_waitcnt lgkmcnt(0)":::"memory"); \
      _Pragma("unroll") for(int d_=0;d_<4;++d_) _Pragma("unroll") for(int r=0;r<16;++r)o[d_][r]*=wsf[crow(r,hi)]; } }while(0)
  f32x16 pA0,pA1,pB0,pB1;
  int sl_prev=0,sl_cur=0,sl_next=SLOTB;
  #define ROT() do{sl_prev=sl_cur;sl_cur=sl_next;sl_next=(sl_next==(NSLOT-1)*SLOTB)?0:sl_next+SLOTB;}while(0)
  DMA_K(2,2*SLOTB);
  WAIT_BAR(1);
  { bf16x8 qr[4]; _Pragma("unroll") for(int d0=0;d0<4;++d0)qr[d0]=QF(d0); qkt(pA0,pA1,Kbase,qr,zero16,r32,hi); } asm volatile("s_nop 15\n\ts_nop 7":"+v"(pA0),"+v"(pA1));CMASK(pA0,pA1,0);
  START(pA0,pA1);
  _Pragma("unroll") for(int r=0;r<16;++r)pA1[r]=__builtin_amdgcn_exp2f(fsub_s(pA1[r],mhat));
  WAIT_BAR(0);
  DMA_K(3,0);DMA_V(1,SLOTB);
  ROT();
  kload8(kf,kp0+sl_cur);
  WAIT_BAR(3);
  s16x4 vlo[8],vhi[8]; u32x4 pw0,pw1,pw2,pw3;
  #define PKW(P,B) cvtpk_s(P[B],P[B+1])
  #define PAF(k) __builtin_bit_cast(bf16x8,pw##k)
  #define VFR(i) (bf16x8){vlo[i][0],vlo[i][1],vlo[i][2],vlo[i][3],vhi[i][0],vhi[i][1],vhi[i][2],vhi[i][3]}
  #define PIN(x) asm volatile("":"+v"(x))
  #define MX3(a,b,c) __builtin_fmaxf(__builtin_fmaxf((a),(b)),(c))
  #define GAPA(MF,A0,A1,A2,A3,W0,W1,PW) do{ MF; sacc+=A0; sacc+=A1; sacc+=A2; sacc+=A3; PIN(sacc); W0; W1; PIN(PW); SBAR(); }while(0)
  #define EX(v) __builtin_amdgcn_exp2f(v)
  #define GAPB(MF,X,B) do{ MF; X[B]=EX(X[B]-mhat); X[B+1]=EX(X[B+1]-mhat); PIN(X); SBAR(); }while(0)
  #define VRD(i) do{ vlo[i]=vtr(vp_+(((i)>>2)*4096+((i)&3)*1024)); vhi[i]=vtr(vp_+(((i)>>2)*4096+((i)&3)*1024+512)); }while(0)
  #define VRD2(i) do{ vlo[i]=vtr(vp_+(8192+((i)>>2)*4096+((i)&3)*1024)); vhi[i]=vtr(vp_+(8192+((i)>>2)*4096+((i)&3)*1024+512)); SBAR(); }while(0)
  #define KRD(G,j) do{ if(G){ kload2(kf,kp0+sl_next,j); SBAR(); } }while(0)
  #define STEP(C0,C1,P0,P1,t,GK,GV,GL) do{ SBAR(); \
    const lds_cptr vp_=vp0+2*sl_prev; \
    bf16x8 q_a=QF(0),q_b; \
    VRD(0); q_b=QF(1); SBAR(); float sacc=(P0[0]+P0[1]); \
    GAPA(C0=__builtin_amdgcn_mfma_f32_32x32x16_bf16(kf[0],q_a,zero16,0,0,0), P0[2],P0[3],P0[4],P0[5],     pw0[0]=PKW(P0,0), pw0[1]=PKW(P0,2), pw0); \
    VRD(4); SBAR(); GAPA(C1=__builtin_amdgcn_mfma_f32_32x32x16_bf16(kf[1],q_a,zero16,0,0,0), P0[6],P0[7],P0[8],P0[9],     pw0[2]=PKW(P0,4), pw0[3]=PKW(P0,6), pw0); \
    VRD(1); q_a=QF(2); SBAR(); GAPA(C0=__builtin_amdgcn_mfma_f32_32x32x16_bf16(kf[2],q_b,C0,0,0,0),   P0[10],P0[11],P0[12],P0[13], pw1[0]=PKW(P0,8), pw1[1]=PKW(P0,10), pw1); \
    VRD(5); SBAR(); GAPA(C1=__builtin_amdgcn_mfma_f32_32x32x16_bf16(kf[3],q_b,C1,0,0,0),   P0[14],P0[15],P1[0],P1[1],   pw1[2]=PKW(P0,12),pw1[3]=PKW(P0,14), pw1); \
    VRD(2); q_b=QF(3); SBAR(); GAPA(C0=__builtin_amdgcn_mfma_f32_32x32x16_bf16(kf[4],q_a,C0,0,0,0),   P1[2],P1[3],P1[4],P1[5],     pw2[0]=PKW(P1,0), pw2[1]=PKW(P1,2), pw2); \
    VRD(6); SBAR(); GAPA(C1=__builtin_amdgcn_mfma_f32_32x32x16_bf16(kf[5],q_a,C1,0,0,0),   P1[6],P1[7],P1[8],P1[9],     pw2[2]=PKW(P1,4), pw2[3]=PKW(P1,6), pw2); \
    VRD(3); SBAR(); GAPA(C0=__builtin_amdgcn_mfma_f32_32x32x16_bf16(kf[6],q_b,C0,0,0,0),   P1[10],P1[11],P1[12],P1[13], pw3[0]=PKW(P1,8), pw3[1]=PKW(P1,10), pw3); \
    VRD(7); SBAR(); GAPA(C1=__builtin_amdgcn_mfma_f32_32x32x16_bf16(kf[7],q_b,C1,0,0,0),   P1[14],P1[15],0.f,0.f,       pw3[2]=PKW(P1,12),pw3[3]=PKW(P1,14), pw3); \
    l_reg+=sacc; \
    if(GK){DMA_K((t)+3,sl_cur);} if(GV){DMA_V((t)+1,sl_next);} \
    CMASK(C0,C1,t); \
    { float a=MX3(C0[0],C0[1],C1[0]),b=MX3(C0[2],C0[3],C1[1]); a=MX3(a,C1[2],C1[3]); \
      _Pragma("unroll") for(int r=4;r<16;r+=4){a=MX3(a,C0[r],C0[r+1]);b=MX3(b,C0[r+2],C0[r+3]);a=MX3(a,C1[r],C1[r+1]);b=MX3(b,C1[r+2],C1[r+3]);} \
      float rm=__builtin_fmaxf(a,b); { auto rr=__builtin_amdgcn_permlane32_swap(__float_as_uint(rm),__float_as_uint(rm),false,false); rm=__builtin_fmaxf(__uint_as_float(rr[0]),__uint_as_float(rr[1])); } \
      resc=false; \
      rm-=mhat; \
      if(__builtin_expect(__any(rm>(float)THRL),0)){ const float dl=__builtin_fmaxf(rm,0.f); mhat+=dl; \
        const float f=__builtin_amdgcn_exp2f(-dl); l_reg*=f; if(hi==0)wsf[r32]=f; resc=true; } } \
    SBAR(); \
    GAPB(o[0]=__builtin_amdgcn_mfma_f32_32x32x16_bf16(PAF(0),VFR(0),o[0],0,0,0), C0,0);  VRD2(0); \
    GAPB(o[1]=__builtin_amdgcn_mfma_f32_32x32x16_bf16(PAF(0),VFR(4),o[1],0,0,0), C0,2);  VRD2(4); \
    GAPB(o[0]=__builtin_amdgcn_mfma_f32_32x32x16_bf16(PAF(1),VFR(1),o[0],0,0,0), C0,4);  VRD2(1); \
    GAPB(o[1]=__builtin_amdgcn_mfma_f32_32x32x16_bf16(PAF(1),VFR(5),o[1],0,0,0), C0,6);  VRD2(5); \
    GAPB(o[0]=__builtin_amdgcn_mfma_f32_32x32x16_bf16(PAF(2),VFR(2),o[0],0,0,0), C0,8);  VRD2(2); \
    GAPB(o[1]=__builtin_amdgcn_mfma_f32_32x32x16_bf16(PAF(2),VFR(6),o[1],0,0,0), C0,10); VRD2(6); \
    GAPB(o[0]=__builtin_amdgcn_mfma_f32_32x32x16_bf16(PAF(3),VFR(3),o[0],0,0,0), C0,12); VRD2(3); \
    GAPB(o[1]=__builtin_amdgcn_mfma_f32_32x32x16_bf16(PAF(3),VFR(7),o[1],0,0,0), C0,14); VRD2(7); \
    GAPB(o[2]=__builtin_amdgcn_mfma_f32_32x32x16_bf16(PAF(0),VFR(0),o[2],0,0,0), C1,0); \
    GAPB(o[3]=__builtin_amdgcn_mfma_f32_32x32x16_bf16(PAF(0),VFR(4),o[3],0,0,0), C1,2); \
    KRD(GL,0); GAPB(o[2]=__builtin_amdgcn_mfma_f32_32x32x16_bf16(PAF(1),VFR(1),o[2],0,0,0), C1,4); \
    KRD(GL,1); GAPB(o[3]=__builtin_amdgcn_mfma_f32_32x32x16_bf16(PAF(1),VFR(5),o[3],0,0,0), C1,6); \
    KRD(GL,2); GAPB(o[2]=__builtin_amdgcn_mfma_f32_32x32x16_bf16(PAF(2),VFR(2),o[2],0,0,0), C1,8); \
    KRD(GL,3); GAPB(o[3]=__builtin_amdgcn_mfma_f32_32x32x16_bf16(PAF(2),VFR(6),o[3],0,0,0), C1,10); \
    GAPB(o[2]=__builtin_amdgcn_mfma_f32_32x32x16_bf16(PAF(3),VFR(3),o[2],0,0,0), C1,12); \
    GAPB(o[3]=__builtin_amdgcn_mfma_f32_32x32x16_bf16(PAF(3),VFR(7),o[3],0,0,0), C1,14); \
    }while(0)
  int t=1;
  #undef CMASK
  #define CMASK(P0,P1,t) do{}while(0)
  for(;t+5<NT;t+=2){
    STEP(pB0,pB1,pA0,pA1,t,true,true,true);     WAIT_BAR(3); RESC(); ROT();
    STEP(pA0,pA1,pB0,pB1,t+1,true,true,true);   WAIT_BAR(3); RESC(); ROT();
  }
  #undef CMASK
  #define CMASK(P0,P1,t) do{int jb_=(t)-(NT-4); if(BAND||jb_>=0)cmask<BAND>(P0,P1,64*(t)-moff,qrel,hi);}while(0)
  #define ENDW(tt) do{ if((tt)+3<NT){WAIT_BAR(3);} else if((tt)+2<NT){WAIT_BAR(2);} else {WAIT_BAR(0);} }while(0)
  for(;t+1<NT;t+=2){
    STEP(pB0,pB1,pA0,pA1,t,(t+3<NT),(t+1<NT),(t+1<NT));       ENDW(t);   RESC(); ROT();
    STEP(pA0,pA1,pB0,pB1,t+1,(t+4<NT),(t+2<NT),(t+2<NT));     ENDW(t+1); RESC(); ROT();
  }
  STEP(pB0,pB1,pA0,pA1,NT-1,false,false,false); RESC();
  { float sacc=pB0[0]+pB0[1]; _Pragma("unroll") for(int r=2;r<16;++r)sacc+=pB0[r]; _Pragma("unroll") for(int r=0;r<16;++r)sacc+=pB1[r]; l_reg+=sacc;
    pw0=(u32x4){PKW(pB0,0),PKW(pB0,2),PKW(pB0,4),PKW(pB0,6)};pw1=(u32x4){PKW(pB0,8),PKW(pB0,10),PKW(pB0,12),PKW(pB0,14)};pw2=(u32x4){PKW(pB1,0),PKW(pB1,2),PKW(pB1,4),PKW(pB1,6)};pw3=(u32x4){PKW(pB1,8),PKW(pB1,10),PKW(pB1,12),PKW(pB1,14)};
    SBAR(); pv4(o,vb0+2*sl_cur,PAF(0),PAF(1),PAF(2),PAF(3)); }
  #undef PKW
  #undef PAF
  #undef VFR
  #undef PIN
  #undef MX3
  #undef GAPA
  #undef GAPB
  #undef EX
  #undef VRD
  #undef VRD2
  #undef QF
  #undef KRD
  #undef STEP
  #undef ENDW
  {auto rr=__builtin_amdgcn_permlane32_swap(__float_as_uint(l_reg),__float_as_uint(l_reg),false,false);l_reg=__uint_as_float(rr[0])+__uint_as_float(rr[1]);}
  if(hi==0)wsf[32+r32]=l_reg;asm volatile("s_waitcnt lgkmcnt(0)":::"memory");
  float rli[16];
  #pragma unroll
  for(int r=0;r<16;++r)rli[r]=__builtin_amdgcn_rcpf(wsf[32+crow(r,hi)]);
  asm volatile("s_waitcnt lgkmcnt(0)\n\ts_barrier":::"memory");
  bf16*Owa=Oa+(long)(wid*QBLK)*orsa; bf16*Owb=Ob+(long)(wid*QBLK)*ors;
  { bf16*stg=(bf16*)(shm)+wid*4096;
    #pragma unroll
    for(int r=0;r<16;++r){const int orow=crow(r,hi);
      #pragma unroll
      for(int d0=0;d0<4;++d0)stg[orow*128+d0*32+r32]=__float2bfloat16(o[d0][r]*rli[r]);}
    asm volatile("s_waitcnt lgkmcnt(0)":::"memory");
    #pragma unroll
    for(int i=0;i<8;++i){const int row=i*4+(lane>>4),ch=lane&15; const u32x4 v=*(const u32x4*)(stg+row*128+ch*8);
      if(ch<8){ATTN_STORE16(Owa+(long)row*orsa+ch*8,v);} else {ATTN_STORE16(Owb+(long)row*ors+(ch-8)*8,v);} } }
  asm volatile("s_waitcnt lgkmcnt(0)\n\ts_barrier":::"memory");
  #undef DMA_K
  #undef DMA_V
  #undef CMASK
  #undef START
  #undef RESC
  #undef ROT
}
struct AttnUnitDV { const bf16* Q; const bf16* K; const bf16* V; bf16* Oa; bf16* Ob; long rs, orsa, ors; int NT, moff; };
template<class Sched,int THRL> __device__ __forceinline__ void attn_phase_dv(char*lds,const Sched&S){
  AttnUnitDV u;
  for(int i=0;S.next(i,u);++i){ attn_unit_dv<THRL>(u.Q,u.K,u.V,u.Oa,u.orsa,u.Ob,u.ors,u.rs,u.NT,u.moff,lds); }
}
constexpr int ATTN_LDS_BYTES=LDS_BYTES;
struct AttnUnit { const bf16* Q; const bf16* K; const bf16* V; bf16* O; float* lse; long rs, ors, lrs; int NT, moff; };
template<class Sched,int THRL,bool BAND> __device__ __forceinline__ void attn_phase(char*lds,const Sched&S){
  AttnUnit u;
  for(int i=0;S.next(i,u);++i){ attn_unit<THRL,BAND>(u.Q,u.K,u.V,u.O,u.rs,u.ors,u.NT,u.moff,u.lse,u.lrs,lds); }
}
#undef SBAR
#undef WAIT_BAR
}
#define GAS __attribute__((address_space(1)))
#define LAS __attribute__((address_space(3)))
typedef unsigned short bf16;
typedef unsigned v4u __attribute__((ext_vector_type(4)));
typedef float f32x4 __attribute__((ext_vector_type(4)));
typedef short bf16x8 __attribute__((ext_vector_type(8)));
typedef GAS unsigned gu32;
typedef GAS unsigned long long gu64;
#define RLX_AGENT __ATOMIC_RELAXED, __HIP_MEMORY_SCOPE_AGENT
#define LDS_WAIT() asm volatile("s_waitcnt lgkmcnt(0)" ::: "memory")
#define VM_WAIT() asm volatile("s_waitcnt vmcnt(0)" ::: "memory")
__device__ __forceinline__ unsigned long long rt() { return __builtin_amdgcn_s_memrealtime(); }

#define XB_TMO      128
#define XB_XCNT(j)  (256  + 64 * (j))
#define XB_XSUB(j)  (1280 + 64 * (j))
#define XB_XGEN(j)  (2304 + 64 * (j))
#define XB_TOP      3328
#define XB_TOPGEN   3392
#define XCD_BAR_WORDS 3456
#define XB_SPIN_CAP (1u << 18)

__device__ __forceinline__ unsigned xb_ld(unsigned* p)              { return __hip_atomic_load(p, __ATOMIC_RELAXED, __HIP_MEMORY_SCOPE_AGENT); }
__device__ __forceinline__ unsigned xb_add(unsigned* p, unsigned v) { return __hip_atomic_fetch_add(p, v, __ATOMIC_RELAXED, __HIP_MEMORY_SCOPE_AGENT); }
__device__ __forceinline__ unsigned xb_xcc_id() { return (unsigned)__builtin_amdgcn_s_getreg((3 << 11) | 20) & 0xFu; }
#define XB_SPIN(cond, bar) do { unsigned _sp = 0; while (cond) { __builtin_amdgcn_s_sleep(1); \
    if ((++_sp & 255u) == 0u) { if (xb_ld(&(bar)[XB_TMO])) break; if (_sp > XB_SPIN_CAP) { atomicAdd(&(bar)[XB_TMO], 1u); break; } } } } while (0)

struct XcdBarrier {
    unsigned* bar; unsigned x;
    volatile LAS unsigned* st;
};

__device__ __forceinline__ XcdBarrier xcd_barrier_post(unsigned* bar, volatile LAS unsigned* st) {
    XcdBarrier b; b.bar = bar; b.x = xb_xcc_id(); b.st = st;
    if (threadIdx.x == 0) (void)xb_add(&bar[XB_XCNT(b.x)], 1u);
    return b;
}
__device__ __forceinline__ void xcd_barrier_complete(unsigned* bar, unsigned x, unsigned& nloc, unsigned& nx) {
    const unsigned G = gridDim.x * gridDim.y * gridDim.z;
    unsigned sum, cnt, mine, sp = 0u;
    for (;;) {
        sum = 0u; cnt = 0u; mine = 0u;
#pragma unroll
        for (unsigned j = 0; j < 16; ++j) { const unsigned c = xb_ld(&bar[XB_XCNT(j)]); sum += c; cnt += (c > 0u) ? 1u : 0u; mine = (j == x) ? c : mine; }
        if (sum == G) break;
        __builtin_amdgcn_s_sleep(1);
        if ((++sp & 255u) == 0u) { if (xb_ld(&bar[XB_TMO])) break; if (sp > XB_SPIN_CAP) { atomicAdd(&bar[XB_TMO], 1u); break; } }
    }
    nloc = mine > 0u ? mine : 1u; nx = cnt > 0u ? cnt : 1u;
}

__device__ __forceinline__ void xcd_barrier(const XcdBarrier& b) {
    asm volatile("s_waitcnt vmcnt(0)" ::: "memory");
    __syncthreads();
    if (threadIdx.x == 0) {
        unsigned* bar = b.bar;
        __builtin_amdgcn_s_waitcnt(0);
        unsigned nloc = b.st[0], nx = b.st[1];
        if (nloc == 0u) { xcd_barrier_complete(bar, b.x, nloc, nx); b.st[0] = nloc; b.st[1] = nx; }
        const unsigned old = xb_add(&bar[XB_XSUB(b.x)], 1u);
        const unsigned gen = old / nloc;
        if (old + 1u == (gen + 1u) * nloc) {
            __builtin_amdgcn_fence(__ATOMIC_RELEASE, "agent");
            asm volatile("s_waitcnt vmcnt(0)" ::: "memory");
            const unsigned og = xb_add(&bar[XB_TOP], 1u);
            const unsigned tg = og / nx;
            if (og + 1u == (tg + 1u) * nx) xb_add(&bar[XB_TOPGEN], 1u);
            else XB_SPIN(xb_ld(&bar[XB_TOPGEN]) == tg, bar);
            __builtin_amdgcn_fence(__ATOMIC_ACQUIRE, "agent");
            xb_add(&bar[XB_XGEN(b.x)], 1u);
            asm volatile("s_waitcnt vmcnt(0)" ::: "memory");
        } else {
            XB_SPIN(xb_ld(&bar[XB_XGEN(b.x)]) == gen, bar);
            __builtin_amdgcn_fence(__ATOMIC_ACQUIRE, "agent");
            asm volatile("s_waitcnt vmcnt(0)" ::: "memory");
        }
    }
    __syncthreads();
}

constexpr int NWAVES = 8;
constexpr int RING_OFF = 0, RING_BYTES = 131072;
constexpr int LDSCTL_OFF = RING_BYTES, MISC_OFF = LDSCTL_OFF + 320;
constexpr int LDS_BYTES = 147456;
constexpr int CW_TMO = 0, CW_CODE = 1, CW_BAR = 4096;

__device__ __forceinline__ int lane_id() { int l = (int)(threadIdx.x & 63u); asm volatile("" : "+v"(l)); return l; }
__device__ __forceinline__ int tid_id() { int t = (int)threadIdx.x; asm volatile("" : "+v"(t)); return t; }
struct Frame {
    LAS unsigned char* lds;
    volatile LAS unsigned* MISC;
    gu32* ctl;
    int wave, vcu, G;
};

__device__ __forceinline__ void p0_transpose_item(const float* W, int K, int N, bf16_t* WT, int k0, int n0, int drow0, LAS float* scr, int lane, const float* gain) {
    const float* src = W + (size_t)(k0 + (lane >> 5)) * N + n0 + (lane & 31);
    float v[32];
#pragma unroll
    for (int i = 0; i < 32; ++i) v[i] = src[(size_t)(2 * i) * N];
    const int c = lane & 7;
    f32x4 g0 = {1.f, 1.f, 1.f, 1.f}, g1 = g0;
    if (gain) { g0 = *(const f32x4*)(gain + k0 + 8 * c); g1 = *(const f32x4*)(gain + k0 + 8 * c + 4); }
#pragma unroll
    for (int i = 0; i < 32; ++i) scr[(2 * i + (lane >> 5)) * 33 + (lane & 31)] = v[i];
    LDS_WAIT(); asm volatile("" ::: "memory");
#pragma unroll
    for (int j = 0; j < 4; ++j) { const int n = (lane >> 3) + 8 * j; const LAS float* s = scr + (8 * c) * 33 + n;
        v4u o; o.x = pk2bf(s[0 * 33] * g0[0], s[1 * 33] * g0[1]); o.y = pk2bf(s[2 * 33] * g0[2], s[3 * 33] * g0[3]); o.z = pk2bf(s[4 * 33] * g1[0], s[5 * 33] * g1[1]); o.w = pk2bf(s[6 * 33] * g1[2], s[7 * 33] * g1[3]);
        *(GAS v4u*)(WT + (size_t)(drow0 + n) * K + k0 + 8 * c) = o; }
    LDS_WAIT(); asm volatile("" ::: "memory");
}
__device__ __forceinline__ void rms_row_to_bf16(const float* xrow, const float* g, bf16_t* orow, int lane) {
    const f32x4* xr = (const f32x4*)xrow + lane;
    f32x4 v[4]; float s = 0.f;
#pragma unroll
    for (int j = 0; j < 4; ++j) { v[j] = xr[64 * j]; s += (v[j].x * v[j].x + v[j].y * v[j].y) + (v[j].z * v[j].z + v[j].w * v[j].w); }
    const float r = rsqrtf(wave_sum(s) * (1.f / DM) + EPS);
    unsigned long long* o8 = (unsigned long long*)orow + lane;
#pragma unroll
    for (int j = 0; j < 4; ++j) { const f32x4 gg = *((const f32x4*)g + lane + 64 * j);
        o8[64 * j] = (unsigned long long)pk2bf(v[j].x * r * gg.x, v[j].y * r * gg.y) | ((unsigned long long)pk2bf(v[j].z * r * gg.z, v[j].w * r * gg.w) << 32); }
}
__device__ __forceinline__ void row_to_bf16_sq(const float* xrow, bf16_t* orow, float* rsq16, int lane) {
    const f32x4* xr = (const f32x4*)xrow + lane;
    f32x4 v[4]; float s = 0.f;
#pragma unroll
    for (int j = 0; j < 4; ++j) { v[j] = xr[64 * j]; s += (v[j].x * v[j].x + v[j].y * v[j].y) + (v[j].z * v[j].z + v[j].w * v[j].w); }
    s = wave_sum(s);
    unsigned long long* o8 = (unsigned long long*)orow + lane;
#pragma unroll
    for (int j = 0; j < 4; ++j) o8[64 * j] = (unsigned long long)pk2bf(v[j].x, v[j].y) | ((unsigned long long)pk2bf(v[j].z, v[j].w) << 32);
    if (lane < 4) rsq16[lane] = (lane == 0) ? s : 0.f;
}
__device__ __forceinline__ void rms_row_final(const bf16_t* hrow, float* orow, const float* g, const float* rsq4, int lane) {
    float s = (lane < 4) ? rsq4[lane] : 0.f;
    const unsigned long long* h8 = (const unsigned long long*)hrow + lane;
    unsigned long long hv[4];
#pragma unroll
    for (int j = 0; j < 4; ++j) hv[j] = h8[64 * j];
    s = wave_sum(s);
    const float r = rsqrtf(s * (1.f / DM) + EPS);
    f32x4* o = (f32x4*)orow + lane;
#pragma unroll
    for (int j = 0; j < 4; ++j) { const f32x4 gg = *((const f32x4*)g + lane + 64 * j); const unsigned lo = (unsigned)hv[j], hi = (unsigned)(hv[j] >> 32);
        o[64 * j] = (f32x4){__uint_as_float(lo << 16), __uint_as_float(lo & 0xffff0000u), __uint_as_float(hi << 16), __uint_as_float(hi & 0xffff0000u)} * r * gg; }
}
__device__ __forceinline__ void rms_row_inplace_rsq(float* xrow, const float* g, const float* rsq16, int lane) {
    f32x4* xr = (f32x4*)xrow + lane;
    float s = (lane < 4) ? rsq16[lane] : 0.f;
    s = wave_sum(s);
    const float r = rsqrtf(s * (1.f / DM) + EPS);
#pragma unroll
    for (int j = 0; j < 4; ++j) { const f32x4 gg = *((const f32x4*)g + lane + 64 * j); xr[64 * j] = xr[64 * j] * r * gg; }
}
__device__ __forceinline__ void rms_row_inplace(float* xrow, const float* g, int lane) {
    f32x4* xr = (f32x4*)xrow + lane;
    f32x4 v[4]; float s = 0.f;
#pragma unroll
    for (int j = 0; j < 4; ++j) { v[j] = xr[64 * j]; s += (v[j].x * v[j].x + v[j].y * v[j].y) + (v[j].z * v[j].z + v[j].w * v[j].w); }
    const float r = rsqrtf(wave_sum(s) * (1.f / DM) + EPS);
#pragma unroll
    for (int j = 0; j < 4; ++j) { const f32x4 gg = *((const f32x4*)g + lane + 64 * j); xr[64 * j] = v[j] * r * gg; }
}

struct Args { const float* in[23]; float* out; unsigned char* ws; int ph_lo, ph_hi, li, pad; };

struct WDesc { const float* W; int K, N; bf16_t* WT; int mode; int items; };

constexpr int CI0 = (DM / 64) * (N_IN0 / 32), CI1 = (DM / 64) * (DM / 32), CI2 = (DM / 64) * (N_QKV / 32), CI4 = (DM / 64) * (NUP / 32), CI6 = (DFF / 64) * (DM / 32), CI8 = (128 / 64) * (128 / 32);
constexpr int CB_P0_END = CI0;
constexpr int CB_1_END = CB_P0_END + CI1 + CI4 + CI6 + 4 * CI8;
constexpr int CB_2_END = CB_1_END + CI2 + CI1 + CI4 + CI6;
__device__ __forceinline__ void convert_items(Frame& F, const Args& a, unsigned char* ws, int it_begin, int it_end, int worker, int nworkers) {
    LAS float* scr = (LAS float*)(F.lds + RING_OFF + F.wave * 16384);
    const int lane = lane_id();
    for (int it = it_begin + worker; it < it_end; it += nworkers) {
        int r = it; const float* W; int K, N; bf16_t* WT; int mode = 0; const float* gain = nullptr;
        if (r < CI0) { W = a.in[5]; K = DM; N = N_IN0; WT = (bf16_t*)(ws + WS_W_IN0); gain = a.in[2]; }
        else if ((r -= CI0) < CI1) { W = a.in[11]; K = DM; N = DM; WT = (bf16_t*)(ws + WS_W_OUT0); }
        else if ((r -= CI1) < CI4) { W = a.in[19]; K = DM; N = NUP; WT = (bf16_t*)(ws + WS_W_UP); mode = 1; gain = a.in[3]; }
        else if ((r -= CI4) < CI6) { W = a.in[22]; K = DFF; N = DM; WT = (bf16_t*)(ws + WS_W_DN); }
        else if ((r -= CI6) < 4 * CI8) { const int g = r / CI8; r -= g * CI8; W = a.in[9] + (size_t)g * 128 * 128; K = 128; N = 128; WT = (bf16_t*)(ws + WS_PWT) + (size_t)g * 128 * 128; }
        else if ((r -= 4 * CI8) < CI2) { W = a.in[12]; K = DM; N = N_QKV; WT = (bf16_t*)(ws + WS_W_QKV); gain = a.in[2] + DM; }
        else if ((r -= CI2) < CI1) { W = a.in[18]; K = DM; N = DM; WT = (bf16_t*)(ws + WS_W_OUT1); }
        else if ((r -= CI1) < CI4) { W = a.in[19] + (size_t)DM * NUP; K = DM; N = NUP; WT = (bf16_t*)(ws + WS_W_UP) + (size_t)NUP * DM; mode = 1; gain = a.in[3] + DM; }
        else { r -= CI4; W = a.in[22] + (size_t)DFF * DM; K = DFF; N = DM; WT = (bf16_t*)(ws + WS_W_DN) + (size_t)DM * DFF; }
        const int nblk = N / 32, kb = r / nblk, nb = r % nblk, k0 = 64 * kb, n0 = 32 * nb;
        int d0 = n0;
        if (mode == 1) { if (n0 < DFF) d0 = 256 * (n0 / 128) + (n0 % 128); else { const int q = n0 - DFF; d0 = 256 * (q / 128) + 128 + (q % 128); } }
        p0_transpose_item(W, K, N, WT, k0, n0, d0, scr, lane, gain);
    }
}
__device__ __forceinline__ void convert_in_tail(Frame& F, const Args& a, unsigned char* ws, int nwg, int it_begin, int it_end) {
    const int rem = nwg % F.G, first = rem, nw = (rem > 0) ? F.G - rem : F.G, c = (int)blockIdx.x;
    if (rem > 0 && c < first) return;
    convert_items(F, a, ws, it_begin, it_end, (c - (rem > 0 ? first : 0)) * NWAVES + F.wave, nw * NWAVES);
}
__device__ __forceinline__ void p0_prologue(Frame& F, const Args& a) {
    const int lane = lane_id(), tid = tid_id();
    const int gw = F.vcu * NWAVES + F.wave, NGW = F.G * NWAVES;
    unsigned char* ws = a.ws;
    convert_items(F, a, ws, 0, CB_P0_END, gw, NGW);
    { const float* w_s = a.in[7]; bf16_t* Wb = (bf16_t*)(ws + WS_WSB);
      for (int idx = (F.vcu * NWAVES * 64) + tid; idx < 4 * 128 * 128; idx += F.G * NWAVES * 64) { const int t = (idx >> 7) & 127, sidx = idx & 127; Wb[idx] = (sidx <= t) ? f2bf(w_s[idx]) : (bf16_t)0; } }
    { bf16_t* XN = (bf16_t*)(ws + WS_XN); float* rsq = (float*)(ws + WS_RSQ); const float* x = a.in[0];
      for (int m0 = gw * 4; m0 < M; m0 += NGW * 4) {
          f32x4 v[4][4];
#pragma unroll
          for (int r = 0; r < 4; ++r)
#pragma unroll
              for (int j = 0; j < 4; ++j) v[r][j] = *((const f32x4*)(x + (size_t)(m0 + r) * DM) + lane + 64 * j);
#pragma unroll
          for (int r = 0; r < 4; ++r) { float sq = 0.f;
#pragma unroll
              for (int j = 0; j < 4; ++j) sq += (v[r][j].x * v[r][j].x + v[r][j].y * v[r][j].y) + (v[r][j].z * v[r][j].z + v[r][j].w * v[r][j].w);
              sq = wave_sum(sq);
              unsigned long long* o8 = (unsigned long long*)(XN + (size_t)(m0 + r) * DM) + lane;
#pragma unroll
              for (int j = 0; j < 4; ++j) o8[64 * j] = (unsigned long long)pk2bf(v[r][j].x, v[r][j].y) | ((unsigned long long)pk2bf(v[r][j].z, v[r][j].w) << 32);
              if (lane < 4) rsq[(size_t)(m0 + r) * 4 + lane] = (lane == 0) ? sq : 0.f; } } }
}

#ifndef PG8_SP2
#define PG8_SP2 true
#endif
#ifndef PG8_ALIGN
#define PG8_ALIGN true
#endif

struct SchedC {
    int vcu, G; attn_body::bf16* QKV; attn_body::bf16* OCA;
    __device__ __forceinline__ bool next(int it, attn_body::AttnUnitDV& u) const {
        constexpr long P = attn_body::PITCH;
        const int per = 3, s = vcu + (it / per) * G, k = it % per;
        if (s >= 256) return false;
        const int x = s >> 5, l = s & 31, i = l & 15, hl = (l >> 4) * 3 + k;
        const int qb = (k == 0) ? i : (k == 1) ? ((i + 8) & 15) : (i < 8 ? 14 - 2 * i : 31 - 2 * i);
        const int bj = x * 6 + hl, b = bj / 12, j = bj % 12, h = j >> 1;
        const long rowbase = (long)b * SEQ, q0 = (long)qb * 256;
        u.Q = QKV + (rowbase + q0) * P + j * 64; u.K = QKV + rowbase * P + 768 + j * 64; u.V = QKV + rowbase * P + 1536 + h * 128;
        u.Oa = OCA + (rowbase + q0) * 768 + j * 64; u.orsa = 768; u.Ob = QKV + (rowbase + q0) * P + j * 64; u.ors = P; u.rs = P;
        u.NT = 4 * qb + 4; u.moff = (int)q0;
        return true;
    }
};
struct SchedD {
    int vcu, G; attn_body::bf16* QKV; float* LSE;
    __device__ __forceinline__ bool next(int it, attn_body::AttnUnit& u) const {
        constexpr long P = attn_body::PITCH;
        const int ud = vcu + it * G; if (ud >= 768) return false;
        const int b = ud / 192, rem = ud % 192, head = rem >> 4, idx = rem & 15, g = head >> 2;
        const int dl = (g == 0) ? 1 : (g == 1 ? 4 : 16), nb = 16 / dl, r = idx / nb, qb = idx % nb;
        const long rowbase = (long)b * SEQ + r; const int q0 = 256 * qb, kstart = (q0 >= 128) ? q0 - 128 : 0;
        u.rs = (long)dl * P; u.ors = u.rs; u.lrs = (long)dl * 12;
        u.Q = QKV + (rowbase + (long)q0 * dl) * P + 2304 + head * 64; u.O = QKV + (rowbase + (long)q0 * dl) * P + 2304 + head * 64;
        u.K = QKV + (rowbase + (long)kstart * dl) * P + 3072 + head * 64; u.V = QKV + (rowbase + (long)kstart * dl) * P + 3840 + head * 64;
        u.NT = (q0 + 256 - kstart) / 64; u.moff = q0 - kstart; u.lse = LSE + (rowbase + (long)q0 * dl) * 12 + head;
        return true;
    }
};
__device__ __forceinline__ f32x4 bf4lo(const u32x4 w) { return (f32x4){__uint_as_float(w.x << 16), __uint_as_float(w.x & 0xffff0000u), __uint_as_float(w.y << 16), __uint_as_float(w.y & 0xffff0000u)}; }
__device__ __forceinline__ f32x4 bf4hi(const u32x4 w) { return (f32x4){__uint_as_float(w.z << 16), __uint_as_float(w.z & 0xffff0000u), __uint_as_float(w.w << 16), __uint_as_float(w.w & 0xffff0000u)}; }
__device__ __forceinline__ u32x4 pack8(const f32x4 a, const f32x4 b) { u32x4 o; o.x = pk2bf(a[0], a[1]); o.y = pk2bf(a[2], a[3]); o.z = pk2bf(b[0], b[1]); o.w = pk2bf(b[2], b[3]); return o; }
__device__ __forceinline__ void post_attention_phase(Frame& F, const Args& a, unsigned char* ws) {
    const bf16_t* QKV = (const bf16_t*)(ws + WS_QKV); const bf16_t* OCA = (const bf16_t*)(ws + WS_OCA); const float* LSE = (const float*)(ws + WS_LSE);
    bf16_t* Y1 = (bf16_t*)(ws + WS_QKV) + Y1_COL;
    const int lane = lane_id(), gw = F.vcu * NWAVES + F.wave, NGW = F.G * NWAVES;
    const float lam = __expf(wave_sum(a.in[13][lane] * a.in[14][lane])) - __expf(wave_sum(a.in[15][lane] * a.in[16][lane])) + LAMBDA_INIT;
    const bool isC = lane < 48;
    const int h = lane >> 3, c = lane & 7, hh = (lane - 48) >> 2, dc = (lane & 3) * 16;
    f32x4 ga0, ga1, gb0, gb1;
    { const float f = 1.f - LAMBDA_INIT; const float* sg = a.in[17] + 8 * c;
      ga0 = *(const f32x4*)sg * f; ga1 = *(const f32x4*)(sg + 4) * f; gb0 = *(const f32x4*)(sg + 64) * f; gb1 = *(const f32x4*)(sg + 68) * f; }
    for (int row = gw; row < M; row += NGW) {
        const bf16_t* qa = OCA + (size_t)row * 768; const bf16_t* qb = QKV + (size_t)row * N_QKV; bf16_t* y = Y1 + (size_t)row * N_QKV;
        if (isC) {
            const u32x4 a0 = *(const u32x4*)(qa + (2 * h) * 64 + 8 * c), a1 = *(const u32x4*)(qa + (2 * h + 1) * 64 + 8 * c);
            const u32x4 b0 = *(const u32x4*)(qb + (2 * h) * 64 + 8 * c), b1 = *(const u32x4*)(qb + (2 * h + 1) * 64 + 8 * c);
            const f32x4 x0 = bf4lo(a0) - lam * bf4lo(a1), x1 = bf4hi(a0) - lam * bf4hi(a1), z0 = bf4lo(b0) - lam * bf4lo(b1), z1 = bf4hi(b0) - lam * bf4hi(b1);
            float q = ((x0[0] * x0[0] + x0[1] * x0[1]) + (x0[2] * x0[2] + x0[3] * x0[3])) + ((x1[0] * x1[0] + x1[1] * x1[1]) + (x1[2] * x1[2] + x1[3] * x1[3]))
                    + ((z0[0] * z0[0] + z0[1] * z0[1]) + (z0[2] * z0[2] + z0[3] * z0[3])) + ((z1[0] * z1[0] + z1[1] * z1[1]) + (z1[2] * z1[2] + z1[3] * z1[3]));
            q += dpp_f<0xB1>(q); q += dpp_f<0x4E>(q); q += dpp_f<0x141>(q);
            const float r = rsqrtf(q * (1.f / 128.f) + EPS);
            *(u32x4*)(y + h * 128 + 8 * c) = pack8(x0 * ga0 * r, x1 * ga1 * r);
            *(u32x4*)(y + h * 128 + 64 + 8 * c) = pack8(z0 * gb0 * r, z1 * gb1 * r);
        } else {
            const float l0 = LSE[(size_t)row * 12 + hh], l1 = LSE[(size_t)row * 12 + 4 + hh], l2 = LSE[(size_t)row * 12 + 8 + hh];
            const float mx = fmaxf(l0, fmaxf(l1, l2));
            float w0 = __builtin_amdgcn_exp2f(l0 - mx), w1 = __builtin_amdgcn_exp2f(l1 - mx), w2 = __builtin_amdgcn_exp2f(l2 - mx);
            const float inv = 1.f / (w0 + w1 + w2); w0 *= inv; w1 *= inv; w2 *= inv;
            const bf16_t* d0 = qb + 2304 + hh * 64 + dc;
#pragma unroll
            for (int k = 0; k < 2; ++k) {
                const u32x4 v0 = *(const u32x4*)(d0 + 8 * k), v1 = *(const u32x4*)(d0 + 256 + 8 * k), v2 = *(const u32x4*)(d0 + 512 + 8 * k);
                *(u32x4*)(y + 768 + hh * 64 + dc + 8 * k) = pack8(w0 * bf4lo(v0) + w1 * bf4lo(v1) + w2 * bf4lo(v2), w0 * bf4hi(v0) + w1 * bf4hi(v1) + w2 * bf4hi(v2));
            }
        }
    }
}

constexpr int MXP = 136;
__device__ __forceinline__ void mixer_phase(Frame& F, const Args& a, unsigned char* ws) {
    const bf16_t* P = (const bf16_t*)(ws + WS_P); bf16_t* Y = (bf16_t*)(ws + WS_Y);
    const bf16_t* Wb = (const bf16_t*)(ws + WS_WSB); const bf16_t* PWt = (const bf16_t*)(ws + WS_PWT);
    const float* v_gain = a.in[6]; const float* b_s = a.in[8]; const float* pool_scale = a.in[10];
    LAS bf16_t* T = (LAS bf16_t*)(F.lds + RING_OFF);
    LAS bf16_t* T2 = (LAS bf16_t*)(F.lds + RING_OFF + 128 * MXP * 2);
    LAS float* rs = (LAS float*)(F.lds + RING_OFF + 2 * 128 * MXP * 2);
    const int tid = tid_id(), wid = tid >> 6, lane = tid & 63, fr = lane & 15, fq = lane >> 4;
    for (int u = F.vcu; u < 1024; u += F.G) {
        const bool isA = u < 512; const int blk = (u & 511) >> 2, g = u & 3, row0 = blk * 128;
        f32x4 acc[8];
#pragma unroll
        for (int j = 0; j < 8; ++j) acc[j] = (f32x4){0.f, 0.f, 0.f, 0.f};
        if (isA) {
            bf16x8 xr[16], xv[4], wf[4]; u32x2 ug[8];
#pragma unroll
            for (int i = 0; i < 16; ++i) xr[i] = *(const bf16x8*)(P + (size_t)(row0 + wid * 16 + i) * N_IN0 + 512 + lane * 8);
#pragma unroll
            for (int k = 0; k < 4; ++k) { const int it = tid + 512 * k, sr = it & 127, cc = it >> 7; xv[k] = *(const bf16x8*)(P + (size_t)(row0 + sr) * N_IN0 + 512 + g * 128 + cc * 8); }
            const bf16_t* wrow = Wb + ((size_t)g * 128 + wid * 16 + fr) * 128 + fq * 8;
#pragma unroll
            for (int ks = 0; ks < 4; ++ks) wf[ks] = *(const bf16x8*)(wrow + ks * 32);
            const int t = wid * 16 + fr;
#pragma unroll
            for (int j = 0; j < 8; ++j) ug[j] = *(const u32x2*)(P + (size_t)(row0 + t) * N_IN0 + g * 128 + j * 16 + fq * 4);
            const float bias = b_s[g * 128 + t];
#pragma unroll
            for (int i = 0; i < 16; ++i) { float q = 0.f;
#pragma unroll
                for (int e = 0; e < 8; ++e) { const float f = bf2f((bf16_t)xr[i][e]); q += f * f; }
                q = wave_sum(q);
                if (lane == 0) rs[wid * 16 + i] = rsqrtf(q * (1.f / 512.f) + EPS); }
            __syncthreads();
#pragma unroll
            for (int k = 0; k < 4; ++k) { const int it = tid + 512 * k, sr = it & 127, cc = it >> 7; const float r = rs[sr];
                const f32x4 g0 = *(const f32x4*)(v_gain + g * 128 + cc * 8), g1 = *(const f32x4*)(v_gain + g * 128 + cc * 8 + 4);
#pragma unroll
                for (int e = 0; e < 8; ++e) T[(cc * 8 + e) * MXP + sr] = f2bf(bf2f((bf16_t)xv[k][e]) * r * (e < 4 ? g0[e & 3] : g1[e & 3])); }
            __syncthreads();
            const int nks = (wid >> 1) + 1;
#pragma unroll
            for (int ks = 0; ks < 4; ++ks) if (ks < nks) {
#pragma unroll
                for (int j = 0; j < 8; ++j) { const bf16x8 bfr = *(const LAS bf16x8*)(T + (j * 16 + fr) * MXP + ks * 32 + fq * 8);
                    acc[j] = __builtin_amdgcn_mfma_f32_16x16x32_bf16(bfr, wf[ks], acc[j], 0, 0, 0); }
            }
#pragma unroll
            for (int j = 0; j < 8; ++j) { const int col = g * 128 + j * 16 + fq * 4; const u32x2 uu = ug[j];
                const float u0 = __uint_as_float(uu.x << 16), u1 = __uint_as_float(uu.x & 0xffff0000u), u2 = __uint_as_float(uu.y << 16), u3 = __uint_as_float(uu.y & 0xffff0000u);
                u32x2 o; o.x = pk2bf(u0 * (acc[j][0] + bias), u1 * (acc[j][1] + bias)); o.y = pk2bf(u2 * (acc[j][2] + bias), u3 * (acc[j][3] + bias));
                *(u32x2*)(Y + (size_t)(row0 + t) * DM + col) = o; }
        } else {
            const int w = 2 << g; const float inv_w = 1.f / (float)w;
            const int cc = tid & 15, rg = tid >> 4, r0 = row0 + rg * 4, t0 = r0 & (SEQ - 1);
            const bf16_t* xp = P + 1024 + g * 128 + cc * 8;
            bf16x8 hx[19];
#pragma unroll
            for (int j = 0; j < 19; ++j) { const int dr = j - 15; hx[j] = (bf16x8){0, 0, 0, 0, 0, 0, 0, 0};
                if (dr > -w && t0 + dr >= 0) hx[j] = *(const bf16x8*)(xp + (size_t)(r0 + dr) * N_IN0); }
            bf16x8 pw4[4];
#pragma unroll
            for (int k = 0; k < 4; ++k) { const int it = tid + 512 * k, d = it >> 4, c8 = it & 15; pw4[k] = *(const bf16x8*)(PWt + ((size_t)g * 128 + d) * 128 + c8 * 8); }
#pragma unroll
            for (int k = 0; k < 4; ++k) { const int it = tid + 512 * k, d = it >> 4, c8 = it & 15; *(LAS bf16x8*)(T2 + d * MXP + c8 * 8) = pw4[k]; }
#pragma unroll
            for (int i = 0; i < 4; ++i) { const int ts = t0 + i;
                float sum[8];
#pragma unroll
                for (int e = 0; e < 8; ++e) sum[e] = 0.f;
#pragma unroll
                for (int jj = 0; jj < 16; ++jj) { if (jj < w) {
#pragma unroll
                        for (int e = 0; e < 8; ++e) sum[e] += bf2f((bf16_t)hx[15 + i - jj][e]); } }
                const float ic = (ts + 1 < w) ? 1.f / (float)(ts + 1) : inv_w;
                u32x4 o; unsigned ow[4];
#pragma unroll
                for (int e = 0; e < 8; e += 2) ow[e >> 1] = pk2bf(sum[e] * ic - bf2f((bf16_t)hx[15 + i][e]), sum[e + 1] * ic - bf2f((bf16_t)hx[15 + i][e + 1]));
                o.x = ow[0]; o.y = ow[1]; o.z = ow[2]; o.w = ow[3];
                *(LAS u32x4*)(T + (rg * 4 + i) * MXP + cc * 8) = o; }
            __syncthreads();
#pragma unroll
            for (int ks = 0; ks < 4; ++ks) {
                const bf16x8 af = *(const LAS bf16x8*)(T + (wid * 16 + fr) * MXP + ks * 32 + fq * 8);
#pragma unroll
                for (int j = 0; j < 8; ++j) { const bf16x8 bfr = *(const LAS bf16x8*)(T2 + (j * 16 + fr) * MXP + ks * 32 + fq * 8);
                    acc[j] = __builtin_amdgcn_mfma_f32_16x16x32_bf16(bfr, af, acc[j], 0, 0, 0); }
            }
            const int t = wid * 16 + fr;
#pragma unroll
            for (int j = 0; j < 8; ++j) { const int d = g * 128 + j * 16 + fq * 4; const f32x4 sc = *(const f32x4*)(pool_scale + d);
                u32x2 o; o.x = pk2bf(acc[j][0] * sc[0], acc[j][1] * sc[1]); o.y = pk2bf(acc[j][2] * sc[2], acc[j][3] * sc[3]);
                *(u32x2*)(Y + (size_t)(row0 + t) * DM + 512 + d) = o; }
        }
        __syncthreads();
    }
}

__device__ __forceinline__ void ffn_fix_phase(Frame& F, const Args& a, unsigned char* ws, int layer) {
    bf16_t* HM = (bf16_t*)(ws + WS_HMID);
    const float* halo = (const float*)(ws + WS_HALO); const float* tops = (const float*)(ws + WS_TOPS); const float* topg = (const float*)(ws + WS_TOPG);
    const float* cw = a.in[20] + (size_t)layer * 3 * DFF;
    const int tid = tid_id();
    constexpr int CPR = DFF / 4;
    for (int it = F.vcu * (NWAVES * 64) + tid; it < 64 * 2 * CPR; it += F.G * NWAVES * 64) {
        const int pm = it / (2 * CPR), rem = it % (2 * CPR), rr = rem / CPR, c = (rem % CPR) * 4;
        if ((pm & 15) == 0) continue;
        const size_t off = ((size_t)pm * 2 + rr) * DFF + c;
        f32x4 sv = *(const f32x4*)(tops + off); const f32x4 g = *(const f32x4*)(topg + off);
        const f32x4 h1 = *(const f32x4*)(halo + ((size_t)(pm - 1) * 2 + 1) * DFF + c), h0 = *(const f32x4*)(halo + ((size_t)(pm - 1) * 2 + 0) * DFF + c);
        const f32x4 w0 = *(const f32x4*)(cw + c), w1 = *(const f32x4*)(cw + DFF + c);
        if (rr == 0) sv = sv + w1 * h1 + w0 * h0; else sv = sv + w0 * h1;
        u32x2 o; o.x = pk2bf(gelu_tanh(sv[0]) * g[0], gelu_tanh(sv[1]) * g[1]); o.y = pk2bf(gelu_tanh(sv[2]) * g[2], gelu_tanh(sv[3]) * g[3]);
        *(u32x2*)(HM + (size_t)(pm * 256 + rr) * DFF + c) = o;
    }
}

#define OPQ_S(x) asm volatile("" : "+s"(x))
__device__ __forceinline__ Frame make_frame(unsigned char* ws) {
    extern __shared__ __attribute__((aligned(16))) unsigned char lds_[];
    Frame F;
    F.lds = (LAS unsigned char*)lds_;
    F.MISC = (volatile LAS unsigned*)(F.lds + MISC_OFF);
    F.wave = __builtin_amdgcn_readfirstlane((int)threadIdx.x >> 6);
    int G = gridDim.x, bx = blockIdx.x; OPQ_S(G); OPQ_S(bx);
    F.G = G; F.vcu = (G % 8 == 0) ? (bx % 8) * (G / 8) + bx / 8 : bx;
    F.ctl = (gu32*)(ws + WS_CTL);
    return F;
}
__global__ void __launch_bounds__(NWAVES * 64, 2) mk_fwd(Args args) {
    extern __shared__ __attribute__((aligned(16))) unsigned char lds[];
    for (int u = threadIdx.x; u < (LDS_BYTES - LDSCTL_OFF) / 4; u += NWAVES * 64) ((LAS unsigned*)((LAS unsigned char*)lds + LDSCTL_OFF))[u] = 0u;
    __syncthreads();
    const int lo = args.ph_lo, hi = args.ph_hi;
    if (hi - lo > 1) { unsigned char* ws = args.ws; (void)xcd_barrier_post((unsigned*)((gu32*)(ws + WS_CTL) + CW_BAR) + args.li * XCD_BAR_WORDS, (volatile LAS unsigned*)((LAS unsigned char*)lds + MISC_OFF) + 8); }
#ifdef MK_DIAG
    if (blockIdx.x == 0 && threadIdx.x == 0) ((unsigned long long*)(args.ws + WS_CTL + 524288))[31] = __builtin_amdgcn_s_memrealtime();
#endif
    int pc = 0;
#define PHASE_BEGIN if (pc >= lo && pc < hi) { size_t z_ = 0; OPQ_S(z_); unsigned char* ws = args.ws + z_; float* out = args.out + z_; Frame F = make_frame(ws); bf16_t* XN = (bf16_t*)(ws + WS_XN); (void)XN; (void)out;
#ifdef MK_DIAG
#define DIAG_STAMP(k) do { if (blockIdx.x == 0 && threadIdx.x == 0) ((unsigned long long*)(ws + WS_CTL + 524288))[(k)] = __builtin_amdgcn_s_memrealtime(); } while (0)
#else
#define DIAG_STAMP(k) do { } while (0)
#endif
#define PHASE_END if (pc + 1 < hi) { XcdBarrier bar; bar.bar = (unsigned*)(F.ctl + CW_BAR) + args.li * XCD_BAR_WORDS; bar.x = xb_xcc_id(); bar.st = F.MISC + 8; xcd_barrier(bar); } DIAG_STAMP(pc); } ++pc;

    PHASE_BEGIN p0_prologue(F, args); PHASE_END
    PHASE_BEGIN
        pg8::Gemm g{XN, (const bf16_t*)(ws + WS_W_IN0), M, N_IN0, DM}; pg8::StaticOrder S; S.init(M, N_IN0, F.G, (int)blockIdx.x);
        pg8::EpiBf16G E{(bf16_t*)(ws + WS_P), N_IN0, 4, (const float*)(ws + WS_RSQ)};
        pg8::gemm_phase<pg8::EpiBf16G, pg8::StaticOrder, PG8_ALIGN, PG8_SP2>(F.lds + RING_OFF, g, S, E);
        convert_in_tail(F, args, ws, (M / 256) * (N_IN0 / 256), CB_P0_END, CB_1_END);
    PHASE_END
    PHASE_BEGIN mixer_phase(F, args, ws); PHASE_END
    PHASE_BEGIN
        pg8::Gemm g{(const bf16_t*)(ws + WS_Y), (const bf16_t*)(ws + WS_W_OUT0), M, DM, DM}; pg8::StaticOrder S; S.init(M, DM, F.G, (int)blockIdx.x);
        pg8::EpiRes E{XN, (float*)(ws + WS_RSQ)};
        pg8::gemm_phase<pg8::EpiRes, pg8::StaticOrder, PG8_ALIGN, PG8_SP2>(F.lds + RING_OFF, g, S, E);
    PHASE_END
#define RMS_PHASE(gain_ptr) PHASE_BEGIN { const float* gain = (gain_ptr); const int lane = lane_id(); const int gw = F.vcu * NWAVES + F.wave, NGW = F.G * NWAVES; \
        for (int m = gw; m < M; m += NGW) rms_row_to_bf16(out + (size_t)m * DM, gain, XN + (size_t)m * DM, lane); } PHASE_END
#define UP_PHASE(layer, abuf) PHASE_BEGIN { pg8::Gemm g{(const bf16_t*)(ws + (abuf)), (const bf16_t*)(ws + WS_W_UP) + (size_t)(layer) * NUP * DM, M, NUP, DM}; pg8::StaticOrder S; S.init(M, NUP, F.G, (int)blockIdx.x); \
        pg8::EpiUpConv E{(bf16_t*)(ws + WS_HMID), args.in[20] + (size_t)(layer) * 3 * DFF, args.in[21] + (size_t)(layer) * DFF, (float*)(ws + WS_HALO), (float*)(ws + WS_TOPS), (float*)(ws + WS_TOPG), (const float*)(ws + WS_RSQ)}; \
        pg8::gemm_phase<pg8::EpiUpConv, pg8::StaticOrder, true, PG8_SP2>(F.lds + RING_OFF, g, S, E); \
        if ((layer) == 0) convert_in_tail(F, args, ws, (M / 256) * (NUP / 256), CB_1_END, CB_2_END); } PHASE_END
#define DOWN_PHASE(layer) PHASE_BEGIN { pg8::Gemm g{(const bf16_t*)(ws + WS_HMID), (const bf16_t*)(ws + WS_W_DN) + (size_t)(layer) * DM * DFF, M, DM, DFF}; pg8::StaticOrder S; S.init(M, DM, F.G, (int)blockIdx.x); \
        pg8::EpiRes E{XN, (float*)(ws + WS_RSQ)}; \
        pg8::gemm_phase<pg8::EpiRes, pg8::StaticOrder, PG8_ALIGN, PG8_SP2>(F.lds + RING_OFF, g, S, E); } PHASE_END
    UP_PHASE(0, WS_XN)
    PHASE_BEGIN ffn_fix_phase(F, args, ws, 0); PHASE_END
    DOWN_PHASE(0)
    PHASE_BEGIN
        pg8::Gemm g{XN, (const bf16_t*)(ws + WS_W_QKV), M, N_QKV, DM}; pg8::StaticOrder S; S.init(M, N_QKV, F.G, (int)blockIdx.x);
        pg8::EpiQKV E{(bf16_t*)(ws + WS_QKV), (const int*)args.in[1], (const float*)(ws + WS_RSQ)};
        pg8::gemm_phase<pg8::EpiQKV, pg8::StaticOrder, PG8_ALIGN, PG8_SP2>(F.lds + RING_OFF, g, S, E);
    PHASE_END
    PHASE_BEGIN
        { const SchedC SC{F.vcu, F.G, (attn_body::bf16*)(ws + WS_QKV), (attn_body::bf16*)(ws + WS_OCA)};
          attn_body::attn_phase_dv<SchedC, 8>((char*)lds + RING_OFF, SC); }
        { const SchedD SD{F.vcu, F.G, (attn_body::bf16*)(ws + WS_QKV), (float*)(ws + WS_LSE)};
          attn_body::attn_phase<SchedD, 8, true>((char*)lds + RING_OFF, SD); }
    PHASE_END
    PHASE_BEGIN post_attention_phase(F, args, ws); PHASE_END
    PHASE_BEGIN
        pg8::Gemm g{(const bf16_t*)(ws + WS_QKV) + Y1_COL, (const bf16_t*)(ws + WS_W_OUT1), M, DM, DM, N_QKV}; pg8::StaticOrder S; S.init(M, DM, F.G, (int)blockIdx.x);
        pg8::EpiRes E{XN, (float*)(ws + WS_RSQ)};
        pg8::gemm_phase<pg8::EpiRes, pg8::StaticOrder, PG8_ALIGN, PG8_SP2>(F.lds + RING_OFF, g, S, E);
    PHASE_END
    UP_PHASE(1, WS_XN)
    PHASE_BEGIN ffn_fix_phase(F, args, ws, 1); PHASE_END
    DOWN_PHASE(1)
    PHASE_BEGIN
        const int lane = lane_id(); const int gw = F.vcu * NWAVES + F.wave, NGW = F.G * NWAVES;
        for (int m = gw; m < M; m += NGW) rms_row_final(XN + (size_t)m * DM, out + (size_t)m * DM, args.in[4], (const float*)(ws + WS_RSQ) + (size_t)m * 4, lane);
    PHASE_END
#ifdef MK_DIAG
    __syncthreads();
    if (blockIdx.x == 0 && threadIdx.x < 64) {
        asm volatile("s_waitcnt vmcnt(0)" ::: "memory");
        const unsigned long long* st = (const unsigned long long*)(args.ws + WS_CTL + 524288);
        const unsigned long long a1 = __hip_atomic_load(st + MK_DIAG_SEL1, __ATOMIC_RELAXED, __HIP_MEMORY_SCOPE_AGENT), b1 = __hip_atomic_load(st + (MK_DIAG_SEL1 == 0 ? 31 : MK_DIAG_SEL1 - 1), __ATOMIC_RELAXED, __HIP_MEMORY_SCOPE_AGENT);
        const unsigned long long a2 = __hip_atomic_load(st + MK_DIAG_SEL2, __ATOMIC_RELAXED, __HIP_MEMORY_SCOPE_AGENT), b2 = __hip_atomic_load(st + (MK_DIAG_SEL2 == 0 ? 31 : MK_DIAG_SEL2 - 1), __ATOMIC_RELAXED, __HIP_MEMORY_SCOPE_AGENT);
        const float d1 = (float)(long long)(a1 - b1) * 0.01f, d2 = (float)(long long)(a2 - b2) * 0.01f;
        for (int i = threadIdx.x; i <= 4096; i += 64) args.out[i] = (i == 0) ? d1 : d2;
    }
#endif
#undef PHASE_BEGIN
#undef PHASE_END
}
constexpr int N_PHASES = 15;

#ifndef MK_N_LAUNCHES
#define MK_N_LAUNCHES 1
#endif
extern "C" void kernel_launch(void* const* d_in, const int* in_sizes, int n_in, void* d_out, int out_size, void* d_ws, size_t ws_size, hipStream_t stream) {
    static int grid = 0;
    if (grid == 0) {
        int dev = 0, cus = 0;
        if (hipGetDevice(&dev) != hipSuccess || hipDeviceGetAttribute(&cus, hipDeviceAttributeMultiprocessorCount, dev) != hipSuccess) { fprintf(stderr, "kernel_launch: device query failed\n"); grid = -1; return; }
        if (hipFuncSetAttribute((const void*)mk_fwd, hipFuncAttributeMaxDynamicSharedMemorySize, LDS_BYTES) != hipSuccess) { fprintf(stderr, "kernel_launch: hipFuncSetAttribute failed\n"); grid = -1; return; }
        int per_cu = 0;
        if (hipOccupancyMaxActiveBlocksPerMultiprocessor(&per_cu, (const void*)mk_fwd, NWAVES * 64, LDS_BYTES) != hipSuccess || per_cu < 1) fprintf(stderr, "kernel_launch: occupancy query reports %d workgroups per CU\n", per_cu);
        (void)hipGetLastError();
        grid = cus > 0 ? cus : 256;
    }
    if (grid < 0) return;
    unsigned char* ws = (unsigned char*)d_ws;
    (void)hipMemsetAsync(ws + WS_CTL, 0, CTL_ZERO_BYTES, stream);
    Args a{};
    for (int i = 0; i < 23; ++i) a.in[i] = (const float*)d_in[i];
    a.out = (float*)d_out; a.ws = ws;
#ifdef MK_DUP_PHASE
    if (true) {
        a.li = 0; a.ph_lo = 0; a.ph_hi = MK_DUP_PHASE + 1; hipLaunchKernelGGL(mk_fwd, dim3(grid), dim3(NWAVES * 64), LDS_BYTES, stream, a);
        a.li = 1; a.ph_lo = MK_DUP_PHASE; a.ph_hi = MK_DUP_PHASE + 1; hipLaunchKernelGGL(mk_fwd, dim3(grid), dim3(NWAVES * 64), LDS_BYTES, stream, a);
        a.li = 2; a.ph_lo = MK_DUP_PHASE + 1; a.ph_hi = N_PHASES; hipLaunchKernelGGL(mk_fwd, dim3(grid), dim3(NWAVES * 64), LDS_BYTES, stream, a);
    } else
#endif
    if (MK_N_LAUNCHES == 1) {
        a.ph_lo = 0; a.ph_hi = N_PHASES;
        hipLaunchKernelGGL(mk_fwd, dim3(grid), dim3(NWAVES * 64), LDS_BYTES, stream, a);
    } else {
        for (int p = 0; p < N_PHASES; ++p) { a.ph_lo = p; a.ph_hi = p + 1; hipLaunchKernelGGL(mk_fwd, dim3(grid), dim3(NWAVES * 64), LDS_BYTES, stream, a); }
    }
}
```

```cpp
#include <hip/hip_runtime.h>
#include <cstdint>
#include <cstdio>

typedef unsigned short bf16_t;
typedef short bf16x8 __attribute__((ext_vector_type(8)));
typedef float f32x4 __attribute__((ext_vector_type(4)));
typedef float f32x2 __attribute__((ext_vector_type(2)));
typedef unsigned u32x4 __attribute__((ext_vector_type(4)));
typedef unsigned u32x2 __attribute__((ext_vector_type(2)));

constexpr int BATCH = 4, SEQ = 4096, DM = 1024, M = BATCH * SEQ;
constexpr int DFF = 2816, NUP = 2 * DFF;
constexpr int N_IN0 = 1536, N_QKV = 4608;
constexpr float EPS = 1e-6f;
constexpr float LAMBDA_INIT = 0.35550906759f;

__device__ __forceinline__ float bf2f(bf16_t v) { return __uint_as_float(((unsigned)v) << 16); }
__device__ __forceinline__ bf16_t f2bf(float f) { unsigned u = __float_as_uint(f); return (bf16_t)((u + 0x7fffu + ((u >> 16) & 1u)) >> 16); }
__device__ __forceinline__ unsigned pk2bf(float lo, float hi) { return (unsigned)f2bf(lo) | ((unsigned)f2bf(hi) << 16); }
__device__ __forceinline__ float gelu_tanh(float x) {
    const float y = x * (0.7978845608028654f + 0.035677408136300125f * x * x);
    return x * __builtin_amdgcn_rcpf(1.0f + __builtin_amdgcn_exp2f(-2.8853900817779268f * y));
}
template <int CTRL> __device__ __forceinline__ float dpp_f(float v) { return __int_as_float(__builtin_amdgcn_update_dpp(0, __float_as_int(v), CTRL, 0xf, 0xf, true)); }
__device__ __forceinline__ float swz_xor16(float v) { return __int_as_float(__builtin_amdgcn_ds_swizzle(__float_as_int(v), 0x401F)); }
__device__ __forceinline__ float wave_sum(float v) {
    v += dpp_f<0xB1>(v);
    v += dpp_f<0x4E>(v);
    v += dpp_f<0x141>(v);
    v += dpp_f<0x140>(v);
    v += swz_xor16(v);
    const auto rr = __builtin_amdgcn_permlane32_swap(__float_as_uint(v), __float_as_uint(v), false, false);
    return __uint_as_float(rr[0]) + __uint_as_float(rr[1]);
}

constexpr size_t MiB = 1u << 20;
constexpr size_t WS_CTL = 0, CTL_ZERO_BYTES = 1 * MiB;
constexpr size_t WS_W_IN0 = 1 * MiB;
constexpr size_t WS_W_OUT0 = 4 * MiB;
constexpr size_t WS_W_QKV = 6 * MiB;
constexpr size_t WS_W_OUT1 = 15 * MiB;
constexpr size_t WS_W_UP = 17 * MiB;
constexpr size_t WS_W_DN = 39 * MiB;
constexpr size_t WS_ROPE = 50 * MiB;
constexpr size_t WS_WSB = 51 * MiB;
constexpr size_t WS_PWT = 51 * MiB + 256 * 1024;
constexpr size_t WS_XN = 52 * MiB;
constexpr size_t WS_BUF = 84 * MiB;
constexpr size_t WS_P = WS_BUF, WS_Y = 132 * MiB;
constexpr size_t WS_HMID = 116 * MiB;
constexpr size_t WS_HALO = 204 * MiB, WS_TOPS = 206 * MiB, WS_TOPG = 208 * MiB;
constexpr size_t WS_QKV = WS_BUF;
constexpr int Y1_COL = 768;
constexpr size_t WS_OCA = 228 * MiB;
constexpr size_t WS_RSQ = 253 * MiB;
constexpr size_t WS_LSE = 252 * MiB;
namespace pg8 {
#define PG8_LAS __attribute__((address_space(3)))
typedef unsigned short bf16_t;
typedef short bf16x8 __attribute__((ext_vector_type(8)));
typedef float f32x4 __attribute__((ext_vector_type(4)));
typedef unsigned u32x4 __attribute__((ext_vector_type(4)));
constexpr int BM = 256, BK = 64, HALF = 128, HTB = HALF * BK * 2  , STAGE_BYTES = 8 * HTB, NXCD = 8, WGM = 8;

__host__ __device__ __forceinline__ int lds_byte(int r, int c) { const int st = (r >> 4) * 2 + (c >> 5), rr = r & 15, cc = c & 31, ob = rr * 64 + cc * 2; return st * 1024 + (ob ^ (((ob >> 9) & 1) << 5)); }
__host__ __device__ __forceinline__ void stage_rc(int b, int& R, int& C) { const int st = b / 1024, sb = b % 1024, swz = sb ^ (((sb >> 9) & 1) << 5); R = (st >> 1) * 16 + swz / 64; C = (st & 1) * 32 + (swz % 64) / 2; }
__host__ __device__ __forceinline__ int perm32(int rho) { const int n = rho >> 4, i = rho & 15; return 8 * (i >> 2) + 4 * n + (i & 3); }

struct Unit { int pm, pn; };
struct Gemm { const bf16_t* A; const bf16_t* Bt; int M, N, K, lda; };

struct StaticOrder {
    int nM, nN, nwg, G, c;
    __host__ __device__ __forceinline__ void init(int M, int N, int G_, int c_) { nM = M / BM; nN = N / BM; nwg = nM * nN; G = G_; c = c_; }
    __host__ __device__ __forceinline__ bool next(int i, Unit& u) const {
        const long L = (long)i * G + c; if (L >= nwg) return false;
        int wgid = (int)L; { const int q = nwg / NXCD, r = nwg % NXCD, xcd = wgid % NXCD, off = wgid / NXCD; wgid = (xcd < r ? xcd * (q + 1) : r * (q + 1) + (xcd - r) * q) + off; }
        const int nig = WGM * nN, gid = wgid / nig, fm = gid * WGM, gsz = (nM - fm) < WGM ? (nM - fm) : WGM;
        u.pm = fm + ((wgid % nig) % gsz); u.pn = (wgid % nig) / gsz; return true;
    }
    __device__ __forceinline__ void a_ready(const Unit&) const {}
    __device__ __forceinline__ void done(const Unit&) const {}
};


__device__ __forceinline__ unsigned cvt_pk_bf16(float lo, float hi) { unsigned r; asm volatile("v_cvt_pk_bf16_f32 %0, %1, %2" : "=v"(r) : "v"(lo), "v"(hi)); return r; }

__device__ __forceinline__ float rstd_of(const f32x4 p) { return rsqrtf(((p[0] + p[1]) + (p[2] + p[3])) * (1.f / 1024.f) + 1e-6f); }
struct EpiBf16G {
    static constexpr bool PERM = true, AFTER_DRAIN = false;
    bf16_t* O; int ldc; int gelu_tiles; const float* rsq;
    __device__ __forceinline__ void operator()(const f32x4 (&acc)[2][2][4][2], const Unit& u, int wr, int wc, int fr, int fq) const {
        const int row0 = u.pm * BM + wr * 64 + fr, col0 = u.pn * BM + wc * 32 + 8 * fq;
        const bool g = u.pn < gelu_tiles;
        f32x4 pr[2][4];
#pragma unroll
        for (int ai = 0; ai < 2; ++ai)
#pragma unroll
            for (int m = 0; m < 4; ++m) pr[ai][m] = rsq ? *(const f32x4*)(rsq + (size_t)(row0 + ai * HALF + m * 16) * 4) : (f32x4){0.f, 0.f, 0.f, 0.f};
#pragma unroll
        for (int ai = 0; ai < 2; ++ai)
#pragma unroll
            for (int m = 0; m < 4; ++m) { bf16_t* rowp = O + (size_t)(row0 + ai * HALF + m * 16) * ldc + col0; const float rstd = rsq ? rstd_of(pr[ai][m]) : 1.f;
#pragma unroll
                for (int bj = 0; bj < 2; ++bj) { f32x4 v0 = acc[ai][bj][m][0] * rstd, v1 = acc[ai][bj][m][1] * rstd;
                    if (g) { v0 = (f32x4){gelu_tanh(v0[0]), gelu_tanh(v0[1]), gelu_tanh(v0[2]), gelu_tanh(v0[3])}; v1 = (f32x4){gelu_tanh(v1[0]), gelu_tanh(v1[1]), gelu_tanh(v1[2]), gelu_tanh(v1[3])}; }
                    u32x4 w; w.x = cvt_pk_bf16(v0[0], v0[1]); w.y = cvt_pk_bf16(v0[2], v0[3]); w.z = cvt_pk_bf16(v1[0], v1[1]); w.w = cvt_pk_bf16(v1[2], v1[3]);
                    *(u32x4*)(rowp + bj * HALF) = w; } }
    }
};
constexpr int XCH_LDS_OFF = 132096;
struct EpiRes {
    static constexpr bool PERM = false, AFTER_DRAIN = false;
    bf16_t* hb; float* rsq;
    __device__ __forceinline__ void operator()(const f32x4 (&acc)[2][2][4][2], const Unit& u, int wr, int wc, int fr, int fq) const {
        extern __shared__ __attribute__((aligned(16))) unsigned char lds_all_[];
        PG8_LAS float* S = (PG8_LAS float*)((PG8_LAS unsigned char*)lds_all_ + XCH_LDS_OFF);
        const int row0 = u.pm * BM + wr * 64 + fr, col0 = u.pn * BM + wc * 32 + 4 * fq;
#pragma unroll
        for (int ai = 0; ai < 2; ++ai) {
            u32x2 bs[4][2][2];
#pragma unroll
            for (int m = 0; m < 4; ++m)
#pragma unroll
                for (int bj = 0; bj < 2; ++bj)
#pragma unroll
                    for (int n = 0; n < 2; ++n) bs[m][bj][n] = *(const u32x2*)(hb + (size_t)(row0 + ai * HALF + m * 16) * 1024 + col0 + bj * HALF + n * 16);
#pragma unroll
            for (int m = 0; m < 4; ++m) { const int row = row0 + ai * HALF + m * 16; const size_t off = (size_t)row * 1024 + col0; float q = 0.f;
#pragma unroll
                for (int bj = 0; bj < 2; ++bj)
#pragma unroll
                    for (int n = 0; n < 2; ++n) { const u32x2 b = bs[m][bj][n];
                        const f32x4 h = (f32x4){__uint_as_float(b.x << 16), __uint_as_float(b.x & 0xffff0000u), __uint_as_float(b.y << 16), __uint_as_float(b.y & 0xffff0000u)} + acc[ai][bj][m][n];
                        q += (h[0] * h[0] + h[1] * h[1]) + (h[2] * h[2] + h[3] * h[3]);
                        u32x2 w; w.x = cvt_pk_bf16(h[0], h[1]); w.y = cvt_pk_bf16(h[2], h[3]); *(u32x2*)(hb + off + bj * HALF + n * 16) = w; }
                q += swz_xor16(q);
                { const auto rr = __builtin_amdgcn_permlane32_swap(__float_as_uint(q), __float_as_uint(q), false, false); q = __uint_as_float(rr[0]) + __uint_as_float(rr[1]); }
                if (fq == 0) S[(ai * HALF + wr * 64 + m * 16 + fr) * 4 + wc] = q; }
        }
        asm volatile("s_waitcnt lgkmcnt(0)" ::: "memory"); __builtin_amdgcn_s_barrier(); asm volatile("" ::: "memory");
        const int t = (int)threadIdx.x;
        if (t < 256) { const f32x4 p = *(const PG8_LAS f32x4*)(S + t * 4); rsq[(size_t)(u.pm * BM + t) * 4 + u.pn] = (p[0] + p[1]) + (p[2] + p[3]); }
    }
};
constexpr float ATT_C2 = 0.125f * 1.4426950408889634f;
struct EpiQKV {
    static constexpr bool PERM = true, AFTER_DRAIN = false;
    bf16_t* O; const int* pos; const float* rsq;
    __device__ __forceinline__ void operator()(const f32x4 (&acc)[2][2][4][2], const Unit& u, int wr, int wc, int fr, int fq) const {
        const int row0 = u.pm * BM + wr * 64 + fr, col0 = u.pn * BM + wc * 32 + 8 * fq;
        const int pn = u.pn;
        const bool is_rope = (pn < 6) || (pn >= 9 && pn < 15);
        const bool is_q = (pn < 3) || (pn >= 9 && pn < 12);
        const float sc = is_q ? ATT_C2 : 1.f;
        const bool do_rot = is_rope && ((wc & 1) == 0);
        const float sgn = (fq == 0) ? -1.f : 1.f;
        f32x4 pr[2][4]; int ps[2][4];
#pragma unroll
        for (int ai = 0; ai < 2; ++ai)
#pragma unroll
            for (int m = 0; m < 4; ++m) { pr[ai][m] = *(const f32x4*)(rsq + (size_t)(row0 + ai * HALF + m * 16) * 4); ps[ai][m] = do_rot ? pos[row0 + ai * HALF + m * 16] : 0; }
        const f32x4 f0 = {0.15915494309189535f, 0.03086376340470123f, 0.005985185712713705f, 0.001160663641240061f};
        const f32x4 f1 = {0.00022507907903927653f, 4.364795279280289e-05f, 8.464330808241401e-06f, 1.6414262627950345e-06f};
#pragma unroll
        for (int ai = 0; ai < 2; ++ai)
#pragma unroll
            for (int m = 0; m < 4; ++m) { const int row = row0 + ai * HALF + m * 16; bf16_t* rowp = O + (size_t)row * 4608 + col0;
                f32x4 cs0 = {1.f, 1.f, 1.f, 1.f}, cs1 = cs0, sn0 = {0.f, 0.f, 0.f, 0.f}, sn1 = sn0;
                if (do_rot) { const float p = (float)ps[ai][m];
#pragma unroll
                    for (int e = 0; e < 4; ++e) { const float r0 = __builtin_amdgcn_fractf(p * f0[e]), r1 = __builtin_amdgcn_fractf(p * f1[e]);
                        cs0[e] = __builtin_amdgcn_cosf(r0); sn0[e] = __builtin_amdgcn_sinf(r0) * sgn; cs1[e] = __builtin_amdgcn_cosf(r1); sn1[e] = __builtin_amdgcn_sinf(r1) * sgn; } }
                const float rstd = rstd_of(pr[ai][m]) * sc;
#pragma unroll
                for (int bj = 0; bj < 2; ++bj) { f32x4 v0 = acc[ai][bj][m][0] * rstd, v1 = acc[ai][bj][m][1] * rstd;
                    if (do_rot) {
                        f32x4 p0, p1;
#pragma unroll
                        for (int e = 0; e < 4; ++e) { p0[e] = swz_xor16(v0[e]); p1[e] = swz_xor16(v1[e]); }
                        if (fq < 2) { v0 = v0 * cs0 + p0 * sn0; v1 = v1 * cs1 + p1 * sn1; }
                    }
                    u32x4 w; w.x = cvt_pk_bf16(v0[0], v0[1]); w.y = cvt_pk_bf16(v0[2], v0[3]); w.z = cvt_pk_bf16(v1[0], v1[1]); w.w = cvt_pk_bf16(v1[2], v1[3]);
                    *(u32x4*)(rowp + bj * HALF) = w; } }
    }
};

template <int CTRL> __device__ __forceinline__ f32x4 dpp4(f32x4 v) { return (f32x4){dpp_f<CTRL>(v[0]), dpp_f<CTRL>(v[1]), dpp_f<CTRL>(v[2]), dpp_f<CTRL>(v[3])}; }
struct EpiUpConv {
    static constexpr bool PERM = true, AFTER_DRAIN = false;
    bf16_t* HM; const float* cw; const float* cb; float* halo; float* tops; float* topg; const float* rsq;
    __device__ __forceinline__ void operator()(const f32x4 (&acc)[2][2][4][2], const Unit& u, int wr_, int wc_, int fr_, int fq_) const {
        int tid_ = threadIdx.x; asm volatile("" : "+v"(tid_));
        const int wid_ = __builtin_amdgcn_readfirstlane(tid_ >> 6), wr = wid_ >> 2, wc = wid_ & 3, fr = tid_ & 15, fq = (tid_ >> 4) & 3; (void)wr_; (void)wc_; (void)fr_; (void)fq_;
        extern __shared__ __attribute__((aligned(16))) unsigned char lds_all_[];
        PG8_LAS float* X = (PG8_LAS float*)((PG8_LAS unsigned char*)lds_all_ + XCH_LDS_OFF);
        const int cl = wc * 32 + 8 * fq, hc = u.pn * 128 + cl;
        float rstd[2][4];
        { f32x4 pr[2][4];
#pragma unroll
          for (int ai = 0; ai < 2; ++ai)
#pragma unroll
              for (int m = 0; m < 4; ++m) pr[ai][m] = *(const f32x4*)(rsq + (size_t)(u.pm * BM + ai * HALF + wr * 64 + m * 16 + fr) * 4);
#pragma unroll
          for (int ai = 0; ai < 2; ++ai)
#pragma unroll
              for (int m = 0; m < 4; ++m) rstd[ai][m] = rstd_of(pr[ai][m]); }
        if (fr >= 14) {
#pragma unroll
            for (int ai = 0; ai < 2; ++ai) { PG8_LAS float* xp = X + (((ai * 2 + wr) * 2 + (fr - 14)) * 128 + cl);
                *(PG8_LAS f32x4*)xp = acc[ai][0][3][0] * rstd[ai][3]; *(PG8_LAS f32x4*)(xp + 4) = acc[ai][0][3][1] * rstd[ai][3]; }
            if (wr == 1) { float* hp = halo + ((size_t)u.pm * 2 + (fr - 14)) * 2816 + hc; *(f32x4*)hp = acc[1][0][3][0] * rstd[1][3]; *(f32x4*)(hp + 4) = acc[1][0][3][1] * rstd[1][3]; }
        }
        asm volatile("s_waitcnt lgkmcnt(0)" ::: "memory"); __builtin_amdgcn_s_barrier(); asm volatile("" ::: "memory");
        const bool needs_fix = (u.pm & 15) != 0;
#pragma unroll
        for (int n = 0; n < 2; ++n) {
            const f32x4 w0 = *(const f32x4*)(cw + hc + 4 * n), w1 = *(const f32x4*)(cw + 2816 + hc + 4 * n), w2 = *(const f32x4*)(cw + 2 * 2816 + hc + 4 * n), bb = *(const f32x4*)(cb + hc + 4 * n);
#pragma unroll
            for (int ai = 0; ai < 2; ++ai) {
                f32x4 pa, pb;
                const bool has_pred = !(ai == 0 && wr == 0);
                const int pblk = (wr == 1) ? (ai * 2) : 1;
                if (has_pred) { pa = *(const PG8_LAS f32x4*)(X + ((pblk * 2 + 1) * 128 + cl + 4 * n)); pb = *(const PG8_LAS f32x4*)(X + ((pblk * 2 + 0) * 128 + cl + 4 * n)); }
                else { pa = (f32x4){0.f, 0.f, 0.f, 0.f}; pb = pa; }
                f32x4 r1p = pa, r2p = (fr == 1) ? pa : pb;
                size_t ho = (size_t)(u.pm * BM + ai * HALF + wr * 64 + fr) * 2816 + hc + 4 * n; asm volatile("" : "+v"(ho));
#pragma unroll
                for (int m = 0; m < 4; ++m) {
                    const f32x4 x = acc[ai][0][m][n] * rstd[ai][m];
                    const f32x4 R1 = dpp4<0x121>(x), R2 = dpp4<0x122>(x);
                    const f32x4 p1 = (fr >= 1) ? R1 : r1p;
                    const f32x4 p2 = (fr >= 2) ? R2 : r2p;
                    const f32x4 sv = w2 * x + w1 * p1 + w0 * p2 + bb;
                    r1p = R1; r2p = R2;
                    const f32x4 g = acc[ai][1][m][n] * rstd[ai][m];
                    if (ai == 0 && m == 0) { if (wr == 0 && fr < 2 && needs_fix) { const size_t off = ((size_t)u.pm * 2 + fr) * 2816 + hc + 4 * n; *(f32x4*)(tops + off) = sv; *(f32x4*)(topg + off) = g; } }
                    u32x2 w; w.x = cvt_pk_bf16(gelu_tanh(sv[0]) * g[0], gelu_tanh(sv[1]) * g[1]); w.y = cvt_pk_bf16(gelu_tanh(sv[2]) * g[2], gelu_tanh(sv[3]) * g[3]);
                    *(u32x2*)(HM + ho) = w; ho += 16 * 2816;
                    asm volatile("" : "+v"(ho) :: "memory");
                }
            }
        }
    }
};
template <class Epi, class Sched, bool ALIGN_EPI = false, bool SP2 = false>
__device__ __forceinline__ void gemm_phase(PG8_LAS unsigned char* lds, const Gemm g, const Sched& S, const Epi& E) {
    int tid_ = threadIdx.x; asm volatile("" : "+v"(tid_));
    const int tid = tid_, wid = __builtin_amdgcn_readfirstlane(tid >> 6), lane = tid & 63, wr = wid >> 2, wc = wid & 3, fr = lane & 15, fq = lane >> 4;
    const int K = g.K, nt = K / BK, LDA = g.lda ? g.lda : g.K;
    unsigned voffA[2], voffB[2];
#pragma unroll
    for (int i = 0; i < 2; ++i) { int R, C; stage_rc(tid * 16 + i * 8192, R, C); const int Rb = Epi::PERM ? ((R & ~31) + perm32(R & 31)) : R;
        voffA[i] = (unsigned)(R * LDA + C) * 2u; voffB[i] = (unsigned)(Rb * K + C) * 2u; }
    const size_t kstep = (size_t)(BK * 2);
    const size_t hstep = (size_t)HALF * K * 2;
    const size_t tstep = 2 * hstep;
    const size_t hstepA = (size_t)HALF * LDA * 2, tstepA = 2 * hstepA;
    const unsigned ldsw = (unsigned)wid * 1024u;
    const int aoff = lds_byte(wr * 64 + fr, fq * 8), boff = lds_byte(wc * 32 + fr, fq * 8);
#define PG8_SA(b, h) (((b) * 2 + (h)) * HTB)
#define PG8_SB(b, h) ((4 + (b) * 2 + (h)) * HTB)
#define PG8_STAGE(bufoff, gbase, voff) do { _Pragma("unroll") for (int _i = 0; _i < 2; ++_i) \
        __builtin_amdgcn_global_load_lds((const unsigned*)((const char*)(gbase) + (voff)[_i]), (PG8_LAS unsigned*)(lds + (bufoff) + ldsw + _i * 8192), 16, 0, 0); } while (0)
#define PG8_LDA(dst, b, h) do { _Pragma("unroll") for (int m = 0; m < 4; ++m) _Pragma("unroll") for (int k = 0; k < 2; ++k) dst[m][k] = *(const PG8_LAS bf16x8*)(lds + PG8_SA(b, h) + aoff + m * 2048 + k * 1024); } while (0)
#define PG8_LDB(dst, b, h) do { _Pragma("unroll") for (int n = 0; n < 2; ++n) _Pragma("unroll") for (int k = 0; k < 2; ++k) dst[n][k] = *(const PG8_LAS bf16x8*)(lds + PG8_SB(b, h) + boff + n * 2048 + k * 1024); } while (0)
#define PG8_MMA(ai, bj, At, Bt) do { __builtin_amdgcn_s_setprio(1); _Pragma("unroll") for (int m = 0; m < 4; ++m) _Pragma("unroll") for (int n = 0; n < 2; ++n) _Pragma("unroll") for (int k = 0; k < 2; ++k) \
        acc[ai][bj][m][n] = __builtin_amdgcn_mfma_f32_16x16x32_bf16(Bt[n][k], At[m][k], acc[ai][bj][m][n], 0, 0, 0); __builtin_amdgcn_s_setprio(0); } while (0)
#define PG8_WAIT_V(n) asm volatile("s_waitcnt vmcnt(" #n ")" ::: "memory")
#define PG8_WAIT_L(n) asm volatile("s_waitcnt lgkmcnt(" #n ")" ::: "memory")
#define PG8_BAR __builtin_amdgcn_s_barrier()
#define PG8_SCHED __builtin_amdgcn_sched_barrier(0)
    Unit cur, nxt; int ui = 0;
    if (!S.next(0, cur)) return;
    f32x4 acc[2][2][4][2];
#pragma unroll
    for (int a = 0; a < 2; ++a)
#pragma unroll
        for (int b = 0; b < 2; ++b)
#pragma unroll
            for (int m = 0; m < 4; ++m)
#pragma unroll
                for (int n = 0; n < 2; ++n) acc[a][b][m][n] = (f32x4){0.f, 0.f, 0.f, 0.f};
    bf16x8 At[4][2], B0[2][2], B1[2][2];
    const char* cA = (const char*)g.A + (size_t)cur.pm * tstepA; const char* cB = (const char*)g.Bt + (size_t)cur.pn * tstep;
    S.a_ready(cur);
    if constexpr (SP2) {
        PG8_STAGE(PG8_SB(0, 0), cB, voffB); PG8_STAGE(PG8_SB(0, 1), cB + hstep, voffB); PG8_STAGE(PG8_SA(0, 0), cA, voffA); PG8_STAGE(PG8_SA(0, 1), cA + hstepA, voffA);
        if (wr == 1) PG8_BAR;
        PG8_WAIT_V(2); PG8_BAR;
        PG8_STAGE(PG8_SB(1, 0), cB + kstep, voffB); PG8_STAGE(PG8_SA(1, 0), cA + kstep, voffA); PG8_STAGE(PG8_SB(1, 1), cB + hstep + kstep, voffB);
        PG8_WAIT_V(6); PG8_BAR;
    } else {
        PG8_STAGE(PG8_SB(0, 0), cB, voffB); PG8_STAGE(PG8_SA(0, 0), cA, voffA); PG8_STAGE(PG8_SB(0, 1), cB + hstep, voffB); PG8_STAGE(PG8_SA(0, 1), cA + hstepA, voffA);
        if (wr == 1) PG8_BAR;
        PG8_WAIT_V(4); PG8_BAR;
        PG8_STAGE(PG8_SB(1, 0), cB + kstep, voffB); PG8_STAGE(PG8_SA(1, 0), cA + kstep, voffA); PG8_STAGE(PG8_SB(1, 1), cB + hstep + kstep, voffB);
        PG8_WAIT_V(6); PG8_BAR;
    }
    for (;;) {
        const bool has_next = S.next(ui + 1, nxt);
        const char* nA = has_next ? (const char*)g.A + (size_t)nxt.pm * tstepA : cA; const char* nB = has_next ? (const char*)g.Bt + (size_t)nxt.pn * tstep : cB;
        for (int t = 0; t < nt; t += 2) {
            const bool last = (t == nt - 2);
            const char* a1 = cA + (size_t)(t + 1) * kstep;
            const char* a2 = last ? nA : cA + (size_t)(t + 2) * kstep; const char* b2 = last ? nB : cB + (size_t)(t + 2) * kstep;
            const char* a3 = a2 + kstep; const char* b3 = b2 + kstep;
            if (last && has_next) S.a_ready(nxt);
            if constexpr (SP2) {
            PG8_LDB(B0, 0, 0); PG8_LDB(B1, 0, 1); PG8_SCHED; PG8_LDA(At, 0, 0); PG8_STAGE(PG8_SA(1, 1), a1 + hstepA, voffA);
            PG8_WAIT_V(8); PG8_WAIT_L(0); PG8_BAR; PG8_MMA(0, 0, At, B0); PG8_MMA(0, 1, At, B1); PG8_BAR; PG8_SCHED;
            PG8_LDA(At, 0, 1); PG8_STAGE(PG8_SB(0, 0), b2, voffB); PG8_STAGE(PG8_SB(0, 1), b2 + hstep, voffB); PG8_STAGE(PG8_SA(0, 0), a2, voffA);
            PG8_WAIT_V(8); PG8_WAIT_L(0); PG8_BAR; PG8_MMA(1, 0, At, B0); PG8_MMA(1, 1, At, B1); PG8_BAR; PG8_SCHED;
            PG8_LDB(B0, 1, 0); PG8_LDB(B1, 1, 1); PG8_SCHED; PG8_LDA(At, 1, 0); PG8_STAGE(PG8_SA(0, 1), a2 + hstepA, voffA);
            PG8_WAIT_V(8); PG8_WAIT_L(0); PG8_BAR; PG8_MMA(0, 0, At, B0); PG8_MMA(0, 1, At, B1); PG8_BAR; PG8_SCHED;
            PG8_LDA(At, 1, 1); PG8_STAGE(PG8_SB(1, 0), b3, voffB); PG8_STAGE(PG8_SB(1, 1), b3 + hstep, voffB); PG8_STAGE(PG8_SA(1, 0), a3, voffA);
            PG8_WAIT_V(8); PG8_WAIT_L(0); PG8_BAR; PG8_MMA(1, 0, At, B0); PG8_MMA(1, 1, At, B1); PG8_BAR; PG8_SCHED;
            } else {
            PG8_LDB(B0, 0, 0); PG8_SCHED; PG8_LDA(At, 0, 0); PG8_STAGE(PG8_SA(1, 1), a1 + hstepA, voffA);
            PG8_WAIT_L(8); PG8_BAR; PG8_WAIT_L(0); PG8_MMA(0, 0, At, B0); PG8_BAR; PG8_SCHED;
            PG8_LDB(B1, 0, 1); PG8_STAGE(PG8_SB(0, 0), b2, voffB);
            PG8_BAR; PG8_WAIT_L(0); PG8_MMA(0, 1, At, B1); PG8_BAR;
            PG8_LDA(At, 0, 1); PG8_STAGE(PG8_SA(0, 0), a2, voffA);
            PG8_BAR; PG8_WAIT_L(0); PG8_MMA(1, 0, At, B0); PG8_BAR; PG8_SCHED;
            PG8_STAGE(PG8_SB(0, 1), b2 + hstep, voffB);
            PG8_WAIT_V(6); PG8_BAR; PG8_MMA(1, 1, At, B1); PG8_BAR;
            PG8_LDB(B0, 1, 0); PG8_SCHED; PG8_LDA(At, 1, 0); PG8_STAGE(PG8_SA(0, 1), a2 + hstepA, voffA);
            PG8_WAIT_L(8); PG8_BAR; PG8_WAIT_L(0); PG8_MMA(0, 0, At, B0); PG8_BAR; PG8_SCHED;
            PG8_LDB(B1, 1, 1); PG8_STAGE(PG8_SB(1, 0), b3, voffB);
            PG8_BAR; PG8_WAIT_L(0); PG8_MMA(0, 1, At, B1); PG8_BAR;
            PG8_LDA(At, 1, 1); PG8_STAGE(PG8_SA(1, 0), a3, voffA);
            PG8_BAR; PG8_WAIT_L(0); PG8_MMA(1, 0, At, B0); PG8_BAR; PG8_SCHED;
            PG8_STAGE(PG8_SB(1, 1), b3 + hstep, voffB);
            PG8_WAIT_V(6); PG8_BAR; PG8_MMA(1, 1, At, B1); PG8_BAR;
            }
        }
        if constexpr (ALIGN_EPI) { if (wr == 0) PG8_BAR; }
        if constexpr (!Epi::AFTER_DRAIN) { E(acc, cur, wr, wc, fr, fq); S.done(cur); }
        if (!has_next) break;
#pragma unroll
        for (int a = 0; a < 2; ++a)
#pragma unroll
            for (int b = 0; b < 2; ++b)
#pragma unroll
                for (int m = 0; m < 4; ++m)
#pragma unroll
                    for (int n = 0; n < 2; ++n) acc[a][b][m][n] = (f32x4){0.f, 0.f, 0.f, 0.f};
        cur = nxt; cA = nA; cB = nB; ++ui;
        if constexpr (ALIGN_EPI) { if (wr == 1) PG8_BAR; }
    }
    PG8_WAIT_V(0);
    if constexpr (!ALIGN_EPI) { if (wr == 0) PG8_BAR; }
    PG8_BAR;
    if constexpr (Epi::AFTER_DRAIN) { E.fused(acc, cur, wr, wc, fr, fq, lds, wid, lane); S.done(cur); }
#undef PG8_SA
#undef PG8_SB
#undef PG8_STAGE
#undef PG8_LDA
#undef PG8_LDB
#undef PG8_MMA
#undef PG8_WAIT_V
#undef PG8_WAIT_L
#undef PG8_BAR
#undef PG8_SCHED
}
}
#include <hip/hip_bf16.h>
#include <cmath>
namespace attn_body {
using bf16=__hip_bfloat16;
using bf16x8=__attribute__((ext_vector_type(8)))short;
using s16x4=__attribute__((ext_vector_type(4)))short;
using f32x16=__attribute__((ext_vector_type(16)))float;
using u32x4=__attribute__((ext_vector_type(4)))unsigned;
constexpr int D=64,PITCH=4608;
constexpr int NW=8,QBLK=32,QB=QBLK*NW,KVBLK=64;
constexpr int ATTN_UNIT_ROWS=QB;
__device__ __forceinline__ int crow(int r,int hi){return (r&3)+8*(r>>2)+4*hi;}
#define SBAR() __builtin_amdgcn_sched_barrier(0)
template<bool BAND> __device__ __forceinline__ void cmask(f32x16&p0,f32x16&p1,int kvbase,int qrel,int hi){
  const float NEG=-INFINITY; int kb=kvbase+4*hi;
  #pragma unroll
  for(int r=0;r<16;++r){int kv=kb+(r&3)+8*(r>>2); if(kv>qrel||(BAND&&kv<qrel-128))p0[r]=NEG; if(kv+32>qrel||(BAND&&kv+32<qrel-128))p1[r]=NEG;}
}

constexpr int NSLOT=3, SLOTB=8192;
constexpr int LDS_K=0, LDS_V=NSLOT*SLOTB, LDS_WS=2*NSLOT*SLOTB, LDS_OST=LDS_WS+NW*64*4, LDS_BYTES=LDS_OST+NW*4096;
constexpr float C2=0.125f*1.4426950408889634f;
__device__ __forceinline__ void glds16(const void*gsrc,unsigned lds_dst){unsigned keep;
  asm volatile("s_mov_b32 %0, m0\n\ts_mov_b32 m0, %2\n\ts_nop 0\n\tglobal_load_lds_dwordx4 %1, off\n\ts_mov_b32 m0, %0":"=&s"(keep):"v"(gsrc),"s"(lds_dst):"memory");}
__device__ __forceinline__ float max3f(float a,float b,float c){float r;asm("v_max3_f32 %0, %1, %2, %3":"=v"(r):"v"(a),"v"(b),"v"(c));return r;}
__device__ __forceinline__ float max2f(float a,float b){float r;asm("v_max_f32_e32 %0, %1, %2":"=v"(r):"v"(a),"v"(b));return r;}
__device__ __forceinline__ float fadd_s(float a,float b){float r;asm("v_add_f32_e32 %0, %1, %2":"=v"(r):"v"(a),"v"(b));return r;}
__device__ __forceinline__ float fsub_s(float a,float b){float r;asm("v_sub_f32_e32 %0, %1, %2":"=v"(r):"v"(a),"v"(b));return r;}
typedef float f32x2_t __attribute__((ext_vector_type(2))); typedef __bf16 bf16x2_t __attribute__((ext_vector_type(2)));
__device__ __forceinline__ unsigned cvtpk_s(float lo,float hi){f32x2_t v={lo,hi};bf16x2_t b=__builtin_convertvector(v,bf16x2_t);return __builtin_bit_cast(unsigned,b);}
#define WAIT_BAR(N) asm volatile("s_waitcnt vmcnt(" #N ") lgkmcnt(0)\n\ts_barrier":::"memory")

__device__ __forceinline__ void qkt(f32x16&p0,f32x16&p1,const char*Kslot,const bf16x8*qr,const f32x16&negm,int r32,int hi){
  const char*kb=Kslot+hi*1024+r32*16;
  #pragma unroll
  for(int d0=0;d0<4;++d0){
    const bf16x8 b0=*reinterpret_cast<const bf16x8*>(kb+d0*2048);
    const bf16x8 b1=*reinterpret_cast<const bf16x8*>(kb+d0*2048+512);
    if(d0==0){p0=__builtin_amdgcn_mfma_f32_32x32x16_bf16(b0,qr[0],negm,0,0,0);p1=__builtin_amdgcn_mfma_f32_32x32x16_bf16(b1,qr[0],negm,0,0,0);}
    else{p0=__builtin_amdgcn_mfma_f32_32x32x16_bf16(b0,qr[d0],p0,0,0,0);p1=__builtin_amdgcn_mfma_f32_32x32x16_bf16(b1,qr[d0],p1,0,0,0);}}
}
typedef __attribute__((address_space(3))) const char* lds_cptr;
typedef short v4i16_t __attribute__((ext_vector_type(4)));
__device__ __forceinline__ void kload8(bf16x8*kf,lds_cptr kp){
  kf[0]=*(const __attribute__((address_space(3))) bf16x8*)(kp);      kf[1]=*(const __attribute__((address_space(3))) bf16x8*)(kp+512);
  kf[2]=*(const __attribute__((address_space(3))) bf16x8*)(kp+2048); kf[3]=*(const __attribute__((address_space(3))) bf16x8*)(kp+2560);
  kf[4]=*(const __attribute__((address_space(3))) bf16x8*)(kp+4096); kf[5]=*(const __attribute__((address_space(3))) bf16x8*)(kp+4608);
  kf[6]=*(const __attribute__((address_space(3))) bf16x8*)(kp+6144); kf[7]=*(const __attribute__((address_space(3))) bf16x8*)(kp+6656);
}
__device__ __forceinline__ void kload2(bf16x8*kf,lds_cptr kp,int j){ kf[2*j]=*(const __attribute__((address_space(3))) bf16x8*)(kp+j*2048); kf[2*j+1]=*(const __attribute__((address_space(3))) bf16x8*)(kp+j*2048+512); }
__device__ __forceinline__ s16x4 vtr(lds_cptr p){ return __builtin_bit_cast(s16x4,__builtin_amdgcn_ds_read_tr16_b64_v4i16((__attribute__((address_space(3))) v4i16_t*)p)); }
__device__ __forceinline__ float rowmax(const f32x16&p0,const f32x16&p1){
  float a=max3f(p0[0],p0[1],p1[0]),b=max3f(p0[2],p0[3],p1[1]);a=max3f(a,p1[2],p1[3]);
  #pragma unroll
  for(int r=4;r<16;r+=4){a=max3f(a,p0[r],p0[r+1]);b=max3f(b,p0[r+2],p0[r+3]);a=max3f(a,p1[r],p1[r+1]);b=max3f(b,p1[r+2],p1[r+3]);}
  const float m=max2f(a,b);
  auto rr=__builtin_amdgcn_permlane32_swap(__float_as_uint(m),__float_as_uint(m),false,false);
  return max2f(__uint_as_float(rr[0]),__uint_as_float(rr[1]));
}
__device__ __forceinline__ void pv(f32x16*o,int vb,bf16x8 pa0,bf16x8 pa1,bf16x8 pa2,bf16x8 pa3){
  #pragma unroll
  for(int d0=0;d0<2;++d0){s16x4 lo[4],hi[4];
    #pragma unroll
    for(int ks=0;ks<4;++ks){
      asm volatile("ds_read_b64_tr_b16 %0,%1 offset:%c2":"=&v"(lo[ks]):"v"(vb),"i"(d0*4096+ks*1024):"memory");
      asm volatile("ds_read_b64_tr_b16 %0,%1 offset:%c2":"=&v"(hi[ks]):"v"(vb),"i"(d0*4096+ks*1024+512):"memory");}
    asm volatile("s_waitcnt lgkmcnt(0)":::"memory");SBAR();
    #define PK(k) (bf16x8){lo[k][0],lo[k][1],lo[k][2],lo[k][3],hi[k][0],hi[k][1],hi[k][2],hi[k][3]}
    o[d0]=__builtin_amdgcn_mfma_f32_32x32x16_bf16(pa0,PK(0),o[d0],0,0,0);
    o[d0]=__builtin_amdgcn_mfma_f32_32x32x16_bf16(pa1,PK(1),o[d0],0,0,0);
    o[d0]=__builtin_amdgcn_mfma_f32_32x32x16_bf16(pa2,PK(2),o[d0],0,0,0);
    o[d0]=__builtin_amdgcn_mfma_f32_32x32x16_bf16(pa3,PK(3),o[d0],0,0,0);
    #undef PK
  }
}

#ifndef ATTN_STORE16
#define ATTN_STORE16(p,v) (*(u32x4*)(p)=(v))
#endif
template<int THRL,bool BAND> __device__ __forceinline__ void attn_unit(const bf16*Qb,const bf16*__restrict__ Kb,const bf16*__restrict__ Vb,bf16*Ob,const long rs,const long ors,const int NT,const int moff,float*lse,const long lrs,char*shm){
  int tid_=threadIdx.x; asm volatile("":"+v"(tid_));
  const int tid=tid_,lane=tid&63,r32=lane&31,hi=lane>>5; const int wid=__builtin_amdgcn_readfirstlane(tid>>6);
  const bf16*Qw=Qb+(long)(wid*QBLK)*rs;
  const bf16*Kh=Kb,*Vh=Vb;
  const unsigned lds0=(unsigned)(uintptr_t)shm;
  float*wsf=(float*)(shm+LDS_WS)+wid*64;
  const bf16*ksrc=Kh+(long)lane*rs+wid*8;
  const bf16*vsrc=Vh+(long)(16*(wid&3)+(lane>>2))*rs+(wid>>2)*32+(lane&3)*8;
  const unsigned kdst=lds0+LDS_K+wid*1024, vdst=lds0+LDS_V+wid*1024;
  #define DMA_K(t,slot) glds16(ksrc+(long)(t)*KVBLK*rs,(unsigned)__builtin_amdgcn_readfirstlane(kdst+(slot)))
  #define DMA_V(t,slot) glds16(vsrc+(long)(t)*KVBLK*rs,(unsigned)__builtin_amdgcn_readfirstlane(vdst+(slot)))
  const int vb0=(int)(lds0+LDS_V)+((lane>>4)&1)*32+(lane&3)*8+(4*hi+((lane&15)>>2))*64;
  const char*Kbase=shm+LDS_K; bf16x8 kf[8];
  const lds_cptr shm3=(lds_cptr)shm; const lds_cptr kp0=shm3+LDS_K+hi*1024+r32*16; const lds_cptr vp0=shm3+LDS_V+((lane>>4)&1)*32+(lane&3)*8+(4*hi+((lane&15)>>2))*64;
  DMA_K(0,0);DMA_V(0,0);DMA_K(1,SLOTB);
  bf16x8 qr[4];
  #pragma unroll
  for(int d0=0;d0<4;++d0)qr[d0]=*reinterpret_cast<const bf16x8*>(&Qw[(long)r32*rs+d0*16+hi*8]);
  float mhat=0.f,l_reg=0.f;f32x16 o[2];o[0]=f32x16{};o[1]=f32x16{};f32x16 negm=f32x16{};asm volatile("":"+v"(negm));
  const int qrel=wid*QBLK+r32;
  #define CMASK(P0,P1,t) do{int jb_=(t)-(NT-4); if(BAND||jb_>=0)cmask<BAND>(P0,P1,64*(t)-moff,qrel,hi);}while(0)
  bool resc=false;
  #define START(P0,P1) do{ const float rm=BAND?__builtin_fmaxf(rowmax(P0,P1),-64.f):rowmax(P0,P1); resc=false; \
    { const float dl=rm; mhat=fadd_s(mhat,dl); \
      _Pragma("unroll") for(int r=0;r<16;++r){P0[r]=fsub_s(P0[r],dl);P1[r]=fsub_s(P1[r],dl);} \
      _Pragma("unroll") for(int r=0;r<16;++r)negm[r]=-mhat; asm volatile("":"+v"(negm)); } \
    _Pragma("unroll") for(int r=0;r<16;++r)P0[r]=__builtin_amdgcn_exp2f(P0[r]); }while(0)
  #define RESC() do{ if(resc){ asm volatile("s_waitcnt lgkmcnt(0)":::"memory"); \
      _Pragma("unroll") for(int d_=0;d_<2;++d_) _Pragma("unroll") for(int r=0;r<16;++r)o[d_][r]*=wsf[crow(r,hi)]; } }while(0)
  f32x16 pA0,pA1,pB0,pB1;
  int sl_prev=0,sl_cur=0,sl_next=SLOTB;
  #define ROT() do{sl_prev=sl_cur;sl_cur=sl_next;sl_next=(sl_next==(NSLOT-1)*SLOTB)?0:sl_next+SLOTB;}while(0)
  DMA_K(2,2*SLOTB);
  WAIT_BAR(3);
  qkt(pA0,pA1,Kbase,qr,negm,r32,hi);asm volatile("s_nop 15\n\ts_nop 7":"+v"(pA0),"+v"(pA1));CMASK(pA0,pA1,0);
  START(pA0,pA1);
  _Pragma("unroll") for(int r=0;r<16;++r)pA1[r]=__builtin_amdgcn_exp2f(pA1[r]);
  WAIT_BAR(0);
  DMA_K(3,0);DMA_V(1,SLOTB);
  ROT();
  kload8(kf,kp0+sl_cur);
  WAIT_BAR(2);
  s16x4 vlo[8],vhi[8]; u32x4 pw0,pw1,pw2,pw3;
  #define PKW(P,B) cvtpk_s(P[B],P[B+1])
  #define PAF(k) __builtin_bit_cast(bf16x8,pw##k)
  #define VFR(i) (bf16x8){vlo[i][0],vlo[i][1],vlo[i][2],vlo[i][3],vhi[i][0],vhi[i][1],vhi[i][2],vhi[i][3]}
  #define PIN(x) asm volatile("":"+v"(x))
  #define MX3(a,b,c) __builtin_fmaxf(__builtin_fmaxf((a),(b)),(c))
  #define GAPA(MF,A0,A1,A2,A3,W0,W1,PW) do{ MF; sacc+=A0; sacc+=A1; sacc+=A2; sacc+=A3; PIN(sacc); W0; W1; PIN(PW); SBAR(); }while(0)
  #define EX(v) __builtin_amdgcn_exp2f(v)
  #define GAPB(MF,X,B) do{ MF; X[B]=EX(X[B]); X[B+1]=EX(X[B+1]); X[B+2]=EX(X[B+2]); X[B+3]=EX(X[B+3]); PIN(X); SBAR(); }while(0)
  #define VRD(i) do{ vlo[i]=vtr(vp_+(((i)>>2)*4096+((i)&3)*1024)); vhi[i]=vtr(vp_+(((i)>>2)*4096+((i)&3)*1024+512)); }while(0)
  #define KRD(G,j) do{ if(G){ kload2(kf,kp0+sl_next,j); SBAR(); } }while(0)
  #define STEP(C0,C1,P0,P1,t,GK,GV,GL) do{ SBAR(); \
    const lds_cptr vp_=vp0+sl_prev; \
    VRD(0); SBAR(); float sacc=(P0[0]+P0[1]); \
    GAPA(C0=__builtin_amdgcn_mfma_f32_32x32x16_bf16(kf[0],qr[0],negm,0,0,0), P0[2],P0[3],P0[4],P0[5],     pw0[0]=PKW(P0,0), pw0[1]=PKW(P0,2), pw0); \
    VRD(4); SBAR(); GAPA(C1=__builtin_amdgcn_mfma_f32_32x32x16_bf16(kf[1],qr[0],negm,0,0,0), P0[6],P0[7],P0[8],P0[9],     pw0[2]=PKW(P0,4), pw0[3]=PKW(P0,6), pw0); \
    VRD(1); SBAR(); GAPA(C0=__builtin_amdgcn_mfma_f32_32x32x16_bf16(kf[2],qr[1],C0,0,0,0),   P0[10],P0[11],P0[12],P0[13], pw1[0]=PKW(P0,8), pw1[1]=PKW(P0,10), pw1); \
    VRD(5); SBAR(); GAPA(C1=__builtin_amdgcn_mfma_f32_32x32x16_bf16(kf[3],qr[1],C1,0,0,0),   P0[14],P0[15],P1[0],P1[1],   pw1[2]=PKW(P0,12),pw1[3]=PKW(P0,14), pw1); \
    VRD(2); SBAR(); GAPA(C0=__builtin_amdgcn_mfma_f32_32x32x16_bf16(kf[4],qr[2],C0,0,0,0),   P1[2],P1[3],P1[4],P1[5],     pw2[0]=PKW(P1,0), pw2[1]=PKW(P1,2), pw2); \
    VRD(6); SBAR(); GAPA(C1=__builtin_amdgcn_mfma_f32_32x32x16_bf16(kf[5],qr[2],C1,0,0,0),   P1[6],P1[7],P1[8],P1[9],     pw2[2]=PKW(P1,4), pw2[3]=PKW(P1,6), pw2); \
    VRD(3); SBAR(); GAPA(C0=__builtin_amdgcn_mfma_f32_32x32x16_bf16(kf[6],qr[3],C0,0,0,0),   P1[10],P1[11],P1[12],P1[13], pw3[0]=PKW(P1,8), pw3[1]=PKW(P1,10), pw3); \
    VRD(7); SBAR(); GAPA(C1=__builtin_amdgcn_mfma_f32_32x32x16_bf16(kf[7],qr[3],C1,0,0,0),   P1[14],P1[15],0.f,0.f,       pw3[2]=PKW(P1,12),pw3[3]=PKW(P1,14), pw3); \
    l_reg+=sacc; \
    if(GK){DMA_K((t)+3,sl_cur);} if(GV){DMA_V((t)+1,sl_next);} \
    CMASK(C0,C1,t); \
    { float a=MX3(C0[0],C0[1],C1[0]),b=MX3(C0[2],C0[3],C1[1]); a=MX3(a,C1[2],C1[3]); \
      _Pragma("unroll") for(int r=4;r<16;r+=4){a=MX3(a,C0[r],C0[r+1]);b=MX3(b,C0[r+2],C0[r+3]);a=MX3(a,C1[r],C1[r+1]);b=MX3(b,C1[r+2],C1[r+3]);} \
      float rm=__builtin_fmaxf(a,b); { auto rr=__builtin_amdgcn_permlane32_swap(__float_as_uint(rm),__float_as_uint(rm),false,false); rm=__builtin_fmaxf(__uint_as_float(rr[0]),__uint_as_float(rr[1])); } \
      resc=false; \
      if(__builtin_expect(__any(rm>(float)THRL),0)){ const float dl=__builtin_fmaxf(rm,0.f); mhat+=dl; \
        _Pragma("unroll") for(int r=0;r<16;++r){C0[r]-=dl;C1[r]-=dl;} \
        _Pragma("unroll") for(int r=0;r<16;++r)negm[r]=-mhat; asm volatile("":"+v"(negm)); \
        const float f=__builtin_amdgcn_exp2f(-dl); l_reg*=f; if(hi==0)wsf[r32]=f; resc=true; } } \
    SBAR(); \
    GAPB(o[0]=__builtin_amdgcn_mfma_f32_32x32x16_bf16(PAF(0),VFR(0),o[0],0,0,0), C0,0); \
    GAPB(o[1]=__builtin_amdgcn_mfma_f32_32x32x16_bf16(PAF(0),VFR(4),o[1],0,0,0), C0,4); \
    KRD(GL,0); GAPB(o[0]=__builtin_amdgcn_mfma_f32_32x32x16_bf16(PAF(1),VFR(1),o[0],0,0,0), C0,8); \
    KRD(GL,1); GAPB(o[1]=__builtin_amdgcn_mfma_f32_32x32x16_bf16(PAF(1),VFR(5),o[1],0,0,0), C0,12); \
    KRD(GL,2); GAPB(o[0]=__builtin_amdgcn_mfma_f32_32x32x16_bf16(PAF(2),VFR(2),o[0],0,0,0), C1,0); \
    KRD(GL,3); GAPB(o[1]=__builtin_amdgcn_mfma_f32_32x32x16_bf16(PAF(2),VFR(6),o[1],0,0,0), C1,4); \
    GAPB(o[0]=__builtin_amdgcn_mfma_f32_32x32x16_bf16(PAF(3),VFR(3),o[0],0,0,0), C1,8); \
    GAPB(o[1]=__builtin_amdgcn_mfma_f32_32x32x16_bf16(PAF(3),VFR(7),o[1],0,0,0), C1,12); \
    }while(0)
  int t=1;
  #undef CMASK
  #define CMASK(P0,P1,t) do{}while(0)
  for(;t+5<NT;t+=2){
    STEP(pB0,pB1,pA0,pA1,t,true,true,true);     WAIT_BAR(2); RESC(); ROT();
    STEP(pA0,pA1,pB0,pB1,t+1,true,true,true);   WAIT_BAR(2); RESC(); ROT();
  }
  #undef CMASK
  #define CMASK(P0,P1,t) do{int jb_=(t)-(NT-4); if(BAND||jb_>=0)cmask<BAND>(P0,P1,64*(t)-moff,qrel,hi);}while(0)
  #define ENDW(tt) do{ if((tt)+3<NT){WAIT_BAR(2);} else if((tt)+2<NT){WAIT_BAR(1);} else {WAIT_BAR(0);} }while(0)
  for(;t+1<NT;t+=2){
    STEP(pB0,pB1,pA0,pA1,t,(t+3<NT),(t+1<NT),(t+1<NT));       ENDW(t);   RESC(); ROT();
    STEP(pA0,pA1,pB0,pB1,t+1,(t+4<NT),(t+2<NT),(t+2<NT));     ENDW(t+1); RESC(); ROT();
  }
  STEP(pB0,pB1,pA0,pA1,NT-1,false,false,false); RESC();
  { float sacc=pB0[0]+pB0[1]; _Pragma("unroll") for(int r=2;r<16;++r)sacc+=pB0[r]; _Pragma("unroll") for(int r=0;r<16;++r)sacc+=pB1[r]; l_reg+=sacc;
    pw0=(u32x4){PKW(pB0,0),PKW(pB0,2),PKW(pB0,4),PKW(pB0,6)};pw1=(u32x4){PKW(pB0,8),PKW(pB0,10),PKW(pB0,12),PKW(pB0,14)};pw2=(u32x4){PKW(pB1,0),PKW(pB1,2),PKW(pB1,4),PKW(pB1,6)};pw3=(u32x4){PKW(pB1,8),PKW(pB1,10),PKW(pB1,12),PKW(pB1,14)};
    SBAR(); pv(o,vb0+sl_cur,PAF(0),PAF(1),PAF(2),PAF(3)); }
  #undef PKW
  #undef PAF
  #undef VFR
  #undef PIN
  #undef MX3
  #undef GAPA
  #undef GAPB
  #undef EX
  #undef VRD
  #undef KRD
  #undef STEP
  #undef ENDW
  {auto rr=__builtin_amdgcn_permlane32_swap(__float_as_uint(l_reg),__float_as_uint(l_reg),false,false);l_reg=__uint_as_float(rr[0])+__uint_as_float(rr[1]);}
  if(hi==0)wsf[32+r32]=l_reg;asm volatile("s_waitcnt lgkmcnt(0)":::"memory");
  float rli[16];
  #pragma unroll
  for(int r=0;r<16;++r)rli[r]=__builtin_amdgcn_rcpf(wsf[32+crow(r,hi)]);
  bf16*Ow=Ob+(long)(wid*QBLK)*ors;
  if(BAND){ if(hi==0) lse[(long)(wid*QBLK+r32)*lrs]=mhat+__builtin_amdgcn_logf(l_reg); }
  { bf16*stg=(bf16*)(shm+LDS_OST)+wid*2048;
    #pragma unroll
    for(int r=0;r<16;++r){const int orow=crow(r,hi);
      #pragma unroll
      for(int d0=0;d0<2;++d0)stg[orow*64+d0*32+r32]=__float2bfloat16(o[d0][r]*rli[r]);}
    asm volatile("s_waitcnt lgkmcnt(0)":::"memory");
    #pragma unroll
    for(int i=0;i<4;++i){const int row=i*8+(lane>>3),ch=lane&7; const u32x4 v=*(const u32x4*)(stg+row*64+ch*8); ATTN_STORE16(Ow+(long)row*ors+ch*8,v);} }
  asm volatile("s_waitcnt lgkmcnt(0)\n\ts_barrier":::"memory");
  #undef DMA_K
  #undef DMA_V
  #undef CMASK
  #undef START
  #undef RESC
  #undef ROT
}
__device__ __forceinline__ void pv4(f32x16*o,int vb,bf16x8 pa0,bf16x8 pa1,bf16x8 pa2,bf16x8 pa3){
  #pragma unroll
  for(int d0=0;d0<4;++d0){s16x4 lo[4],hi[4];
    #pragma unroll
    for(int ks=0;ks<4;++ks){
      asm volatile("ds_read_b64_tr_b16 %0,%1 offset:%c2":"=&v"(lo[ks]):"v"(vb),"i"(d0*4096+ks*1024):"memory");
      asm volatile("ds_read_b64_tr_b16 %0,%1 offset:%c2":"=&v"(hi[ks]):"v"(vb),"i"(d0*4096+ks*1024+512):"memory");}
    asm volatile("s_waitcnt lgkmcnt(0)":::"memory");SBAR();
    #define PK(k) (bf16x8){lo[k][0],lo[k][1],lo[k][2],lo[k][3],hi[k][0],hi[k][1],hi[k][2],hi[k][3]}
    o[d0]=__builtin_amdgcn_mfma_f32_32x32x16_bf16(pa0,PK(0),o[d0],0,0,0);
    o[d0]=__builtin_amdgcn_mfma_f32_32x32x16_bf16(pa1,PK(1),o[d0],0,0,0);
    o[d0]=__builtin_amdgcn_mfma_f32_32x32x16_bf16(pa2,PK(2),o[d0],0,0,0);
    o[d0]=__builtin_amdgcn_mfma_f32_32x32x16_bf16(pa3,PK(3),o[d0],0,0,0);
    #undef PK
  }
}
template<int THRL> __device__ __forceinline__ void attn_unit_dv(const bf16*Qb,const bf16*__restrict__ Kb,const bf16*__restrict__ Vb,bf16*Oa,const long orsa,bf16*Ob,const long ors,const long rs,const int NT,const int moff,char*shm){
  constexpr bool BAND=false;
  int tid_=threadIdx.x; asm volatile("":"+v"(tid_));
  const int tid=tid_,lane=tid&63,r32=lane&31,hi=lane>>5; const int wid=__builtin_amdgcn_readfirstlane(tid>>6);
  const bf16*Qw=Qb+(long)(wid*QBLK)*rs;
  const bf16*Kh=Kb,*Vh=Vb;
  constexpr int LDS_K=0, LDS_V=NSLOT*SLOTB, SLOTV=2*SLOTB, LDS_WS=LDS_V+NSLOT*SLOTV, LDS_Q=LDS_WS+NW*64*4;
  const unsigned lds0=(unsigned)(uintptr_t)shm;
  float*wsf=(float*)(shm+LDS_WS)+wid*64;
  const bf16*ksrc=Kh+(long)lane*rs+wid*8;
  const bf16*vsrc=Vh+(long)(16*(wid&3)+(lane>>2))*rs+(wid>>2)*32+(lane&3)*8;
  const unsigned kdst=lds0+LDS_K+wid*1024, vdst=lds0+LDS_V+wid*1024;
  #define DMA_K(t,slot) glds16(ksrc+(long)(t)*KVBLK*rs,(unsigned)__builtin_amdgcn_readfirstlane(kdst+(slot)))
  #define DMA_V(t,slot) do{ glds16(vsrc+(long)(t)*KVBLK*rs,(unsigned)__builtin_amdgcn_readfirstlane(vdst+2*(slot))); glds16(vsrc+64+(long)(t)*KVBLK*rs,(unsigned)__builtin_amdgcn_readfirstlane(vdst+8192+2*(slot))); }while(0)
  const int vb0=(int)(lds0+LDS_V)+((lane>>4)&1)*32+(lane&3)*8+(4*hi+((lane&15)>>2))*64;
  const char*Kbase=shm+LDS_K; bf16x8 kf[8];
  const lds_cptr shm3=(lds_cptr)shm; const lds_cptr kp0=shm3+LDS_K+hi*1024+r32*16; const lds_cptr vp0=shm3+LDS_V+((lane>>4)&1)*32+(lane&3)*8+(4*hi+((lane&15)>>2))*64;
  DMA_K(0,0);DMA_V(0,0);DMA_K(1,SLOTB);
  typedef __attribute__((address_space(3))) bf16x8* lds_q8;
  const lds_q8 qlds=(lds_q8)(shm3+LDS_Q+wid*4096)+lane;
  { bf16x8 qr[4];
    #pragma unroll
    for(int d0=0;d0<4;++d0)qr[d0]=*reinterpret_cast<const bf16x8*>(&Qw[(long)r32*rs+d0*16+hi*8]);
    #pragma unroll
    for(int d0=0;d0<4;++d0)qlds[d0*64]=qr[d0]; }
  #define QF(d0) (qlds[(d0)*64])
  float mhat=0.f,l_reg=0.f;f32x16 o[4];o[0]=f32x16{};o[1]=f32x16{};o[2]=f32x16{};o[3]=f32x16{};const f32x16 zero16=f32x16{};
  const int qrel=wid*QBLK+r32;
  #define CMASK(P0,P1,t) do{int jb_=(t)-(NT-4); if(BAND||jb_>=0)cmask<BAND>(P0,P1,64*(t)-moff,qrel,hi);}while(0)
  bool resc=false;
  #define START(P0,P1) do{ const float rm=rowmax(P0,P1); resc=false; mhat=rm; \
    _Pragma("unroll") for(int r=0;r<16;++r)P0[r]=__builtin_amdgcn_exp2f(fsub_s(P0[r],mhat)); }while(0)
  #define RESC() do{ if(resc){ asm volatile("s_waitcnt lgkmcnt(0)":::"memory"); \
      _Pragma("unroll") for(int d_=0;d_<4;++d_) _Pragma("unroll") for(int r=0;r<16;++r)o[d_][r]*=wsf[crow(r,hi)]; } }while(0)
  f32x16 pA0,pA1,pB0,pB1;
  int sl_prev=0,sl_cur=0,sl_next=SLOTB;
  #define ROT() do{sl_prev=sl_cur;sl_cur=sl_next;sl_next=(sl_next==(NSLOT-1)*SLOTB)?0:sl_next+SLOTB;}while(0)
  DMA_K(2,2*SLOTB);
  WAIT_BAR(1);
  { bf16x8 qr[4]; _Pragma("unroll") for(int d0=0;d0<4;++d0)qr[d0]=QF(d0); qkt(pA0,pA1,Kbase,qr,zero16,r32,hi); } asm volatile("s_nop 15\n\ts_nop 7":"+v"(pA0),"+v"(pA1));CMASK(pA0,pA1,0);
  START(pA0,pA1);
  _Pragma("unroll") for(int r=0;r<16;++r)pA1[r]=__builtin_amdgcn_exp2f(fsub_s(pA1[r],mhat));
  WAIT_BAR(0);
  DMA_K(3,0);DMA_V(1,SLOTB);
  ROT();
  kload8(kf,kp0+sl_cur);
  WAIT_BAR(3);
  s16x4 vlo[8],vhi[8]; u32x4 pw0,pw1,pw2,pw3;
  #define PKW(P,B) cvtpk_s(P[B],P[B+1])
  #define PAF(k) __builtin_bit_cast(bf16x8,pw##k)
  #define VFR(i) (bf16x8){vlo[i][0],vlo[i][1],vlo[i][2],vlo[i][3],vhi[i][0],vhi[i][1],vhi[i][2],vhi[i][3]}
  #define PIN(x) asm volatile("":"+v"(x))
  #define MX3(a,b,c) __builtin_fmaxf(__builtin_fmaxf((a),(b)),(c))
  #define GAPA(MF,A0,A1,A2,A3,W0,W1,PW) do{ MF; sacc+=A0; sacc+=A1; sacc+=A2; sacc+=A3; PIN(sacc); W0; W1; PIN(PW); SBAR(); }while(0)
  #define EX(v) __builtin_amdgcn_exp2f(v)
  #define GAPB(MF,X,B) do{ MF; X[B]=EX(X[B]-mhat); X[B+1]=EX(X[B+1]-mhat); PIN(X); SBAR(); }while(0)
  #define VRD(i) do{ vlo[i]=vtr(vp_+(((i)>>2)*4096+((i)&3)*1024)); vhi[i]=vtr(vp_+(((i)>>2)*4096+((i)&3)*1024+512)); }while(0)
  #define VRD2(i) do{ vlo[i]=vtr(vp_+(8192+((i)>>2)*4096+((i)&3)*1024)); vhi[i]=vtr(vp_+(8192+((i)>>2)*4096+((i)&3)*1024+512)); SBAR(); }while(0)
  #define KRD(G,j) do{ if(G){ kload2(kf,kp0+sl_next,j); SBAR(); } }while(0)
  #define STEP(C0,C1,P0,P1,t,GK,GV,GL) do{ SBAR(); \
    const lds_cptr vp_=vp0+2*sl_prev; \
    bf16x8 q_a=QF(0),q_b; \
    VRD(0); q_b=QF(1); SBAR(); float sacc=(P0[0]+P0[1]); \
    GAPA(C0=__builtin_amdgcn_mfma_f32_32x32x16_bf16(kf[0],q_a,zero16,0,0,0), P0[2],P0[3],P0[4],P0[5],     pw0[0]=PKW(P0,0), pw0[1]=PKW(P0,2), pw0); \
    VRD(4); SBAR(); GAPA(C1=__builtin_amdgcn_mfma_f32_32x32x16_bf16(kf[1],q_a,zero16,0,0,0), P0[6],P0[7],P0[8],P0[9],     pw0[2]=PKW(P0,4), pw0[3]=PKW(P0,6), pw0); \
    VRD(1); q_a=QF(2); SBAR(); GAPA(C0=__builtin_amdgcn_mfma_f32_32x32x16_bf16(kf[2],q_b,C0,0,0,0),   P0[10],P0[11],P0[12],P0[13], pw1[0]=PKW(P0,8), pw1[1]=PKW(P0,10), pw1); \
    VRD(5); SBAR(); GAPA(C1=__builtin_amdgcn_mfma_f32_32x32x16_bf16(kf[3],q_b,C1,0,0,0),   P0[14],P0[15],P1[0],P1[1],   pw1[2]=PKW(P0,12),pw1[3]=PKW(P0,14), pw1); \
    VRD(2); q_b=QF(3); SBAR(); GAPA(C0=__builtin_amdgcn_mfma_f32_32x32x16_bf16(kf[4],q_a,C0,0,0,0),   P1[2],P1[3],P1[4],P1[5],     pw2[0]=PKW(P1,0), pw2[1]=PKW(P1,2), pw2); \
    VRD(6); SBAR(); GAPA(C1=__builtin_amdgcn_mfma_f32_32x32x16_bf16(kf[5],q_a,C1,0,0,0),   P1[6],P1[7],P1[8],P1[9],     pw2[2]=PKW(P1,4), pw2[3]=PKW(P1,6), pw2); \
    VRD(3); SBAR(); GAPA(C0=__builtin_amdgcn_mfma_f32_32x32x16_bf16(kf[6],q_b,C0,0,0,0),   P1[10],P1[11],P1[12],P1[13], pw3[0]=PKW(P1,8), pw3[1]=PKW(P1,10), pw3); \
    VRD(7); SBAR(); GAPA(C1=__builtin_amdgcn_mfma_f32_32x32x16_bf16(kf[7],q_b,C1,0,0,0),   P1[14],P1[15],0.f,0.f,       pw3[2]=PKW(P1,12),pw3[3]=PKW(P1,14), pw3); \
    l_reg+=sacc; \
    if(GK){DMA_K((t)+3,sl_cur);} if(GV){DMA_V((t)+1,sl_next);} \
    CMASK(C0,C1,t); \
    { float a=MX3(C0[0],C0[1],C1[0]),b=MX3(C0[2],C0[3],C1[1]); a=MX3(a,C1[2],C1[3]); \
      _Pragma("unroll") for(int r=4;r<16;r+=4){a=MX3(a,C0[r],C0[r+1]);b=MX3(b,C0[r+2],C0[r+3]);a=MX3(a,C1[r],C1[r+1]);b=MX3(b,C1[r+2],C1[r+3]);} \
      float rm=__builtin_fmaxf(a,b); { auto rr=__builtin_amdgcn_permlane32_swap(__float_as_uint(rm),__float_as_uint(rm),false,false); rm=__builtin_fmaxf(__uint_as_float(rr[0]),__uint_as_float(rr[1])); } \
      resc=false; \
      rm-=mhat; \
      if(__builtin_expect(__any(rm>(float)THRL),0)){ const float dl=__builtin_fmaxf(rm,0.f); mhat+=dl; \
        const float f=__builtin_amdgcn_exp2f(-dl); l_reg*=f; if(hi==0)wsf[r32]=f; resc=true; } } \
    SBAR(); \
    GAPB(o[0]=__builtin_amdgcn_mfma_f32_32x32x16_bf16(PAF(0),VFR(0),o[0],0,0,0), C0,0);  VRD2(0); \
    GAPB(o[1]=__builtin_amdgcn_mfma_f32_32x32x16_bf16(PAF(0),VFR(4),o[1],0,0,0), C0,2);  VRD2(4); \
    GAPB(o[0]=__builtin_amdgcn_mfma_f32_32x32x16_bf16(PAF(1),VFR(1),o[0],0,0,0), C0,4);  VRD2(1); \
    GAPB(o[1]=__builtin_amdgcn_mfma_f32_32x32x16_bf16(PAF(1),VFR(5),o[1],0,0,0), C0,6);  VRD2(5); \
    GAPB(o[0]=__builtin_amdgcn_mfma_f32_32x32x16_bf16(PAF(2),VFR(2),o[0],0,0,0), C0,8);  VRD2(2); \
    GAPB(o[1]=__builtin_amdgcn_mfma_f32_32x32x16_bf16(PAF(2),VFR(6),o[1],0,0,0), C0,10); VRD2(6); \
    GAPB(o[0]=__builtin_amdgcn_mfma_f32_32x32x16_bf16(PAF(3),VFR(3),o[0],0,0,0), C0,12); VRD2(3); \
    GAPB(o[1]=__builtin_amdgcn_mfma_f32_32x32x16_bf16(PAF(3),VFR(7),o[1],0,0,0), C0,14); VRD2(7); \
    GAPB(o[2]=__builtin_amdgcn_mfma_f32_32x32x16_bf16(PAF(0),VFR(0),o[2],0,0,0), C1,0); \
    GAPB(o[3]=__builtin_amdgcn_mfma_f32_32x32x16_bf16(PAF(0),VFR(4),o[3],0,0,0), C1,2); \
    KRD(GL,0); GAPB(o[2]=__builtin_amdgcn_mfma_f32_32x32x16_bf16(PAF(1),VFR(1),o[2],0,0,0), C1,4); \
    KRD(GL,1); GAPB(o[3]=__builtin_amdgcn_mfma_f32_32x32x16_bf16(PAF(1),VFR(5),o[3],0,0,0), C1,6); \
    KRD(GL,2); GAPB(o[2]=__builtin_amdgcn_mfma_f32_32x32x16_bf16(PAF(2),VFR(2),o[2],0,0,0), C1,8); \
    KRD(GL,3); GAPB(o[3]=__builtin_amdgcn_mfma_f32_32x32x16_bf16(PAF(2),VFR(6),o[3],0,0,0), C1,10); \
    GAPB(o[2]=__builtin_amdgcn_mfma_f32_32x32x16_bf16(PAF(3),VFR(3),o[2],0,0,0), C1,12); \
    GAPB(o[3]=__builtin_amdgcn_mfma_f32_32x32x16_bf16(PAF(3),VFR(7),o[3],0,0,0), C1,14); \
    }while(0)
  int t=1;
  #undef CMASK
  #define CMASK(P0,P1,t) do{}while(0)
  for(;t+5<NT;t+=2){
    STEP(pB0,pB1,pA0,pA1,t,true,true,true);     WAIT_BAR(3); RESC(); ROT();
    STEP(pA0,pA1,pB0,pB1,t+1,true,true,true);   WAIT_BAR(3); RESC(); ROT();
  }
  #undef CMASK
  #define CMASK(P0,P1,t) do{int jb_=(t)-(NT-4); if(BAND||jb_>=0)cmask<BAND>(P0,P1,64*(t)-moff,qrel,hi);}while(0)
  #define ENDW(tt) do{ if((tt)+3<NT){WAIT_BAR(3);} else if((tt)+2<NT){WAIT_BAR(2);} else {WAIT_BAR(0);} }while(0)
  for(;t+1<NT;t+=2){
    STEP(pB0,pB1,pA0,pA1,t,(t+3<NT),(t+1<NT),(t+1<NT));       ENDW(t);   RESC(); ROT();
    STEP(pA0,pA1,pB0,pB1,t+1,(t+4<NT),(t+2<NT),(t+2<NT));     ENDW(t+1); RESC(); ROT();
  }
  STEP(pB0,pB1,pA0,pA1,NT-1,false,false,false); RESC();
  { float sacc=pB0[0]+pB0[1]; _Pragma("unroll") for(int r=2;r<16;++r)sacc+=pB0[r]; _Pragma("unroll") for(int r=0;r<16;++r)sacc+=pB1[r]; l_reg+=sacc;
    pw0=(u32x4){PKW(pB0,0),PKW(pB0,2),PKW(pB0,4),PKW(pB0,6)};pw1=(u32x4){PKW(pB0,8),PKW(pB0,10),PKW(pB0,12),PKW(pB0,14)};pw2=(u32x4){PKW(pB1,0),PKW(pB1,2),PKW(pB1,4),PKW(pB1,6)};pw3=(u32x4){PKW(pB1,8),PKW(pB1,10),PKW(pB1,12),PKW(pB1,14)};
    SBAR(); pv4(o,vb0+2*sl_cur,PAF(0),PAF(1),PAF(2),PAF(3)); }
  #undef PKW
  #undef PAF
  #undef VFR
  #undef PIN
  #undef MX3
  #undef GAPA
  #undef GAPB
  #undef EX
  #undef VRD
  #undef VRD2
  #undef QF
  #undef KRD
  #undef STEP
  #undef ENDW
  {auto rr=__builtin_amdgcn_permlane32_swap(__float_as_uint(l_reg),__float_as_uint(l_reg),false,false);l_reg=__uint_as_float(rr[0])+__uint_as_float(rr[1]);}
  if(hi==0)wsf[32+r32]=l_reg;asm volatile("s_waitcnt lgkmcnt(0)":::"memory");
  float rli[16];
  #pragma unroll
  for(int r=0;r<16;++r)rli[r]=__builtin_amdgcn_rcpf(wsf[32+crow(r,hi)]);
  asm volatile("s_waitcnt lgkmcnt(0)\n\ts_barrier":::"memory");
  bf16*Owa=Oa+(long)(wid*QBLK)*orsa; bf16*Owb=Ob+(long)(wid*QBLK)*ors;
  { bf16*stg=(bf16*)(shm)+wid*4096;
    #pragma unroll
    for(int r=0;r<16;++r){const int orow=crow(r,hi);
      #pragma unroll
      for(int d0=0;d0<4;++d0)stg[orow*128+d0*32+r32]=__float2bfloat16(o[d0][r]*rli[r]);}
    asm volatile("s_waitcnt lgkmcnt(0)":::"memory");
    #pragma unroll
    for(int i=0;i<8;++i){const int row=i*4+(lane>>4),ch=lane&15; const u32x4 v=*(const u32x4*)(stg+row*128+ch*8);
      if(ch<8){ATTN_STORE16(Owa+(long)row*orsa+ch*8,v);} else {ATTN_STORE16(Owb+(long)row*ors+(ch-8)*8,v);} } }
  asm volatile("s_waitcnt lgkmcnt(0)\n\ts_barrier":::"memory");
  #undef DMA_K
  #undef DMA_V
  #undef CMASK
  #undef START
  #undef RESC
  #undef ROT
}
struct AttnUnitDV { const bf16* Q; const bf16* K; const bf16* V; bf16* Oa; bf16* Ob; long rs, orsa, ors; int NT, moff; };
template<class Sched,int THRL> __device__ __forceinline__ void attn_phase_dv(char*lds,const Sched&S){
  AttnUnitDV u;
  for(int i=0;S.next(i,u);++i){ attn_unit_dv<THRL>(u.Q,u.K,u.V,u.Oa,u.orsa,u.Ob,u.ors,u.rs,u.NT,u.moff,lds); }
}
constexpr int ATTN_LDS_BYTES=LDS_BYTES;
struct AttnUnit { const bf16* Q; const bf16* K; const bf16* V; bf16* O; float* lse; long rs, ors, lrs; int NT, moff; };
template<class Sched,int THRL,bool BAND> __device__ __forceinline__ void attn_phase(char*lds,const Sched&S){
  AttnUnit u;
  for(int i=0;S.next(i,u);++i){ attn_unit<THRL,BAND>(u.Q,u.K,u.V,u.O,u.rs,u.ors,u.NT,u.moff,u.lse,u.lrs,lds); }
}
#undef SBAR
#undef WAIT_BAR
}
#define GAS __attribute__((address_space(1)))
#define LAS __attribute__((address_space(3)))
typedef unsigned short bf16;
typedef unsigned v4u __attribute__((ext_vector_type(4)));
typedef float f32x4 __attribute__((ext_vector_type(4)));
typedef short bf16x8 __attribute__((ext_vector_type(8)));
typedef GAS unsigned gu32;
typedef GAS unsigned long long gu64;
#define RLX_AGENT __ATOMIC_RELAXED, __HIP_MEMORY_SCOPE_AGENT
#define LDS_WAIT() asm volatile("s_waitcnt lgkmcnt(0)" ::: "memory")
#define VM_WAIT() asm volatile("s_waitcnt vmcnt(0)" ::: "memory")
__device__ __forceinline__ unsigned long long rt() { return __builtin_amdgcn_s_memrealtime(); }

#define XB_TMO      128
#define XB_XCNT(j)  (256  + 64 * (j))
#define XB_XSUB(j)  (1280 + 64 * (j))
#define XB_XGEN(j)  (2304 + 64 * (j))
#define XB_TOP      3328
#define XB_TOPGEN   3392
#define XCD_BAR_WORDS 3456
#define XB_SPIN_CAP (1u << 18)

__device__ __forceinline__ unsigned xb_ld(unsigned* p)              { return __hip_atomic_load(p, __ATOMIC_RELAXED, __HIP_MEMORY_SCOPE_AGENT); }
__device__ __forceinline__ unsigned xb_add(unsigned* p, unsigned v) { return __hip_atomic_fetch_add(p, v, __ATOMIC_RELAXED, __HIP_MEMORY_SCOPE_AGENT); }
__device__ __forceinline__ unsigned xb_xcc_id() { return (unsigned)__builtin_amdgcn_s_getreg((3 << 11) | 20) & 0xFu; }
#define XB_SPIN(cond, bar) do { unsigned _sp = 0; while (cond) { __builtin_amdgcn_s_sleep(1); \
    if ((++_sp & 255u) == 0u) { if (xb_ld(&(bar)[XB_TMO])) break; if (_sp > XB_SPIN_CAP) { atomicAdd(&(bar)[XB_TMO], 1u); break; } } } } while (0)

struct XcdBarrier {
    unsigned* bar; unsigned x;
    volatile LAS unsigned* st;
};

__device__ __forceinline__ XcdBarrier xcd_barrier_post(unsigned* bar, volatile LAS unsigned* st) {
    XcdBarrier b; b.bar = bar; b.x = xb_xcc_id(); b.st = st;
    if (threadIdx.x == 0) (void)xb_add(&bar[XB_XCNT(b.x)], 1u);
    return b;
}
__device__ __forceinline__ void xcd_barrier_complete(unsigned* bar, unsigned x, unsigned& nloc, unsigned& nx) {
    const unsigned G = gridDim.x * gridDim.y * gridDim.z;
    unsigned sum, cnt, mine, sp = 0u;
    for (;;) {
        sum = 0u; cnt = 0u; mine = 0u;
#pragma unroll
        for (unsigned j = 0; j < 16; ++j) { const unsigned c = xb_ld(&bar[XB_XCNT(j)]); sum += c; cnt += (c > 0u) ? 1u : 0u; mine = (j == x) ? c : mine; }
        if (sum == G) break;
        __builtin_amdgcn_s_sleep(1);
        if ((++sp & 255u) == 0u) { if (xb_ld(&bar[XB_TMO])) break; if (sp > XB_SPIN_CAP) { atomicAdd(&bar[XB_TMO], 1u); break; } }
    }
    nloc = mine > 0u ? mine : 1u; nx = cnt > 0u ? cnt : 1u;
}

__device__ __forceinline__ void xcd_barrier(const XcdBarrier& b) {
    asm volatile("s_waitcnt vmcnt(0)" ::: "memory");
    __syncthreads();
    if (threadIdx.x == 0) {
        unsigned* bar = b.bar;
        __builtin_amdgcn_s_waitcnt(0);
        unsigned nloc = b.st[0], nx = b.st[1];
        if (nloc == 0u) { xcd_barrier_complete(bar, b.x, nloc, nx); b.st[0] = nloc; b.st[1] = nx; }
        const unsigned old = xb_add(&bar[XB_XSUB(b.x)], 1u);
        const unsigned gen = old / nloc;
        if (old + 1u == (gen + 1u) * nloc) {
            __builtin_amdgcn_fence(__ATOMIC_RELEASE, "agent");
            asm volatile("s_waitcnt vmcnt(0)" ::: "memory");
            const unsigned og = xb_add(&bar[XB_TOP], 1u);
            const unsigned tg = og / nx;
            if (og + 1u == (tg + 1u) * nx) xb_add(&bar[XB_TOPGEN], 1u);
            else XB_SPIN(xb_ld(&bar[XB_TOPGEN]) == tg, bar);
            __builtin_amdgcn_fence(__ATOMIC_ACQUIRE, "agent");
            xb_add(&bar[XB_XGEN(b.x)], 1u);
            asm volatile("s_waitcnt vmcnt(0)" ::: "memory");
        } else {
            XB_SPIN(xb_ld(&bar[XB_XGEN(b.x)]) == gen, bar);
            __builtin_amdgcn_fence(__ATOMIC_ACQUIRE, "agent");
            asm volatile("s_waitcnt vmcnt(0)" ::: "memory");
        }
    }
    __syncthreads();
}

constexpr int NWAVES = 8;
constexpr int RING_OFF = 0, RING_BYTES = 131072;
constexpr int LDSCTL_OFF = RING_BYTES, MISC_OFF = LDSCTL_OFF + 320;
constexpr int LDS_BYTES = 147456;
constexpr int CW_TMO = 0, CW_CODE = 1, CW_BAR = 4096;

__device__ __forceinline__ int lane_id() { int l = (int)(threadIdx.x & 63u); asm volatile("" : "+v"(l)); return l; }
__device__ __forceinline__ int tid_id() { int t = (int)threadIdx.x; asm volatile("" : "+v"(t)); return t; }
struct Frame {
    LAS unsigned char* lds;
    volatile LAS unsigned* MISC;
    gu32* ctl;
    int wave, vcu, G;
};

__device__ __forceinline__ void p0_transpose_item(const float* W, int K, int N, bf16_t* WT, int k0, int n0, int drow0, LAS float* scr, int lane, const float* gain) {
    const float* src = W + (size_t)(k0 + (lane >> 5)) * N + n0 + (lane & 31);
    float v[32];
#pragma unroll
    for (int i = 0; i < 32; ++i) v[i] = src[(size_t)(2 * i) * N];
    const int c = lane & 7;
    f32x4 g0 = {1.f, 1.f, 1.f, 1.f}, g1 = g0;
    if (gain) { g0 = *(const f32x4*)(gain + k0 + 8 * c); g1 = *(const f32x4*)(gain + k0 + 8 * c + 4); }
#pragma unroll
    for (int i = 0; i < 32; ++i) scr[(2 * i + (lane >> 5)) * 33 + (lane & 31)] = v[i];
    LDS_WAIT(); asm volatile("" ::: "memory");
#pragma unroll
    for (int j = 0; j < 4; ++j) { const int n = (lane >> 3) + 8 * j; const LAS float* s = scr + (8 * c) * 33 + n;
        v4u o; o.x = pk2bf(s[0 * 33] * g0[0], s[1 * 33] * g0[1]); o.y = pk2bf(s[2 * 33] * g0[2], s[3 * 33] * g0[3]); o.z = pk2bf(s[4 * 33] * g1[0], s[5 * 33] * g1[1]); o.w = pk2bf(s[6 * 33] * g1[2], s[7 * 33] * g1[3]);
        *(GAS v4u*)(WT + (size_t)(drow0 + n) * K + k0 + 8 * c) = o; }
    LDS_WAIT(); asm volatile("" ::: "memory");
}
__device__ __forceinline__ void rms_row_to_bf16(const float* xrow, const float* g, bf16_t* orow, int lane) {
    const f32x4* xr = (const f32x4*)xrow + lane;
    f32x4 v[4]; float s = 0.f;
#pragma unroll
    for (int j = 0; j < 4; ++j) { v[j] = xr[64 * j]; s += (v[j].x * v[j].x + v[j].y * v[j].y) + (v[j].z * v[j].z + v[j].w * v[j].w); }
    const float r = rsqrtf(wave_sum(s) * (1.f / DM) + EPS);
    unsigned long long* o8 = (unsigned long long*)orow + lane;
#pragma unroll
    for (int j = 0; j < 4; ++j) { const f32x4 gg = *((const f32x4*)g + lane + 64 * j);
        o8[64 * j] = (unsigned long long)pk2bf(v[j].x * r * gg.x, v[j].y * r * gg.y) | ((unsigned long long)pk2bf(v[j].z * r * gg.z, v[j].w * r * gg.w) << 32); }
}
__device__ __forceinline__ void row_to_bf16_sq(const float* xrow, bf16_t* orow, float* rsq16, int lane) {
    const f32x4* xr = (const f32x4*)xrow + lane;
    f32x4 v[4]; float s = 0.f;
#pragma unroll
    for (int j = 0; j < 4; ++j) { v[j] = xr[64 * j]; s += (v[j].x * v[j].x + v[j].y * v[j].y) + (v[j].z * v[j].z + v[j].w * v[j].w); }
    s = wave_sum(s);
    unsigned long long* o8 = (unsigned long long*)orow + lane;
#pragma unroll
    for (int j = 0; j < 4; ++j) o8[64 * j] = (unsigned long long)pk2bf(v[j].x, v[j].y) | ((unsigned long long)pk2bf(v[j].z, v[j].w) << 32);
    if (lane < 4) rsq16[lane] = (lane == 0) ? s : 0.f;
}
__device__ __forceinline__ void rms_row_final(const bf16_t* hrow, float* orow, const float* g, const float* rsq4, int lane) {
    float s = (lane < 4) ? rsq4[lane] : 0.f;
    const unsigned long long* h8 = (const unsigned long long*)hrow + lane;
    unsigned long long hv[4];
#pragma unroll
    for (int j = 0; j < 4; ++j) hv[j] = h8[64 * j];
    s = wave_sum(s);
    const float r = rsqrtf(s * (1.f / DM) + EPS);
    f32x4* o = (f32x4*)orow + lane;
#pragma unroll
    for (int j = 0; j < 4; ++j) { const f32x4 gg = *((const f32x4*)g + lane + 64 * j); const unsigned lo = (unsigned)hv[j], hi = (unsigned)(hv[j] >> 32);
        o[64 * j] = (f32x4){__uint_as_float(lo << 16), __uint_as_float(lo & 0xffff0000u), __uint_as_float(hi << 16), __uint_as_float(hi & 0xffff0000u)} * r * gg; }
}
__device__ __forceinline__ void rms_row_inplace_rsq(float* xrow, const float* g, const float* rsq16, int lane) {
    f32x4* xr = (f32x4*)xrow + lane;
    float s = (lane < 4) ? rsq16[lane] : 0.f;
    s = wave_sum(s);
    const float r = rsqrtf(s * (1.f / DM) + EPS);
#pragma unroll
    for (int j = 0; j < 4; ++j) { const f32x4 gg = *((const f32x4*)g + lane + 64 * j); xr[64 * j] = xr[64 * j] * r * gg; }
}
__device__ __forceinline__ void rms_row_inplace(float* xrow, const float* g, int lane) {
    f32x4* xr = (f32x4*)xrow + lane;
    f32x4 v[4]; float s = 0.f;
#pragma unroll
    for (int j = 0; j < 4; ++j) { v[j] = xr[64 * j]; s += (v[j].x * v[j].x + v[j].y * v[j].y) + (v[j].z * v[j].z + v[j].w * v[j].w); }
    const float r = rsqrtf(wave_sum(s) * (1.f / DM) + EPS);
#pragma unroll
    for (int j = 0; j < 4; ++j) { const f32x4 gg = *((const f32x4*)g + lane + 64 * j); xr[64 * j] = v[j] * r * gg; }
}

struct Args { const float* in[23]; float* out; unsigned char* ws; int ph_lo, ph_hi, li, pad; };

struct WDesc { const float* W; int K, N; bf16_t* WT; int mode; int items; };

constexpr int CI0 = (DM / 64) * (N_IN0 / 32), CI1 = (DM / 64) * (DM / 32), CI2 = (DM / 64) * (N_QKV / 32), CI4 = (DM / 64) * (NUP / 32), CI6 = (DFF / 64) * (DM / 32), CI8 = (128 / 64) * (128 / 32);
constexpr int CB_P0_END = CI0;
constexpr int CB_1_END = CB_P0_END + CI1 + CI4 + CI6 + 4 * CI8;
constexpr int CB_2_END = CB_1_END + CI2 + CI1 + CI4 + CI6;
__device__ __forceinline__ void convert_items(Frame& F, const Args& a, unsigned char* ws, int it_begin, int it_end, int worker, int nworkers) {
    LAS float* scr = (LAS float*)(F.lds + RING_OFF + F.wave * 16384);
    const int lane = lane_id();
    for (int it = it_begin + worker; it < it_end; it += nworkers) {
        int r = it; const float* W; int K, N; bf16_t* WT; int mode = 0; const float* gain = nullptr;
        if (r < CI0) { W = a.in[5]; K = DM; N = N_IN0; WT = (bf16_t*)(ws + WS_W_IN0); gain = a.in[2]; }
        else if ((r -= CI0) < CI1) { W = a.in[11]; K = DM; N = DM; WT = (bf16_t*)(ws + WS_W_OUT0); }
        else if ((r -= CI1) < CI4) { W = a.in[19]; K = DM; N = NUP; WT = (bf16_t*)(ws + WS_W_UP); mode = 1; gain = a.in[3]; }
        else if ((r -= CI4) < CI6) { W = a.in[22]; K = DFF; N = DM; WT = (bf16_t*)(ws + WS_W_DN); }
        else if ((r -= CI6) < 4 * CI8) { const int g = r / CI8; r -= g * CI8; W = a.in[9] + (size_t)g * 128 * 128; K = 128; N = 128; WT = (bf16_t*)(ws + WS_PWT) + (size_t)g * 128 * 128; }
        else if ((r -= 4 * CI8) < CI2) { W = a.in[12]; K = DM; N = N_QKV; WT = (bf16_t*)(ws + WS_W_QKV); gain = a.in[2] + DM; }
        else if ((r -= CI2) < CI1) { W = a.in[18]; K = DM; N = DM; WT = (bf16_t*)(ws + WS_W_OUT1); }
        else if ((r -= CI1) < CI4) { W = a.in[19] + (size_t)DM * NUP; K = DM; N = NUP; WT = (bf16_t*)(ws + WS_W_UP) + (size_t)NUP * DM; mode = 1; gain = a.in[3] + DM; }
        else { r -= CI4; W = a.in[22] + (size_t)DFF * DM; K = DFF; N = DM; WT = (bf16_t*)(ws + WS_W_DN) + (size_t)DM * DFF; }
        const int nblk = N / 32, kb = r / nblk, nb = r % nblk, k0 = 64 * kb, n0 = 32 * nb;
        int d0 = n0;
        if (mode == 1) { if (n0 < DFF) d0 = 256 * (n0 / 128) + (n0 % 128); else { const int q = n0 - DFF; d0 = 256 * (q / 128) + 128 + (q % 128); } }
        p0_transpose_item(W, K, N, WT, k0, n0, d0, scr, lane, gain);
    }
}
__device__ __forceinline__ void convert_in_tail(Frame& F, const Args& a, unsigned char* ws, int nwg, int it_begin, int it_end) {
    const int rem = nwg % F.G, first = rem, nw = (rem > 0) ? F.G - rem : F.G, c = (int)blockIdx.x;
    if (rem > 0 && c < first) return;
    convert_items(F, a, ws, it_begin, it_end, (c - (rem > 0 ? first : 0)) * NWAVES + F.wave, nw * NWAVES);
}
__device__ __forceinline__ void p0_prologue(Frame& F, const Args& a) {
    const int lane = lane_id(), tid = tid_id();
    const int gw = F.vcu * NWAVES + F.wave, NGW = F.G * NWAVES;
    unsigned char* ws = a.ws;
    convert_items(F, a, ws, 0, CB_P0_END, gw, NGW);
    { const float* w_s = a.in[7]; bf16_t* Wb = (bf16_t*)(ws + WS_WSB);
      for (int idx = (F.vcu * NWAVES * 64) + tid; idx < 4 * 128 * 128; idx += F.G * NWAVES * 64) { const int t = (idx >> 7) & 127, sidx = idx & 127; Wb[idx] = (sidx <= t) ? f2bf(w_s[idx]) : (bf16_t)0; } }
    { bf16_t* XN = (bf16_t*)(ws + WS_XN); float* rsq = (float*)(ws + WS_RSQ); const float* x = a.in[0];
      for (int m0 = gw * 2; m0 < M; m0 += NGW * 2) {
          f32x4 v[2][4];
#pragma unroll
          for (int r = 0; r < 2; ++r)
#pragma unroll
              for (int j = 0; j < 4; ++j) v[r][j] = *((const f32x4*)(x + (size_t)(m0 + r) * DM) + lane + 64 * j);
#pragma unroll
          for (int r = 0; r < 2; ++r) { float sq = 0.f;
#pragma unroll
              for (int j = 0; j < 4; ++j) sq += (v[r][j].x * v[r][j].x + v[r][j].y * v[r][j].y) + (v[r][j].z * v[r][j].z + v[r][j].w * v[r][j].w);
              sq = wave_sum(sq);
              unsigned long long* o8 = (unsigned long long*)(XN + (size_t)(m0 + r) * DM) + lane;
#pragma unroll
              for (int j = 0; j < 4; ++j) o8[64 * j] = (unsigned long long)pk2bf(v[r][j].x, v[r][j].y) | ((unsigned long long)pk2bf(v[r][j].z, v[r][j].w) << 32);
              if (lane < 4) rsq[(size_t)(m0 + r) * 4 + lane] = (lane == 0) ? sq : 0.f; } } }
}

#ifndef PG8_SP2
#define PG8_SP2 true
#endif
#ifndef PG8_ALIGN
#define PG8_ALIGN true
#endif

struct SchedC {
    int vcu, G; attn_body::bf16* QKV; attn_body::bf16* OCA;
    __device__ __forceinline__ bool next(int it, attn_body::AttnUnitDV& u) const {
        constexpr long P = attn_body::PITCH;
        const int per = 3, s = vcu + (it / per) * G, k = it % per;
        if (s >= 256) return false;
        const int x = s >> 5, l = s & 31, i = l & 15, hl = (l >> 4) * 3 + k;
        const int qb = (k == 0) ? i : (k == 1) ? ((i + 8) & 15) : (i < 8 ? 14 - 2 * i : 31 - 2 * i);
        const int bj = x * 6 + hl, b = bj / 12, j = bj % 12, h = j >> 1;
        const long rowbase = (long)b * SEQ, q0 = (long)qb * 256;
        u.Q = QKV + (rowbase + q0) * P + j * 64; u.K = QKV + rowbase * P + 768 + j * 64; u.V = QKV + rowbase * P + 1536 + h * 128;
        u.Oa = OCA + (rowbase + q0) * 768 + j * 64; u.orsa = 768; u.Ob = QKV + (rowbase + q0) * P + j * 64; u.ors = P; u.rs = P;
        u.NT = 4 * qb + 4; u.moff = (int)q0;
        return true;
    }
};
struct SchedD {
    int vcu, G; attn_body::bf16* QKV; float* LSE;
    __device__ __forceinline__ bool next(int it, attn_body::AttnUnit& u) const {
        constexpr long P = attn_body::PITCH;
        const int ud = vcu + it * G; if (ud >= 768) return false;
        const int b = ud / 192, rem = ud % 192, head = rem >> 4, idx = rem & 15, g = head >> 2;
        const int dl = (g == 0) ? 1 : (g == 1 ? 4 : 16), nb = 16 / dl, r = idx / nb, qb = idx % nb;
        const long rowbase = (long)b * SEQ + r; const int q0 = 256 * qb, kstart = (q0 >= 128) ? q0 - 128 : 0;
        u.rs = (long)dl * P; u.ors = u.rs; u.lrs = (long)dl * 12;
        u.Q = QKV + (rowbase + (long)q0 * dl) * P + 2304 + head * 64; u.O = QKV + (rowbase + (long)q0 * dl) * P + 2304 + head * 64;
        u.K = QKV + (rowbase + (long)kstart * dl) * P + 3072 + head * 64; u.V = QKV + (rowbase + (long)kstart * dl) * P + 3840 + head * 64;
        u.NT = (q0 + 256 - kstart) / 64; u.moff = q0 - kstart; u.lse = LSE + (rowbase + (long)q0 * dl) * 12 + head;
        return true;
    }
};
__device__ __forceinline__ f32x4 bf4lo(const u32x4 w) { return (f32x4){__uint_as_float(w.x << 16), __uint_as_float(w.x & 0xffff0000u), __uint_as_float(w.y << 16), __uint_as_float(w.y & 0xffff0000u)}; }
__device__ __forceinline__ f32x4 bf4hi(const u32x4 w) { return (f32x4){__uint_as_float(w.z << 16), __uint_as_float(w.z & 0xffff0000u), __uint_as_float(w.w << 16), __uint_as_float(w.w & 0xffff0000u)}; }
__device__ __forceinline__ u32x4 pack8(const f32x4 a, const f32x4 b) { u32x4 o; o.x = pk2bf(a[0], a[1]); o.y = pk2bf(a[2], a[3]); o.z = pk2bf(b[0], b[1]); o.w = pk2bf(b[2], b[3]); return o; }
__device__ __forceinline__ void post_attention_phase(Frame& F, const Args& a, unsigned char* ws) {
    const bf16_t* QKV = (const bf16_t*)(ws + WS_QKV); const bf16_t* OCA = (const bf16_t*)(ws + WS_OCA); const float* LSE = (const float*)(ws + WS_LSE);
    bf16_t* Y1 = (bf16_t*)(ws + WS_QKV) + Y1_COL;
    const int lane = lane_id(), gw = F.vcu * NWAVES + F.wave, NGW = F.G * NWAVES;
    const float lam = __expf(wave_sum(a.in[13][lane] * a.in[14][lane])) - __expf(wave_sum(a.in[15][lane] * a.in[16][lane])) + LAMBDA_INIT;
    const bool isC = lane < 48;
    const int h = lane >> 3, c = lane & 7, hh = (lane - 48) >> 2, dc = (lane & 3) * 16;
    f32x4 ga0, ga1, gb0, gb1;
    { const float f = 1.f - LAMBDA_INIT; const float* sg = a.in[17] + 8 * c;
      ga0 = *(const f32x4*)sg * f; ga1 = *(const f32x4*)(sg + 4) * f; gb0 = *(const f32x4*)(sg + 64) * f; gb1 = *(const f32x4*)(sg + 68) * f; }
    for (int row = gw; row < M; row += NGW) {
        const bf16_t* qa = OCA + (size_t)row * 768; const bf16_t* qb = QKV + (size_t)row * N_QKV; bf16_t* y = Y1 + (size_t)row * N_QKV;
        if (isC) {
            const u32x4 a0 = *(const u32x4*)(qa + (2 * h) * 64 + 8 * c), a1 = *(const u32x4*)(qa + (2 * h + 1) * 64 + 8 * c);
            const u32x4 b0 = *(const u32x4*)(qb + (2 * h) * 64 + 8 * c), b1 = *(const u32x4*)(qb + (2 * h + 1) * 64 + 8 * c);
            const f32x4 x0 = bf4lo(a0) - lam * bf4lo(a1), x1 = bf4hi(a0) - lam * bf4hi(a1), z0 = bf4lo(b0) - lam * bf4lo(b1), z1 = bf4hi(b0) - lam * bf4hi(b1);
            float q = ((x0[0] * x0[0] + x0[1] * x0[1]) + (x0[2] * x0[2] + x0[3] * x0[3])) + ((x1[0] * x1[0] + x1[1] * x1[1]) + (x1[2] * x1[2] + x1[3] * x1[3]))
                    + ((z0[0] * z0[0] + z0[1] * z0[1]) + (z0[2] * z0[2] + z0[3] * z0[3])) + ((z1[0] * z1[0] + z1[1] * z1[1]) + (z1[2] * z1[2] + z1[3] * z1[3]));
            q += dpp_f<0xB1>(q); q += dpp_f<0x4E>(q); q += dpp_f<0x141>(q);
            const float r = rsqrtf(q * (1.f / 128.f) + EPS);
            *(u32x4*)(y + h * 128 + 8 * c) = pack8(x0 * ga0 * r, x1 * ga1 * r);
            *(u32x4*)(y + h * 128 + 64 + 8 * c) = pack8(z0 * gb0 * r, z1 * gb1 * r);
        } else {
            const float l0 = LSE[(size_t)row * 12 + hh], l1 = LSE[(size_t)row * 12 + 4 + hh], l2 = LSE[(size_t)row * 12 + 8 + hh];
            const float mx = fmaxf(l0, fmaxf(l1, l2));
            float w0 = __builtin_amdgcn_exp2f(l0 - mx), w1 = __builtin_amdgcn_exp2f(l1 - mx), w2 = __builtin_amdgcn_exp2f(l2 - mx);
            const float inv = 1.f / (w0 + w1 + w2); w0 *= inv; w1 *= inv; w2 *= inv;
            const bf16_t* d0 = qb + 2304 + hh * 64 + dc;
#pragma unroll
            for (int k = 0; k < 2; ++k) {
                const u32x4 v0 = *(const u32x4*)(d0 + 8 * k), v1 = *(const u32x4*)(d0 + 256 + 8 * k), v2 = *(const u32x4*)(d0 + 512 + 8 * k);
                *(u32x4*)(y + 768 + hh * 64 + dc + 8 * k) = pack8(w0 * bf4lo(v0) + w1 * bf4lo(v1) + w2 * bf4lo(v2), w0 * bf4hi(v0) + w1 * bf4hi(v1) + w2 * bf4hi(v2));
            }
        }
    }
}

constexpr int MXP = 136;
__device__ __forceinline__ void mixer_phase(Frame& F, const Args& a, unsigned char* ws) {
    const bf16_t* P = (const bf16_t*)(ws + WS_P); bf16_t* Y = (bf16_t*)(ws + WS_Y);
    const bf16_t* Wb = (const bf16_t*)(ws + WS_WSB); const bf16_t* PWt = (const bf16_t*)(ws + WS_PWT);
    const float* v_gain = a.in[6]; const float* b_s = a.in[8]; const float* pool_scale = a.in[10];
    LAS bf16_t* T = (LAS bf16_t*)(F.lds + RING_OFF);
    LAS bf16_t* T2 = (LAS bf16_t*)(F.lds + RING_OFF + 128 * MXP * 2);
    LAS float* rs = (LAS float*)(F.lds + RING_OFF + 2 * 128 * MXP * 2);
    const int tid = tid_id(), wid = tid >> 6, lane = tid & 63, fr = lane & 15, fq = lane >> 4;
    for (int u = F.vcu; u < 1024; u += F.G) {
        const bool isA = u < 512; const int blk = (u & 511) >> 2, g = u & 3, row0 = blk * 128;
        f32x4 acc[8];
#pragma unroll
        for (int j = 0; j < 8; ++j) acc[j] = (f32x4){0.f, 0.f, 0.f, 0.f};
        if (isA) {
            bf16x8 xr[16], xv[4], wf[4]; u32x2 ug[8];
#pragma unroll
            for (int i = 0; i < 16; ++i) xr[i] = *(const bf16x8*)(P + (size_t)(row0 + wid * 16 + i) * N_IN0 + 512 + lane * 8);
#pragma unroll
            for (int k = 0; k < 4; ++k) { const int it = tid + 512 * k, sr = it & 127, cc = it >> 7; xv[k] = *(const bf16x8*)(P + (size_t)(row0 + sr) * N_IN0 + 512 + g * 128 + cc * 8); }
            const bf16_t* wrow = Wb + ((size_t)g * 128 + wid * 16 + fr) * 128 + fq * 8;
#pragma unroll
            for (int ks = 0; ks < 4; ++ks) wf[ks] = *(const bf16x8*)(wrow + ks * 32);
            const int t = wid * 16 + fr;
#pragma unroll
            for (int j = 0; j < 8; ++j) ug[j] = *(const u32x2*)(P + (size_t)(row0 + t) * N_IN0 + g * 128 + j * 16 + fq * 4);
            const float bias = b_s[g * 128 + t];
#pragma unroll
            for (int i = 0; i < 16; ++i) { float q = 0.f;
#pragma unroll
                for (int e = 0; e < 8; ++e) { const float f = bf2f((bf16_t)xr[i][e]); q += f * f; }
                q = wave_sum(q);
                if (lane == 0) rs[wid * 16 + i] = rsqrtf(q * (1.f / 512.f) + EPS); }
            __syncthreads();
#pragma unroll
            for (int k = 0; k < 4; ++k) { const int it = tid + 512 * k, sr = it & 127, cc = it >> 7; const float r = rs[sr];
                const f32x4 g0 = *(const f32x4*)(v_gain + g * 128 + cc * 8), g1 = *(const f32x4*)(v_gain + g * 128 + cc * 8 + 4);
#pragma unroll
                for (int e = 0; e < 8; ++e) T[(cc * 8 + e) * MXP + sr] = f2bf(bf2f((bf16_t)xv[k][e]) * r * (e < 4 ? g0[e & 3] : g1[e & 3])); }
            __syncthreads();
            const int nks = (wid >> 1) + 1;
#pragma unroll
            for (int ks = 0; ks < 4; ++ks) if (ks < nks) {
#pragma unroll
                for (int j = 0; j < 8; ++j) { const bf16x8 bfr = *(const LAS bf16x8*)(T + (j * 16 + fr) * MXP + ks * 32 + fq * 8);
                    acc[j] = __builtin_amdgcn_mfma_f32_16x16x32_bf16(bfr, wf[ks], acc[j], 0, 0, 0); }
            }
#pragma unroll
            for (int j = 0; j < 8; ++j) { const int col = g * 128 + j * 16 + fq * 4; const u32x2 uu = ug[j];
                const float u0 = __uint_as_float(uu.x << 16), u1 = __uint_as_float(uu.x & 0xffff0000u), u2 = __uint_as_float(uu.y << 16), u3 = __uint_as_float(uu.y & 0xffff0000u);
                u32x2 o; o.x = pk2bf(u0 * (acc[j][0] + bias), u1 * (acc[j][1] + bias)); o.y = pk2bf(u2 * (acc[j][2] + bias), u3 * (acc[j][3] + bias));
                *(u32x2*)(Y + (size_t)(row0 + t) * DM + col) = o; }
        } else {
            const int w = 2 << g; const float inv_w = 1.f / (float)w;
            const int cc = tid & 15, rg = tid >> 4, r0 = row0 + rg * 4, t0 = r0 & (SEQ - 1);
            const bf16_t* xp = P + 1024 + g * 128 + cc * 8;
            bf16x8 hx[19];
#pragma unroll
            for (int j = 0; j < 19; ++j) { const int dr = j - 15; hx[j] = (bf16x8){0, 0, 0, 0, 0, 0, 0, 0};
                if (dr > -w && t0 + dr >= 0) hx[j] = *(const bf16x8*)(xp + (size_t)(r0 + dr) * N_IN0); }
            bf16x8 pw4[4];
#pragma unroll
            for (int k = 0; k < 4; ++k) { const int it = tid + 512 * k, d = it >> 4, c8 = it & 15; pw4[k] = *(const bf16x8*)(PWt + ((size_t)g * 128 + d) * 128 + c8 * 8); }
#pragma unroll
            for (int k = 0; k < 4; ++k) { const int it = tid + 512 * k, d = it >> 4, c8 = it & 15; *(LAS bf16x8*)(T2 + d * MXP + c8 * 8) = pw4[k]; }
#pragma unroll
            for (int i = 0; i < 4; ++i) { const int ts = t0 + i;
                float sum[8];
#pragma unroll
                for (int e = 0; e < 8; ++e) sum[e] = 0.f;
#pragma unroll
                for (int jj = 0; jj < 16; ++jj) { if (jj < w) {
#pragma unroll
                        for (int e = 0; e < 8; ++e) sum[e] += bf2f((bf16_t)hx[15 + i - jj][e]); } }
                const float ic = (ts + 1 < w) ? 1.f / (float)(ts + 1) : inv_w;
                u32x4 o; unsigned ow[4];
#pragma unroll
                for (int e = 0; e < 8; e += 2) ow[e >> 1] = pk2bf(sum[e] * ic - bf2f((bf16_t)hx[15 + i][e]), sum[e + 1] * ic - bf2f((bf16_t)hx[15 + i][e + 1]));
                o.x = ow[0]; o.y = ow[1]; o.z = ow[2]; o.w = ow[3];
                *(LAS u32x4*)(T + (rg * 4 + i) * MXP + cc * 8) = o; }
            __syncthreads();
#pragma unroll
            for (int ks = 0; ks < 4; ++ks) {
                const bf16x8 af = *(const LAS bf16x8*)(T + (wid * 16 + fr) * MXP + ks * 32 + fq * 8);
#pragma unroll
                for (int j = 0; j < 8; ++j) { const bf16x8 bfr = *(const LAS bf16x8*)(T2 + (j * 16 + fr) * MXP + ks * 32 + fq * 8);
                    acc[j] = __builtin_amdgcn_mfma_f32_16x16x32_bf16(bfr, af, acc[j], 0, 0, 0); }
            }
            const int t = wid * 16 + fr;
#pragma unroll
            for (int j = 0; j < 8; ++j) { const int d = g * 128 + j * 16 + fq * 4; const f32x4 sc = *(const f32x4*)(pool_scale + d);
                u32x2 o; o.x = pk2bf(acc[j][0] * sc[0], acc[j][1] * sc[1]); o.y = pk2bf(acc[j][2] * sc[2], acc[j][3] * sc[3]);
                *(u32x2*)(Y + (size_t)(row0 + t) * DM + 512 + d) = o; }
        }
        __syncthreads();
    }
}

__device__ __forceinline__ void ffn_fix_panel(const Args& a, unsigned char* ws, int layer, int pm, int tid) {
    bf16_t* HM = (bf16_t*)(ws + WS_HMID);
    const float* halo = (const float*)(ws + WS_HALO); const float* tops = (const float*)(ws + WS_TOPS); const float* topg = (const float*)(ws + WS_TOPG);
    const float* cw = a.in[20] + (size_t)layer * 3 * DFF;
    constexpr int CPR = DFF / 4;
    for (int it = tid; it < 2 * CPR; it += NWAVES * 64) {
        const int rr = it / CPR, c = (it % CPR) * 4;
        const size_t off = ((size_t)pm * 2 + rr) * DFF + c;
        f32x4 sv = *(const f32x4*)(tops + off); const f32x4 g = *(const f32x4*)(topg + off);
        const f32x4 h1 = *(const f32x4*)(halo + ((size_t)(pm - 1) * 2 + 1) * DFF + c), h0 = *(const f32x4*)(halo + ((size_t)(pm - 1) * 2 + 0) * DFF + c);
        const f32x4 w0 = *(const f32x4*)(cw + c), w1 = *(const f32x4*)(cw + DFF + c);
        if (rr == 0) sv = sv + w1 * h1 + w0 * h0; else sv = sv + w0 * h1;
        u32x2 o; o.x = pk2bf(gelu_tanh(sv[0]) * g[0], gelu_tanh(sv[1]) * g[1]); o.y = pk2bf(gelu_tanh(sv[2]) * g[2], gelu_tanh(sv[3]) * g[3]);
        *(u32x2*)(HM + (size_t)(pm * 256 + rr) * DFF + c) = o;
    }
}

#define OPQ_S(x) asm volatile("" : "+s"(x))
__device__ __forceinline__ Frame make_frame(unsigned char* ws) {
    extern __shared__ __attribute__((aligned(16))) unsigned char lds_[];
    Frame F;
    F.lds = (LAS unsigned char*)lds_;
    F.MISC = (volatile LAS unsigned*)(F.lds + MISC_OFF);
    F.wave = __builtin_amdgcn_readfirstlane((int)threadIdx.x >> 6);
    int G = gridDim.x, bx = blockIdx.x; OPQ_S(G); OPQ_S(bx);
    F.G = G; F.vcu = (G % 8 == 0) ? (bx % 8) * (G / 8) + bx / 8 : bx;
    F.ctl = (gu32*)(ws + WS_CTL);
    return F;
}
__global__ void __launch_bounds__(NWAVES * 64, 2) mk_fwd(Args args) {
    extern __shared__ __attribute__((aligned(16))) unsigned char lds[];
    for (int u = threadIdx.x; u < (LDS_BYTES - LDSCTL_OFF) / 4; u += NWAVES * 64) ((LAS unsigned*)((LAS unsigned char*)lds + LDSCTL_OFF))[u] = 0u;
    __syncthreads();
    const int lo = args.ph_lo, hi = args.ph_hi;
    if (hi - lo > 1) { unsigned char* ws = args.ws; (void)xcd_barrier_post((unsigned*)((gu32*)(ws + WS_CTL) + CW_BAR) + args.li * XCD_BAR_WORDS, (volatile LAS unsigned*)((LAS unsigned char*)lds + MISC_OFF) + 8); }
#ifdef MK_DIAG
    if (blockIdx.x == 0 && threadIdx.x == 0) ((unsigned long long*)(args.ws + WS_CTL + 524288))[31] = __builtin_amdgcn_s_memrealtime();
#endif
    int pc = 0;
#define PHASE_BEGIN if (pc >= lo && pc < hi) { size_t z_ = 0; OPQ_S(z_); unsigned char* ws = args.ws + z_; float* out = args.out + z_; Frame F = make_frame(ws); bf16_t* XN = (bf16_t*)(ws + WS_XN); (void)XN; (void)out;
#ifdef MK_DIAG
#define DIAG_STAMP(k) do { if (blockIdx.x == 0 && threadIdx.x == 0) ((unsigned long long*)(ws + WS_CTL + 524288))[(k)] = __builtin_amdgcn_s_memrealtime(); } while (0)
#else
#define DIAG_STAMP(k) do { } while (0)
#endif
#define PHASE_END if (pc + 1 < hi) { XcdBarrier bar; bar.bar = (unsigned*)(F.ctl + CW_BAR) + args.li * XCD_BAR_WORDS; bar.x = xb_xcc_id(); bar.st = F.MISC + 8; xcd_barrier(bar); } DIAG_STAMP(pc); } ++pc;

    PHASE_BEGIN p0_prologue(F, args); PHASE_END
    PHASE_BEGIN
        pg8::Gemm g{XN, (const bf16_t*)(ws + WS_W_IN0), M, N_IN0, DM}; pg8::StaticOrder S; S.init(M, N_IN0, F.G, (int)blockIdx.x);
        pg8::EpiBf16G E{(bf16_t*)(ws + WS_P), N_IN0, 4, (const float*)(ws + WS_RSQ)};
        pg8::gemm_phase<pg8::EpiBf16G, pg8::StaticOrder, PG8_ALIGN, PG8_SP2>(F.lds + RING_OFF, g, S, E);
        convert_in_tail(F, args, ws, (M / 256) * (N_IN0 / 256), CB_P0_END, CB_1_END);
    PHASE_END
    PHASE_BEGIN mixer_phase(F, args, ws); PHASE_END
    PHASE_BEGIN
        pg8::Gemm g{(const bf16_t*)(ws + WS_Y), (const bf16_t*)(ws + WS_W_OUT0), M, DM, DM}; pg8::StaticOrder S; S.init(M, DM, F.G, (int)blockIdx.x);
        pg8::EpiRes E{XN, (float*)(ws + WS_RSQ)};
        pg8::gemm_phase<pg8::EpiRes, pg8::StaticOrder, PG8_ALIGN, PG8_SP2>(F.lds + RING_OFF, g, S, E);
    PHASE_END
#define RMS_PHASE(gain_ptr) PHASE_BEGIN { const float* gain = (gain_ptr); const int lane = lane_id(); const int gw = F.vcu * NWAVES + F.wave, NGW = F.G * NWAVES; \
        for (int m = gw; m < M; m += NGW) rms_row_to_bf16(out + (size_t)m * DM, gain, XN + (size_t)m * DM, lane); } PHASE_END
#define UP_PHASE(layer, abuf) PHASE_BEGIN { pg8::Gemm g{(const bf16_t*)(ws + (abuf)), (const bf16_t*)(ws + WS_W_UP) + (size_t)(layer) * NUP * DM, M, NUP, DM}; pg8::StaticOrder S; S.init(M, NUP, F.G, (int)blockIdx.x); \
        pg8::EpiUpConv E{(bf16_t*)(ws + WS_HMID), args.in[20] + (size_t)(layer) * 3 * DFF, args.in[21] + (size_t)(layer) * DFF, (float*)(ws + WS_HALO), (float*)(ws + WS_TOPS), (float*)(ws + WS_TOPG), (const float*)(ws + WS_RSQ)}; \
        pg8::gemm_phase<pg8::EpiUpConv, pg8::StaticOrder, true, PG8_SP2>(F.lds + RING_OFF, g, S, E); \
        if ((layer) == 0) convert_in_tail(F, args, ws, (M / 256) * (NUP / 256), CB_1_END, CB_2_END); } PHASE_END
#define DOWN_PHASE(layer) PHASE_BEGIN { pg8::Gemm g{(const bf16_t*)(ws + WS_HMID), (const bf16_t*)(ws + WS_W_DN) + (size_t)(layer) * DM * DFF, M, DM, DFF}; pg8::StaticOrder S; S.init(M, DM, F.G, (int)blockIdx.x); \
        { const int tid = tid_id(); pg8::Unit fu; for (int i = 0; S.next(i, fu); ++i) if ((fu.pm & 15) != 0) ffn_fix_panel(args, ws, (layer), fu.pm, tid); \
          asm volatile("s_waitcnt vmcnt(0)" ::: "memory"); __syncthreads(); }     \
        pg8::EpiRes E{XN, (float*)(ws + WS_RSQ)}; \
        pg8::gemm_phase<pg8::EpiRes, pg8::StaticOrder, PG8_ALIGN, PG8_SP2>(F.lds + RING_OFF, g, S, E); } PHASE_END
    UP_PHASE(0, WS_XN)
    DOWN_PHASE(0)
    PHASE_BEGIN
        pg8::Gemm g{XN, (const bf16_t*)(ws + WS_W_QKV), M, N_QKV, DM}; pg8::StaticOrder S; S.init(M, N_QKV, F.G, (int)blockIdx.x);
        pg8::EpiQKV E{(bf16_t*)(ws + WS_QKV), (const int*)args.in[1], (const float*)(ws + WS_RSQ)};
        pg8::gemm_phase<pg8::EpiQKV, pg8::StaticOrder, PG8_ALIGN, PG8_SP2>(F.lds + RING_OFF, g, S, E);
    PHASE_END
    PHASE_BEGIN
        { const SchedC SC{F.vcu, F.G, (attn_body::bf16*)(ws + WS_QKV), (attn_body::bf16*)(ws + WS_OCA)};
          attn_body::attn_phase_dv<SchedC, 8>((char*)lds + RING_OFF, SC); }
        { const SchedD SD{F.vcu, F.G, (attn_body::bf16*)(ws + WS_QKV), (float*)(ws + WS_LSE)};
          attn_body::attn_phase<SchedD, 8, true>((char*)lds + RING_OFF, SD); }
    PHASE_END
    PHASE_BEGIN post_attention_phase(F, args, ws); PHASE_END
    PHASE_BEGIN
        pg8::Gemm g{(const bf16_t*)(ws + WS_QKV) + Y1_COL, (const bf16_t*)(ws + WS_W_OUT1), M, DM, DM, N_QKV}; pg8::StaticOrder S; S.init(M, DM, F.G, (int)blockIdx.x);
        pg8::EpiRes E{XN, (float*)(ws + WS_RSQ)};
        pg8::gemm_phase<pg8::EpiRes, pg8::StaticOrder, PG8_ALIGN, PG8_SP2>(F.lds + RING_OFF, g, S, E);
    PHASE_END
    UP_PHASE(1, WS_XN)
    DOWN_PHASE(1)
    PHASE_BEGIN
        const int lane = lane_id(); const int gw = F.vcu * NWAVES + F.wave, NGW = F.G * NWAVES;
        for (int m = gw; m < M; m += NGW) rms_row_final(XN + (size_t)m * DM, out + (size_t)m * DM, args.in[4], (const float*)(ws + WS_RSQ) + (size_t)m * 4, lane);
    PHASE_END
#ifdef MK_DIAG
    __syncthreads();
    if (blockIdx.x == 0 && threadIdx.x < 64) {
        asm volatile("s_waitcnt vmcnt(0)" ::: "memory");
        const unsigned long long* st = (const unsigned long long*)(args.ws + WS_CTL + 524288);
        const unsigned long long a1 = __hip_atomic_load(st + MK_DIAG_SEL1, __ATOMIC_RELAXED, __HIP_MEMORY_SCOPE_AGENT), b1 = __hip_atomic_load(st + (MK_DIAG_SEL1 == 0 ? 31 : MK_DIAG_SEL1 - 1), __ATOMIC_RELAXED, __HIP_MEMORY_SCOPE_AGENT);
        const unsigned long long a2 = __hip_atomic_load(st + MK_DIAG_SEL2, __ATOMIC_RELAXED, __HIP_MEMORY_SCOPE_AGENT), b2 = __hip_atomic_load(st + (MK_DIAG_SEL2 == 0 ? 31 : MK_DIAG_SEL2 - 1), __ATOMIC_RELAXED, __HIP_MEMORY_SCOPE_AGENT);
        const float d1 = (float)(long long)(a1 - b1) * 0.01f, d2 = (float)(long long)(a2 - b2) * 0.01f;
        for (int i = threadIdx.x; i <= 4096; i += 64) args.out[i] = (i == 0) ? d1 : d2;
    }
#endif
#undef PHASE_BEGIN
#undef PHASE_END
}
constexpr int N_PHASES = 13;

#ifndef MK_N_LAUNCHES
#define MK_N_LAUNCHES 1
#endif
extern "C" void kernel_launch(void* const* d_in, const int* in_sizes, int n_in, void* d_out, int out_size, void* d_ws, size_t ws_size, hipStream_t stream) {
    static int grid = 0;
    if (grid == 0) {
        int dev = 0, cus = 0;
        if (hipGetDevice(&dev) != hipSuccess || hipDeviceGetAttribute(&cus, hipDeviceAttributeMultiprocessorCount, dev) != hipSuccess) { fprintf(stderr, "kernel_launch: device query failed\n"); grid = -1; return; }
        if (hipFuncSetAttribute((const void*)mk_fwd, hipFuncAttributeMaxDynamicSharedMemorySize, LDS_BYTES) != hipSuccess) { fprintf(stderr, "kernel_launch: hipFuncSetAttribute failed\n"); grid = -1; return; }
        int per_cu = 0;
        if (hipOccupancyMaxActiveBlocksPerMultiprocessor(&per_cu, (const void*)mk_fwd, NWAVES * 64, LDS_BYTES) != hipSuccess || per_cu < 1) fprintf(stderr, "kernel_launch: occupancy query reports %d workgroups per CU\n", per_cu);
        (void)hipGetLastError();
        grid = cus > 0 ? cus : 256;
    }
    if (grid < 0) return;
    unsigned char* ws = (unsigned char*)d_ws;
    (void)hipMemsetAsync(ws + WS_CTL, 0, CTL_ZERO_BYTES, stream);
    Args a{};
    for (int i = 0; i < 23; ++i) a.in[i] = (const float*)d_in[i];
    a.out = (float*)d_out; a.ws = ws;
#ifdef MK_DUP_PHASE
    if (true) {
        a.li = 0; a.ph_lo = 0; a.ph_hi = MK_DUP_PHASE + 1; hipLaunchKernelGGL(mk_fwd, dim3(grid), dim3(NWAVES * 64), LDS_BYTES, stream, a);
        a.li = 1; a.ph_lo = MK_DUP_PHASE; a.ph_hi = MK_DUP_PHASE + 1; hipLaunchKernelGGL(mk_fwd, dim3(grid), dim3(NWAVES * 64), LDS_BYTES, stream, a);
        a.li = 2; a.ph_lo = MK_DUP_PHASE + 1; a.ph_hi = N_PHASES; hipLaunchKernelGGL(mk_fwd, dim3(grid), dim3(NWAVES * 64), LDS_BYTES, stream, a);
    } else
#endif
    if (MK_N_LAUNCHES == 1) {
        a.ph_lo = 0; a.ph_hi = N_PHASES;
        hipLaunchKernelGGL(mk_fwd, dim3(grid), dim3(NWAVES * 64), LDS_BYTES, stream, a);
    } else {
        for (int p = 0; p < N_PHASES; ++p) { a.ph_lo = p; a.ph_hi = p + 1; hipLaunchKernelGGL(mk_fwd, dim3(grid), dim3(NWAVES * 64), LDS_BYTES, stream, a); }
    }
}
```
